# Optimizing an MI355X kernel written in HIP

```python
import math
import jax, jax.numpy as jnp
from jax import lax
import numpy as np

D_MODEL = 1024
BATCH = 4
SEQ = 8192
DEPTH = 1

EPS = 1e-6
ROPE_THETA = 10000.0
NEG = -1e30
M_HEADS = 4
M_DQK = 64
M_DV = 128
M_CHUNK = 64
M_CONV = 4
M_QK = M_HEADS * M_DQK
M_V = M_HEADS * M_DV
N_HEADS = 8
N_KV = 2
N_HG = N_HEADS // N_KV
N_DH = 64
N_Q = N_HEADS * N_DH
N_KVW = N_KV * N_DH
CMP_LEN = 32
CMP_STRIDE = 16
CMP_HIDDEN = 256
SEL_BLOCK = 64
SEL_TOPN = 16
WINDOW = 512
Q_BLOCK = 128
FORCE_BONUS = 1e4
D_FF = 2816
FFN_CONV = 3
IN_SIZES = (M_QK, M_QK, M_V, M_V, M_HEADS, M_HEADS,
            N_Q, N_KVW, N_KVW, N_KVW, N_KVW, N_KVW, N_KVW, 3 * N_HEADS,
            D_MODEL, D_MODEL)
D_IN = sum(IN_SIZES)

kernel_name = "hybrid_mlstm_nsa_convffn"


def rmsnorm(x, w):
    xf = x.astype(jnp.float32)
    y = xf * lax.rsqrt(jnp.mean(xf * xf, axis=-1, keepdims=True) + EPS)
    return (y * w.astype(jnp.float32)).astype(x.dtype)


def causal_dwconv(x, w, b):
    K = w.shape[0]
    S = x.shape[1]
    xp = jnp.pad(x, ((0, 0), (K - 1, 0), (0, 0)))
    y = xp[:, 0:S] * w[0]
    for k in range(1, K):
        y = y + xp[:, k:k + S] * w[k]
    return y + b


def rope_tables(S):
    pos = jnp.arange(S, dtype=jnp.float32)
    inv = ROPE_THETA ** (-jnp.arange(0, N_DH, 2, dtype=jnp.float32) / N_DH)
    ang = pos[:, None] * inv[None, :]
    return jnp.cos(ang), jnp.sin(ang)


def apply_rope(x, cos, sin):
    x1, x2 = jnp.split(x.astype(jnp.float32), 2, axis=-1)
    c = cos[None, :, None, :]
    s = sin[None, :, None, :]
    return jnp.concatenate([x1 * c - x2 * s, x2 * c + x1 * s], axis=-1).astype(x.dtype)


def mlstm_chunkwise(q, k, v, i_pre, logf):
    B, NH, S, DQK = q.shape
    DV = v.shape[-1]
    L = M_CHUNK
    NC = S // L
    q = q.reshape(B, NH, NC, L, DQK) * (DQK ** -0.5)
    k = k.reshape(B, NH, NC, L, DQK)
    v = v.reshape(B, NH, NC, L, DV)
    i_pre = i_pre.reshape(B, NH, NC, L)
    logf = logf.reshape(B, NH, NC, L)
    b = jnp.cumsum(logf, axis=-1)
    g = b[..., -1]
    a = g[..., None] - b + i_pre
    a_max = jnp.max(a, axis=-1)
    w = jnp.exp(a - a_max[..., None])
    dC = jnp.einsum('bhcl,bhcld,bhcle->bhcde', w, k, v)
    dn = jnp.einsum('bhcl,bhcld->bhcd', w, k)

    def step(carry, inp):
        C, n, m = carry
        dC_c, dn_c, g_c, am_c = inp
        m_new = jnp.maximum(g_c + m, am_c)
        decay = jnp.exp(g_c + m - m_new)
        scl = jnp.exp(am_c - m_new)
        C_new = decay[..., None, None] * C + scl[..., None, None] * dC_c
        n_new = decay[..., None] * n + scl[..., None] * dn_c
        return (C_new, n_new, m_new), (C, n, m)

    init = (jnp.zeros((B, NH, DQK, DV), jnp.float32),
            jnp.zeros((B, NH, DQK), jnp.float32),
            jnp.zeros((B, NH), jnp.float32))
    xs = (jnp.moveaxis(dC, 2, 0), jnp.moveaxis(dn, 2, 0),
          jnp.moveaxis(g, 2, 0), jnp.moveaxis(a_max, 2, 0))
    _, (C_prev, n_prev, m_prev) = lax.scan(step, init, xs)
    C_prev = jnp.moveaxis(C_prev, 0, 2)
    n_prev = jnp.moveaxis(n_prev, 0, 2)
    m_prev = jnp.moveaxis(m_prev, 0, 2)

    causal = jnp.tril(jnp.ones((L, L), dtype=bool))
    D = b[..., :, None] - b[..., None, :] + i_pre[..., None, :]
    D = jnp.where(causal, D, NEG)
    inter = b + m_prev[..., None]
    m_t = jnp.maximum(inter, jnp.max(D, axis=-1))
    Dw = jnp.exp(D - m_t[..., None])
    s = jnp.einsum('bhctd,bhcsd->bhcts', q, k) * Dw
    isc = jnp.exp(inter - m_t)
    num = isc[..., None] * jnp.einsum('bhctd,bhcde->bhcte', q, C_prev) \
        + jnp.einsum('bhcts,bhcse->bhcte', s, v)
    den = isc * jnp.einsum('bhctd,bhcd->bhct', q, n_prev) + jnp.sum(s, axis=-1)
    h = num / jnp.maximum(jnp.abs(den), jnp.exp(-m_t))[..., None]
    return h.reshape(B, NH, S, DV)


def compress_blocks(kv, pe, w1, w2):
    B, G, S, dh = kv.shape
    ncmp = (S - CMP_LEN) // CMP_STRIDE + 1
    idx = (jnp.arange(ncmp) * CMP_STRIDE)[:, None] + jnp.arange(CMP_LEN)[None, :]
    blk = kv[:, :, idx] + pe
    flat = blk.reshape(B, G, ncmp, CMP_LEN * dh)
    return jax.nn.gelu(flat @ w1, approximate=False) @ w2


def masked_softmax(s, mask):
    s = jnp.where(mask, s.astype(jnp.float32), NEG)
    p = jax.nn.softmax(s, axis=-1)
    return jnp.where(mask, p, 0.0)


def nsa_branches(q, kc, vc, ks, vs, kw, vw):
    B, G, HG, S, dh = q.shape
    nqb = S // Q_BLOCK
    nsel = S // SEL_BLOCK
    topn = min(SEL_TOPN, nsel)
    ncmp = kc.shape[2]
    scale = dh ** -0.5
    cstart = jnp.arange(ncmp) * CMP_STRIDE
    cend = cstart + CMP_LEN - 1
    sstart = jnp.arange(nsel) * SEL_BLOCK
    send = sstart + SEL_BLOCK - 1
    overlap = ((cstart[:, None] <= send[None, :]) & (cend[:, None] >= sstart[None, :])).astype(jnp.float32)
    ksb = ks.reshape(B, G, nsel, SEL_BLOCK, dh)
    vsb = vs.reshape(B, G, nsel, SEL_BLOCK, dh)
    kwp = jnp.pad(kw, ((0, 0), (0, 0), (WINDOW, 0), (0, 0)))
    vwp = jnp.pad(vw, ((0, 0), (0, 0), (WINDOW, 0), (0, 0)))
    qblocks = jnp.moveaxis(q.reshape(B, G, HG, nqb, Q_BLOCK, dh), 3, 0)
    gather = jax.vmap(jax.vmap(lambda blocks, ix: blocks[ix]))
    jsel = jnp.arange(nsel)
    win_off = jnp.arange(Q_BLOCK + WINDOW)
    sb_off = jnp.arange(SEL_BLOCK)

    def one_block(args):
        qi, qb = args
        s0 = qi * Q_BLOCK
        tpos = s0 + jnp.arange(Q_BLOCK)
        cmask = cend[None, :] <= tpos[:, None]
        pc = masked_softmax(jnp.einsum('bghqd,bgnd->bghqn', qb, kc) * scale, cmask)
        o_cmp = jnp.einsum('bghqn,bgnd->bghqd', pc.astype(vc.dtype), vc)
        imp = jnp.einsum('bghqn,nj->bgqj', pc, overlap)
        cur = tpos // SEL_BLOCK
        forced = (jsel[None, :] == 0) | (jsel[None, :] == cur[:, None]) | (jsel[None, :] == cur[:, None] - 1)
        imp = jnp.where(forced, FORCE_BONUS, imp)
        imp = jnp.where(jsel[None, :] > cur[:, None], NEG, imp)
        _, idx = lax.top_k(imp, topn)
        ksel = gather(ksb, idx).reshape(B, G, Q_BLOCK, topn * SEL_BLOCK, dh)
        vsel = gather(vsb, idx).reshape(B, G, Q_BLOCK, topn * SEL_BLOCK, dh)
        spos = (idx[..., None] * SEL_BLOCK + sb_off).reshape(B, G, Q_BLOCK, topn * SEL_BLOCK)
        smask = (spos <= tpos[None, None, :, None])[:, :, None]
        ps = masked_softmax(jnp.einsum('bghqd,bgqmd->bghqm', qb, ksel) * scale, smask)
        o_slc = jnp.einsum('bghqm,bgqmd->bghqd', ps.astype(vsel.dtype), vsel)
        kwin = lax.dynamic_slice_in_dim(kwp, s0, Q_BLOCK + WINDOW, axis=2)
        vwin = lax.dynamic_slice_in_dim(vwp, s0, Q_BLOCK + WINDOW, axis=2)
        kpos = s0 - WINDOW + win_off
        wmask = (kpos[None, :] <= tpos[:, None]) & (kpos[None, :] > tpos[:, None] - WINDOW) & (kpos[None, :] >= 0)
        pw = masked_softmax(jnp.einsum('bghqd,bgkd->bghqk', qb, kwin) * scale, wmask)
        o_win = jnp.einsum('bghqk,bgkd->bghqd', pw.astype(vwin.dtype), vwin)
        return o_cmp, o_slc, o_win

    o_cmp, o_slc, o_win = lax.map(one_block, (jnp.arange(nqb), qblocks))
    unblock = lambda o: jnp.moveaxis(o, 0, 3).reshape(B, G, HG, S, dh)
    return unblock(o_cmp), unblock(o_slc), unblock(o_win)


def hybrid_layer(x, cos, sin, norm1_w, w_in, m_conv_w, m_conv_b, m_igate_b, m_fgate_b, m_out_norm_w,
                 q_norm_w, kcmp_norm_w, kslc_norm_w, kwin_norm_w,
                 cmp_k_pe, cmp_k_w1, cmp_k_w2, cmp_v_pe, cmp_v_w1, cmp_v_w2,
                 w_up_m, w_up_n, merge_gate_b, w_out,
                 norm2_w, ffn_w_up, ffn_conv_w, ffn_conv_b, ffn_w_down):
    B, S, _ = x.shape
    h = rmsnorm(x, norm1_w)
    proj = h @ w_in
    split_pts = np.cumsum(IN_SIZES)[:-1].tolist()
    (mq, mk, mv, mo, mi, mf, nq, kc, vc, ks, vs, kw, vw, ng, gm, gn) = jnp.split(proj, split_pts, axis=-1)

    qk = jax.nn.silu(causal_dwconv(jnp.concatenate([mq, mk], axis=-1), m_conv_w, m_conv_b))
    mq, mk = jnp.split(qk, 2, axis=-1)
    to_mheads = lambda t, d: t.reshape(B, S, M_HEADS, d).transpose(0, 2, 1, 3).astype(jnp.float32)
    i_pre = (mi + m_igate_b).astype(jnp.float32).transpose(0, 2, 1)
    logf = jax.nn.log_sigmoid((mf + m_fgate_b).astype(jnp.float32)).transpose(0, 2, 1)
    hm = mlstm_chunkwise(to_mheads(mq, M_DQK), to_mheads(mk, M_DQK), to_mheads(mv, M_DV), i_pre, logf)
    hm = rmsnorm(hm.transpose(0, 2, 1, 3), m_out_norm_w)
    hm = hm.reshape(B, S, M_V).astype(x.dtype) * jax.nn.sigmoid(mo)

    qn = apply_rope(rmsnorm(nq.reshape(B, S, N_HEADS, N_DH), q_norm_w), cos, sin)
    kv_heads = lambda t: t.reshape(B, S, N_KV, N_DH)
    to_groups = lambda t: t.transpose(0, 2, 1, 3)
    kc_t = to_groups(apply_rope(rmsnorm(kv_heads(kc), kcmp_norm_w), cos, sin))
    ks_t = to_groups(apply_rope(rmsnorm(kv_heads(ks), kslc_norm_w), cos, sin))
    kw_t = to_groups(apply_rope(rmsnorm(kv_heads(kw), kwin_norm_w), cos, sin))
    vc_t = to_groups(kv_heads(vc))
    vs_t = to_groups(kv_heads(vs))
    vw_t = to_groups(kv_heads(vw))
    qg = qn.reshape(B, S, N_KV, N_HG, N_DH).transpose(0, 2, 3, 1, 4)
    kcmp = compress_blocks(kc_t, cmp_k_pe, cmp_k_w1, cmp_k_w2)
    vcmp = compress_blocks(vc_t, cmp_v_pe, cmp_v_w1, cmp_v_w2)
    o_cmp, o_slc, o_win = nsa_branches(qg, kcmp, vcmp, ks_t, vs_t, kw_t, vw_t)
    gates = jax.nn.sigmoid(ng.reshape(B, S, N_KV, N_HG, 3).transpose(0, 2, 3, 1, 4))
    on = gates[..., 0:1] * o_cmp + gates[..., 1:2] * o_slc + gates[..., 2:3] * o_win
    on = on.transpose(0, 3, 1, 2, 4).reshape(B, S, N_Q)

    y = jax.nn.sigmoid(gm + merge_gate_b[0]) * (hm @ w_up_m) \
        + jax.nn.sigmoid(gn + merge_gate_b[1]) * (on @ w_up_n)
    x = x + y @ w_out

    h2 = rmsnorm(x, norm2_w)
    a, v = jnp.split(h2 @ ffn_w_up, 2, axis=-1)
    a = jax.nn.gelu(causal_dwconv(a, ffn_conv_w, ffn_conv_b), approximate=False)
    return x + (a * v) @ ffn_w_down


def setup_inputs(seed: int = 0) -> dict:
    key = jax.random.key(seed)
    ks = jax.random.split(key, 32)
    f32 = jnp.float32
    nrm = lambda k, shape, s: jax.random.normal(k, shape, f32) * s
    gain = lambda k, shape: 1.0 + 0.02 * jax.random.normal(k, shape, f32)
    Ld = DEPTH
    return {
        "x": nrm(ks[0], (BATCH, SEQ, D_MODEL), 1.0),
        "norm1_w": gain(ks[1], (Ld, D_MODEL)),
        "w_in": nrm(ks[2], (Ld, D_MODEL, D_IN), D_MODEL ** -0.5),
        "m_conv_w": nrm(ks[3], (Ld, M_CONV, 2 * M_QK), M_CONV ** -0.5),
        "m_conv_b": nrm(ks[4], (Ld, 2 * M_QK), 0.01),
        "m_igate_b": nrm(ks[5], (Ld, M_HEADS), 0.1),
        "m_fgate_b": jnp.linspace(3.0, 6.0, M_HEADS, dtype=f32)[None, :] + nrm(ks[6], (Ld, M_HEADS), 0.01),
        "m_out_norm_w": gain(ks[7], (Ld, M_HEADS, M_DV)),
        "q_norm_w": gain(ks[8], (Ld, N_DH)),
        "kcmp_norm_w": gain(ks[9], (Ld, N_DH)),
        "kslc_norm_w": gain(ks[10], (Ld, N_DH)),
        "kwin_norm_w": gain(ks[11], (Ld, N_DH)),
        "cmp_k_pe": nrm(ks[12], (Ld, CMP_LEN, N_DH), 0.02),
        "cmp_k_w1": nrm(ks[13], (Ld, CMP_LEN * N_DH, CMP_HIDDEN), (CMP_LEN * N_DH) ** -0.5),
        "cmp_k_w2": nrm(ks[14], (Ld, CMP_HIDDEN, N_DH), CMP_HIDDEN ** -0.5),
        "cmp_v_pe": nrm(ks[15], (Ld, CMP_LEN, N_DH), 0.02),
        "cmp_v_w1": nrm(ks[16], (Ld, CMP_LEN * N_DH, CMP_HIDDEN), (CMP_LEN * N_DH) ** -0.5),
        "cmp_v_w2": nrm(ks[17], (Ld, CMP_HIDDEN, N_DH), CMP_HIDDEN ** -0.5),
        "w_up_m": nrm(ks[18], (Ld, M_V, D_MODEL), M_V ** -0.5),
        "w_up_n": nrm(ks[19], (Ld, N_Q, D_MODEL), N_Q ** -0.5),
        "merge_gate_b": nrm(ks[20], (Ld, 2, D_MODEL), 0.01),
        "w_out": nrm(ks[21], (Ld, D_MODEL, D_MODEL), D_MODEL ** -0.5),
        "norm2_w": gain(ks[22], (Ld, D_MODEL)),
        "ffn_w_up": nrm(ks[23], (Ld, D_MODEL, 2 * D_FF), D_MODEL ** -0.5),
        "ffn_conv_w": nrm(ks[24], (Ld, FFN_CONV, D_FF), FFN_CONV ** -0.5),
        "ffn_conv_b": nrm(ks[25], (Ld, D_FF), 0.01),
        "ffn_w_down": nrm(ks[26], (Ld, D_FF, D_MODEL), D_FF ** -0.5),
    }


def reference(x, norm1_w, w_in, m_conv_w, m_conv_b, m_igate_b, m_fgate_b, m_out_norm_w,
              q_norm_w, kcmp_norm_w, kslc_norm_w, kwin_norm_w,
              cmp_k_pe, cmp_k_w1, cmp_k_w2, cmp_v_pe, cmp_v_w1, cmp_v_w2,
              w_up_m, w_up_n, merge_gate_b, w_out,
              norm2_w, ffn_w_up, ffn_conv_w, ffn_conv_b, ffn_w_down):
    cos, sin = rope_tables(x.shape[1])
    layer_params = (norm1_w, w_in, m_conv_w, m_conv_b, m_igate_b, m_fgate_b, m_out_norm_w,
                    q_norm_w, kcmp_norm_w, kslc_norm_w, kwin_norm_w,
                    cmp_k_pe, cmp_k_w1, cmp_k_w2, cmp_v_pe, cmp_v_w1, cmp_v_w2,
                    w_up_m, w_up_n, merge_gate_b, w_out,
                    norm2_w, ffn_w_up, ffn_conv_w, ffn_conv_b, ffn_w_down)
    for layer in range(DEPTH):
        x = hybrid_layer(x, cos, sin, *[p[layer] for p in layer_params])
    return x
```

```cpp
#include <hip/hip_runtime.h>
#define HD __host__ __device__
#include <math.h>
#ifndef HD
#define HD
#endif
namespace nv {
constexpr int DM = 1024, DIN = 4896, MQK = 256, MV = 512, MH = 4, DQK = 64, DV = 128;
constexpr int NH = 8, NKV = 2, NHG = 4, DH = 64, NQ = 512, NKVW = 128;
constexpr int CMPL = 32, CMPS = 16, CMPH = 256, SELB = 64, TOPN = 16, WIN = 512, DFF = 2816;
constexpr int C_MQ = 0, C_MK = 256, C_MV = 512, C_MO = 1024, C_MI = 1536, C_MF = 1540, C_NQ = 1544, C_KC = 2056, C_VC = 2184, C_KS = 2312, C_VS = 2440,
              C_KW = 2568, C_VW = 2696, C_NG = 2824, C_GM = 2848, C_GN = 3872;
static_assert(C_GN + 1024 == DIN, "cols");
constexpr float EPS = 1e-6f, NEGV = -1e30f, FORCE = 1e4f;

HD inline float sigmoidf_(float x) { return 1.0f / (1.0f + expf(-x)); }
HD inline float gelu_(float x) { return 0.5f * x * (1.0f + erff(x * 0.70710678118654752f)); }
HD inline float logsig_(float x) { return x >= 0.f ? -log1pf(expf(-x)) : x - log1pf(expf(x)); }

HD inline void n_rms(int t, const float* x, const float* w, float* h) {
    const float* r = x + (size_t)t * DM; float s = 0.f;
    for (int i = 0; i < DM; ++i) s += r[i] * r[i];
    const float rs = 1.0f / sqrtf(s / DM + EPS);
    for (int i = 0; i < DM; ++i) h[(size_t)t * DM + i] = r[i] * rs * w[i];
}
HD inline void n_rope_tab(int i, float* cs, float* sn) {
    const int t = i >> 5, j = i & 31;
    const double inv = pow(10000.0, -(double)j / 32.0); const double ang = (double)t * inv;
    cs[i] = (float)cos(ang); sn[i] = (float)sin(ang);
}
HD inline void n_conv_silu(int i, const float* proj, const float* cw, const float* cb, float* qk) {
    const int t = i >> 9, c = i & 511; float a = cb[c];
    for (int k = 0; k < 4; ++k) { const int tt = t - 3 + k; if (tt >= 0) a += cw[k * 512 + c] * proj[(size_t)tt * DIN + C_MQ + c]; }
    qk[i] = a * sigmoidf_(a);
}
HD inline void n_gates(int i, const float* proj, const float* igb, const float* fgb, float* ipre, float* logf) {
    const int t = i >> 2, h = i & 3;
    ipre[i] = proj[(size_t)t * DIN + C_MI + h] + igb[h];
    logf[i] = logsig_(proj[(size_t)t * DIN + C_MF + h] + fgb[h]);
}
HD inline void n_mlstm(int i, int Sn, const float* qk, const float* proj, const float* ipre, const float* logf, float* hraw) {
    const int h = i >> 7, e = i & 127;
    float C[64], n[64];
#pragma unroll
    for (int d = 0; d < 64; ++d) { C[d] = 0.f; n[d] = 0.f; }
    float m = 0.f;
    for (int t = 0; t < Sn; ++t) {
        const float lf = logf[t * 4 + h], ip = ipre[t * 4 + h];
        const float mn = fmaxf(lf + m, ip); const float dec = expf(lf + m - mn), sc = expf(ip - mn); m = mn;
        const float v = proj[(size_t)t * DIN + C_MV + h * 128 + e];
        const float* q = qk + (size_t)t * 512 + h * 64; const float* k = qk + (size_t)t * 512 + 256 + h * 64;
        float num = 0.f, den = 0.f;
#pragma unroll
        for (int d = 0; d < 64; ++d) { const float kd = k[d]; C[d] = dec * C[d] + sc * kd * v; n[d] = dec * n[d] + sc * kd; const float qd = q[d] * 0.125f; num += qd * C[d]; den += qd * n[d]; }
        hraw[(size_t)t * 512 + h * 128 + e] = num / fmaxf(fabsf(den), expf(-m));
    }
}
HD inline void n_hm(int i, const float* hraw, const float* onw, const float* proj, float* hm) {
    const int t = i >> 2, h = i & 3; const float* r = hraw + (size_t)t * 512 + h * 128; float s = 0.f;
    for (int e = 0; e < 128; ++e) s += r[e] * r[e];
    const float rs = 1.0f / sqrtf(s / 128.f + EPS);
    for (int e = 0; e < 128; ++e) hm[(size_t)t * 512 + h * 128 + e] = r[e] * rs * onw[h * 128 + e] * sigmoidf_(proj[(size_t)t * DIN + C_MO + h * 128 + e]);
}
HD inline void n_normrope(int i, const float* proj, const float* qw, const float* kcw, const float* ksw, const float* kww, const float* cs, const float* sn,
                          float* qn, float* kct, float* kst, float* kwt) {
    const int t = i / 14, hh = i % 14; const float* src; const float* w; float* dst;
    if (hh < 8) { src = proj + (size_t)t * DIN + C_NQ + hh * 64; w = qw; dst = qn + (size_t)t * 512 + hh * 64; }
    else { const int ty = (hh - 8) >> 1, g = (hh - 8) & 1; const int col = ty == 0 ? C_KC : ty == 1 ? C_KS : C_KW; src = proj + (size_t)t * DIN + col + g * 64;
        w = ty == 0 ? kcw : ty == 1 ? ksw : kww; dst = (ty == 0 ? kct : ty == 1 ? kst : kwt) + (size_t)t * 128 + g * 64; }
    float s = 0.f; for (int d = 0; d < 64; ++d) s += src[d] * src[d];
    const float rs = 1.0f / sqrtf(s / 64.f + EPS);
    for (int j = 0; j < 32; ++j) { const float x1 = src[j] * rs * w[j], x2 = src[j + 32] * rs * w[j + 32]; const float c = cs[t * 32 + j], sv = sn[t * 32 + j];
        dst[j] = x1 * c - x2 * sv; dst[j + 32] = x2 * c + x1 * sv; }
}
HD inline void n_cmp_hidden(int i, int ncmp, const float* kct, const float* proj, const float* kpe, const float* kw1, const float* vpe, const float* vw1, float* hid) {
    const int j = i & 255; int r = i >> 8; const int c = r % ncmp; r /= ncmp; const int g = r & 1, kv = r >> 1;
    const float* pe = kv ? vpe : kpe; const float* w1 = kv ? vw1 : kw1; float a = 0.f;
    for (int l = 0; l < 32; ++l) { const int t = 16 * c + l; const float* src = kv ? proj + (size_t)t * DIN + C_VC + g * 64 : kct + (size_t)t * 128 + g * 64;
        for (int d = 0; d < 64; ++d) a += (src[d] + pe[l * 64 + d]) * w1[(size_t)(l * 64 + d) * 256 + j]; }
    hid[i] = gelu_(a);
}
HD inline void n_cmp_out(int i, const float* hid, const float* kw2, const float* vw2, int ncmp, float* cmp) {
    const int o = i & 63; const int r = i >> 6; const int kv = r / (2 * ncmp); const float* w2 = kv ? vw2 : kw2; float a = 0.f;
    for (int j = 0; j < 256; ++j) a += hid[(size_t)r * 256 + j] * w2[j * 64 + o];
    cmp[i] = a;
}
HD inline void n_cmp_attn(int i, int ncmp, int nsel, const float* qn, const float* cmp  , float* ocmp, float* imp) {
    const int t = i >> 1, g = i & 1; const int nvalid = t >= 31 ? ((t - 31) / 16 + 1 < ncmp ? (t - 31) / 16 + 1 : ncmp) : 0;
    const float* kc = cmp + (size_t)(0 * 2 + g) * ncmp * 64; const float* vc = cmp + (size_t)(1 * 2 + g) * ncmp * 64;
    float* im = imp + (size_t)i * nsel; for (int j = 0; j < nsel; ++j) im[j] = 0.f;
    for (int hg = 0; hg < 4; ++hg) {
        const float* qp = qn + (size_t)t * 512 + (g * 4 + hg) * 64; float q[64], o[64];
#pragma unroll
        for (int d = 0; d < 64; ++d) { q[d] = qp[d] * 0.125f; o[d] = 0.f; }
        if (nvalid > 0) {
            float m = -INFINITY;
            for (int c = 0; c < nvalid; ++c) { float s = 0.f;
#pragma unroll
                for (int d = 0; d < 64; ++d) s += q[d] * kc[c * 64 + d];
                m = fmaxf(m, s); }
            float l = 0.f;
            for (int c = 0; c < nvalid; ++c) { float s = 0.f;
#pragma unroll
                for (int d = 0; d < 64; ++d) s += q[d] * kc[c * 64 + d];
                l += expf(s - m); }
            for (int c = 0; c < nvalid; ++c) { float s = 0.f;
#pragma unroll
                for (int d = 0; d < 64; ++d) s += q[d] * kc[c * 64 + d];
                const float p = expf(s - m) / l;
#pragma unroll
                for (int d = 0; d < 64; ++d) o[d] += p * vc[c * 64 + d];
                im[c >> 2] += p; if ((c & 3) == 3 && (c >> 2) + 1 < nsel) im[(c >> 2) + 1] += p; }
        }
        float* op = ocmp + (size_t)t * 512 + (g * 4 + hg) * 64;
#pragma unroll
        for (int d = 0; d < 64; ++d) op[d] = o[d];
    }
}
HD inline void n_topk(int i, int nsel, float* imp, int* idx) {
    const int t = i >> 1; const int cur = t >> 6; float* im = imp + (size_t)i * nsel; const int topn = nsel < TOPN ? nsel : TOPN;
    for (int j = 0; j < nsel; ++j) { float v = im[j]; if (j == 0 || j == cur || j == cur - 1) v = FORCE; if (j > cur) v = NEGV; im[j] = v; }
    unsigned long long tk0 = 0ull, tk1 = 0ull;
    for (int r = 0; r < topn; ++r) { float best = -INFINITY; int bj = -1;
        for (int j = 0; j < nsel; ++j) { const bool taken = j < 64 ? ((tk0 >> j) & 1ull) : ((tk1 >> (j - 64)) & 1ull); if (!taken && im[j] > best) { best = im[j]; bj = j; } }
        if (bj < 64) tk0 |= 1ull << bj; else tk1 |= 1ull << (bj - 64);
        idx[(size_t)i * TOPN + r] = bj; }
}
HD inline void n_slc(int i, int nsel, const float* qn, const float* kst, const float* proj, const int* idx, float* oslc) {
    const int hg = i & 3, tg = i >> 2, g = tg & 1, t = tg >> 1; const int topn = nsel < TOPN ? nsel : TOPN;
    const float* qp = qn + (size_t)t * 512 + (g * 4 + hg) * 64; float q[64], o[64];
#pragma unroll
    for (int d = 0; d < 64; ++d) { q[d] = qp[d] * 0.125f; o[d] = 0.f; }
    float m = -INFINITY, l = 0.f;
    for (int r = 0; r < topn; ++r) { const int blk = idx[(size_t)tg * TOPN + r];
        for (int off = 0; off < 64; ++off) { const int pos = blk * 64 + off; if (pos > t) break;
            const float* k = kst + (size_t)pos * 128 + g * 64; const float* v = proj + (size_t)pos * DIN + C_VS + g * 64; float s = 0.f;
#pragma unroll
            for (int d = 0; d < 64; ++d) s += q[d] * k[d];
            const float mn = fmaxf(m, s); const float a = expf(m - mn), p = expf(s - mn); m = mn; l = l * a + p;
#pragma unroll
            for (int d = 0; d < 64; ++d) o[d] = o[d] * a + p * v[d]; } }
    float* op = oslc + (size_t)t * 512 + (g * 4 + hg) * 64; const float il = 1.0f / l;
#pragma unroll
    for (int d = 0; d < 64; ++d) op[d] = o[d] * il;
}
HD inline void n_win(int i, const float* qn, const float* kwt, const float* proj, float* owin) {
    const int hg = i & 3, tg = i >> 2, g = tg & 1, t = tg >> 1;
    const float* qp = qn + (size_t)t * 512 + (g * 4 + hg) * 64; float q[64], o[64];
#pragma unroll
    for (int d = 0; d < 64; ++d) { q[d] = qp[d] * 0.125f; o[d] = 0.f; }
    float m = -INFINITY, l = 0.f; const int p0 = t - WIN + 1 > 0 ? t - WIN + 1 : 0;
    for (int pos = p0; pos <= t; ++pos) { const float* k = kwt + (size_t)pos * 128 + g * 64; const float* v = proj + (size_t)pos * DIN + C_VW + g * 64; float s = 0.f;
#pragma unroll
        for (int d = 0; d < 64; ++d) s += q[d] * k[d];
        const float mn = fmaxf(m, s); const float a = expf(m - mn), p = expf(s - mn); m = mn; l = l * a + p;
#pragma unroll
        for (int d = 0; d < 64; ++d) o[d] = o[d] * a + p * v[d]; }
    float* op = owin + (size_t)t * 512 + (g * 4 + hg) * 64; const float il = 1.0f / l;
#pragma unroll
    for (int d = 0; d < 64; ++d) op[d] = o[d] * il;
}
HD inline void n_on(int i, const float* proj, const float* oc, const float* os, const float* ow, float* on) {
    const int t = i >> 9, c = i & 511, head = c >> 6; const float* gp = proj + (size_t)t * DIN + C_NG + head * 3;
    on[i] = sigmoidf_(gp[0]) * oc[i] + sigmoidf_(gp[1]) * os[i] + sigmoidf_(gp[2]) * ow[i];
}
HD inline void n_y(int i, const float* proj, const float* mgb, const float* t1, const float* t2, float* y) {
    const int t = i >> 10, c = i & 1023;
    y[i] = sigmoidf_(proj[(size_t)t * DIN + C_GM + c] + mgb[c]) * t1[i] + sigmoidf_(proj[(size_t)t * DIN + C_GN + c] + mgb[1024 + c]) * t2[i];
}
HD inline void n_add(int i, const float* a, const float* b, float* o) { o[i] = a[i] + b[i]; }
HD inline void n_ffn_mid(int i, const float* u, const float* cw, const float* cb, float* mid) {
    const int t = i / DFF, c = i % DFF; float a = cb[c];
    for (int k = 0; k < 3; ++k) { const int tt = t - 2 + k; if (tt >= 0) a += cw[k * DFF + c] * u[(size_t)tt * (2 * DFF) + c]; }
    mid[i] = gelu_(a) * u[(size_t)t * (2 * DFF) + DFF + c];
}
}
typedef float f32x4 __attribute__((ext_vector_type(4)));
#define RUNK(name, n, ...) { const int _n = (int)(n); name##_k<<<(_n + 255) / 256, 256, 0, stream>>>(_n, __VA_ARGS__); }
#define DEFK(name, params, call) __global__ void __launch_bounds__(256) name##_k params { const int i = blockIdx.x * 256 + threadIdx.x; if (i < n) { call; } }
using namespace nv;
DEFK(rms, (int n, const float* x, const float* w, float* h), n_rms(i, x, w, h))
DEFK(ropetab, (int n, float* cs, float* sn), n_rope_tab(i, cs, sn))
DEFK(convsilu, (int n, const float* proj, const float* cw, const float* cb, float* qk), n_conv_silu(i, proj, cw, cb, qk))
DEFK(gates, (int n, const float* proj, const float* igb, const float* fgb, float* ipre, float* logf), n_gates(i, proj, igb, fgb, ipre, logf))
DEFK(mlstm, (int n, int Sn, const float* qk, const float* proj, const float* ipre, const float* logf, float* hraw), n_mlstm(i, Sn, qk, proj, ipre, logf, hraw))
DEFK(hm, (int n, const float* hraw, const float* onw, const float* proj, float* hmo), n_hm(i, hraw, onw, proj, hmo))
DEFK(normrope, (int n, const float* proj, const float* qw, const float* kcw, const float* ksw, const float* kww, const float* cs, const float* sn, float* qn, float* kct, float* kst, float* kwt),
     n_normrope(i, proj, qw, kcw, ksw, kww, cs, sn, qn, kct, kst, kwt))
DEFK(cmphid, (int n, int ncmp, const float* kct, const float* proj, const float* kpe, const float* kw1, const float* vpe, const float* vw1, float* hid), n_cmp_hidden(i, ncmp, kct, proj, kpe, kw1, vpe, vw1, hid))
DEFK(cmpout, (int n, const float* hid, const float* kw2, const float* vw2, int ncmp, float* cmp), n_cmp_out(i, hid, kw2, vw2, ncmp, cmp))
DEFK(cmpattn, (int n, int ncmp, int nsel, const float* qn, const float* cmp, float* ocmp, float* imp), n_cmp_attn(i, ncmp, nsel, qn, cmp, ocmp, imp))
DEFK(topk, (int n, int nsel, float* imp, int* idx), n_topk(i, nsel, imp, idx))
DEFK(slc, (int n, int nsel, const float* qn, const float* kst, const float* proj, const int* idx, float* oslc), n_slc(i, nsel, qn, kst, proj, idx, oslc))
DEFK(win, (int n, const float* qn, const float* kwt, const float* proj, float* owin), n_win(i, qn, kwt, proj, owin))
DEFK(onk, (int n, const float* proj, const float* oc, const float* os, const float* ow, float* on), n_on(i, proj, oc, os, ow, on))
DEFK(yk, (int n, const float* proj, const float* mgb, const float* t1, const float* t2, float* y), n_y(i, proj, mgb, t1, t2, y))
DEFK(addk, (int n, const float* a, const float* b, float* o), n_add(i, a, b, o))
DEFK(ffnmid, (int n, const float* u, const float* cw, const float* cb, float* mid), n_ffn_mid(i, u, cw, cb, mid))

__global__ void __launch_bounds__(256) gemm_f32_k(const float* __restrict__ A, int lda, const float* __restrict__ B, int ldb, float* __restrict__ C, int ldc, int M, int N, int K) {
    const int lane = threadIdx.x & 63, wave = threadIdx.x >> 6; const int ntn = N / 32; const long tile = (long)blockIdx.x * 4 + wave;
    if (tile >= (long)(M / 64) * ntn) return;
    const int m0 = (int)(tile / ntn) * 64, n0 = (int)(tile % ntn) * 32, row = lane & 15, q = lane >> 4;
    f32x4 acc[4][2];
#pragma unroll
    for (int m = 0; m < 4; ++m)
#pragma unroll
        for (int n = 0; n < 2; ++n) acc[m][n] = (f32x4){0.f, 0.f, 0.f, 0.f};
    for (int k0 = 0; k0 < K; k0 += 16) {
        f32x4 a[4]; float b[4][2];
#pragma unroll
        for (int m = 0; m < 4; ++m) a[m] = *(const f32x4*)(A + (size_t)(m0 + 16 * m + row) * lda + k0 + 4 * q);
#pragma unroll
        for (int j = 0; j < 4; ++j)
#pragma unroll
            for (int n = 0; n < 2; ++n) b[j][n] = B[(size_t)(k0 + 4 * q + j) * ldb + n0 + 16 * n + row];
#pragma unroll
        for (int j = 0; j < 4; ++j)
#pragma unroll
            for (int m = 0; m < 4; ++m)
#pragma unroll
                for (int n = 0; n < 2; ++n) acc[m][n] = __builtin_amdgcn_mfma_f32_16x16x4f32(a[m][j], b[j][n], acc[m][n], 0, 0, 0);
    }
#pragma unroll
    for (int m = 0; m < 4; ++m)
#pragma unroll
        for (int n = 0; n < 2; ++n)
#pragma unroll
            for (int r = 0; r < 4; ++r) C[(size_t)(m0 + 16 * m + 4 * q + r) * ldc + n0 + 16 * n + row] = acc[m][n][r];
}
static void gemm(hipStream_t stream, const float* A, int lda, const float* B, int ldb, float* C, int ldc, int M, int N, int K) {
    const long tiles = (long)(M / 64) * (N / 32); gemm_f32_k<<<(int)((tiles + 3) / 4), 256, 0, stream>>>(A, lda, B, ldb, C, ldc, M, N, K);
}

extern "C" void kernel_launch(void* const* d_in, const int* in_sizes, int n_in, void* d_out, int out_size, void* d_ws, size_t ws_size, hipStream_t stream) {
    const float* in[27]; for (int i = 0; i < 27; ++i) in[i] = (const float*)d_in[i];
    const float *x = in[0], *norm1 = in[1], *w_in = in[2], *mcw = in[3], *mcb = in[4], *igb = in[5], *fgb = in[6], *onw = in[7], *qw = in[8], *kcw = in[9], *ksw = in[10], *kww = in[11],
                *kpe = in[12], *kw1 = in[13], *kw2 = in[14], *vpe = in[15], *vw1 = in[16], *vw2 = in[17], *wum = in[18], *wun = in[19], *mgb = in[20], *wout = in[21], *norm2 = in[22],
                *fup = in[23], *fcw = in[24], *fcb = in[25], *fdn = in[26];
    const int B = 4, S = 8192, Sn = S; const int ncmp = (Sn - 32) / 16 + 1, nsel = Sn / 64;
    char* ws = (char*)d_ws; const size_t MB = 1u << 20;
    float* cs = (float*)(ws + 0 * MB); float* sn = (float*)(ws + 1 * MB); float* ipre = (float*)(ws + 2 * MB); float* logf = (float*)(ws + 3 * MB);
    float* cmpb = (float*)(ws + 4 * MB); float* hid = (float*)(ws + 5 * MB); int* idx = (int*)(ws + 8 * MB);
    float* proj = (float*)(ws + 16 * MB); float* u = proj; float* h = (float*)(ws + 192 * MB);
    float* qk = (float*)(ws + 224 * MB); float* hraw = (float*)(ws + 240 * MB); float* hmb = (float*)(ws + 256 * MB); float* qn = (float*)(ws + 272 * MB);
    float* kct = (float*)(ws + 288 * MB); float* kst = (float*)(ws + 292 * MB); float* kwt = (float*)(ws + 296 * MB); float* imp = (float*)(ws + 300 * MB);
    float* oc = (float*)(ws + 308 * MB); float* os = (float*)(ws + 324 * MB); float* ow = (float*)(ws + 340 * MB); float* on = (float*)(ws + 356 * MB); float* t1 = (float*)(ws + 372 * MB);
    float* mid = oc; float* t2 = (float*)(ws + 404 * MB); float* y = t2; float* t3 = (float*)(ws + 436 * MB);
    RUNK(ropetab, Sn * 32, cs, sn);
    for (int b = 0; b < B; ++b) {
        const float* xb = x + (size_t)b * S * 1024; float* x1 = (float*)d_out + (size_t)b * S * 1024;
        RUNK(rms, Sn, xb, norm1, h);
        gemm(stream, h, 1024, w_in, DIN, proj, DIN, Sn, DIN, 1024);
        RUNK(convsilu, Sn * 512, proj, mcw, mcb, qk);
        RUNK(gates, Sn * 4, proj, igb, fgb, ipre, logf);
        RUNK(mlstm, 512, Sn, qk, proj, ipre, logf, hraw);
        RUNK(hm, Sn * 4, hraw, onw, proj, hmb);
        RUNK(normrope, Sn * 14, proj, qw, kcw, ksw, kww, cs, sn, qn, kct, kst, kwt);
        RUNK(cmphid, 4 * ncmp * 256, ncmp, kct, proj, kpe, kw1, vpe, vw1, hid);
        RUNK(cmpout, 4 * ncmp * 64, hid, kw2, vw2, ncmp, cmpb);
        RUNK(cmpattn, Sn * 2, ncmp, nsel, qn, cmpb, oc, imp);
        RUNK(topk, Sn * 2, nsel, imp, idx);
        RUNK(slc, Sn * 8, nsel, qn, kst, proj, idx, os);
        RUNK(win, Sn * 8, qn, kwt, proj, ow);
        RUNK(onk, Sn * 512, proj, oc, os, ow, on);
        gemm(stream, hmb, 512, wum, 1024, t1, 1024, Sn, 1024, 512);
        gemm(stream, on, 512, wun, 1024, t2, 1024, Sn, 1024, 512);
        RUNK(yk, Sn * 1024, proj, mgb, t1, t2, y);
        gemm(stream, y, 1024, wout, 1024, t3, 1024, Sn, 1024, 1024);
        RUNK(addk, Sn * 1024, xb, t3, x1);
        RUNK(rms, Sn, x1, norm2, h);
        gemm(stream, h, 1024, fup, 5632, u, 5632, Sn, 5632, 1024);
        RUNK(ffnmid, Sn * 2816, u, fcw, fcb, mid);
        gemm(stream, mid, 2816, fdn, 1024, t3, 1024, Sn, 1024, 2816);
        RUNK(addk, Sn * 1024, x1, t3, x1);
    }
}
```

```cpp
#include <hip/hip_runtime.h>
#include <hip/hip_cooperative_groups.h>
#include <cstdio>
#include <cstdint>
namespace cg = cooperative_groups;
constexpr int NB = 4, DM = 1024, DIN = 4896, DFF = 2816, NCMP = 511, NSEL = 128;
constexpr int C_MQ = 0, C_MK = 256, C_MV = 512, C_MO = 1024, C_MI = 1536, C_MF = 1540, C_NQ = 1544, C_KC = 2056, C_VC = 2184, C_KS = 2312, C_VS = 2440, C_KW = 2568, C_VW = 2696, C_NG = 2824, C_GM = 2848;
constexpr size_t MiB = 1u << 20;
constexpr size_t WS_CTL = 0;
constexpr size_t WS_ROPEC = 1 * MiB, WS_ROPES = 2 * MiB, WS_RSTD1 = 3 * MiB, WS_SSQ2 = 4 * MiB, WS_SMALLG = 6 * MiB, WS_SEL = 10 * MiB, WS_CMPB = 11 * MiB, WS_CBIAS = 12 * MiB;
constexpr size_t WS_EDGEA = 13 * MiB, WS_EDGEV = 19 * MiB, WS_IPRE = 22 * MiB, WS_LOGF = 22 * MiB + 524288, WS_MLS = 23 * MiB;
constexpr size_t WS_WIN = 24 * MiB  , WS_WG = 30 * MiB  , WS_WMN = 34 * MiB, WS_WOUT = 36 * MiB, WS_WUP = 38 * MiB, WS_WDN = 49 * MiB, WS_CW1 = 55 * MiB;
constexpr size_t WS_XB = 60 * MiB;
constexpr size_t WS_QKPRE = 124 * MiB, WS_MV = 156 * MiB, WS_MO = 188 * MiB, WS_NQ = 220 * MiB, WS_KC = 252 * MiB, WS_KS = 260 * MiB, WS_KW = 268 * MiB, WS_VC = 276 * MiB, WS_VS = 284 * MiB, WS_VW = 292 * MiB;
constexpr size_t WS_HMON = 300 * MiB;
constexpr size_t WS_DC = 364 * MiB, WS_CPREV = 428 * MiB, WS_CMPH = 492 * MiB;
constexpr size_t WS_GM = 124 * MiB, WS_GN = 188 * MiB;
constexpr size_t WS_Y = 364 * MiB;
constexpr size_t WS_MID = 124 * MiB;
constexpr size_t WS_END = 500 * MiB;
constexpr size_t WS_QKF = 364 * MiB  , WS_HRAW = 428 * MiB  , WS_IMP = 364 * MiB  , WS_IDX = 396 * MiB  ;
constexpr int RING_BYTES = 131072, LDS_EX = RING_BYTES  , LDS_BYTES = 147456;

namespace pg8 {
#define PG8_LAS __attribute__((address_space(3)))
typedef unsigned short bf16_t;
typedef short bf16x8 __attribute__((ext_vector_type(8)));
typedef float f32x4 __attribute__((ext_vector_type(4)));
typedef unsigned u32x4 __attribute__((ext_vector_type(4)));
constexpr int BM = 256, BK = 64, HALF = 128, HTB = HALF * BK * 2  , STAGE_BYTES = 8 * HTB, NXCD = 8, WGM = 8;

__host__ __device__ __forceinline__ int lds_byte(int r, int c) { const int st = (r >> 4) * 2 + (c >> 5), rr = r & 15, cc = c & 31, ob = rr * 64 + cc * 2; return st * 1024 + (ob ^ (((ob >> 9) & 1) << 5)); }
__host__ __device__ __forceinline__ void stage_rc(int b, int& R, int& C) { const int st = b / 1024, sb = b % 1024, swz = sb ^ (((sb >> 9) & 1) << 5); R = (st >> 1) * 16 + swz / 64; C = (st & 1) * 32 + (swz % 64) / 2; }
__host__ __device__ __forceinline__ int perm32(int rho) { const int n = rho >> 4, i = rho & 15; return 8 * (i >> 2) + 4 * n + (i & 3); }

struct Unit { int pm, pn; };
struct Gemm { const bf16_t* A; const bf16_t* Bt; int M, N, K; int lda; int ksA; };

struct StaticOrder {
    int nM, nN, nwg, G, c;
    __host__ __device__ void init(int M, int N, int G_, int c_) { nM = M / BM; nN = N / BM; nwg = nM * nN; G = G_; c = c_; }
    __host__ __device__ bool next(int i, Unit& u) const {
        const long L = (long)i * G + c; if (L >= nwg) return false;
        int wgid = (int)L; { const int q = nwg / NXCD, r = nwg % NXCD, xcd = wgid % NXCD, off = wgid / NXCD; wgid = (xcd < r ? xcd * (q + 1) : r * (q + 1) + (xcd - r) * q) + off; }
        const int nig = WGM * nN, gid = wgid / nig, fm = gid * WGM, gsz = (nM - fm) < WGM ? (nM - fm) : WGM;
        u.pm = fm + ((wgid % nig) % gsz); u.pn = (wgid % nig) / gsz; return true;
    }
    __device__ __forceinline__ const char* a_ptr(const Gemm& g, const Unit& u) const { return (const char*)g.A + (size_t)u.pm * BM * g.lda * 2; }
    __device__ __forceinline__ const char* b_ptr(const Gemm& g, const Unit& u) const { return (const char*)g.Bt + (size_t)u.pn * BM * g.K * 2; }
    __device__ __forceinline__ void a_ready(const Unit&) const {}
    __device__ __forceinline__ void done(const Unit&) const {}
};

__device__ __forceinline__ unsigned cvt_pk_bf16(float lo, float hi) { unsigned r; asm volatile("v_cvt_pk_bf16_f32 %0, %1, %2" : "=v"(r) : "v"(lo), "v"(hi)); return r; }
typedef float f32x2 __attribute__((ext_vector_type(2)));
__device__ __forceinline__ f32x2 gelu_pk(f32x2 v) {
    const f32x2 av = __builtin_elementwise_abs(v), d = av * 0.2316418882f + 1.0f;
    f32x2 t; t.x = __builtin_amdgcn_rcpf(d.x); t.y = __builtin_amdgcn_rcpf(d.y);
    f32x2 q = t * 0.5307027145f + (-0.7265760135f); q = q * t + 0.7107068705f; q = q * t + (-0.142248368f); q = q * t + 0.127414796f; q = q * t;
    const f32x2 s = (v * v) * (-0.72134752044f);
    f32x2 e; e.x = __builtin_amdgcn_exp2f(s.x); e.y = __builtin_amdgcn_exp2f(s.y);
    const f32x2 m = v * (q * e), r = v - m;
    f32x2 o; o.x = v.x < 0.f ? m.x : r.x; o.y = v.y < 0.f ? m.y : r.y; return o;
}

constexpr int TT = 32768, SEQ = 8192;
constexpr float NEPS = 1e-6f;
constexpr float QC2 = 0.125f * 1.4426950408889634f;
typedef unsigned u32x2 __attribute__((ext_vector_type(2)));
__device__ __forceinline__ float bf2f(unsigned short v) { return __uint_as_float((unsigned)v << 16); }
__device__ __forceinline__ float bflo(unsigned w) { return __uint_as_float(w << 16); }
__device__ __forceinline__ float bfhi(unsigned w) { return __uint_as_float(w & 0xffff0000u); }
__device__ __forceinline__ float sigm(float x) { return 1.0f / (1.0f + __expf(-x)); }
__device__ __forceinline__ u32x4 pack8(const f32x4& a, const f32x4& b) { u32x4 w; w.x = cvt_pk_bf16(a[0], a[1]); w.y = cvt_pk_bf16(a[2], a[3]); w.z = cvt_pk_bf16(b[0], b[1]); w.w = cvt_pk_bf16(b[2], b[3]); return w; }
__device__ __forceinline__ void unpack8(const u32x4& w, f32x4& a, f32x4& b) { a = (f32x4){bflo(w.x), bfhi(w.x), bflo(w.y), bfhi(w.y)}; b = (f32x4){bflo(w.z), bfhi(w.z), bflo(w.w), bfhi(w.w)}; }


struct EpiInProj {
    static constexpr bool PERM = true, AFTER_DRAIN = false, HAS_MID = false;
    unsigned char* ws; const float *qnw, *kcw, *ksw, *kww;
    __device__ __forceinline__ void mid(f32x4 (&)[2][2][4][2], const Unit&, int, int, int, int) const {}
    __device__ __forceinline__ void operator()(f32x4 (&acc)[2][2][4][2], const Unit& u, int wr, int wc, int fr, int fq) const {
        const int pn = u.pn; int row0 = u.pm * BM + wr * 64 + fr; asm volatile("" : "+v"(row0));
        const float* rstd = (const float*)(ws + WS_RSTD1); const float* rope_c = (const float*)(ws + WS_ROPEC); const float* rope_s = (const float*)(ws + WS_ROPES);
        if (pn < 6) {
            bf16_t* base = (bf16_t*)(ws + (pn < 2 ? WS_QKPRE : pn < 4 ? WS_MV : WS_MO)); const int col0 = (pn & 1) * 256 + wc * 32 + 8 * fq;
#pragma unroll
            for (int ai = 0; ai < 2; ++ai)
#pragma unroll
                for (int m = 0; m < 4; ++m) { const int row = row0 + ai * HALF + m * 16; const float rs = rstd[row]; bf16_t* rowp = base + (size_t)row * 512 + col0;
#pragma unroll
                    for (int bj = 0; bj < 2; ++bj) *(u32x4*)(rowp + bj * HALF) = pack8(acc[ai][bj][m][0] * rs, acc[ai][bj][m][1] * rs); asm volatile("" ::: "memory"); }
        } else if (pn < 11) {
            bf16_t* dst; int ld; const float* nw = nullptr; float osc = 1.0f;
            if (pn < 8) { dst = (bf16_t*)(ws + WS_NQ) + (4 * (pn - 6) + wc) * 64; ld = 512; nw = qnw; osc = QC2; }
            else { const int seg = (pn - 8) * 2 + (wc >> 1);
                const size_t so = seg == 0 ? WS_KC : seg == 1 ? WS_KS : seg == 2 ? WS_KW : seg == 3 ? WS_VC : seg == 4 ? WS_VS : WS_VW;
                dst = (bf16_t*)(ws + so) + (wc & 1) * 64; ld = 128; nw = seg == 0 ? kcw : seg == 1 ? ksw : seg == 2 ? kww : nullptr; }
#pragma unroll
            for (int ai = 0; ai < 2; ++ai)
#pragma unroll
                for (int m = 0; m < 4; ++m) { const int row = row0 + ai * HALF + m * 16; const float rs = rstd[row];
#pragma unroll
                    for (int n = 0; n < 2; ++n) { acc[ai][0][m][n] = acc[ai][0][m][n] * rs; acc[ai][1][m][n] = acc[ai][1][m][n] * rs; }
                    if (nw) {
                        float s = 0.f;
#pragma unroll
                        for (int n = 0; n < 2; ++n)
#pragma unroll
                            for (int e = 0; e < 4; ++e) s += acc[ai][0][m][n][e] * acc[ai][0][m][n][e] + acc[ai][1][m][n][e] * acc[ai][1][m][n][e];
                        s += __shfl_xor(s, 16); s += __shfl_xor(s, 32);
                        const float rn = 1.0f / sqrtf(s * (1.0f / 64.0f) + NEPS); const int tp = row & (SEQ - 1);
#pragma unroll
                        for (int n = 0; n < 2; ++n) { const f32x4 c = *(const f32x4*)(rope_c + tp * 32 + 8 * fq + 4 * n), sn = *(const f32x4*)(rope_s + tp * 32 + 8 * fq + 4 * n);
                            const f32x4 w0 = *(const f32x4*)(nw + 8 * fq + 4 * n), w1 = *(const f32x4*)(nw + 32 + 8 * fq + 4 * n);
                            const f32x4 a = acc[ai][0][m][n] * rn * w0, b = acc[ai][1][m][n] * rn * w1; acc[ai][0][m][n] = (a * c - b * sn) * osc; acc[ai][1][m][n] = (b * c + a * sn) * osc;
                            asm volatile("" : "+v"(acc[ai][0][m][n]), "+v"(acc[ai][1][m][n]) :: "memory"); }
                    }
                    bf16_t* rowp = dst + (size_t)row * ld + 8 * fq;
                    *(u32x4*)(rowp) = pack8(acc[ai][0][m][0], acc[ai][0][m][1]); *(u32x4*)(rowp + 32) = pack8(acc[ai][1][m][0], acc[ai][1][m][1]); asm volatile("" ::: "memory"); }
        } else {
            if (wc == 0) {
#pragma unroll
                for (int ai = 0; ai < 2; ++ai)
#pragma unroll
                    for (int m = 0; m < 4; ++m) { const int row = row0 + ai * HALF + m * 16; const float rs = rstd[row]; float* rowp = (float*)(ws + WS_SMALLG) + (size_t)row * 32 + 8 * fq;
                        *(f32x4*)(rowp) = acc[ai][0][m][0] * rs; *(f32x4*)(rowp + 4) = acc[ai][0][m][1] * rs; }
            }
        }
    }
};
struct EpiGate {
    static constexpr bool PERM = true, AFTER_DRAIN = false, HAS_MID = false;
    const float* rstd; const float* bias  ; bf16_t* gm; bf16_t* gn;
    __device__ __forceinline__ void mid(f32x4 (&)[2][2][4][2], const Unit&, int, int, int, int) const {}
    __device__ __forceinline__ void operator()(f32x4 (&acc)[2][2][4][2], const Unit& u, int wr, int wc, int fr, int fq) const {
        int row0 = u.pm * BM + wr * 64 + fr; asm volatile("" : "+v"(row0)); const int which = u.pn >> 2, col0 = (u.pn & 3) * 256 + wc * 32 + 8 * fq; bf16_t* base = which ? gn : gm; const float* bp = bias + which * 1024 + col0;
        f32x4 bv[2][2];
#pragma unroll
        for (int bj = 0; bj < 2; ++bj)
#pragma unroll
            for (int n = 0; n < 2; ++n) bv[bj][n] = *(const f32x4*)(bp + bj * HALF + 4 * n);
#pragma unroll
        for (int ai = 0; ai < 2; ++ai)
#pragma unroll
            for (int m = 0; m < 4; ++m) { const int row = row0 + ai * HALF + m * 16; const float rs = rstd[row]; bf16_t* rowp = base + (size_t)row * 1024 + col0;
#pragma unroll
                for (int bj = 0; bj < 2; ++bj) { f32x4 v0 = acc[ai][bj][m][0] * rs + bv[bj][0], v1 = acc[ai][bj][m][1] * rs + bv[bj][1];
#pragma unroll
                    for (int e = 0; e < 4; ++e) { v0[e] = sigm(v0[e]); v1[e] = sigm(v1[e]); }
                    *(u32x4*)(rowp + bj * HALF) = pack8(v0, v1); } }
    }
};
struct EpiMerge {
    static constexpr bool PERM = true, AFTER_DRAIN = false, HAS_MID = true;
    const bf16_t* gm; const bf16_t* gn; bf16_t* y;
    __device__ __forceinline__ void mid(f32x4 (&acc)[2][2][4][2], const Unit& u, int wr, int wc, int fr, int fq) const {
        int row0 = u.pm * BM + wr * 64 + fr; asm volatile("" : "+v"(row0)); const int col0 = u.pn * BM + wc * 32 + 8 * fq;
#pragma unroll
        for (int ai = 0; ai < 2; ++ai)
#pragma unroll
            for (int m = 0; m < 4; ++m) { const size_t off = (size_t)(row0 + ai * HALF + m * 16) * 1024 + col0;
#pragma unroll
                for (int bj = 0; bj < 2; ++bj) { const u32x4 a = *(const u32x4*)(gm + off + bj * HALF), b = *(const u32x4*)(gn + off + bj * HALF); f32x4 a0, a1, b0, b1; unpack8(a, a0, a1); unpack8(b, b0, b1);
#pragma unroll
                    for (int e = 0; e < 4; ++e) { acc[ai][bj][m][0][e] *= a0[e] * __builtin_amdgcn_rcpf(fmaxf(b0[e], 1e-30f)); acc[ai][bj][m][1][e] *= a1[e] * __builtin_amdgcn_rcpf(fmaxf(b1[e], 1e-30f)); }
                    asm volatile("" : "+v"(acc[ai][bj][m][0]), "+v"(acc[ai][bj][m][1]) :: "memory"); }
                asm volatile("" : "+v"(acc[ai][0][m][0]), "+v"(acc[ai][0][m][1]), "+v"(acc[ai][1][m][0]), "+v"(acc[ai][1][m][1]) :: "memory"); }
    }
    __device__ __forceinline__ void operator()(f32x4 (&acc)[2][2][4][2], const Unit& u, int wr, int wc, int fr, int fq) const {
        int row0 = u.pm * BM + wr * 64 + fr; asm volatile("" : "+v"(row0)); const int col0 = u.pn * BM + wc * 32 + 8 * fq;
#pragma unroll
        for (int ai = 0; ai < 2; ++ai)
#pragma unroll
            for (int m = 0; m < 4; ++m) { const size_t off = (size_t)(row0 + ai * HALF + m * 16) * 1024 + col0;
#pragma unroll
                for (int bj = 0; bj < 2; ++bj) { const u32x4 b = *(const u32x4*)(gn + off + bj * HALF); f32x4 b0, b1; unpack8(b, b0, b1);
                    *(u32x4*)(y + off + bj * HALF) = pack8(acc[ai][bj][m][0] * b0, acc[ai][bj][m][1] * b1); } }
    }
};
struct EpiWout {
    static constexpr bool PERM = true, AFTER_DRAIN = false, HAS_MID = false;
    const float* x; float* x1; bf16_t* x1b; float* ssq  ;
    __device__ __forceinline__ void mid(f32x4 (&)[2][2][4][2], const Unit&, int, int, int, int) const {}
    __device__ __forceinline__ void operator()(f32x4 (&acc)[2][2][4][2], const Unit& u, int wr, int wc, int fr, int fq) const {
        int row0 = u.pm * BM + wr * 64 + fr; asm volatile("" : "+v"(row0)); const int col0 = u.pn * BM + wc * 32 + 8 * fq;
#pragma unroll
        for (int ai = 0; ai < 2; ++ai)
#pragma unroll
            for (int m = 0; m < 4; ++m) { const int row = row0 + ai * HALF + m * 16; const size_t off = (size_t)row * 1024 + col0; float s = 0.f;
#pragma unroll
                for (int bj = 0; bj < 2; ++bj) { const f32x4 v0 = *(const f32x4*)(x + off + bj * HALF) + acc[ai][bj][m][0], v1 = *(const f32x4*)(x + off + bj * HALF + 4) + acc[ai][bj][m][1];
                    *(f32x4*)(x1 + off + bj * HALF) = v0; *(f32x4*)(x1 + off + bj * HALF + 4) = v1; *(u32x4*)(x1b + off + bj * HALF) = pack8(v0, v1);
#pragma unroll
                    for (int e = 0; e < 4; ++e) s += v0[e] * v0[e] + v1[e] * v1[e]; }
                s += __shfl_xor(s, 16); s += __shfl_xor(s, 32);
                if (fq == 0) ssq[(size_t)row * 16 + u.pn * 4 + wc] = s; }
    }
};
__device__ __forceinline__ float dpp_shr(float old, float v, int n) { return n == 1 ? __builtin_bit_cast(float, __builtin_amdgcn_update_dpp(__builtin_bit_cast(int, old), __builtin_bit_cast(int, v), 0x111, 0xf, 0xf, false))
                                                                                       : __builtin_bit_cast(float, __builtin_amdgcn_update_dpp(__builtin_bit_cast(int, old), __builtin_bit_cast(int, v), 0x112, 0xf, 0xf, false)); }
__device__ __forceinline__ float dpp_shl15(float v) { return __builtin_bit_cast(float, __builtin_amdgcn_update_dpp(0, __builtin_bit_cast(int, v), 0x10F, 0xf, 0xf, true)); }
__device__ __forceinline__ float dpp_shl14(float v) { return __builtin_bit_cast(float, __builtin_amdgcn_update_dpp(0, __builtin_bit_cast(int, v), 0x10E, 0xf, 0xf, true)); }
struct EpiFfnUp {
    static constexpr bool PERM = true, AFTER_DRAIN = false, HAS_MID = false;
    const float* ssq; const float* cw  ; const float* cb; bf16_t* midb; float* edgeA  ; float* edgeV  ; PG8_LAS float* ex  ;
    __device__ __forceinline__ void mid(f32x4 (&)[2][2][4][2], const Unit&, int, int, int, int) const {}
    __device__ __forceinline__ void operator()(f32x4 (&acc)[2][2][4][2], const Unit& u, int wr, int wc, int fr, int fq) const {
        constexpr int FF = 2816;
        int row0 = u.pm * BM + wr * 64 + fr; asm volatile("" : "+v"(row0)); const int cl = wc * 32 + 8 * fq, col0 = u.pn * 128 + cl;
#pragma unroll
        for (int ai = 0; ai < 2; ++ai)
#pragma unroll
            for (int m = 0; m < 4; ++m) { const int row = row0 + ai * HALF + m * 16; const f32x4* sp = (const f32x4*)(ssq + (size_t)row * 16); const f32x4 s0 = sp[0], s1 = sp[1], s2 = sp[2], s3 = sp[3];
                const float ss = ((s0[0] + s0[1]) + (s0[2] + s0[3])) + ((s1[0] + s1[1]) + (s1[2] + s1[3])) + ((s2[0] + s2[1]) + (s2[2] + s2[3])) + ((s3[0] + s3[1]) + (s3[2] + s3[3]));
                const float rs = 1.0f / sqrtf(ss * (1.0f / 1024.0f) + NEPS);
#pragma unroll
                for (int n = 0; n < 2; ++n) { acc[ai][0][m][n] = acc[ai][0][m][n] * rs; acc[ai][1][m][n] = acc[ai][1][m][n] * rs; }
                asm volatile("" : "+v"(acc[ai][0][m][0]), "+v"(acc[ai][0][m][1]), "+v"(acc[ai][1][m][0]), "+v"(acc[ai][1][m][1]) :: "memory"); }
#pragma unroll
        for (int ai = 0; ai < 2; ++ai) { const int s = ai * 2 + wr;
            if (fr >= 14) { PG8_LAS float* p = ex + (s * 2 + (fr - 14)) * 128 + cl; *(PG8_LAS f32x4*)(p) = acc[ai][0][3][0]; *(PG8_LAS f32x4*)(p + 4) = acc[ai][0][3][1]; } }
        if (wr == 0 && fr < 2) { float* pa = edgeA + ((size_t)u.pm * 4 + fr) * FF + col0; float* pv = edgeV + ((size_t)u.pm * 2 + fr) * FF + col0;
            *(f32x4*)(pa) = acc[0][0][0][0]; *(f32x4*)(pa + 4) = acc[0][0][0][1]; *(f32x4*)(pv) = acc[0][1][0][0]; *(f32x4*)(pv + 4) = acc[0][1][0][1]; }
        if (wr == 1 && fr >= 14) { float* pa = edgeA + ((size_t)u.pm * 4 + 2 + (fr - 14)) * FF + col0; *(f32x4*)(pa) = acc[1][0][3][0]; *(f32x4*)(pa + 4) = acc[1][0][3][1]; }
        asm volatile("s_waitcnt lgkmcnt(0)" ::: "memory"); __builtin_amdgcn_s_barrier(); asm volatile("" ::: "memory");
        f32x4 w0[2], w1[2], w2[2], bb[2];
#pragma unroll
        for (int n = 0; n < 2; ++n) { w0[n] = *(const f32x4*)(cw + col0 + 4 * n); w1[n] = *(const f32x4*)(cw + FF + col0 + 4 * n); w2[n] = *(const f32x4*)(cw + 2 * FF + col0 + 4 * n); bb[n] = *(const f32x4*)(cb + col0 + 4 * n); }
#pragma unroll
        for (int ai = 0; ai < 2; ++ai) { const int s = ai * 2 + wr;
            f32x4 t1[2], t2[2];
#pragma unroll
            for (int n = 0; n < 2; ++n) { f32x4 h62 = (f32x4){0.f, 0.f, 0.f, 0.f}, h63 = h62;
                if (s > 0) { h62 = *(const PG8_LAS f32x4*)(ex + ((s - 1) * 2 + 0) * 128 + cl + 4 * n); h63 = *(const PG8_LAS f32x4*)(ex + ((s - 1) * 2 + 1) * 128 + cl + 4 * n); }
                t1[n] = h63; t2[n] = fr == 0 ? h62 : h63; }
#pragma unroll
            for (int m = 0; m < 4; ++m) { f32x4 o[2];
#pragma unroll
                for (int n = 0; n < 2; ++n) {
                    f32x4 cv;
#pragma unroll
                    for (int e = 0; e < 4; ++e) { const float X = acc[ai][0][m][n][e]; const float p1 = dpp_shr(t1[n][e], X, 1), p2 = dpp_shr(t2[n][e], X, 2);
                        t1[n][e] = dpp_shl15(X); t2[n][e] = dpp_shl14(X);
                        cv[e] = w2[n][e] * X + w1[n][e] * p1 + w0[n][e] * p2 + bb[n][e]; }
                    const f32x2 ga = gelu_pk((f32x2){cv[0], cv[1]}), gb = gelu_pk((f32x2){cv[2], cv[3]});
                    o[n] = (f32x4){ga.x, ga.y, gb.x, gb.y} * acc[ai][1][m][n]; }
                const bool skip = (s == 0 && m == 0 && fr < 2);
                if (!skip) *(u32x4*)(midb + (size_t)(row0 + ai * HALF + m * 16) * FF + col0) = pack8(o[0], o[1]);
                asm volatile("" ::: "memory"); }
        }
    }
};
struct EpiFfnDown {
    static constexpr bool PERM = true, AFTER_DRAIN = false, HAS_MID = false;
    float* out;
    __device__ __forceinline__ void mid(f32x4 (&)[2][2][4][2], const Unit&, int, int, int, int) const {}
    __device__ __forceinline__ void operator()(f32x4 (&acc)[2][2][4][2], const Unit& u, int wr, int wc, int fr, int fq) const {
        int row0 = u.pm * BM + wr * 64 + fr; asm volatile("" : "+v"(row0)); const int col0 = u.pn * BM + wc * 32 + 8 * fq;
#pragma unroll
        for (int ai = 0; ai < 2; ++ai)
#pragma unroll
            for (int m = 0; m < 4; ++m) { const size_t off = (size_t)(row0 + ai * HALF + m * 16) * 1024 + col0;
#pragma unroll
                for (int bj = 0; bj < 2; ++bj) { float* p = out + off + bj * HALF; const f32x4 v0 = *(const f32x4*)(p) + acc[ai][bj][m][0], v1 = *(const f32x4*)(p + 4) + acc[ai][bj][m][1]; *(f32x4*)(p) = v0; *(f32x4*)(p + 4) = v1; } }
    }
};
struct EpiCmpHid {
    static constexpr bool PERM = true, AFTER_DRAIN = false, HAS_MID = false;
    const float* cbias  ; bf16_t* hid;
    __device__ __forceinline__ void mid(f32x4 (&)[2][2][4][2], const Unit&, int, int, int, int) const {}
    __device__ __forceinline__ void operator()(f32x4 (&acc)[2][2][4][2], const Unit& u, int wr, int wc, int fr, int fq) const {
        int row0 = u.pm * BM + wr * 64 + fr; asm volatile("" : "+v"(row0)); const int col0 = wc * 32 + 8 * fq; const float* bp = cbias + (u.pm >> 4) * 256 + col0;
#pragma unroll
        for (int ai = 0; ai < 2; ++ai)
#pragma unroll
            for (int m = 0; m < 4; ++m) { bf16_t* rowp = hid + (size_t)(row0 + ai * HALF + m * 16) * 256 + col0;
#pragma unroll
                for (int bj = 0; bj < 2; ++bj) { f32x4 v0 = acc[ai][bj][m][0] + *(const f32x4*)(bp + bj * HALF), v1 = acc[ai][bj][m][1] + *(const f32x4*)(bp + bj * HALF + 4);
                    const f32x2 g0 = gelu_pk((f32x2){v0[0], v0[1]}), g1 = gelu_pk((f32x2){v0[2], v0[3]}), g2 = gelu_pk((f32x2){v1[0], v1[1]}), g3 = gelu_pk((f32x2){v1[2], v1[3]});
                    *(u32x4*)(rowp + bj * HALF) = pack8((f32x4){g0.x, g0.y, g1.x, g1.y}, (f32x4){g2.x, g2.y, g3.x, g3.y}); } }
    }
};
struct CmpOrder {
    int G, c; const bf16_t* kc; const bf16_t* vc; const bf16_t* w1t;
    __device__ bool next(int i, Unit& u) const { const int L = i * G + c; if (L >= 32) return false; u.pm = L; u.pn = 0; return true; }
    __device__ __forceinline__ const char* a_ptr(const Gemm&, const Unit& u) const { const int kvbg = u.pm >> 1, half = u.pm & 1, kv = kvbg >> 3, b = (kvbg >> 1) & 3, g = kvbg & 1;
        return (const char*)((kv ? vc : kc) + ((size_t)(b * SEQ + 16 * 256 * half) * 128 + g * 64)); }
    __device__ __forceinline__ const char* b_ptr(const Gemm&, const Unit& u) const { return (const char*)(w1t + (size_t)(u.pm >> 4) * 256 * 2048); }
    __device__ __forceinline__ void a_ready(const Unit&) const {}
    __device__ __forceinline__ void done(const Unit&) const {}
};
template <class Epi, class Sched, bool ALIGN_EPI = false, bool SP2 = false>
__device__ __forceinline__ void gemm_phase(PG8_LAS unsigned char* lds, const Gemm g, const Sched& S, const Epi& E) {
    int tid_ = threadIdx.x; asm volatile("" : "+v"(tid_));
    const int tid = tid_, wid = __builtin_amdgcn_readfirstlane(tid >> 6), lane = tid & 63, wr = wid >> 2, wc = wid & 3, fr = lane & 15, fq = lane >> 4;
    const int K = g.K, nt = K / BK;
    unsigned voffA[2], voffB[2];
#pragma unroll
    for (int i = 0; i < 2; ++i) { int R, C; stage_rc(tid * 16 + i * 8192, R, C); const int Rb = Epi::PERM ? ((R & ~31) + perm32(R & 31)) : R;
        voffA[i] = (unsigned)(R * g.lda + C) * 2u; voffB[i] = (unsigned)(Rb * K + C) * 2u; }
    const size_t kstepA = (size_t)g.ksA, kstepB = (size_t)(BK * 2);
    const size_t hstepA = (size_t)HALF * g.lda * 2, hstepB = (size_t)HALF * K * 2;
    const unsigned ldsw = (unsigned)wid * 1024u;
    const int aoff = lds_byte(wr * 64 + fr, fq * 8), boff = lds_byte(wc * 32 + fr, fq * 8);
#define PG8_SA(b, h) (((b) * 2 + (h)) * HTB)
#define PG8_SB(b, h) ((4 + (b) * 2 + (h)) * HTB)
#define PG8_STAGE(bufoff, gbase, voff) do { _Pragma("unroll") for (int _i = 0; _i < 2; ++_i) \
        __builtin_amdgcn_global_load_lds((const unsigned*)((const char*)(gbase) + (voff)[_i]), (PG8_LAS unsigned*)(lds + (bufoff) + ldsw + _i * 8192), 16, 0, 0); } while (0)
#define PG8_LDA(dst, b, h) do { _Pragma("unroll") for (int m = 0; m < 4; ++m) _Pragma("unroll") for (int k = 0; k < 2; ++k) dst[m][k] = *(const PG8_LAS bf16x8*)(lds + PG8_SA(b, h) + aoff + m * 2048 + k * 1024); } while (0)
#define PG8_LDB(dst, b, h) do { _Pragma("unroll") for (int n = 0; n < 2; ++n) _Pragma("unroll") for (int k = 0; k < 2; ++k) dst[n][k] = *(const PG8_LAS bf16x8*)(lds + PG8_SB(b, h) + boff + n * 2048 + k * 1024); } while (0)
#define PG8_MMA(ai, bj, At, Bt) do { __builtin_amdgcn_s_setprio(1); _Pragma("unroll") for (int m = 0; m < 4; ++m) _Pragma("unroll") for (int n = 0; n < 2; ++n) _Pragma("unroll") for (int k = 0; k < 2; ++k) \
        acc[ai][bj][m][n] = __builtin_amdgcn_mfma_f32_16x16x32_bf16(Bt[n][k], At[m][k], acc[ai][bj][m][n], 0, 0, 0); __builtin_amdgcn_s_setprio(0); } while (0)
#define PG8_WAIT_V(n) asm volatile("s_waitcnt vmcnt(" #n ")" ::: "memory")
#define PG8_WAIT_L(n) asm volatile("s_waitcnt lgkmcnt(" #n ")" ::: "memory")
#define PG8_BAR __builtin_amdgcn_s_barrier()
#define PG8_SCHED __builtin_amdgcn_sched_barrier(0)
    Unit cur, nxt; int ui = 0;
    if (!S.next(0, cur)) return;
    f32x4 acc[2][2][4][2];
#pragma unroll
    for (int a = 0; a < 2; ++a)
#pragma unroll
        for (int b = 0; b < 2; ++b)
#pragma unroll
            for (int m = 0; m < 4; ++m)
#pragma unroll
                for (int n = 0; n < 2; ++n) acc[a][b][m][n] = (f32x4){0.f, 0.f, 0.f, 0.f};
    bf16x8 At[4][2], B0[2][2], B1[2][2];
    const char* cA = S.a_ptr(g, cur); const char* cB = S.b_ptr(g, cur);
    S.a_ready(cur);
    if constexpr (SP2) {
        PG8_STAGE(PG8_SB(0, 0), cB, voffB); PG8_STAGE(PG8_SB(0, 1), cB + hstepB, voffB); PG8_STAGE(PG8_SA(0, 0), cA, voffA); PG8_STAGE(PG8_SA(0, 1), cA + hstepA, voffA);
        if (wr == 1) PG8_BAR;
        PG8_WAIT_V(2); PG8_BAR;
        PG8_STAGE(PG8_SB(1, 0), cB + kstepB, voffB); PG8_STAGE(PG8_SA(1, 0), cA + kstepA, voffA); PG8_STAGE(PG8_SB(1, 1), cB + hstepB + kstepB, voffB);
        PG8_WAIT_V(6); PG8_BAR;
    } else {
        PG8_STAGE(PG8_SB(0, 0), cB, voffB); PG8_STAGE(PG8_SA(0, 0), cA, voffA); PG8_STAGE(PG8_SB(0, 1), cB + hstepB, voffB); PG8_STAGE(PG8_SA(0, 1), cA + hstepA, voffA);
        if (wr == 1) PG8_BAR;
        PG8_WAIT_V(4); PG8_BAR;
        PG8_STAGE(PG8_SB(1, 0), cB + kstepB, voffB); PG8_STAGE(PG8_SA(1, 0), cA + kstepA, voffA); PG8_STAGE(PG8_SB(1, 1), cB + hstepB + kstepB, voffB);
        PG8_WAIT_V(6); PG8_BAR;
    }
    for (;;) {
        const bool has_next = S.next(ui + 1, nxt);
        const char* nA = has_next ? S.a_ptr(g, nxt) : cA; const char* nB = has_next ? S.b_ptr(g, nxt) : cB;
        for (int t = 0; t < nt; t += 2) {
            if constexpr (Epi::HAS_MID) { if (t == nt / 2) E.mid(acc, cur, wr, wc, fr, fq); }
            const bool last = (t == nt - 2);
            const char* a1 = cA + (size_t)(t + 1) * kstepA;
            const char* a2 = last ? nA : cA + (size_t)(t + 2) * kstepA; const char* b2 = last ? nB : cB + (size_t)(t + 2) * kstepB;
            const char* a3 = a2 + kstepA; const char* b3 = b2 + kstepB;
            if (last && has_next) S.a_ready(nxt);
            if constexpr (SP2) {
            PG8_LDB(B0, 0, 0); PG8_LDB(B1, 0, 1); PG8_SCHED; PG8_LDA(At, 0, 0); PG8_STAGE(PG8_SA(1, 1), a1 + hstepA, voffA);
            PG8_WAIT_V(8); PG8_WAIT_L(0); PG8_BAR; PG8_MMA(0, 0, At, B0); PG8_MMA(0, 1, At, B1); PG8_BAR; PG8_SCHED;
            PG8_LDA(At, 0, 1); PG8_STAGE(PG8_SB(0, 0), b2, voffB); PG8_STAGE(PG8_SB(0, 1), b2 + hstepB, voffB); PG8_STAGE(PG8_SA(0, 0), a2, voffA);
            PG8_WAIT_V(8); PG8_WAIT_L(0); PG8_BAR; PG8_MMA(1, 0, At, B0); PG8_MMA(1, 1, At, B1); PG8_BAR; PG8_SCHED;
            PG8_LDB(B0, 1, 0); PG8_LDB(B1, 1, 1); PG8_SCHED; PG8_LDA(At, 1, 0); PG8_STAGE(PG8_SA(0, 1), a2 + hstepA, voffA);
            PG8_WAIT_V(8); PG8_WAIT_L(0); PG8_BAR; PG8_MMA(0, 0, At, B0); PG8_MMA(0, 1, At, B1); PG8_BAR; PG8_SCHED;
            PG8_LDA(At, 1, 1); PG8_STAGE(PG8_SB(1, 0), b3, voffB); PG8_STAGE(PG8_SB(1, 1), b3 + hstepB, voffB); PG8_STAGE(PG8_SA(1, 0), a3, voffA);
            PG8_WAIT_V(8); PG8_WAIT_L(0); PG8_BAR; PG8_MMA(1, 0, At, B0); PG8_MMA(1, 1, At, B1); PG8_BAR; PG8_SCHED;
            } else {
            PG8_LDB(B0, 0, 0); PG8_SCHED; PG8_LDA(At, 0, 0); PG8_STAGE(PG8_SA(1, 1), a1 + hstepA, voffA);
            PG8_WAIT_L(8); PG8_BAR; PG8_WAIT_L(0); PG8_MMA(0, 0, At, B0); PG8_BAR; PG8_SCHED;
            PG8_LDB(B1, 0, 1); PG8_STAGE(PG8_SB(0, 0), b2, voffB);
            PG8_BAR; PG8_WAIT_L(0); PG8_MMA(0, 1, At, B1); PG8_BAR;
            PG8_LDA(At, 0, 1); PG8_STAGE(PG8_SA(0, 0), a2, voffA);
            PG8_BAR; PG8_WAIT_L(0); PG8_MMA(1, 0, At, B0); PG8_BAR; PG8_SCHED;
            PG8_STAGE(PG8_SB(0, 1), b2 + hstepB, voffB);
            PG8_WAIT_V(6); PG8_BAR; PG8_MMA(1, 1, At, B1); PG8_BAR;
            PG8_LDB(B0, 1, 0); PG8_SCHED; PG8_LDA(At, 1, 0); PG8_STAGE(PG8_SA(0, 1), a2 + hstepA, voffA);
            PG8_WAIT_L(8); PG8_BAR; PG8_WAIT_L(0); PG8_MMA(0, 0, At, B0); PG8_BAR; PG8_SCHED;
            PG8_LDB(B1, 1, 1); PG8_STAGE(PG8_SB(1, 0), b3, voffB);
            PG8_BAR; PG8_WAIT_L(0); PG8_MMA(0, 1, At, B1); PG8_BAR;
            PG8_LDA(At, 1, 1); PG8_STAGE(PG8_SA(1, 0), a3, voffA);
            PG8_BAR; PG8_WAIT_L(0); PG8_MMA(1, 0, At, B0); PG8_BAR; PG8_SCHED;
            PG8_STAGE(PG8_SB(1, 1), b3 + hstepB, voffB);
            PG8_WAIT_V(6); PG8_BAR; PG8_MMA(1, 1, At, B1); PG8_BAR;
            }
        }
        if constexpr (ALIGN_EPI) { if (wr == 0) PG8_BAR; }
        if constexpr (!Epi::AFTER_DRAIN) { E(acc, cur, wr, wc, fr, fq); S.done(cur); }
        if (!has_next) break;
#pragma unroll
        for (int a = 0; a < 2; ++a)
#pragma unroll
            for (int b = 0; b < 2; ++b)
#pragma unroll
                for (int m = 0; m < 4; ++m)
#pragma unroll
                    for (int n = 0; n < 2; ++n) acc[a][b][m][n] = (f32x4){0.f, 0.f, 0.f, 0.f};
        cur = nxt; cA = nA; cB = nB; ++ui;
        if constexpr (ALIGN_EPI) { if (wr == 1) PG8_BAR; }
    }
    PG8_WAIT_V(0);
    if constexpr (!ALIGN_EPI) { if (wr == 0) PG8_BAR; }
    PG8_BAR;
    if constexpr (Epi::AFTER_DRAIN) { E.fused(acc, cur, wr, wc, fr, fq, lds, wid, lane); S.done(cur); }
#undef PG8_SA
#undef PG8_SB
#undef PG8_STAGE
#undef PG8_LDA
#undef PG8_LDB
#undef PG8_MMA
#undef PG8_WAIT_V
#undef PG8_WAIT_L
#undef PG8_BAR
#undef PG8_SCHED
}
}

using pg8::bf16_t; using pg8::f32x4; using pg8::u32x4; using pg8::TT; using pg8::SEQ; using pg8::NEPS; using pg8::QC2; using pg8::bf2f; using pg8::sigm;
#define LAS __attribute__((address_space(3)))
struct Args { const float* in[27]; float* out; unsigned char* ws; };

__device__ __forceinline__ unsigned f2bf(float f) { unsigned u = __builtin_bit_cast(unsigned, f); return (u + 0x7fffu + ((u >> 16) & 1u)) >> 16; }
__device__ __forceinline__ unsigned pk2(float lo, float hi) { return f2bf(lo) | (f2bf(hi) << 16); }
__device__ __forceinline__ float wave_sum(float v) {
#pragma unroll
    for (int o = 1; o < 64; o <<= 1) v += __shfl_xor(v, o);
    return v;
}
template <class F> __device__ __forceinline__ void transpose_item(const float* W, int ldw, int k0src, const float* kscale, bf16_t* WT, int ldt, int k0dst, int row0, LAS float* scr, int lane, F srccol) {
    const int j = lane & 31; const int sc = srccol(j);
#pragma unroll 8
    for (int i = 0; i < 32; ++i) { const int kk = 2 * i + (lane >> 5); float v = 0.f; if (sc >= 0) { v = W[(size_t)(k0src + kk) * ldw + sc]; if (kscale) v *= kscale[k0src + kk]; } scr[kk * 33 + j] = v; }
    asm volatile("s_waitcnt lgkmcnt(0)" ::: "memory");
    const int c = lane & 7;
#pragma unroll
    for (int jj = 0; jj < 4; ++jj) { const int n = (lane >> 3) + 8 * jj; const LAS float* s = scr + (8 * c) * 33 + n;
        u32x4 o; o.x = pk2(s[0 * 33], s[1 * 33]); o.y = pk2(s[2 * 33], s[3 * 33]); o.z = pk2(s[4 * 33], s[5 * 33]); o.w = pk2(s[6 * 33], s[7 * 33]);
        *(u32x4*)(WT + (size_t)(row0 + n) * ldt + k0dst + 8 * c) = o; }
    asm volatile("s_waitcnt lgkmcnt(0)" ::: "memory");
}
__device__ __forceinline__ int inproj_src(int p) {
    const int tile = p >> 8, l = p & 255;
    if (tile < 6) return p;
    const int half = l >> 7, wh = (l >> 5) & 3, j = l & 31;
    if (tile < 8) return C_NQ + 64 * (4 * (tile - 6) + wh) + 32 * half + j;
    if (tile == 8) return (wh < 2 ? C_KC + 64 * wh : C_KS + 64 * (wh - 2)) + 32 * half + j;
    if (tile == 9) return (wh < 2 ? C_KW + 64 * wh : C_VC + 64 * (wh - 2)) + 32 * half + j;
    if (tile == 10) return (wh < 2 ? C_VS + 64 * wh : C_VW + 64 * (wh - 2)) + 32 * half + j;
    if (l < 8) return C_MI + l; if (l < 32) return C_NG + (l - 8); return -1;
}
struct Ctx { int tid, lane, wave, G, vcu, gw, ngw, gtid, nthr; LAS unsigned char* lds; };

__device__ __forceinline__ void phase_prologue(const Ctx& C, const Args& a) {
    unsigned char* ws = a.ws;
    LAS float* scr = (LAS float*)(C.lds + C.wave * 16384);
    const float* w_in = a.in[2]; const float* norm1 = a.in[1]; const float* norm2 = a.in[22];
    constexpr int I_WIN = 96 * 16, I_WG = 64 * 16, I_WMN = 32 * 16, I_WOUT = 32 * 16, I_WUP = 176 * 16, I_WDN = 32 * 44, I_CW1 = 16 * 32;
    constexpr int NITEMS = I_WIN + I_WG + I_WMN + I_WOUT + I_WUP + I_WDN + I_CW1;
    for (int it = C.gw; it < NITEMS; it += C.ngw) {
        int r = it;
        if (r < I_WIN) { const int blk = r >> 4, kb = r & 15; transpose_item(w_in, DIN, 64 * kb, norm1, (bf16_t*)(ws + WS_WIN), 1024, 64 * kb, 32 * blk, scr, C.lane, [=](int j) { return inproj_src(32 * blk + j); }); continue; } r -= I_WIN;
        if (r < I_WG) { const int blk = r >> 4, kb = r & 15; transpose_item(w_in, DIN, 64 * kb, norm1, (bf16_t*)(ws + WS_WG), 1024, 64 * kb, 32 * blk, scr, C.lane, [=](int j) { return C_GM + 32 * blk + j; }); continue; } r -= I_WG;
        if (r < I_WMN) { const int blk = r >> 4, kb = r & 15; const float* W = kb < 8 ? a.in[18] : a.in[19]; transpose_item(W, 1024, 64 * (kb & 7), nullptr, (bf16_t*)(ws + WS_WMN), 1024, 64 * kb, 32 * blk, scr, C.lane, [=](int j) { return 32 * blk + j; }); continue; } r -= I_WMN;
        if (r < I_WOUT) { const int blk = r >> 4, kb = r & 15; transpose_item(a.in[21], 1024, 64 * kb, nullptr, (bf16_t*)(ws + WS_WOUT), 1024, 64 * kb, 32 * blk, scr, C.lane, [=](int j) { return 32 * blk + j; }); continue; } r -= I_WOUT;
        if (r < I_WUP) { const int blk = r >> 4, kb = r & 15; const int p0 = 32 * blk, pn = p0 >> 8, half = (p0 >> 7) & 1, jj = p0 & 127;
            transpose_item(a.in[23], 2 * DFF, 64 * kb, norm2, (bf16_t*)(ws + WS_WUP), 1024, 64 * kb, p0, scr, C.lane, [=](int j) { return half * DFF + 128 * pn + jj + j; }); continue; } r -= I_WUP;
        if (r < I_WDN) { const int blk = r / 44, kb = r % 44; transpose_item(a.in[26], 1024, 64 * kb, nullptr, (bf16_t*)(ws + WS_WDN), DFF, 64 * kb, 32 * blk, scr, C.lane, [=](int j) { return 32 * blk + j; }); continue; } r -= I_WDN;
        { const int kv = r >> 8, blk = (r >> 5) & 7, kb = r & 31; transpose_item(kv ? a.in[16] : a.in[13], 256, 64 * kb, nullptr, (bf16_t*)(ws + WS_CW1) + (size_t)kv * 256 * 2048, 2048, 64 * kb, 32 * blk, scr, C.lane, [=](int j) { return 32 * blk + j; }); }
    }
    { const float* x = a.in[0]; bf16_t* xb = (bf16_t*)(ws + WS_XB); float* rstd = (float*)(ws + WS_RSTD1);
      for (int m = C.gw; m < TT; m += C.ngw) { const f32x4* xr = (const f32x4*)(x + (size_t)m * DM) + C.lane; f32x4 v[4]; float s = 0.f;
#pragma unroll
          for (int j = 0; j < 4; ++j) { v[j] = xr[64 * j]; s += (v[j][0] * v[j][0] + v[j][1] * v[j][1]) + (v[j][2] * v[j][2] + v[j][3] * v[j][3]); }
          s = wave_sum(s); if (C.lane == 0) rstd[m] = 1.0f / sqrtf(s * (1.0f / DM) + NEPS);
          unsigned long long* o8 = (unsigned long long*)(xb + (size_t)m * DM) + C.lane;
#pragma unroll
          for (int j = 0; j < 4; ++j) o8[64 * j] = (unsigned long long)pk2(v[j][0], v[j][1]) | ((unsigned long long)pk2(v[j][2], v[j][3]) << 32); } }
    { float* rc = (float*)(ws + WS_ROPEC); float* rsn = (float*)(ws + WS_ROPES);
      for (int i = C.gtid; i < SEQ * 32; i += C.nthr) { const int t = i >> 5, j = i & 31; const float inv = (float)pow(10000.0, -(double)j / 32.0); const float ang = (float)t * inv;
          rc[i] = (float)cos((double)ang); rsn[i] = (float)sin((double)ang); } }
    { float* cbias = (float*)(ws + WS_CBIAS);
      for (int i = C.gtid; i < 512; i += C.nthr) { const int kv = i >> 8, j = i & 255; const float* pe = kv ? a.in[15] : a.in[12]; const float* w1 = kv ? a.in[16] : a.in[13]; float s = 0.f;
          for (int k = 0; k < 2048; ++k) s += pe[k] * w1[(size_t)k * 256 + j]; cbias[i] = s; } }
}

__device__ __forceinline__ void m1_conv_gates(const Ctx& C, const Args& a) {
    unsigned char* ws = a.ws; const bf16_t* qkpre = (const bf16_t*)(ws + WS_QKPRE); float* qkf = (float*)(ws + WS_QKF); const float* cw = a.in[3]; const float* cb = a.in[4];
    for (int i = C.gtid; i < TT * 512; i += C.nthr) { const int t = i >> 9, c = i & 511, tp = t & (SEQ - 1); float s = cb[c];
#pragma unroll
        for (int k = 0; k < 4; ++k) { const int d = 3 - k; if (tp >= d) s += cw[k * 512 + c] * bf2f(qkpre[(size_t)(t - d) * 512 + c]); }
        qkf[i] = s * sigm(s); }
    const float* sg = (const float*)(ws + WS_SMALLG); float* ipre = (float*)(ws + WS_IPRE); float* logf = (float*)(ws + WS_LOGF);
    for (int i = C.gtid; i < TT * 4; i += C.nthr) { const int t = i >> 2, h = i & 3; ipre[i] = sg[t * 32 + h] + a.in[5][h]; const float xf = sg[t * 32 + 4 + h] + a.in[6][h];
        logf[i] = xf >= 0.f ? -log1pf(expf(-xf)) : xf - log1pf(expf(xf)); }
}
__device__ __forceinline__ void m2_mlstm_cmphid(const Ctx& C, const Args& a) {
    unsigned char* ws = a.ws; const float* qkf = (const float*)(ws + WS_QKF); const bf16_t* mv = (const bf16_t*)(ws + WS_MV); const float* ipre = (const float*)(ws + WS_IPRE); const float* logf = (const float*)(ws + WS_LOGF);
    float* hraw = (float*)(ws + WS_HRAW);
    for (int i = C.gtid; i < NB * 512; i += C.nthr) { const int b = i >> 9, h = (i >> 7) & 3, e = i & 127; float Cs[64], n[64];
#pragma unroll
        for (int d = 0; d < 64; ++d) { Cs[d] = 0.f; n[d] = 0.f; }
        float m = 0.f;
        for (int tp = 0; tp < SEQ; ++tp) { const int t = b * SEQ + tp; const float lf = logf[t * 4 + h], ip = ipre[t * 4 + h]; const float mn = fmaxf(lf + m, ip); const float dec = expf(lf + m - mn), sc = expf(ip - mn); m = mn;
            const float v = bf2f(mv[(size_t)t * 512 + h * 128 + e]); const float* q = qkf + (size_t)t * 512 + h * 64; const float* k = q + 256; float num = 0.f, den = 0.f;
#pragma unroll
            for (int d = 0; d < 64; ++d) { const float kd = k[d]; Cs[d] = dec * Cs[d] + sc * kd * v; n[d] = dec * n[d] + sc * kd; const float qd = q[d] * 0.125f; num += qd * Cs[d]; den += qd * n[d]; }
            hraw[(size_t)t * 512 + h * 128 + e] = num / fmaxf(fabsf(den), expf(-m)); } }
}
__device__ __forceinline__ void m3_hm_cmpout(const Ctx& C, const Args& a) {
    unsigned char* ws = a.ws; const float* hraw = (const float*)(ws + WS_HRAW); const bf16_t* mo = (const bf16_t*)(ws + WS_MO); bf16_t* hmon = (bf16_t*)(ws + WS_HMON); const float* onw = a.in[7];
    for (int i = C.gtid; i < TT * 4; i += C.nthr) { const int t = i >> 2, h = i & 3; const float* r = hraw + (size_t)t * 512 + h * 128; float s = 0.f;
        for (int e = 0; e < 128; ++e) s += r[e] * r[e];
        const float rs = 1.0f / sqrtf(s * (1.0f / 128.f) + NEPS);
        for (int e = 0; e < 128; ++e) hmon[(size_t)t * 1024 + h * 128 + e] = (bf16_t)f2bf(r[e] * rs * onw[h * 128 + e] * sigm(bf2f(mo[(size_t)t * 512 + h * 128 + e]))); }
    const bf16_t* hid = (const bf16_t*)(ws + WS_CMPH); bf16_t* cmpb = (bf16_t*)(ws + WS_CMPB);
    for (int i = C.gtid; i < 16 * 512 * 64; i += C.nthr) { const int o = i & 63, r = i >> 6, kv = r >> 12; const float* w2 = kv ? a.in[17] : a.in[14]; float s = 0.f;
        if ((r & 511) < NCMP) for (int j = 0; j < 256; ++j) s += bf2f(hid[(size_t)r * 256 + j]) * w2[j * 64 + o];
        cmpb[i] = (bf16_t)f2bf(s); }
}
__device__ __forceinline__ float nsa_gate(const float* sg, int t, int head, int br) { return sigm(sg[(size_t)t * 32 + 8 + head * 3 + br]); }
__device__ __forceinline__ void m4_cmpattn(const Ctx& C, const Args& a) {
    unsigned char* ws = a.ws; const bf16_t* nq = (const bf16_t*)(ws + WS_NQ); const bf16_t* cmpb = (const bf16_t*)(ws + WS_CMPB); const float* sg = (const float*)(ws + WS_SMALLG);
    bf16_t* hmon = (bf16_t*)(ws + WS_HMON); float* imp = (float*)(ws + WS_IMP);
    for (int i = C.gtid; i < TT * 2; i += C.nthr) { const int t = i >> 1, g = i & 1, b = t >> 13, tp = t & (SEQ - 1); const int nvalid = tp >= 31 ? (tp - 31) / 16 + 1 : 0;
        const bf16_t* kc = cmpb + (size_t)((0 * 8 + b * 2 + g) * 512) * 64; const bf16_t* vc = cmpb + (size_t)((1 * 8 + b * 2 + g) * 512) * 64;
        float* im = imp + (size_t)i * NSEL; for (int j = 0; j < NSEL; ++j) im[j] = 0.f;
        for (int hg = 0; hg < 4; ++hg) { const bf16_t* qp = nq + (size_t)t * 512 + (g * 4 + hg) * 64; float q[64], o[64];
#pragma unroll
            for (int d = 0; d < 64; ++d) { q[d] = bf2f(qp[d]); o[d] = 0.f; }
            if (nvalid > 0) { float m = -INFINITY;
                for (int c = 0; c < nvalid; ++c) { float s = 0.f;
#pragma unroll
                    for (int d = 0; d < 64; ++d) s += q[d] * bf2f(kc[c * 64 + d]);
                    m = fmaxf(m, s); }
                float l = 0.f;
                for (int c = 0; c < nvalid; ++c) { float s = 0.f;
#pragma unroll
                    for (int d = 0; d < 64; ++d) s += q[d] * bf2f(kc[c * 64 + d]);
                    l += exp2f(s - m); }
                const float il = 1.0f / l;
                for (int c = 0; c < nvalid; ++c) { float s = 0.f;
#pragma unroll
                    for (int d = 0; d < 64; ++d) s += q[d] * bf2f(kc[c * 64 + d]);
                    const float p = exp2f(s - m) * il;
#pragma unroll
                    for (int d = 0; d < 64; ++d) o[d] += p * bf2f(vc[c * 64 + d]);
                    im[c >> 2] += p; if ((c & 3) == 3 && (c >> 2) + 1 < NSEL) im[(c >> 2) + 1] += p; } }
            const float g0 = nsa_gate(sg, t, g * 4 + hg, 0); bf16_t* op = hmon + (size_t)t * 1024 + 512 + (g * 4 + hg) * 64;
#pragma unroll
            for (int d = 0; d < 64; ++d) op[d] = (bf16_t)f2bf(g0 * o[d]); } }
}
__device__ __forceinline__ void m5_topk(const Ctx& C, const Args& a) {
    unsigned char* ws = a.ws; float* imp = (float*)(ws + WS_IMP); int* idx = (int*)(ws + WS_IDX); unsigned* sel = (unsigned*)(ws + WS_SEL);
    for (int i = C.gtid; i < TT * 2; i += C.nthr) { const int t = i >> 1, tp = t & (SEQ - 1), cur = tp >> 6; float* im = imp + (size_t)i * NSEL;
        for (int j = 0; j < NSEL; ++j) { float v = im[j]; if (j == 0 || j == cur || j == cur - 1) v = 1e4f; if (j > cur) v = -1e30f; im[j] = v; }
        unsigned long long tk0 = 0ull, tk1 = 0ull;
        for (int r = 0; r < 16; ++r) { float best = -INFINITY; int bj = 0;
            for (int j = 0; j < NSEL; ++j) { const bool taken = j < 64 ? ((tk0 >> j) & 1ull) : ((tk1 >> (j - 64)) & 1ull); if (!taken && im[j] > best) { best = im[j]; bj = j; } }
            if (bj < 64) tk0 |= 1ull << bj; else tk1 |= 1ull << (bj - 64);
            idx[(size_t)i * 16 + r] = bj; }
        sel[(size_t)i * 4 + 0] = (unsigned)tk0; sel[(size_t)i * 4 + 1] = (unsigned)(tk0 >> 32); sel[(size_t)i * 4 + 2] = (unsigned)tk1; sel[(size_t)i * 4 + 3] = (unsigned)(tk1 >> 32); }
}
__device__ __forceinline__ void m6_slc_win(const Ctx& C, const Args& a) {
    unsigned char* ws = a.ws; const bf16_t* nq = (const bf16_t*)(ws + WS_NQ); const bf16_t* ks = (const bf16_t*)(ws + WS_KS); const bf16_t* vs = (const bf16_t*)(ws + WS_VS);
    const bf16_t* kw = (const bf16_t*)(ws + WS_KW); const bf16_t* vw = (const bf16_t*)(ws + WS_VW); const float* sg = (const float*)(ws + WS_SMALLG); const int* idx = (const int*)(ws + WS_IDX); bf16_t* hmon = (bf16_t*)(ws + WS_HMON);
    for (int i = C.gtid; i < TT * 8; i += C.nthr) { const int hg = i & 3, tg = i >> 2, g = tg & 1, t = tg >> 1, b = t >> 13, tp = t & (SEQ - 1); const size_t tb = (size_t)b * SEQ;
        const bf16_t* qp = nq + (size_t)t * 512 + (g * 4 + hg) * 64; float q[64], o[64];
#pragma unroll
        for (int d = 0; d < 64; ++d) { q[d] = bf2f(qp[d]); o[d] = 0.f; }
        float m = -INFINITY, l = 0.f;
        for (int r = 0; r < 16; ++r) { const int blk = idx[(size_t)tg * 16 + r];
            for (int off = 0; off < 64; ++off) { const int pos = blk * 64 + off; if (pos > tp) break;
                const bf16_t* k = ks + (tb + pos) * 128 + g * 64; const bf16_t* v = vs + (tb + pos) * 128 + g * 64; float s = 0.f;
#pragma unroll
                for (int d = 0; d < 64; ++d) s += q[d] * bf2f(k[d]);
                const float mn = fmaxf(m, s); const float al = exp2f(m - mn), p = exp2f(s - mn); m = mn; l = l * al + p;
#pragma unroll
                for (int d = 0; d < 64; ++d) o[d] = o[d] * al + p * bf2f(v[d]); } }
        const float g1 = nsa_gate(sg, t, g * 4 + hg, 1) / l; bf16_t* op = hmon + (size_t)t * 1024 + 512 + (g * 4 + hg) * 64;
#pragma unroll
        for (int d = 0; d < 64; ++d) { op[d] = (bf16_t)f2bf(bf2f(op[d]) + g1 * o[d]); o[d] = 0.f; }
        m = -INFINITY; l = 0.f; const int p0 = tp - 511 > 0 ? tp - 511 : 0;
        for (int pos = p0; pos <= tp; ++pos) { const bf16_t* k = kw + (tb + pos) * 128 + g * 64; const bf16_t* v = vw + (tb + pos) * 128 + g * 64; float s = 0.f;
#pragma unroll
            for (int d = 0; d < 64; ++d) s += q[d] * bf2f(k[d]);
            const float mn = fmaxf(m, s); const float al = exp2f(m - mn), p = exp2f(s - mn); m = mn; l = l * al + p;
#pragma unroll
            for (int d = 0; d < 64; ++d) o[d] = o[d] * al + p * bf2f(v[d]); }
        const float g2 = nsa_gate(sg, t, g * 4 + hg, 2) / l;
#pragma unroll
        for (int d = 0; d < 64; ++d) op[d] = (bf16_t)f2bf(bf2f(op[d]) + g2 * o[d]); }
}
__device__ __forceinline__ void p7b_fixup(const Ctx& C, const Args& a) {
    unsigned char* ws = a.ws; const float* eA = (const float*)(ws + WS_EDGEA); const float* eV = (const float*)(ws + WS_EDGEV); bf16_t* mid = (bf16_t*)(ws + WS_MID); const float* cw = a.in[24]; const float* cb = a.in[25];
    for (int i = C.gtid; i < 128 * 2 * DFF; i += C.nthr) { const int c = i % DFF, r = (i / DFF) & 1, pm = i / (2 * DFF); const bool first = (pm & 31) == 0;
        const float x0 = eA[((size_t)pm * 4 + r) * DFF + c];
        const float pA = first ? 0.f : eA[((size_t)(pm - 1) * 4 + 3) * DFF + c], pB = first ? 0.f : eA[((size_t)(pm - 1) * 4 + 2) * DFF + c];
        const float p1 = r == 1 ? eA[((size_t)pm * 4 + 0) * DFF + c] : pA, p2 = r == 1 ? pA : pB;
        const float cv = cw[2 * DFF + c] * x0 + cw[DFF + c] * p1 + cw[c] * p2 + cb[c];
        const pg8::f32x2 gl = pg8::gelu_pk((pg8::f32x2){cv, 0.f});
        mid[(size_t)(pm * 256 + r) * DFF + c] = (bf16_t)f2bf(gl.x * eV[((size_t)pm * 2 + r) * DFF + c]); }
}
#ifndef PG8_SP2
#define PG8_SP2 true
#endif
#define WSP(T, off) ((T*)(ws + (off)))
__device__ __forceinline__ Ctx make_ctx(unsigned char* lds_raw) {
    Ctx C; C.lds = (LAS unsigned char*)lds_raw; { int t_ = threadIdx.x; asm volatile("" : "+v"(t_)); C.tid = t_; } C.lane = C.tid & 63; C.wave = __builtin_amdgcn_readfirstlane(C.tid >> 6); C.G = gridDim.x;
    C.vcu = blockIdx.x; C.gw = blockIdx.x * 8 + C.wave; C.ngw = C.G * 8; C.gtid = blockIdx.x * 512 + C.tid; C.nthr = C.G * 512; return C; }
__device__ __forceinline__ void run_ph0(unsigned char* lds_raw, const Args& args) { const Ctx C = make_ctx(lds_raw); unsigned char* ws = args.ws;
    phase_prologue(C, args);
}
__device__ __forceinline__ void run_ph1(unsigned char* lds_raw, const Args& args) { const Ctx C = make_ctx(lds_raw); unsigned char* ws = args.ws;
    { pg8::Gemm g{WSP(bf16_t, WS_XB), WSP(bf16_t, WS_WIN), TT, 3072, 1024, 1024, 128}; pg8::StaticOrder S; S.init(TT, 3072, C.G, (int)blockIdx.x);
      pg8::EpiInProj E{ws, args.in[8], args.in[9], args.in[10], args.in[11]};
      pg8::gemm_phase<pg8::EpiInProj, pg8::StaticOrder, true, PG8_SP2>(C.lds, g, S, E); }
}
__device__ __forceinline__ void run_ph2(unsigned char* lds_raw, const Args& args) { const Ctx C = make_ctx(lds_raw); unsigned char* ws = args.ws;
    { pg8::Gemm g{nullptr, nullptr, 8192, 256, 2048, 2048, 256}; pg8::CmpOrder S{C.G, (int)blockIdx.x, WSP(bf16_t, WS_KC), WSP(bf16_t, WS_VC), WSP(bf16_t, WS_CW1)};
      pg8::EpiCmpHid E{WSP(float, WS_CBIAS), WSP(bf16_t, WS_CMPH)};
      pg8::gemm_phase<pg8::EpiCmpHid, pg8::CmpOrder, true, PG8_SP2>(C.lds, g, S, E); }
    m1_conv_gates(C, args);
}
__device__ __forceinline__ void run_ph3(unsigned char* lds_raw, const Args& args) { const Ctx C = make_ctx(lds_raw); unsigned char* ws = args.ws;
    m2_mlstm_cmphid(C, args);
}
__device__ __forceinline__ void run_ph4(unsigned char* lds_raw, const Args& args) { const Ctx C = make_ctx(lds_raw); unsigned char* ws = args.ws;
    m3_hm_cmpout(C, args);
}
__device__ __forceinline__ void run_ph5(unsigned char* lds_raw, const Args& args) { const Ctx C = make_ctx(lds_raw); unsigned char* ws = args.ws;
    m4_cmpattn(C, args);
}
__device__ __forceinline__ void run_ph6(unsigned char* lds_raw, const Args& args) { const Ctx C = make_ctx(lds_raw); unsigned char* ws = args.ws;
    m5_topk(C, args);
}
__device__ __forceinline__ void run_ph7(unsigned char* lds_raw, const Args& args) { const Ctx C = make_ctx(lds_raw); unsigned char* ws = args.ws;
    m6_slc_win(C, args);
}
__device__ __forceinline__ void run_ph8(unsigned char* lds_raw, const Args& args) { const Ctx C = make_ctx(lds_raw); unsigned char* ws = args.ws;
    { pg8::Gemm g{WSP(bf16_t, WS_XB), WSP(bf16_t, WS_WG), TT, 2048, 1024, 1024, 128}; pg8::StaticOrder S; S.init(TT, 2048, C.G, (int)blockIdx.x);
      pg8::EpiGate E{WSP(float, WS_RSTD1), args.in[20], WSP(bf16_t, WS_GM), WSP(bf16_t, WS_GN)};
      pg8::gemm_phase<pg8::EpiGate, pg8::StaticOrder, true, PG8_SP2>(C.lds, g, S, E); }
}
__device__ __forceinline__ void run_ph9(unsigned char* lds_raw, const Args& args) { const Ctx C = make_ctx(lds_raw); unsigned char* ws = args.ws;
    { pg8::Gemm g{WSP(bf16_t, WS_HMON), WSP(bf16_t, WS_WMN), TT, 1024, 1024, 1024, 128}; pg8::StaticOrder S; S.init(TT, 1024, C.G, (int)blockIdx.x);
      pg8::EpiMerge E{WSP(bf16_t, WS_GM), WSP(bf16_t, WS_GN), WSP(bf16_t, WS_Y)};
      pg8::gemm_phase<pg8::EpiMerge, pg8::StaticOrder, true, PG8_SP2>(C.lds, g, S, E); }
}
__device__ __forceinline__ void run_ph10(unsigned char* lds_raw, const Args& args) { const Ctx C = make_ctx(lds_raw); unsigned char* ws = args.ws;
    { pg8::Gemm g{WSP(bf16_t, WS_Y), WSP(bf16_t, WS_WOUT), TT, 1024, 1024, 1024, 128}; pg8::StaticOrder S; S.init(TT, 1024, C.G, (int)blockIdx.x);
      pg8::EpiWout E{args.in[0], args.out, WSP(bf16_t, WS_XB), WSP(float, WS_SSQ2)};
      pg8::gemm_phase<pg8::EpiWout, pg8::StaticOrder, true, PG8_SP2>(C.lds, g, S, E); }
}
__device__ __forceinline__ void run_ph11(unsigned char* lds_raw, const Args& args) { const Ctx C = make_ctx(lds_raw); unsigned char* ws = args.ws;
    { pg8::Gemm g{WSP(bf16_t, WS_XB), WSP(bf16_t, WS_WUP), TT, 5632, 1024, 1024, 128}; pg8::StaticOrder S; S.init(TT, 5632, C.G, (int)blockIdx.x);
      pg8::EpiFfnUp E{WSP(float, WS_SSQ2), args.in[24], args.in[25], WSP(bf16_t, WS_MID), WSP(float, WS_EDGEA), WSP(float, WS_EDGEV), (LAS float*)(C.lds + LDS_EX)};
      pg8::gemm_phase<pg8::EpiFfnUp, pg8::StaticOrder, true, PG8_SP2>(C.lds, g, S, E); }
}
__device__ __forceinline__ void run_ph12(unsigned char* lds_raw, const Args& args) { const Ctx C = make_ctx(lds_raw); unsigned char* ws = args.ws;
    p7b_fixup(C, args);
}
__device__ __forceinline__ void run_ph13(unsigned char* lds_raw, const Args& args) { const Ctx C = make_ctx(lds_raw); unsigned char* ws = args.ws;
    { pg8::Gemm g{WSP(bf16_t, WS_MID), WSP(bf16_t, WS_WDN), TT, 1024, 2816, 2816, 128}; pg8::StaticOrder S; S.init(TT, 1024, C.G, (int)blockIdx.x);
      pg8::EpiFfnDown E{args.out};
      pg8::gemm_phase<pg8::EpiFfnDown, pg8::StaticOrder, true, PG8_SP2>(C.lds, g, S, E); }
}
constexpr int NPHASE = 14;
#ifndef SPLIT_TEST
__global__ void __launch_bounds__(512, 2) mega_fwd(Args args) {
    extern __shared__ __attribute__((aligned(16))) unsigned char lds_raw[];
    cg::grid_group grid = cg::this_grid();
    run_ph0(lds_raw, args);
    grid.sync();
    run_ph1(lds_raw, args);
    grid.sync();
    run_ph2(lds_raw, args);
    grid.sync();
    run_ph3(lds_raw, args);
    grid.sync();
    run_ph4(lds_raw, args);
    grid.sync();
    run_ph5(lds_raw, args);
    grid.sync();
    run_ph6(lds_raw, args);
    grid.sync();
    run_ph7(lds_raw, args);
    grid.sync();
    run_ph8(lds_raw, args);
    grid.sync();
    run_ph9(lds_raw, args);
    grid.sync();
    run_ph10(lds_raw, args);
    grid.sync();
    run_ph11(lds_raw, args);
    grid.sync();
    run_ph12(lds_raw, args);
    grid.sync();
    run_ph13(lds_raw, args);
}
#else
__global__ void __launch_bounds__(512, 2) ph0_k(Args args) { extern __shared__ __attribute__((aligned(16))) unsigned char lds_raw[]; run_ph0(lds_raw, args); }
__global__ void __launch_bounds__(512, 2) ph1_k(Args args) { extern __shared__ __attribute__((aligned(16))) unsigned char lds_raw[]; run_ph1(lds_raw, args); }
__global__ void __launch_bounds__(512, 2) ph2_k(Args args) { extern __shared__ __attribute__((aligned(16))) unsigned char lds_raw[]; run_ph2(lds_raw, args); }
__global__ void __launch_bounds__(512, 2) ph3_k(Args args) { extern __shared__ __attribute__((aligned(16))) unsigned char lds_raw[]; run_ph3(lds_raw, args); }
__global__ void __launch_bounds__(512, 2) ph4_k(Args args) { extern __shared__ __attribute__((aligned(16))) unsigned char lds_raw[]; run_ph4(lds_raw, args); }
__global__ void __launch_bounds__(512, 2) ph5_k(Args args) { extern __shared__ __attribute__((aligned(16))) unsigned char lds_raw[]; run_ph5(lds_raw, args); }
__global__ void __launch_bounds__(512, 2) ph6_k(Args args) { extern __shared__ __attribute__((aligned(16))) unsigned char lds_raw[]; run_ph6(lds_raw, args); }
__global__ void __launch_bounds__(512, 2) ph7_k(Args args) { extern __shared__ __attribute__((aligned(16))) unsigned char lds_raw[]; run_ph7(lds_raw, args); }
__global__ void __launch_bounds__(512, 2) ph8_k(Args args) { extern __shared__ __attribute__((aligned(16))) unsigned char lds_raw[]; run_ph8(lds_raw, args); }
__global__ void __launch_bounds__(512, 2) ph9_k(Args args) { extern __shared__ __attribute__((aligned(16))) unsigned char lds_raw[]; run_ph9(lds_raw, args); }
__global__ void __launch_bounds__(512, 2) ph10_k(Args args) { extern __shared__ __attribute__((aligned(16))) unsigned char lds_raw[]; run_ph10(lds_raw, args); }
__global__ void __launch_bounds__(512, 2) ph11_k(Args args) { extern __shared__ __attribute__((aligned(16))) unsigned char lds_raw[]; run_ph11(lds_raw, args); }
__global__ void __launch_bounds__(512, 2) ph12_k(Args args) { extern __shared__ __attribute__((aligned(16))) unsigned char lds_raw[]; run_ph12(lds_raw, args); }
__global__ void __launch_bounds__(512, 2) ph13_k(Args args) { extern __shared__ __attribute__((aligned(16))) unsigned char lds_raw[]; run_ph13(lds_raw, args); }
__global__ void __launch_bounds__(512, 2) mega_fwd(Args args) {}
#endif
extern "C" void kernel_launch(void* const* d_in, const int* in_sizes, int n_in, void* d_out, int out_size, void* d_ws, size_t ws_size, hipStream_t stream) {
    static int grid = 0;
    if (grid == 0) {
        if (n_in != 27 || out_size != TT * DM || ws_size < WS_END) { fprintf(stderr, "kernel_launch: unexpected shapes (n_in %d out %d ws %zu)\n", n_in, out_size, ws_size); grid = -1; return; }
        int dev = 0, cus = 0, per_cu = 0;
        hipGetDevice(&dev); hipDeviceGetAttribute(&cus, hipDeviceAttributeMultiprocessorCount, dev);
        hipFuncSetAttribute((const void*)mega_fwd, hipFuncAttributeMaxDynamicSharedMemorySize, LDS_BYTES);
        hipOccupancyMaxActiveBlocksPerMultiprocessor(&per_cu, (const void*)mega_fwd, 512, LDS_BYTES);
        if (per_cu < 1) { fprintf(stderr, "kernel_launch: occupancy query says %d blocks per CU\n", per_cu); grid = -1; return; }
        grid = cus * 1;
    }
    if (grid < 0) return;
    hipMemsetAsync((char*)d_ws + WS_CTL, 0, 1 * MiB, stream);
    Args a{}; for (int i = 0; i < 27; ++i) a.in[i] = (const float*)d_in[i]; a.out = (float*)d_out; a.ws = (unsigned char*)d_ws;
    void* kargs[] = {&a};
    hipError_t e = hipLaunchCooperativeKernel((const void*)mega_fwd, dim3(grid), dim3(512), kargs, LDS_BYTES, stream);
    if (e != hipSuccess) fprintf(stderr, "cooperative launch failed: %s (grid %d)\n", hipGetErrorString(e), grid);
}
```

```cpp
#include <hip/hip_runtime.h>
#include <hip/hip_cooperative_groups.h>
#include <cstdio>
#include <cstdint>
namespace cg = cooperative_groups;
constexpr int NB = 4, DM = 1024, DIN = 4896, DFF = 2816, NCMP = 511, NSEL = 128;
constexpr int C_MQ = 0, C_MK = 256, C_MV = 512, C_MO = 1024, C_MI = 1536, C_MF = 1540, C_NQ = 1544, C_KC = 2056, C_VC = 2184, C_KS = 2312, C_VS = 2440, C_KW = 2568, C_VW = 2696, C_NG = 2824, C_GM = 2848;
constexpr size_t MiB = 1u << 20;
constexpr size_t WS_CTL = 0;
constexpr size_t WS_ROPEC = 1 * MiB, WS_ROPES = 2 * MiB, WS_RSTD1 = 3 * MiB, WS_SSQ2 = 4 * MiB, WS_SMALLG = 6 * MiB, WS_SEL = 10 * MiB, WS_CMPB = 11 * MiB, WS_CBIAS = 12 * MiB;
constexpr size_t WS_EDGEA = 13 * MiB, WS_EDGEV = 19 * MiB, WS_IPRE = 22 * MiB, WS_LOGF = 22 * MiB + 524288, WS_MLS = 23 * MiB;
constexpr size_t WS_WIN = 24 * MiB  , WS_WG = 30 * MiB  , WS_WMN = 34 * MiB, WS_WOUT = 36 * MiB, WS_WUP = 38 * MiB, WS_WDN = 49 * MiB, WS_CW1 = 55 * MiB;
constexpr size_t WS_XB = 60 * MiB;
constexpr size_t WS_QKPRE = 124 * MiB, WS_MV = 156 * MiB, WS_MO = 188 * MiB, WS_NQ = 220 * MiB, WS_KC = 252 * MiB, WS_KS = 260 * MiB, WS_KW = 268 * MiB, WS_VC = 276 * MiB, WS_VS = 284 * MiB, WS_VW = 292 * MiB;
constexpr size_t WS_HMON = 300 * MiB;
constexpr size_t WS_DC = 364 * MiB, WS_CPREV = 428 * MiB, WS_CMPH = 492 * MiB;
constexpr size_t WS_GM = 124 * MiB, WS_GN = 188 * MiB;
constexpr size_t WS_Y = 364 * MiB;
constexpr size_t WS_MID = 124 * MiB;
constexpr size_t WS_END = 500 * MiB;
constexpr size_t WS_QKF = 364 * MiB  , WS_HRAW = 428 * MiB  , WS_IMP = 364 * MiB  , WS_IDX = 396 * MiB  ;
constexpr int RING_BYTES = 131072, LDS_EX = RING_BYTES  , LDS_BYTES = 147456;

namespace pg8 {
#define PG8_LAS __attribute__((address_space(3)))
typedef unsigned short bf16_t;
typedef short bf16x8 __attribute__((ext_vector_type(8)));
typedef float f32x4 __attribute__((ext_vector_type(4)));
typedef unsigned u32x4 __attribute__((ext_vector_type(4)));
constexpr int BM = 256, BK = 64, HALF = 128, HTB = HALF * BK * 2  , STAGE_BYTES = 8 * HTB, NXCD = 8, WGM = 8;

__host__ __device__ __forceinline__ int lds_byte(int r, int c) { const int st = (r >> 4) * 2 + (c >> 5), rr = r & 15, cc = c & 31, ob = rr * 64 + cc * 2; return st * 1024 + (ob ^ (((ob >> 9) & 1) << 5)); }
__host__ __device__ __forceinline__ void stage_rc(int b, int& R, int& C) { const int st = b / 1024, sb = b % 1024, swz = sb ^ (((sb >> 9) & 1) << 5); R = (st >> 1) * 16 + swz / 64; C = (st & 1) * 32 + (swz % 64) / 2; }
__host__ __device__ __forceinline__ int perm32(int rho) { const int n = rho >> 4, i = rho & 15; return 8 * (i >> 2) + 4 * n + (i & 3); }

struct Unit { int pm, pn; };
struct Gemm { const bf16_t* A; const bf16_t* Bt; int M, N, K; int lda; int ksA; };

struct StaticOrder {
    int nM, nN, nwg, G, c;
    __host__ __device__ void init(int M, int N, int G_, int c_) { nM = M / BM; nN = N / BM; nwg = nM * nN; G = G_; c = c_; }
    __host__ __device__ bool next(int i, Unit& u) const {
        const long L = (long)i * G + c; if (L >= nwg) return false;
        int wgid = (int)L; { const int q = nwg / NXCD, r = nwg % NXCD, xcd = wgid % NXCD, off = wgid / NXCD; wgid = (xcd < r ? xcd * (q + 1) : r * (q + 1) + (xcd - r) * q) + off; }
        const int nig = WGM * nN, gid = wgid / nig, fm = gid * WGM, gsz = (nM - fm) < WGM ? (nM - fm) : WGM;
        u.pm = fm + ((wgid % nig) % gsz); u.pn = (wgid % nig) / gsz; return true;
    }
    __device__ __forceinline__ const char* a_ptr(const Gemm& g, const Unit& u) const { return (const char*)g.A + (size_t)u.pm * BM * g.lda * 2; }
    __device__ __forceinline__ const char* b_ptr(const Gemm& g, const Unit& u) const { return (const char*)g.Bt + (size_t)u.pn * BM * g.K * 2; }
    __device__ __forceinline__ void a_ready(const Unit&) const {}
    __device__ __forceinline__ void done(const Unit&) const {}
};

__device__ __forceinline__ unsigned cvt_pk_bf16(float lo, float hi) { unsigned r; asm volatile("v_cvt_pk_bf16_f32 %0, %1, %2" : "=v"(r) : "v"(lo), "v"(hi)); return r; }
typedef float f32x2 __attribute__((ext_vector_type(2)));
__device__ __forceinline__ f32x2 gelu_pk(f32x2 v) {
    const f32x2 av = __builtin_elementwise_abs(v), d = av * 0.2316418882f + 1.0f;
    f32x2 t; t.x = __builtin_amdgcn_rcpf(d.x); t.y = __builtin_amdgcn_rcpf(d.y);
    f32x2 q = t * 0.5307027145f + (-0.7265760135f); q = q * t + 0.7107068705f; q = q * t + (-0.142248368f); q = q * t + 0.127414796f; q = q * t;
    const f32x2 s = (v * v) * (-0.72134752044f);
    f32x2 e; e.x = __builtin_amdgcn_exp2f(s.x); e.y = __builtin_amdgcn_exp2f(s.y);
    const f32x2 m = v * (q * e), r = v - m;
    f32x2 o; o.x = v.x < 0.f ? m.x : r.x; o.y = v.y < 0.f ? m.y : r.y; return o;
}

constexpr int TT = 32768, SEQ = 8192;
constexpr float NEPS = 1e-6f;
constexpr float QC2 = 0.125f * 1.4426950408889634f;
typedef unsigned u32x2 __attribute__((ext_vector_type(2)));
__device__ __forceinline__ float bf2f(unsigned short v) { return __uint_as_float((unsigned)v << 16); }
__device__ __forceinline__ float bflo(unsigned w) { return __uint_as_float(w << 16); }
__device__ __forceinline__ float bfhi(unsigned w) { return __uint_as_float(w & 0xffff0000u); }
__device__ __forceinline__ float sigm(float x) { return 1.0f / (1.0f + __expf(-x)); }
__device__ __forceinline__ u32x4 pack8(const f32x4& a, const f32x4& b) { u32x4 w; w.x = cvt_pk_bf16(a[0], a[1]); w.y = cvt_pk_bf16(a[2], a[3]); w.z = cvt_pk_bf16(b[0], b[1]); w.w = cvt_pk_bf16(b[2], b[3]); return w; }
__device__ __forceinline__ void unpack8(const u32x4& w, f32x4& a, f32x4& b) { a = (f32x4){bflo(w.x), bfhi(w.x), bflo(w.y), bfhi(w.y)}; b = (f32x4){bflo(w.z), bfhi(w.z), bflo(w.w), bfhi(w.w)}; }


struct EpiInProj {
    static constexpr bool PERM = true, AFTER_DRAIN = false, HAS_MID = false;
    unsigned char* ws; const float *qnw, *kcw, *ksw, *kww;
    __device__ __forceinline__ void mid(f32x4 (&)[2][2][4][2], const Unit&, int, int, int, int) const {}
    __device__ __forceinline__ void operator()(f32x4 (&acc)[2][2][4][2], const Unit& u, int wr, int wc, int fr, int fq) const {
        const int pn = u.pn; int row0 = u.pm * BM + wr * 64 + fr; asm volatile("" : "+v"(row0));
        const float* rstd = (const float*)(ws + WS_RSTD1); const float* rope_c = (const float*)(ws + WS_ROPEC); const float* rope_s = (const float*)(ws + WS_ROPES);
        if (pn < 6) {
            bf16_t* base = (bf16_t*)(ws + (pn < 2 ? WS_QKPRE : pn < 4 ? WS_MV : WS_MO)); const int col0 = (pn & 1) * 256 + wc * 32 + 8 * fq;
#pragma unroll
            for (int ai = 0; ai < 2; ++ai)
#pragma unroll
                for (int m = 0; m < 4; ++m) { const int row = row0 + ai * HALF + m * 16; const float rs = rstd[row]; bf16_t* rowp = base + (size_t)row * 512 + col0;
#pragma unroll
                    for (int bj = 0; bj < 2; ++bj) *(u32x4*)(rowp + bj * HALF) = pack8(acc[ai][bj][m][0] * rs, acc[ai][bj][m][1] * rs); asm volatile("" ::: "memory"); }
        } else if (pn < 11) {
            bf16_t* dst; int ld; const float* nw = nullptr; float osc = 1.0f;
            if (pn < 8) { dst = (bf16_t*)(ws + WS_NQ) + (4 * (pn - 6) + wc) * 64; ld = 512; nw = qnw; osc = QC2; }
            else { const int seg = (pn - 8) * 2 + (wc >> 1);
                const size_t so = seg == 0 ? WS_KC : seg == 1 ? WS_KS : seg == 2 ? WS_KW : seg == 3 ? WS_VC : seg == 4 ? WS_VS : WS_VW;
                dst = (bf16_t*)(ws + so) + (wc & 1) * 64; ld = 128; nw = seg == 0 ? kcw : seg == 1 ? ksw : seg == 2 ? kww : nullptr; }
#pragma unroll
            for (int ai = 0; ai < 2; ++ai)
#pragma unroll
                for (int m = 0; m < 4; ++m) { const int row = row0 + ai * HALF + m * 16; const float rs = rstd[row];
#pragma unroll
                    for (int n = 0; n < 2; ++n) { acc[ai][0][m][n] = acc[ai][0][m][n] * rs; acc[ai][1][m][n] = acc[ai][1][m][n] * rs; }
                    if (nw) {
                        float s = 0.f;
#pragma unroll
                        for (int n = 0; n < 2; ++n)
#pragma unroll
                            for (int e = 0; e < 4; ++e) s += acc[ai][0][m][n][e] * acc[ai][0][m][n][e] + acc[ai][1][m][n][e] * acc[ai][1][m][n][e];
                        s += __shfl_xor(s, 16); s += __shfl_xor(s, 32);
                        const float rn = 1.0f / sqrtf(s * (1.0f / 64.0f) + NEPS); const int tp = row & (SEQ - 1);
#pragma unroll
                        for (int n = 0; n < 2; ++n) { const f32x4 c = *(const f32x4*)(rope_c + tp * 32 + 8 * fq + 4 * n), sn = *(const f32x4*)(rope_s + tp * 32 + 8 * fq + 4 * n);
                            const f32x4 w0 = *(const f32x4*)(nw + 8 * fq + 4 * n), w1 = *(const f32x4*)(nw + 32 + 8 * fq + 4 * n);
                            const f32x4 a = acc[ai][0][m][n] * rn * w0, b = acc[ai][1][m][n] * rn * w1; acc[ai][0][m][n] = (a * c - b * sn) * osc; acc[ai][1][m][n] = (b * c + a * sn) * osc;
                            asm volatile("" : "+v"(acc[ai][0][m][n]), "+v"(acc[ai][1][m][n]) :: "memory"); }
                    }
                    bf16_t* rowp = dst + (size_t)row * ld + 8 * fq;
                    *(u32x4*)(rowp) = pack8(acc[ai][0][m][0], acc[ai][0][m][1]); *(u32x4*)(rowp + 32) = pack8(acc[ai][1][m][0], acc[ai][1][m][1]); asm volatile("" ::: "memory"); }
        } else {
            if (wc == 0) {
#pragma unroll
                for (int ai = 0; ai < 2; ++ai)
#pragma unroll
                    for (int m = 0; m < 4; ++m) { const int row = row0 + ai * HALF + m * 16; const float rs = rstd[row]; float* rowp = (float*)(ws + WS_SMALLG) + (size_t)row * 32 + 8 * fq;
                        *(f32x4*)(rowp) = acc[ai][0][m][0] * rs; *(f32x4*)(rowp + 4) = acc[ai][0][m][1] * rs; }
            }
        }
    }
};
struct EpiGate {
    static constexpr bool PERM = true, AFTER_DRAIN = false, HAS_MID = false;
    const float* rstd; const float* bias  ; bf16_t* gm; bf16_t* gn;
    __device__ __forceinline__ void mid(f32x4 (&)[2][2][4][2], const Unit&, int, int, int, int) const {}
    __device__ __forceinline__ void operator()(f32x4 (&acc)[2][2][4][2], const Unit& u, int wr, int wc, int fr, int fq) const {
        int row0 = u.pm * BM + wr * 64 + fr; asm volatile("" : "+v"(row0)); const int which = u.pn >> 2, col0 = (u.pn & 3) * 256 + wc * 32 + 8 * fq; bf16_t* base = which ? gn : gm; const float* bp = bias + which * 1024 + col0;
        f32x4 bv[2][2];
#pragma unroll
        for (int bj = 0; bj < 2; ++bj)
#pragma unroll
            for (int n = 0; n < 2; ++n) bv[bj][n] = *(const f32x4*)(bp + bj * HALF + 4 * n);
#pragma unroll
        for (int ai = 0; ai < 2; ++ai)
#pragma unroll
            for (int m = 0; m < 4; ++m) { const int row = row0 + ai * HALF + m * 16; const float rs = rstd[row]; bf16_t* rowp = base + (size_t)row * 1024 + col0;
#pragma unroll
                for (int bj = 0; bj < 2; ++bj) { f32x4 v0 = acc[ai][bj][m][0] * rs + bv[bj][0], v1 = acc[ai][bj][m][1] * rs + bv[bj][1];
#pragma unroll
                    for (int e = 0; e < 4; ++e) { v0[e] = sigm(v0[e]); v1[e] = sigm(v1[e]); }
                    *(u32x4*)(rowp + bj * HALF) = pack8(v0, v1); } }
    }
};
struct EpiMerge {
    static constexpr bool PERM = true, AFTER_DRAIN = false, HAS_MID = true;
    const bf16_t* gm; const bf16_t* gn; bf16_t* y;
    __device__ __forceinline__ void mid(f32x4 (&acc)[2][2][4][2], const Unit& u, int wr, int wc, int fr, int fq) const {
        int row0 = u.pm * BM + wr * 64 + fr; asm volatile("" : "+v"(row0)); const int col0 = u.pn * BM + wc * 32 + 8 * fq;
#pragma unroll
        for (int ai = 0; ai < 2; ++ai)
#pragma unroll
            for (int m = 0; m < 4; ++m) { const size_t off = (size_t)(row0 + ai * HALF + m * 16) * 1024 + col0;
#pragma unroll
                for (int bj = 0; bj < 2; ++bj) { const u32x4 a = *(const u32x4*)(gm + off + bj * HALF), b = *(const u32x4*)(gn + off + bj * HALF); f32x4 a0, a1, b0, b1; unpack8(a, a0, a1); unpack8(b, b0, b1);
#pragma unroll
                    for (int e = 0; e < 4; ++e) { acc[ai][bj][m][0][e] *= a0[e] * __builtin_amdgcn_rcpf(fmaxf(b0[e], 1e-30f)); acc[ai][bj][m][1][e] *= a1[e] * __builtin_amdgcn_rcpf(fmaxf(b1[e], 1e-30f)); }
                    asm volatile("" : "+v"(acc[ai][bj][m][0]), "+v"(acc[ai][bj][m][1]) :: "memory"); }
                asm volatile("" : "+v"(acc[ai][0][m][0]), "+v"(acc[ai][0][m][1]), "+v"(acc[ai][1][m][0]), "+v"(acc[ai][1][m][1]) :: "memory"); }
    }
    __device__ __forceinline__ void operator()(f32x4 (&acc)[2][2][4][2], const Unit& u, int wr, int wc, int fr, int fq) const {
        int row0 = u.pm * BM + wr * 64 + fr; asm volatile("" : "+v"(row0)); const int col0 = u.pn * BM + wc * 32 + 8 * fq;
#pragma unroll
        for (int ai = 0; ai < 2; ++ai)
#pragma unroll
            for (int m = 0; m < 4; ++m) { const size_t off = (size_t)(row0 + ai * HALF + m * 16) * 1024 + col0;
#pragma unroll
                for (int bj = 0; bj < 2; ++bj) { const u32x4 b = *(const u32x4*)(gn + off + bj * HALF); f32x4 b0, b1; unpack8(b, b0, b1);
                    *(u32x4*)(y + off + bj * HALF) = pack8(acc[ai][bj][m][0] * b0, acc[ai][bj][m][1] * b1); } }
    }
};
struct EpiWout {
    static constexpr bool PERM = true, AFTER_DRAIN = false, HAS_MID = false;
    const float* x; float* x1; bf16_t* x1b; float* ssq  ;
    __device__ __forceinline__ void mid(f32x4 (&)[2][2][4][2], const Unit&, int, int, int, int) const {}
    __device__ __forceinline__ void operator()(f32x4 (&acc)[2][2][4][2], const Unit& u, int wr, int wc, int fr, int fq) const {
        int row0 = u.pm * BM + wr * 64 + fr; asm volatile("" : "+v"(row0)); const int col0 = u.pn * BM + wc * 32 + 8 * fq;
#pragma unroll
        for (int ai = 0; ai < 2; ++ai)
#pragma unroll
            for (int m = 0; m < 4; ++m) { const int row = row0 + ai * HALF + m * 16; const size_t off = (size_t)row * 1024 + col0; float s = 0.f;
#pragma unroll
                for (int bj = 0; bj < 2; ++bj) { const f32x4 v0 = *(const f32x4*)(x + off + bj * HALF) + acc[ai][bj][m][0], v1 = *(const f32x4*)(x + off + bj * HALF + 4) + acc[ai][bj][m][1];
                    *(f32x4*)(x1 + off + bj * HALF) = v0; *(f32x4*)(x1 + off + bj * HALF + 4) = v1; *(u32x4*)(x1b + off + bj * HALF) = pack8(v0, v1);
#pragma unroll
                    for (int e = 0; e < 4; ++e) s += v0[e] * v0[e] + v1[e] * v1[e]; }
                s += __shfl_xor(s, 16); s += __shfl_xor(s, 32);
                if (fq == 0) ssq[(size_t)row * 16 + u.pn * 4 + wc] = s; }
    }
};
__device__ __forceinline__ float dpp_shr(float old, float v, int n) { return n == 1 ? __builtin_bit_cast(float, __builtin_amdgcn_update_dpp(__builtin_bit_cast(int, old), __builtin_bit_cast(int, v), 0x111, 0xf, 0xf, false))
                                                                                       : __builtin_bit_cast(float, __builtin_amdgcn_update_dpp(__builtin_bit_cast(int, old), __builtin_bit_cast(int, v), 0x112, 0xf, 0xf, false)); }
__device__ __forceinline__ float dpp_shl15(float v) { return __builtin_bit_cast(float, __builtin_amdgcn_update_dpp(0, __builtin_bit_cast(int, v), 0x10F, 0xf, 0xf, true)); }
__device__ __forceinline__ float dpp_shl14(float v) { return __builtin_bit_cast(float, __builtin_amdgcn_update_dpp(0, __builtin_bit_cast(int, v), 0x10E, 0xf, 0xf, true)); }
struct EpiFfnUp {
    static constexpr bool PERM = true, AFTER_DRAIN = false, HAS_MID = false;
    const float* ssq; const float* cw  ; const float* cb; bf16_t* midb; float* edgeA  ; float* edgeV  ; PG8_LAS float* ex  ;
    __device__ __forceinline__ void mid(f32x4 (&)[2][2][4][2], const Unit&, int, int, int, int) const {}
    __device__ __forceinline__ void operator()(f32x4 (&acc)[2][2][4][2], const Unit& u, int wr, int wc, int fr, int fq) const {
        constexpr int FF = 2816;
        int row0 = u.pm * BM + wr * 64 + fr; asm volatile("" : "+v"(row0)); const int cl = wc * 32 + 8 * fq, col0 = u.pn * 128 + cl;
#pragma unroll
        for (int ai = 0; ai < 2; ++ai)
#pragma unroll
            for (int m = 0; m < 4; ++m) { const int row = row0 + ai * HALF + m * 16; const f32x4* sp = (const f32x4*)(ssq + (size_t)row * 16); const f32x4 s0 = sp[0], s1 = sp[1], s2 = sp[2], s3 = sp[3];
                const float ss = ((s0[0] + s0[1]) + (s0[2] + s0[3])) + ((s1[0] + s1[1]) + (s1[2] + s1[3])) + ((s2[0] + s2[1]) + (s2[2] + s2[3])) + ((s3[0] + s3[1]) + (s3[2] + s3[3]));
                const float rs = 1.0f / sqrtf(ss * (1.0f / 1024.0f) + NEPS);
#pragma unroll
                for (int n = 0; n < 2; ++n) { acc[ai][0][m][n] = acc[ai][0][m][n] * rs; acc[ai][1][m][n] = acc[ai][1][m][n] * rs; }
                asm volatile("" : "+v"(acc[ai][0][m][0]), "+v"(acc[ai][0][m][1]), "+v"(acc[ai][1][m][0]), "+v"(acc[ai][1][m][1]) :: "memory"); }
#pragma unroll
        for (int ai = 0; ai < 2; ++ai) { const int s = ai * 2 + wr;
            if (fr >= 14) { PG8_LAS float* p = ex + (s * 2 + (fr - 14)) * 128 + cl; *(PG8_LAS f32x4*)(p) = acc[ai][0][3][0]; *(PG8_LAS f32x4*)(p + 4) = acc[ai][0][3][1]; } }
        if (wr == 0 && fr < 2) { float* pa = edgeA + ((size_t)u.pm * 4 + fr) * FF + col0; float* pv = edgeV + ((size_t)u.pm * 2 + fr) * FF + col0;
            *(f32x4*)(pa) = acc[0][0][0][0]; *(f32x4*)(pa + 4) = acc[0][0][0][1]; *(f32x4*)(pv) = acc[0][1][0][0]; *(f32x4*)(pv + 4) = acc[0][1][0][1]; }
        if (wr == 1 && fr >= 14) { float* pa = edgeA + ((size_t)u.pm * 4 + 2 + (fr - 14)) * FF + col0; *(f32x4*)(pa) = acc[1][0][3][0]; *(f32x4*)(pa + 4) = acc[1][0][3][1]; }
        asm volatile("s_waitcnt lgkmcnt(0)" ::: "memory"); __builtin_amdgcn_s_barrier(); asm volatile("" ::: "memory");
        f32x4 w0[2], w1[2], w2[2], bb[2];
#pragma unroll
        for (int n = 0; n < 2; ++n) { w0[n] = *(const f32x4*)(cw + col0 + 4 * n); w1[n] = *(const f32x4*)(cw + FF + col0 + 4 * n); w2[n] = *(const f32x4*)(cw + 2 * FF + col0 + 4 * n); bb[n] = *(const f32x4*)(cb + col0 + 4 * n); }
#pragma unroll
        for (int ai = 0; ai < 2; ++ai) { const int s = ai * 2 + wr;
            f32x4 t1[2], t2[2];
#pragma unroll
            for (int n = 0; n < 2; ++n) { f32x4 h62 = (f32x4){0.f, 0.f, 0.f, 0.f}, h63 = h62;
                if (s > 0) { h62 = *(const PG8_LAS f32x4*)(ex + ((s - 1) * 2 + 0) * 128 + cl + 4 * n); h63 = *(const PG8_LAS f32x4*)(ex + ((s - 1) * 2 + 1) * 128 + cl + 4 * n); }
                t1[n] = h63; t2[n] = fr == 0 ? h62 : h63; }
#pragma unroll
            for (int m = 0; m < 4; ++m) { f32x4 o[2];
#pragma unroll
                for (int n = 0; n < 2; ++n) {
                    f32x4 cv;
#pragma unroll
                    for (int e = 0; e < 4; ++e) { const float X = acc[ai][0][m][n][e]; const float p1 = dpp_shr(t1[n][e], X, 1), p2 = dpp_shr(t2[n][e], X, 2);
                        t1[n][e] = dpp_shl15(X); t2[n][e] = dpp_shl14(X);
                        cv[e] = w2[n][e] * X + w1[n][e] * p1 + w0[n][e] * p2 + bb[n][e]; }
                    const f32x2 ga = gelu_pk((f32x2){cv[0], cv[1]}), gb = gelu_pk((f32x2){cv[2], cv[3]});
                    o[n] = (f32x4){ga.x, ga.y, gb.x, gb.y} * acc[ai][1][m][n]; }
                const bool skip = (s == 0 && m == 0 && fr < 2);
                if (!skip) *(u32x4*)(midb + (size_t)(row0 + ai * HALF + m * 16) * FF + col0) = pack8(o[0], o[1]);
                asm volatile("" ::: "memory"); }
        }
    }
};
struct EpiFfnDown {
    static constexpr bool PERM = true, AFTER_DRAIN = false, HAS_MID = false;
    float* out;
    __device__ __forceinline__ void mid(f32x4 (&)[2][2][4][2], const Unit&, int, int, int, int) const {}
    __device__ __forceinline__ void operator()(f32x4 (&acc)[2][2][4][2], const Unit& u, int wr, int wc, int fr, int fq) const {
        int row0 = u.pm * BM + wr * 64 + fr; asm volatile("" : "+v"(row0)); const int col0 = u.pn * BM + wc * 32 + 8 * fq;
#pragma unroll
        for (int ai = 0; ai < 2; ++ai)
#pragma unroll
            for (int m = 0; m < 4; ++m) { const size_t off = (size_t)(row0 + ai * HALF + m * 16) * 1024 + col0;
#pragma unroll
                for (int bj = 0; bj < 2; ++bj) { float* p = out + off + bj * HALF; const f32x4 v0 = *(const f32x4*)(p) + acc[ai][bj][m][0], v1 = *(const f32x4*)(p + 4) + acc[ai][bj][m][1]; *(f32x4*)(p) = v0; *(f32x4*)(p + 4) = v1; } }
    }
};
struct EpiCmpHid {
    static constexpr bool PERM = true, AFTER_DRAIN = false, HAS_MID = false;
    const float* cbias  ; bf16_t* hid;
    __device__ __forceinline__ void mid(f32x4 (&)[2][2][4][2], const Unit&, int, int, int, int) const {}
    __device__ __forceinline__ void operator()(f32x4 (&acc)[2][2][4][2], const Unit& u, int wr, int wc, int fr, int fq) const {
        int row0 = u.pm * BM + wr * 64 + fr; asm volatile("" : "+v"(row0)); const int col0 = wc * 32 + 8 * fq; const float* bp = cbias + (u.pm >> 4) * 256 + col0;
#pragma unroll
        for (int ai = 0; ai < 2; ++ai)
#pragma unroll
            for (int m = 0; m < 4; ++m) { bf16_t* rowp = hid + (size_t)(row0 + ai * HALF + m * 16) * 256 + col0;
#pragma unroll
                for (int bj = 0; bj < 2; ++bj) { f32x4 v0 = acc[ai][bj][m][0] + *(const f32x4*)(bp + bj * HALF), v1 = acc[ai][bj][m][1] + *(const f32x4*)(bp + bj * HALF + 4);
                    const f32x2 g0 = gelu_pk((f32x2){v0[0], v0[1]}), g1 = gelu_pk((f32x2){v0[2], v0[3]}), g2 = gelu_pk((f32x2){v1[0], v1[1]}), g3 = gelu_pk((f32x2){v1[2], v1[3]});
                    *(u32x4*)(rowp + bj * HALF) = pack8((f32x4){g0.x, g0.y, g1.x, g1.y}, (f32x4){g2.x, g2.y, g3.x, g3.y}); } }
    }
};
struct CmpOrder {
    int G, c; const bf16_t* kc; const bf16_t* vc; const bf16_t* w1t;
    __device__ bool next(int i, Unit& u) const { const int L = i * G + c; if (L >= 32) return false; u.pm = L; u.pn = 0; return true; }
    __device__ __forceinline__ const char* a_ptr(const Gemm&, const Unit& u) const { const int kvbg = u.pm >> 1, half = u.pm & 1, kv = kvbg >> 3, b = (kvbg >> 1) & 3, g = kvbg & 1;
        return (const char*)((kv ? vc : kc) + ((size_t)(b * SEQ + 16 * 256 * half) * 128 + g * 64)); }
    __device__ __forceinline__ const char* b_ptr(const Gemm&, const Unit& u) const { return (const char*)(w1t + (size_t)(u.pm >> 4) * 256 * 2048); }
    __device__ __forceinline__ void a_ready(const Unit&) const {}
    __device__ __forceinline__ void done(const Unit&) const {}
};
template <class Epi, class Sched, bool ALIGN_EPI = false, bool SP2 = false>
__device__ __forceinline__ void gemm_phase(PG8_LAS unsigned char* lds, const Gemm g, const Sched& S, const Epi& E) {
    int tid_ = threadIdx.x; asm volatile("" : "+v"(tid_));
    const int tid = tid_, wid = __builtin_amdgcn_readfirstlane(tid >> 6), lane = tid & 63, wr = wid >> 2, wc = wid & 3, fr = lane & 15, fq = lane >> 4;
    const int K = g.K, nt = K / BK;
    unsigned voffA[2], voffB[2];
#pragma unroll
    for (int i = 0; i < 2; ++i) { int R, C; stage_rc(tid * 16 + i * 8192, R, C); const int Rb = Epi::PERM ? ((R & ~31) + perm32(R & 31)) : R;
        voffA[i] = (unsigned)(R * g.lda + C) * 2u; voffB[i] = (unsigned)(Rb * K + C) * 2u; }
    const size_t kstepA = (size_t)g.ksA, kstepB = (size_t)(BK * 2);
    const size_t hstepA = (size_t)HALF * g.lda * 2, hstepB = (size_t)HALF * K * 2;
    const unsigned ldsw = (unsigned)wid * 1024u;
    const int aoff = lds_byte(wr * 64 + fr, fq * 8), boff = lds_byte(wc * 32 + fr, fq * 8);
#define PG8_SA(b, h) (((b) * 2 + (h)) * HTB)
#define PG8_SB(b, h) ((4 + (b) * 2 + (h)) * HTB)
#define PG8_STAGE(bufoff, gbase, voff) do { _Pragma("unroll") for (int _i = 0; _i < 2; ++_i) \
        __builtin_amdgcn_global_load_lds((const unsigned*)((const char*)(gbase) + (voff)[_i]), (PG8_LAS unsigned*)(lds + (bufoff) + ldsw + _i * 8192), 16, 0, 0); } while (0)
#define PG8_LDA(dst, b, h) do { _Pragma("unroll") for (int m = 0; m < 4; ++m) _Pragma("unroll") for (int k = 0; k < 2; ++k) dst[m][k] = *(const PG8_LAS bf16x8*)(lds + PG8_SA(b, h) + aoff + m * 2048 + k * 1024); } while (0)
#define PG8_LDB(dst, b, h) do { _Pragma("unroll") for (int n = 0; n < 2; ++n) _Pragma("unroll") for (int k = 0; k < 2; ++k) dst[n][k] = *(const PG8_LAS bf16x8*)(lds + PG8_SB(b, h) + boff + n * 2048 + k * 1024); } while (0)
#define PG8_MMA(ai, bj, At, Bt) do { __builtin_amdgcn_s_setprio(1); _Pragma("unroll") for (int m = 0; m < 4; ++m) _Pragma("unroll") for (int n = 0; n < 2; ++n) _Pragma("unroll") for (int k = 0; k < 2; ++k) \
        acc[ai][bj][m][n] = __builtin_amdgcn_mfma_f32_16x16x32_bf16(Bt[n][k], At[m][k], acc[ai][bj][m][n], 0, 0, 0); __builtin_amdgcn_s_setprio(0); } while (0)
#define PG8_WAIT_V(n) asm volatile("s_waitcnt vmcnt(" #n ")" ::: "memory")
#define PG8_WAIT_L(n) asm volatile("s_waitcnt lgkmcnt(" #n ")" ::: "memory")
#define PG8_BAR __builtin_amdgcn_s_barrier()
#define PG8_SCHED __builtin_amdgcn_sched_barrier(0)
    Unit cur, nxt; int ui = 0;
    if (!S.next(0, cur)) return;
    f32x4 acc[2][2][4][2];
#pragma unroll
    for (int a = 0; a < 2; ++a)
#pragma unroll
        for (int b = 0; b < 2; ++b)
#pragma unroll
            for (int m = 0; m < 4; ++m)
#pragma unroll
                for (int n = 0; n < 2; ++n) acc[a][b][m][n] = (f32x4){0.f, 0.f, 0.f, 0.f};
    bf16x8 At[4][2], B0[2][2], B1[2][2];
    const char* cA = S.a_ptr(g, cur); const char* cB = S.b_ptr(g, cur);
    S.a_ready(cur);
    if constexpr (SP2) {
        PG8_STAGE(PG8_SB(0, 0), cB, voffB); PG8_STAGE(PG8_SB(0, 1), cB + hstepB, voffB); PG8_STAGE(PG8_SA(0, 0), cA, voffA); PG8_STAGE(PG8_SA(0, 1), cA + hstepA, voffA);
        if (wr == 1) PG8_BAR;
        PG8_WAIT_V(2); PG8_BAR;
        PG8_STAGE(PG8_SB(1, 0), cB + kstepB, voffB); PG8_STAGE(PG8_SA(1, 0), cA + kstepA, voffA); PG8_STAGE(PG8_SB(1, 1), cB + hstepB + kstepB, voffB);
        PG8_WAIT_V(6); PG8_BAR;
    } else {
        PG8_STAGE(PG8_SB(0, 0), cB, voffB); PG8_STAGE(PG8_SA(0, 0), cA, voffA); PG8_STAGE(PG8_SB(0, 1), cB + hstepB, voffB); PG8_STAGE(PG8_SA(0, 1), cA + hstepA, voffA);
        if (wr == 1) PG8_BAR;
        PG8_WAIT_V(4); PG8_BAR;
        PG8_STAGE(PG8_SB(1, 0), cB + kstepB, voffB); PG8_STAGE(PG8_SA(1, 0), cA + kstepA, voffA); PG8_STAGE(PG8_SB(1, 1), cB + hstepB + kstepB, voffB);
        PG8_WAIT_V(6); PG8_BAR;
    }
    for (;;) {
        const bool has_next = S.next(ui + 1, nxt);
        const char* nA = has_next ? S.a_ptr(g, nxt) : cA; const char* nB = has_next ? S.b_ptr(g, nxt) : cB;
        for (int t = 0; t < nt; t += 2) {
            if constexpr (Epi::HAS_MID) { if (t == nt / 2) E.mid(acc, cur, wr, wc, fr, fq); }
            const bool last = (t == nt - 2);
            const char* a1 = cA + (size_t)(t + 1) * kstepA;
            const char* a2 = last ? nA : cA + (size_t)(t + 2) * kstepA; const char* b2 = last ? nB : cB + (size_t)(t + 2) * kstepB;
            const char* a3 = a2 + kstepA; const char* b3 = b2 + kstepB;
            if (last && has_next) S.a_ready(nxt);
            if constexpr (SP2) {
            PG8_LDB(B0, 0, 0); PG8_LDB(B1, 0, 1); PG8_SCHED; PG8_LDA(At, 0, 0); PG8_STAGE(PG8_SA(1, 1), a1 + hstepA, voffA);
            PG8_WAIT_V(8); PG8_WAIT_L(0); PG8_BAR; PG8_MMA(0, 0, At, B0); PG8_MMA(0, 1, At, B1); PG8_BAR; PG8_SCHED;
            PG8_LDA(At, 0, 1); PG8_STAGE(PG8_SB(0, 0), b2, voffB); PG8_STAGE(PG8_SB(0, 1), b2 + hstepB, voffB); PG8_STAGE(PG8_SA(0, 0), a2, voffA);
            PG8_WAIT_V(8); PG8_WAIT_L(0); PG8_BAR; PG8_MMA(1, 0, At, B0); PG8_MMA(1, 1, At, B1); PG8_BAR; PG8_SCHED;
            PG8_LDB(B0, 1, 0); PG8_LDB(B1, 1, 1); PG8_SCHED; PG8_LDA(At, 1, 0); PG8_STAGE(PG8_SA(0, 1), a2 + hstepA, voffA);
            PG8_WAIT_V(8); PG8_WAIT_L(0); PG8_BAR; PG8_MMA(0, 0, At, B0); PG8_MMA(0, 1, At, B1); PG8_BAR; PG8_SCHED;
            PG8_LDA(At, 1, 1); PG8_STAGE(PG8_SB(1, 0), b3, voffB); PG8_STAGE(PG8_SB(1, 1), b3 + hstepB, voffB); PG8_STAGE(PG8_SA(1, 0), a3, voffA);
            PG8_WAIT_V(8); PG8_WAIT_L(0); PG8_BAR; PG8_MMA(1, 0, At, B0); PG8_MMA(1, 1, At, B1); PG8_BAR; PG8_SCHED;
            } else {
            PG8_LDB(B0, 0, 0); PG8_SCHED; PG8_LDA(At, 0, 0); PG8_STAGE(PG8_SA(1, 1), a1 + hstepA, voffA);
            PG8_WAIT_L(8); PG8_BAR; PG8_WAIT_L(0); PG8_MMA(0, 0, At, B0); PG8_BAR; PG8_SCHED;
            PG8_LDB(B1, 0, 1); PG8_STAGE(PG8_SB(0, 0), b2, voffB);
            PG8_BAR; PG8_WAIT_L(0); PG8_MMA(0, 1, At, B1); PG8_BAR;
            PG8_LDA(At, 0, 1); PG8_STAGE(PG8_SA(0, 0), a2, voffA);
            PG8_BAR; PG8_WAIT_L(0); PG8_MMA(1, 0, At, B0); PG8_BAR; PG8_SCHED;
            PG8_STAGE(PG8_SB(0, 1), b2 + hstepB, voffB);
            PG8_WAIT_V(6); PG8_BAR; PG8_MMA(1, 1, At, B1); PG8_BAR;
            PG8_LDB(B0, 1, 0); PG8_SCHED; PG8_LDA(At, 1, 0); PG8_STAGE(PG8_SA(0, 1), a2 + hstepA, voffA);
            PG8_WAIT_L(8); PG8_BAR; PG8_WAIT_L(0); PG8_MMA(0, 0, At, B0); PG8_BAR; PG8_SCHED;
            PG8_LDB(B1, 1, 1); PG8_STAGE(PG8_SB(1, 0), b3, voffB);
            PG8_BAR; PG8_WAIT_L(0); PG8_MMA(0, 1, At, B1); PG8_BAR;
            PG8_LDA(At, 1, 1); PG8_STAGE(PG8_SA(1, 0), a3, voffA);
            PG8_BAR; PG8_WAIT_L(0); PG8_MMA(1, 0, At, B0); PG8_BAR; PG8_SCHED;
            PG8_STAGE(PG8_SB(1, 1), b3 + hstepB, voffB);
            PG8_WAIT_V(6); PG8_BAR; PG8_MMA(1, 1, At, B1); PG8_BAR;
            }
        }
        if constexpr (ALIGN_EPI) { if (wr == 0) PG8_BAR; }
        if constexpr (!Epi::AFTER_DRAIN) { E(acc, cur, wr, wc, fr, fq); S.done(cur); }
        if (!has_next) break;
#pragma unroll
        for (int a = 0; a < 2; ++a)
#pragma unroll
            for (int b = 0; b < 2; ++b)
#pragma unroll
                for (int m = 0; m < 4; ++m)
#pragma unroll
                    for (int n = 0; n < 2; ++n) acc[a][b][m][n] = (f32x4){0.f, 0.f, 0.f, 0.f};
        cur = nxt; cA = nA; cB = nB; ++ui;
        if constexpr (ALIGN_EPI) { if (wr == 1) PG8_BAR; }
    }
    PG8_WAIT_V(0);
    if constexpr (!ALIGN_EPI) { if (wr == 0) PG8_BAR; }
    PG8_BAR;
    if constexpr (Epi::AFTER_DRAIN) { E.fused(acc, cur, wr, wc, fr, fq, lds, wid, lane); S.done(cur); }
#undef PG8_SA
#undef PG8_SB
#undef PG8_STAGE
#undef PG8_LDA
#undef PG8_LDB
#undef PG8_MMA
#undef PG8_WAIT_V
#undef PG8_WAIT_L
#undef PG8_BAR
#undef PG8_SCHED
}
}

using pg8::bf16_t; using pg8::f32x4; using pg8::u32x4; using pg8::TT; using pg8::SEQ; using pg8::NEPS; using pg8::QC2; using pg8::bf2f; using pg8::sigm;
#define LAS __attribute__((address_space(3)))
struct Args { const float* in[27]; float* out; unsigned char* ws; };

__device__ __forceinline__ unsigned f2bf(float f) { unsigned u = __builtin_bit_cast(unsigned, f); return (u + 0x7fffu + ((u >> 16) & 1u)) >> 16; }
__device__ __forceinline__ unsigned pk2(float lo, float hi) { return f2bf(lo) | (f2bf(hi) << 16); }
__device__ __forceinline__ float wave_sum(float v) {
#pragma unroll
    for (int o = 1; o < 64; o <<= 1) v += __shfl_xor(v, o);
    return v;
}
template <class F> __device__ __forceinline__ void transpose_item(const float* W, int ldw, int k0src, const float* kscale, bf16_t* WT, int ldt, int k0dst, int row0, LAS float* scr, int lane, F srccol) {
    const int j = lane & 31; const int sc = srccol(j);
#pragma unroll 8
    for (int i = 0; i < 32; ++i) { const int kk = 2 * i + (lane >> 5); float v = 0.f; if (sc >= 0) { v = W[(size_t)(k0src + kk) * ldw + sc]; if (kscale) v *= kscale[k0src + kk]; } scr[kk * 33 + j] = v; }
    asm volatile("s_waitcnt lgkmcnt(0)" ::: "memory");
    const int c = lane & 7;
#pragma unroll
    for (int jj = 0; jj < 4; ++jj) { const int n = (lane >> 3) + 8 * jj; const LAS float* s = scr + (8 * c) * 33 + n;
        u32x4 o; o.x = pk2(s[0 * 33], s[1 * 33]); o.y = pk2(s[2 * 33], s[3 * 33]); o.z = pk2(s[4 * 33], s[5 * 33]); o.w = pk2(s[6 * 33], s[7 * 33]);
        *(u32x4*)(WT + (size_t)(row0 + n) * ldt + k0dst + 8 * c) = o; }
    asm volatile("s_waitcnt lgkmcnt(0)" ::: "memory");
}
__device__ __forceinline__ int inproj_src(int p) {
    const int tile = p >> 8, l = p & 255;
    if (tile < 6) return p;
    const int half = l >> 7, wh = (l >> 5) & 3, j = l & 31;
    if (tile < 8) return C_NQ + 64 * (4 * (tile - 6) + wh) + 32 * half + j;
    if (tile == 8) return (wh < 2 ? C_KC + 64 * wh : C_KS + 64 * (wh - 2)) + 32 * half + j;
    if (tile == 9) return (wh < 2 ? C_KW + 64 * wh : C_VC + 64 * (wh - 2)) + 32 * half + j;
    if (tile == 10) return (wh < 2 ? C_VS + 64 * wh : C_VW + 64 * (wh - 2)) + 32 * half + j;
    if (l < 8) return C_MI + l; if (l < 32) return C_NG + (l - 8); return -1;
}
struct Ctx { int tid, lane, wave, G, vcu, gw, ngw, gtid, nthr; LAS unsigned char* lds; };

__device__ __forceinline__ void phase_prologue(const Ctx& C, const Args& a) {
    unsigned char* ws = a.ws;
    LAS float* scr = (LAS float*)(C.lds + C.wave * 16384);
    const float* w_in = a.in[2]; const float* norm1 = a.in[1]; const float* norm2 = a.in[22];
    constexpr int I_WIN = 96 * 16, I_WG = 64 * 16, I_WMN = 32 * 16, I_WOUT = 32 * 16, I_WUP = 176 * 16, I_WDN = 32 * 44, I_CW1 = 16 * 32;
    constexpr int NITEMS = I_WIN + I_WG + I_WMN + I_WOUT + I_WUP + I_WDN + I_CW1;
    for (int it = C.gw; it < NITEMS; it += C.ngw) {
        int r = it;
        if (r < I_WIN) { const int blk = r >> 4, kb = r & 15; transpose_item(w_in, DIN, 64 * kb, norm1, (bf16_t*)(ws + WS_WIN), 1024, 64 * kb, 32 * blk, scr, C.lane, [=](int j) { return inproj_src(32 * blk + j); }); continue; } r -= I_WIN;
        if (r < I_WG) { const int blk = r >> 4, kb = r & 15; transpose_item(w_in, DIN, 64 * kb, norm1, (bf16_t*)(ws + WS_WG), 1024, 64 * kb, 32 * blk, scr, C.lane, [=](int j) { return C_GM + 32 * blk + j; }); continue; } r -= I_WG;
        if (r < I_WMN) { const int blk = r >> 4, kb = r & 15; const float* W = kb < 8 ? a.in[18] : a.in[19]; transpose_item(W, 1024, 64 * (kb & 7), nullptr, (bf16_t*)(ws + WS_WMN), 1024, 64 * kb, 32 * blk, scr, C.lane, [=](int j) { return 32 * blk + j; }); continue; } r -= I_WMN;
        if (r < I_WOUT) { const int blk = r >> 4, kb = r & 15; transpose_item(a.in[21], 1024, 64 * kb, nullptr, (bf16_t*)(ws + WS_WOUT), 1024, 64 * kb, 32 * blk, scr, C.lane, [=](int j) { return 32 * blk + j; }); continue; } r -= I_WOUT;
        if (r < I_WUP) { const int blk = r >> 4, kb = r & 15; const int p0 = 32 * blk, pn = p0 >> 8, half = (p0 >> 7) & 1, jj = p0 & 127;
            transpose_item(a.in[23], 2 * DFF, 64 * kb, norm2, (bf16_t*)(ws + WS_WUP), 1024, 64 * kb, p0, scr, C.lane, [=](int j) { return half * DFF + 128 * pn + jj + j; }); continue; } r -= I_WUP;
        if (r < I_WDN) { const int blk = r / 44, kb = r % 44; transpose_item(a.in[26], 1024, 64 * kb, nullptr, (bf16_t*)(ws + WS_WDN), DFF, 64 * kb, 32 * blk, scr, C.lane, [=](int j) { return 32 * blk + j; }); continue; } r -= I_WDN;
        { const int kv = r >> 8, blk = (r >> 5) & 7, kb = r & 31; transpose_item(kv ? a.in[16] : a.in[13], 256, 64 * kb, nullptr, (bf16_t*)(ws + WS_CW1) + (size_t)kv * 256 * 2048, 2048, 64 * kb, 32 * blk, scr, C.lane, [=](int j) { return 32 * blk + j; }); }
    }
    { const float* x = a.in[0]; bf16_t* xb = (bf16_t*)(ws + WS_XB); float* rstd = (float*)(ws + WS_RSTD1);
      for (int m = C.gw; m < TT; m += C.ngw) { const f32x4* xr = (const f32x4*)(x + (size_t)m * DM) + C.lane; f32x4 v[4]; float s = 0.f;
#pragma unroll
          for (int j = 0; j < 4; ++j) { v[j] = xr[64 * j]; s += (v[j][0] * v[j][0] + v[j][1] * v[j][1]) + (v[j][2] * v[j][2] + v[j][3] * v[j][3]); }
          s = wave_sum(s); if (C.lane == 0) rstd[m] = 1.0f / sqrtf(s * (1.0f / DM) + NEPS);
          unsigned long long* o8 = (unsigned long long*)(xb + (size_t)m * DM) + C.lane;
#pragma unroll
          for (int j = 0; j < 4; ++j) o8[64 * j] = (unsigned long long)pk2(v[j][0], v[j][1]) | ((unsigned long long)pk2(v[j][2], v[j][3]) << 32); } }
    { float* rc = (float*)(ws + WS_ROPEC); float* rsn = (float*)(ws + WS_ROPES);
      for (int i = C.gtid; i < SEQ * 32; i += C.nthr) { const int t = i >> 5, j = i & 31; const float inv = (float)pow(10000.0, -(double)j / 32.0); const float ang = (float)t * inv;
          rc[i] = (float)cos((double)ang); rsn[i] = (float)sin((double)ang); } }
    { float* cbias = (float*)(ws + WS_CBIAS);
      for (int i = C.gtid; i < 512; i += C.nthr) { const int kv = i >> 8, j = i & 255; const float* pe = kv ? a.in[15] : a.in[12]; const float* w1 = kv ? a.in[16] : a.in[13]; float s = 0.f;
          for (int k = 0; k < 2048; ++k) s += pe[k] * w1[(size_t)k * 256 + j]; cbias[i] = s; } }
}

__device__ __forceinline__ void p7b_fixup(const Ctx& C, const Args& a) {
    unsigned char* ws = a.ws; const float* eA = (const float*)(ws + WS_EDGEA); const float* eV = (const float*)(ws + WS_EDGEV); bf16_t* mid = (bf16_t*)(ws + WS_MID); const float* cw = a.in[24]; const float* cb = a.in[25];
    for (int i = C.gtid; i < 128 * 2 * DFF; i += C.nthr) { const int c = i % DFF, r = (i / DFF) & 1, pm = i / (2 * DFF); const bool first = (pm & 31) == 0;
        const float x0 = eA[((size_t)pm * 4 + r) * DFF + c];
        const float pA = first ? 0.f : eA[((size_t)(pm - 1) * 4 + 3) * DFF + c], pB = first ? 0.f : eA[((size_t)(pm - 1) * 4 + 2) * DFF + c];
        const float p1 = r == 1 ? eA[((size_t)pm * 4 + 0) * DFF + c] : pA, p2 = r == 1 ? pA : pB;
        const float cv = cw[2 * DFF + c] * x0 + cw[DFF + c] * p1 + cw[c] * p2 + cb[c];
        const pg8::f32x2 gl = pg8::gelu_pk((pg8::f32x2){cv, 0.f});
        mid[(size_t)(pm * 256 + r) * DFF + c] = (bf16_t)f2bf(gl.x * eV[((size_t)pm * 2 + r) * DFF + c]); }
}
namespace att {
typedef short bf16x8 __attribute__((ext_vector_type(8)));
typedef short s16x4 __attribute__((ext_vector_type(4)));
typedef float f32x16 __attribute__((ext_vector_type(16)));
typedef unsigned u32x2 __attribute__((ext_vector_type(2)));
enum { M_WIN = 0, M_CMP = 1, M_SLC = 2 };
constexpr int LDS_KV = 0  , LDS_IMP = 32768  ;
__device__ __forceinline__ int crow(int r, int hi) { return (r & 3) + 8 * (r >> 2) + 4 * hi; }
__device__ __forceinline__ s16x4 vtr(const LAS unsigned char* p) { typedef short v4i16_t __attribute__((ext_vector_type(4))); return __builtin_bit_cast(s16x4, __builtin_amdgcn_ds_read_tr16_b64_v4i16((LAS v4i16_t*)p)); }
__device__ __forceinline__ unsigned cvtpk(float lo, float hi) { unsigned r; asm volatile("v_cvt_pk_bf16_f32 %0, %1, %2" : "=v"(r) : "v"(lo), "v"(hi)); return r; }
__device__ __forceinline__ bf16x8 pack_p(const f32x16& p, int base) {
    u32x4 w; w.x = cvtpk(p[base + 0], p[base + 1]); w.y = cvtpk(p[base + 2], p[base + 3]); w.z = cvtpk(p[base + 4], p[base + 5]); w.w = cvtpk(p[base + 6], p[base + 7]); return __builtin_bit_cast(bf16x8, w); }

struct KVRegs { u32x4 k, v; };
template <bool LOADV> __device__ __forceinline__ void kv_load(KVRegs& R, const bf16_t* K, const bf16_t* V, int ldk, int kt, int tid) {
    const int rowl = tid >> 3, ch = tid & 7; const size_t off = (size_t)(64 * kt + rowl) * ldk + ch * 8;
    R.k = *(const u32x4*)(K + off); if (LOADV) R.v = *(const u32x4*)(V + off);
}
template <bool LOADV> __device__ __forceinline__ void kv_write(const KVRegs& R, LAS unsigned char* buf, int tid) {
    const int rowl = tid >> 3, ch = tid & 7;
    *(LAS u32x4*)(buf + rowl * 128 + ((ch ^ (rowl & 7)) << 4)) = R.k; if (LOADV) *(LAS u32x4*)(buf + 8192 + rowl * 128 + (ch << 4)) = R.v;
}
__device__ __forceinline__ void qk_tile(f32x16& s0, f32x16& s1, const LAS unsigned char* buf, const bf16x8 (&qf)[4], int r32, int hi) {
    const f32x16 z = {0.f, 0.f, 0.f, 0.f, 0.f, 0.f, 0.f, 0.f, 0.f, 0.f, 0.f, 0.f, 0.f, 0.f, 0.f, 0.f}; s0 = z; s1 = z;
#pragma unroll
    for (int d0 = 0; d0 < 4; ++d0) { const int c = 2 * d0 + hi;
        const bf16x8 k0 = *(const LAS bf16x8*)(buf + r32 * 128 + ((c ^ (r32 & 7)) << 4)); const bf16x8 k1 = *(const LAS bf16x8*)(buf + (32 + r32) * 128 + ((c ^ (r32 & 7)) << 4));
        s0 = __builtin_amdgcn_mfma_f32_32x32x16_bf16(k0, qf[d0], s0, 0, 0, 0); s1 = __builtin_amdgcn_mfma_f32_32x32x16_bf16(k1, qf[d0], s1, 0, 0, 0); }
}
__device__ __forceinline__ void pv_tile(f32x16 (&o)[2], const LAS unsigned char* vbuf, const f32x16& p0, const f32x16& p1, int lane) {
    const int hi = lane >> 5; const LAS unsigned char* vb = vbuf + (4 * hi + ((lane & 15) >> 2)) * 128 + (16 * ((lane >> 4) & 1) + 4 * (lane & 3)) * 2;
#pragma unroll
    for (int ks = 0; ks < 4; ++ks) { const bf16x8 pb = pack_p(ks < 2 ? p0 : p1, 8 * (ks & 1));
#pragma unroll
        for (int dt = 0; dt < 2; ++dt) { const s16x4 lo = vtr(vb + (16 * ks) * 128 + dt * 64), hi4 = vtr(vb + (16 * ks + 8) * 128 + dt * 64);
            const bf16x8 va = {lo[0], lo[1], lo[2], lo[3], hi4[0], hi4[1], hi4[2], hi4[3]};
            o[dt] = __builtin_amdgcn_mfma_f32_32x32x16_bf16(va, pb, o[dt], 0, 0, 0); } }
}
template <int MODE> __device__ __forceinline__ bool key_valid(int kt, int kh, int r, int hi, int tpos, int aux) {
    const int kp = 64 * kt + 32 * kh + crow(r, hi);
    if (MODE == M_WIN) return kp <= tpos && kp > tpos - 512;
    if (MODE == M_CMP) return kp <= aux;
    return aux != 0 && kp <= tpos;
}

template <int MODE> __device__ __forceinline__ void attn_unit(LAS unsigned char* lds, unsigned char* ws, int b, int g, int qt, int tid) {
    const int lane = tid & 63, wave = __builtin_amdgcn_readfirstlane(tid >> 6), r32 = lane & 31, hi = lane >> 5, hg = wave & 3, th = wave >> 2;
    const int tp0 = 64 * qt, tpos = tp0 + 32 * th + r32; const size_t trow = (size_t)b * SEQ + tpos; const int head = 4 * g + hg;
    const bf16_t *K, *V; int ldk, kt0, kt1;
    if (MODE == M_WIN) { K = (const bf16_t*)(ws + WS_KW) + (size_t)b * SEQ * 128 + g * 64; V = (const bf16_t*)(ws + WS_VW) + (size_t)b * SEQ * 128 + g * 64; ldk = 128; kt0 = qt - 8 > 0 ? qt - 8 : 0; kt1 = qt; }
    else if (MODE == M_SLC) { K = (const bf16_t*)(ws + WS_KS) + (size_t)b * SEQ * 128 + g * 64; V = (const bf16_t*)(ws + WS_VS) + (size_t)b * SEQ * 128 + g * 64; ldk = 128; kt0 = 0; kt1 = qt; }
    else { K = (const bf16_t*)(ws + WS_CMPB) + (size_t)((b * 2 + g) * 512) * 64; V = (const bf16_t*)(ws + WS_CMPB) + (size_t)((8 + b * 2 + g) * 512) * 64; ldk = 64; kt0 = 0; kt1 = (4 * qt + 2) >> 6; }
    bf16x8 qf[4];
    { const bf16_t* qp = (const bf16_t*)(ws + WS_NQ) + trow * 512 + head * 64 + 8 * hi;
#pragma unroll
      for (int d0 = 0; d0 < 4; ++d0) qf[d0] = *(const bf16x8*)(qp + 16 * d0); }
    unsigned selw[4] = {0u, 0u, 0u, 0u};
    if (MODE == M_SLC) { const u32x4 sv = *(const u32x4*)((const unsigned*)(ws + WS_SEL) + (trow * 2 + g) * 4); selw[0] = sv.x; selw[1] = sv.y; selw[2] = sv.z; selw[3] = sv.w; }
    const int cmaxl = tpos >= 31 ? (tpos - 31) >> 4 : -1;
    LAS unsigned char* kvb = lds + LDS_KV;
    float m = -INFINITY, l = 0.f; f32x16 o[2]; { const f32x16 z = {0.f, 0.f, 0.f, 0.f, 0.f, 0.f, 0.f, 0.f, 0.f, 0.f, 0.f, 0.f, 0.f, 0.f, 0.f, 0.f}; o[0] = z; o[1] = z; }
    KVRegs R;
    if (MODE == M_CMP) {
        for (int i = tid; i < 64 * 128; i += 512) ((LAS float*)(lds + LDS_IMP))[i] = 0.f;
        kv_load<false>(R, K, V, ldk, kt0, tid);
        for (int kt = kt0; kt <= kt1; ++kt) { LAS unsigned char* buf = kvb + ((kt - kt0) & 1) * 16384;
            kv_write<false>(R, buf, tid); if (kt < kt1) kv_load<false>(R, K, V, ldk, kt + 1, tid);
            __syncthreads();
            f32x16 s0, s1; qk_tile(s0, s1, buf, qf, r32, hi);
            float mx = -INFINITY;
#pragma unroll
            for (int r = 0; r < 16; ++r) { if (!key_valid<MODE>(kt, 0, r, hi, tpos, cmaxl)) s0[r] = -INFINITY; if (!key_valid<MODE>(kt, 1, r, hi, tpos, cmaxl)) s1[r] = -INFINITY; mx = fmaxf(mx, fmaxf(s0[r], s1[r])); }
            mx = fmaxf(mx, __shfl_xor(mx, 32));
            const float mn = fmaxf(m, mx);
            if (mn > -INFINITY) { float sum = 0.f;
#pragma unroll
                for (int r = 0; r < 16; ++r) sum += exp2f(s0[r] - mn) + exp2f(s1[r] - mn);
                l = l * exp2f(m - mn) + sum; m = mn; }
        }
        __syncthreads();
        l += __shfl_xor(l, 32); const float il = l > 0.f ? 1.0f / l : 0.f;
        LAS float* impt = (LAS float*)(lds + LDS_IMP) + (32 * th + r32) * 128;
        kv_load<true>(R, K, V, ldk, kt0, tid);
        for (int kt = kt0; kt <= kt1; ++kt) { LAS unsigned char* buf = kvb + ((kt - kt0) & 1) * 16384;
            kv_write<true>(R, buf, tid); if (kt < kt1) kv_load<true>(R, K, V, ldk, kt + 1, tid);
            __syncthreads();
            f32x16 s0, s1; qk_tile(s0, s1, buf, qf, r32, hi);
#pragma unroll
            for (int r = 0; r < 16; ++r) { s0[r] = key_valid<MODE>(kt, 0, r, hi, tpos, cmaxl) ? exp2f(s0[r] - m) * il : 0.f; s1[r] = key_valid<MODE>(kt, 1, r, hi, tpos, cmaxl) ? exp2f(s1[r] - m) * il : 0.f; }
#pragma unroll
            for (int kh = 0; kh < 2; ++kh)
#pragma unroll
                for (int rr = 0; rr < 4; ++rr) { const f32x16& p = kh ? s1 : s0; const int j = 16 * kt + 8 * kh + 2 * rr + hi; const float s4 = (p[4 * rr] + p[4 * rr + 1]) + (p[4 * rr + 2] + p[4 * rr + 3]);
                    if (s4 != 0.f) { atomicAdd((float*)(impt + j), s4); if (j + 1 < 128 && p[4 * rr + 3] != 0.f) atomicAdd((float*)(impt + j + 1), p[4 * rr + 3]); } }
            pv_tile(o, buf + 8192, s0, s1, lane);
        }
        __syncthreads();
        l = 1.0f;
    } else {
        kv_load<true>(R, K, V, ldk, kt0, tid);
        for (int kt = kt0; kt <= kt1; ++kt) { LAS unsigned char* buf = kvb + ((kt - kt0) & 1) * 16384;
            kv_write<true>(R, buf, tid); if (kt < kt1) kv_load<true>(R, K, V, ldk, kt + 1, tid);
            __syncthreads();
            int aux = 1;
            if (MODE == M_SLC) { const unsigned w = kt < 32 ? selw[0] : kt < 64 ? selw[1] : kt < 96 ? selw[2] : selw[3]; aux = (w >> (kt & 31)) & 1u; if (__ballot(aux != 0) == 0ull) continue; }
            f32x16 s0, s1; qk_tile(s0, s1, buf, qf, r32, hi);
            bool full;
            if (MODE == M_WIN) full = (64 * kt + 63 <= tp0 + 32 * th) && (64 * kt > tp0 + 32 * th + 31 - 512);
            else full = (kt < qt) && (__ballot(aux == 0) == 0ull);
            float mx = -INFINITY;
            if (!full) {
#pragma unroll
                for (int r = 0; r < 16; ++r) { if (!key_valid<MODE>(kt, 0, r, hi, tpos, aux)) s0[r] = -INFINITY; if (!key_valid<MODE>(kt, 1, r, hi, tpos, aux)) s1[r] = -INFINITY; } }
#pragma unroll
            for (int r = 0; r < 16; ++r) mx = fmaxf(mx, fmaxf(s0[r], s1[r]));
            mx = fmaxf(mx, __shfl_xor(mx, 32));
            const float mn = fmaxf(m, mx);
            if (mn > -INFINITY) {
                const float al = exp2f(m - mn); m = mn; float sum = 0.f;
#pragma unroll
                for (int r = 0; r < 16; ++r) { s0[r] = exp2f(s0[r] - mn); s1[r] = exp2f(s1[r] - mn); sum += s0[r] + s1[r]; }
                l = l * al + sum;
#pragma unroll
                for (int r = 0; r < 16; ++r) { o[0][r] *= al; o[1][r] *= al; }
            } else {
#pragma unroll
                for (int r = 0; r < 16; ++r) { s0[r] = 0.f; s1[r] = 0.f; }
            }
            pv_tile(o, buf + 8192, s0, s1, lane);
        }
        __syncthreads();
        l += __shfl_xor(l, 32);
    }
    { const float* sg = (const float*)(ws + WS_SMALLG); const int br = MODE == M_CMP ? 0 : MODE == M_SLC ? 1 : 2;
      const float gt = sigm(sg[trow * 32 + 8 + head * 3 + br]) * (l > 0.f ? 1.0f / l : 0.f);
      bf16_t* op = (bf16_t*)(ws + WS_HMON) + trow * 1024 + 512 + head * 64 + 4 * hi;
#pragma unroll
      for (int dt = 0; dt < 2; ++dt)
#pragma unroll
          for (int rr = 0; rr < 4; ++rr) { u32x2* p = (u32x2*)(op + 32 * dt + 8 * rr); float v0 = o[dt][4 * rr] * gt, v1 = o[dt][4 * rr + 1] * gt, v2 = o[dt][4 * rr + 2] * gt, v3 = o[dt][4 * rr + 3] * gt;
              if (MODE != M_WIN) { const u32x2 old = *p; v0 += pg8::bflo(old.x); v1 += pg8::bfhi(old.x); v2 += pg8::bflo(old.y); v3 += pg8::bfhi(old.y); }
              u32x2 nw; nw.x = cvtpk(v0, v1); nw.y = cvtpk(v2, v3); *p = nw; } }
    if (MODE == M_CMP) {
        const int cur = qt; unsigned* selg = (unsigned*)(ws + WS_SEL);
        for (int i = 0; i < 8; ++i) { const int tk = 8 * wave + i; const LAS float* row = (const LAS float*)(lds + LDS_IMP) + tk * 128;
            float v0 = row[lane], v1 = row[lane + 64]; const int j0 = lane, j1 = lane + 64;
            if (j0 == 0 || j0 == cur || j0 == cur - 1) v0 = 1e4f; if (j0 > cur) v0 = -1e30f;
            if (j1 == cur || j1 == cur - 1) v1 = 1e4f; if (j1 > cur) v1 = -1e30f;
            unsigned long long m0, m1;
            if (cur < 16) { m0 = (2ull << cur) - 1ull; m1 = 0ull; }
            else {
                const unsigned u0 = __float_as_uint(v0), u1 = __float_as_uint(v1); const unsigned k0 = (u0 & 0x80000000u) ? ~u0 : (u0 | 0x80000000u), k1 = (u1 & 0x80000000u) ? ~u1 : (u1 | 0x80000000u);
                unsigned T = 0u;
                for (int bit = 31; bit >= 0; --bit) { const unsigned cand = T | (1u << bit); const int cnt = __popcll(__ballot(k0 >= cand)) + __popcll(__ballot(k1 >= cand)); if (cnt >= 16) T = cand; }
                const unsigned long long g0 = __ballot(k0 > T), g1 = __ballot(k1 > T), e0 = __ballot(k0 == T), e1 = __ballot(k1 == T);
                const int need = 16 - (__popcll(g0) + __popcll(g1)); const unsigned long long lt = (1ull << lane) - 1ull;
                const bool s0b = (k0 > T) || ((k0 == T) && __popcll(e0 & lt) < need); const bool s1b = (k1 > T) || ((k1 == T) && (__popcll(e0) + __popcll(e1 & lt)) < need);
                m0 = __ballot(s0b); m1 = __ballot(s1b);
            }
            if (lane == 0) { u32x4 sv; sv.x = (unsigned)m0; sv.y = (unsigned)(m0 >> 32); sv.z = (unsigned)m1; sv.w = (unsigned)(m1 >> 32); *(u32x4*)(selg + (((size_t)b * SEQ + tp0 + tk) * 2 + g) * 4) = sv; } }
        __syncthreads();
    }
}
template <int MODE> __device__ __forceinline__ void attn_phase(LAS unsigned char* lds, unsigned char* ws, int G, int cu) {
    int tid = threadIdx.x; asm volatile("" : "+v"(tid));
    for (int u = cu; u < 256; u += G) { const int bg = u >> 5, i = u & 31;
        for (int k = 0; k < 4; ++k) { const int qt = k == 0 ? i : k == 1 ? 63 - i : k == 2 ? 64 + i : 127 - i; attn_unit<MODE>(lds, ws, bg >> 1, bg & 1, qt, tid); } }
}
}
namespace ml {
constexpr size_t WS_GC = WS_MLS, WS_AM = WS_MLS + 8192, WS_MP = WS_MLS + 16384, WS_DN = WS_IPRE, WS_NP = WS_LOGF;
__device__ __forceinline__ float logsig(float x) { return x >= 0.f ? -log1pf(expf(-x)) : x - log1pf(expf(x)); }
__device__ __forceinline__ float scan_add(float v, int lane) {
#pragma unroll
    for (int o = 1; o < 64; o <<= 1) { const float t = __shfl_up(v, o); if (lane >= o) v += t; }
    return v;
}
__device__ __forceinline__ float scan_max(float v, int lane) {
#pragma unroll
    for (int o = 1; o < 64; o <<= 1) { const float t = __shfl_up(v, o); if (lane >= o) v = fmaxf(v, t); }
    return v;
}
__device__ __forceinline__ float wave_max(float v) {
#pragma unroll
    for (int o = 1; o < 64; o <<= 1) v = fmaxf(v, __shfl_xor(v, o));
    return v;
}
__device__ __forceinline__ float conv_silu(const bf16_t* qkpre, const float* cw, const float* cb, size_t trow, int tp, int ch) {
    float s = cb[ch];
#pragma unroll
    for (int k = 0; k < 4; ++k) { const int d = 3 - k; if (tp >= d) s += cw[k * 512 + ch] * bf2f(qkpre[(trow - d) * 512 + ch]); }
    return s * sigm(s);
}
__device__ __forceinline__ void phase_a(LAS unsigned char* lds, const Args& a, int G, int cu) {
    int tid = threadIdx.x; asm volatile("" : "+v"(tid)); const int lane = tid & 63, wave = __builtin_amdgcn_readfirstlane(tid >> 6);
    unsigned char* ws = a.ws; const bf16_t* qkpre = (const bf16_t*)(ws + WS_QKPRE); const bf16_t* mv = (const bf16_t*)(ws + WS_MV); const float* sg = (const float*)(ws + WS_SMALLG);
    LAS float* kw = (LAS float*)lds; LAS float* vv = (LAS float*)(lds + 16384); LAS float* wl = (LAS float*)(lds + 49152);
    for (int U = cu; U < 2048; U += G) { const int c = U & 127, h = (U >> 7) & 3, b = U >> 9; const int tp0 = 64 * c; const size_t t0 = (size_t)b * SEQ + tp0;
        if (wave == 0) { const size_t t = t0 + lane; const float ip = sg[t * 32 + h] + a.in[5][h]; const float lf = logsig(sg[t * 32 + 4 + h] + a.in[6][h]);
            const float bc = scan_add(lf, lane); const float g = __shfl(bc, 63); const float av = g - bc + ip; const float am = wave_max(av); wl[lane] = expf(av - am);
            if (lane == 0) { ((float*)(ws + WS_GC))[U] = g; ((float*)(ws + WS_AM))[U] = am; } }
        for (int i = tid; i < 64 * 128; i += 512) { const int l = i >> 7, e = i & 127; vv[i] = bf2f(mv[(t0 + l) * 512 + h * 128 + e]); }
        __syncthreads();
        for (int i = tid; i < 64 * 64; i += 512) { const int l = i >> 6, d = i & 63; kw[i] = wl[l] * conv_silu(qkpre, a.in[3], a.in[4], t0 + l, tp0 + l, 256 + h * 64 + d); }
        __syncthreads();
        { const int d0 = (tid >> 5) * 4, e0 = (tid & 31) * 4; f32x4 acc[4];
#pragma unroll
          for (int i = 0; i < 4; ++i) acc[i] = (f32x4){0.f, 0.f, 0.f, 0.f};
#pragma unroll 4
          for (int l = 0; l < 64; ++l) { const f32x4 k4 = *(const LAS f32x4*)(kw + l * 64 + d0), v4 = *(const LAS f32x4*)(vv + l * 128 + e0);
#pragma unroll
              for (int i = 0; i < 4; ++i) acc[i] += k4[i] * v4; }
          float* dc = (float*)(ws + WS_DC) + (size_t)U * 8192;
#pragma unroll
          for (int i = 0; i < 4; ++i) *(f32x4*)(dc + (d0 + i) * 128 + e0) = acc[i];
          if (tid < 64) { float s = 0.f; for (int l = 0; l < 64; ++l) s += kw[l * 64 + tid]; ((float*)(ws + WS_DN))[(size_t)U * 64 + tid] = s; } }
        __syncthreads();
    }
}
__device__ __forceinline__ void phase_b(const Args& a, int gtid, int nthr) {
    unsigned char* ws = a.ws; const float* gc = (const float*)(ws + WS_GC); const float* am = (const float*)(ws + WS_AM); float* mp = (float*)(ws + WS_MP);
    const float* dc = (const float*)(ws + WS_DC); float* cp = (float*)(ws + WS_CPREV); const float* dn = (const float*)(ws + WS_DN); float* np = (float*)(ws + WS_NP);
    for (int i = gtid; i < 16 * 8192; i += nthr) { const int bh = i >> 13, de = i & 8191, d = de >> 7, e = de & 127; float C = 0.f, nn = 0.f, m = 0.f;
#pragma unroll 8
        for (int c = 0; c < 128; ++c) { const int U = bh * 128 + c; const float g = gc[U], amx = am[U]; const float x = dc[(size_t)U * 8192 + de];
            cp[(size_t)U * 8192 + de] = C; if (e == 0) { np[(size_t)U * 64 + d] = nn; if (d == 0) mp[U] = m; }
            const float mn = fmaxf(g + m, amx); const float dec = expf(g + m - mn), sc = expf(amx - mn); C = dec * C + sc * x; if (e == 0) nn = dec * nn + sc * dn[(size_t)U * 64 + d]; m = mn; } }
}
__device__ __forceinline__ void phase_c(LAS unsigned char* lds, const Args& a, int G, int cu) {
    int tid = threadIdx.x; asm volatile("" : "+v"(tid)); const int lane = tid & 63, wave = __builtin_amdgcn_readfirstlane(tid >> 6);
    unsigned char* ws = a.ws; const bf16_t* qkpre = (const bf16_t*)(ws + WS_QKPRE); const bf16_t* mv = (const bf16_t*)(ws + WS_MV); const bf16_t* mo = (const bf16_t*)(ws + WS_MO); const float* sg = (const float*)(ws + WS_SMALLG);
    LAS float* BP = (LAS float*)lds;
    LAS float* AT = (LAS float*)(lds + 65536);
    LAS float* qT = (LAS float*)(lds + 98304);
    LAS float* kT = (LAS float*)(lds + 114688);
    LAS float* sm = (LAS float*)(lds + 131072);
    for (int U = cu; U < 2048; U += G) { const int c = U & 127, h = (U >> 7) & 3, b = U >> 9; const int tp0 = 64 * c; const size_t t0 = (size_t)b * SEQ + tp0;
        if (wave == 0) { const size_t t = t0 + lane; const float ip = sg[t * 32 + h] + a.in[5][h]; const float lf = logsig(sg[t * 32 + 4 + h] + a.in[6][h]);
            const float bc = scan_add(lf, lane); const float u = ip - bc; const float pm = scan_max(u, lane); const float mprev = ((const float*)(ws + WS_MP))[U];
            const float mt = bc + fmaxf(mprev, pm); sm[lane] = bc; sm[64 + lane] = u; sm[128 + lane] = mt; sm[192 + lane] = expf(bc + mprev - mt); sm[256 + lane] = ((const float*)(ws + WS_NP))[(size_t)U * 64 + lane]; }
        for (int i = tid; i < 64 * 128; i += 512) { const int l = i >> 7, cch = i & 127, part = cch >> 6, d = cch & 63; const float v = conv_silu(qkpre, a.in[3], a.in[4], t0 + l, tp0 + l, part * 256 + h * 64 + d);
            if (part == 0) qT[d * 64 + l] = v * 0.125f; else kT[d * 64 + l] = v; }
        { const float* cpu = (const float*)(ws + WS_CPREV) + (size_t)U * 8192;
          for (int i = tid; i < 2048; i += 512) *(LAS f32x4*)(BP + 4 * i) = *(const f32x4*)(cpu + 4 * i);
          for (int i = tid; i < 64 * 128; i += 512) { const int l = i >> 7, e = i & 127; BP[8192 + i] = bf2f(mv[(t0 + l) * 512 + h * 128 + e]); } }
        __syncthreads();
        { const int t = tid >> 3, s0 = (tid & 7) * 8; float acc[8];
#pragma unroll
          for (int j = 0; j < 8; ++j) acc[j] = 0.f;
#pragma unroll 4
          for (int d = 0; d < 64; ++d) { const float qv = qT[d * 64 + t]; const f32x4 k0 = *(const LAS f32x4*)(kT + d * 64 + s0), k1 = *(const LAS f32x4*)(kT + d * 64 + s0 + 4);
#pragma unroll
              for (int j = 0; j < 4; ++j) { acc[j] += qv * k0[j]; acc[4 + j] += qv * k1[j]; } }
          const float bt = sm[t] - sm[128 + t];
#pragma unroll
          for (int j = 0; j < 8; ++j) { const int s = s0 + j; AT[(64 + s) * 64 + t] = s <= t ? acc[j] * expf(sm[64 + s] + bt) : 0.f; }
          for (int i = tid; i < 64 * 64; i += 512) { const int tt = i & 63; AT[i] = sm[192 + tt] * qT[i]; } }
        __syncthreads();
        if (wave == 0) { float den = 0.f; for (int k = 0; k < 64; ++k) den += AT[k * 64 + lane] * sm[256 + k]; for (int k = 64; k < 128; ++k) den += AT[k * 64 + lane]; sm[320 + lane] = den; }
        { const int t0l = (tid >> 5) * 4, e0 = (tid & 31) * 4; f32x4 acc[4];
#pragma unroll
          for (int i = 0; i < 4; ++i) acc[i] = (f32x4){0.f, 0.f, 0.f, 0.f};
#pragma unroll 4
          for (int k = 0; k < 128; ++k) { const f32x4 a4 = *(const LAS f32x4*)(AT + k * 64 + t0l), b4 = *(const LAS f32x4*)(BP + k * 128 + e0);
#pragma unroll
              for (int i = 0; i < 4; ++i) acc[i] += a4[i] * b4; }
          __syncthreads();
          const float* onw = a.in[7] + h * 128 + e0; const f32x4 w4 = *(const f32x4*)onw;
#pragma unroll
          for (int i = 0; i < 4; ++i) { const int t = t0l + i; const float dv = 1.0f / fmaxf(fabsf(sm[320 + t]), expf(-sm[128 + t])); f32x4 hv = acc[i] * dv;
              float ss = (hv[0] * hv[0] + hv[1] * hv[1]) + (hv[2] * hv[2] + hv[3] * hv[3]);
#pragma unroll
              for (int o = 1; o < 32; o <<= 1) ss += __shfl_xor(ss, o);
              const float rs = 1.0f / sqrtf(ss * (1.0f / 128.f) + NEPS); const size_t tr = t0 + t;
              const pg8::u32x2 mo2 = *(const pg8::u32x2*)(mo + tr * 512 + h * 128 + e0);
              const float o0 = hv[0] * rs * w4[0] * sigm(pg8::bflo(mo2.x)), o1 = hv[1] * rs * w4[1] * sigm(pg8::bfhi(mo2.x)), o2 = hv[2] * rs * w4[2] * sigm(pg8::bflo(mo2.y)), o3 = hv[3] * rs * w4[3] * sigm(pg8::bfhi(mo2.y));
              pg8::u32x2 ov; ov.x = pk2(o0, o1); ov.y = pk2(o2, o3); *(pg8::u32x2*)((bf16_t*)(ws + WS_HMON) + tr * 1024 + h * 128 + e0) = ov; } }
        __syncthreads();
    }
}
}
__device__ __forceinline__ void cmpout_phase(const Args& a, int gtid, int nthr) {
    unsigned char* ws = a.ws; const bf16_t* hid = (const bf16_t*)(ws + WS_CMPH); bf16_t* cmpb = (bf16_t*)(ws + WS_CMPB);
    for (int i = gtid; i < 16 * 512 * 64; i += nthr) { const int o = i & 63, r = i >> 6, kv = r >> 12; const float* w2 = kv ? a.in[17] : a.in[14]; float s = 0.f;
        if ((r & 511) < NCMP) { const u32x4* hp = (const u32x4*)(hid + (size_t)r * 256);
            for (int j8 = 0; j8 < 32; ++j8) { const u32x4 hv = hp[j8]; f32x4 h0, h1; pg8::unpack8(hv, h0, h1); const float* w = w2 + (j8 * 8) * 64 + o;
                s += h0[0] * w[0] + h0[1] * w[64] + h0[2] * w[128] + h0[3] * w[192] + h1[0] * w[256] + h1[1] * w[320] + h1[2] * w[384] + h1[3] * w[448]; } }
        cmpb[i] = (bf16_t)f2bf(s); }
}
#ifndef PG8_SP2
#define PG8_SP2 true
#endif
#define WSP(T, off) ((T*)(ws + (off)))
__device__ __forceinline__ Ctx make_ctx(unsigned char* lds_raw) {
    Ctx C; C.lds = (LAS unsigned char*)lds_raw; { int t_ = threadIdx.x; asm volatile("" : "+v"(t_)); C.tid = t_; } C.lane = C.tid & 63; C.wave = __builtin_amdgcn_readfirstlane(C.tid >> 6); C.G = gridDim.x;
    C.vcu = blockIdx.x; C.gw = blockIdx.x * 8 + C.wave; C.ngw = C.G * 8; C.gtid = blockIdx.x * 512 + C.tid; C.nthr = C.G * 512; return C; }
__device__ __forceinline__ void run_ph0(unsigned char* lds_raw, const Args& args) { const Ctx C = make_ctx(lds_raw); unsigned char* ws = args.ws;
    phase_prologue(C, args);
}
__device__ __forceinline__ void run_ph1(unsigned char* lds_raw, const Args& args) { const Ctx C = make_ctx(lds_raw); unsigned char* ws = args.ws;
    { pg8::Gemm g{WSP(bf16_t, WS_XB), WSP(bf16_t, WS_WIN), TT, 3072, 1024, 1024, 128}; pg8::StaticOrder S; S.init(TT, 3072, C.G, (int)blockIdx.x);
      pg8::EpiInProj E{ws, args.in[8], args.in[9], args.in[10], args.in[11]};
      pg8::gemm_phase<pg8::EpiInProj, pg8::StaticOrder, true, PG8_SP2>(C.lds, g, S, E); }
}
__device__ __forceinline__ void run_ph2(unsigned char* lds_raw, const Args& args) { const Ctx C = make_ctx(lds_raw); unsigned char* ws = args.ws;
    { pg8::Gemm g{nullptr, nullptr, 8192, 256, 2048, 2048, 256}; pg8::CmpOrder S{C.G, (int)blockIdx.x, WSP(bf16_t, WS_KC), WSP(bf16_t, WS_VC), WSP(bf16_t, WS_CW1)};
      pg8::EpiCmpHid E{WSP(float, WS_CBIAS), WSP(bf16_t, WS_CMPH)};
      pg8::gemm_phase<pg8::EpiCmpHid, pg8::CmpOrder, true, PG8_SP2>(C.lds, g, S, E); }
    ml::phase_a(C.lds, args, C.G, (int)blockIdx.x);
    att::attn_phase<att::M_WIN>(C.lds, ws, C.G, (int)blockIdx.x);
}
__device__ __forceinline__ void run_ph3(unsigned char* lds_raw, const Args& args) { const Ctx C = make_ctx(lds_raw); unsigned char* ws = args.ws;
    cmpout_phase(args, C.gtid, C.nthr);
    ml::phase_b(args, C.gtid, C.nthr);
}
__device__ __forceinline__ void run_ph4(unsigned char* lds_raw, const Args& args) { const Ctx C = make_ctx(lds_raw); unsigned char* ws = args.ws;
    att::attn_phase<att::M_CMP>(C.lds, ws, C.G, (int)blockIdx.x);
    ml::phase_c(C.lds, args, C.G, (int)blockIdx.x);
}
__device__ __forceinline__ void run_ph5(unsigned char* lds_raw, const Args& args) { const Ctx C = make_ctx(lds_raw); unsigned char* ws = args.ws;
    att::attn_phase<att::M_SLC>(C.lds, ws, C.G, (int)blockIdx.x);
}
__device__ __forceinline__ void run_ph6(unsigned char* lds_raw, const Args& args) { const Ctx C = make_ctx(lds_raw); unsigned char* ws = args.ws;
    { pg8::Gemm g{WSP(bf16_t, WS_XB), WSP(bf16_t, WS_WG), TT, 2048, 1024, 1024, 128}; pg8::StaticOrder S; S.init(TT, 2048, C.G, (int)blockIdx.x);
      pg8::EpiGate E{WSP(float, WS_RSTD1), args.in[20], WSP(bf16_t, WS_GM), WSP(bf16_t, WS_GN)};
      pg8::gemm_phase<pg8::EpiGate, pg8::StaticOrder, true, PG8_SP2>(C.lds, g, S, E); }
}
__device__ __forceinline__ void run_ph7(unsigned char* lds_raw, const Args& args) { const Ctx C = make_ctx(lds_raw); unsigned char* ws = args.ws;
    { pg8::Gemm g{WSP(bf16_t, WS_HMON), WSP(bf16_t, WS_WMN), TT, 1024, 1024, 1024, 128}; pg8::StaticOrder S; S.init(TT, 1024, C.G, (int)blockIdx.x);
      pg8::EpiMerge E{WSP(bf16_t, WS_GM), WSP(bf16_t, WS_GN), WSP(bf16_t, WS_Y)};
      pg8::gemm_phase<pg8::EpiMerge, pg8::StaticOrder, true, PG8_SP2>(C.lds, g, S, E); }
}
__device__ __forceinline__ void run_ph8(unsigned char* lds_raw, const Args& args) { const Ctx C = make_ctx(lds_raw); unsigned char* ws = args.ws;
    { pg8::Gemm g{WSP(bf16_t, WS_Y), WSP(bf16_t, WS_WOUT), TT, 1024, 1024, 1024, 128}; pg8::StaticOrder S; S.init(TT, 1024, C.G, (int)blockIdx.x);
      pg8::EpiWout E{args.in[0], args.out, WSP(bf16_t, WS_XB), WSP(float, WS_SSQ2)};
      pg8::gemm_phase<pg8::EpiWout, pg8::StaticOrder, true, PG8_SP2>(C.lds, g, S, E); }
}
__device__ __forceinline__ void run_ph9(unsigned char* lds_raw, const Args& args) { const Ctx C = make_ctx(lds_raw); unsigned char* ws = args.ws;
    { pg8::Gemm g{WSP(bf16_t, WS_XB), WSP(bf16_t, WS_WUP), TT, 5632, 1024, 1024, 128}; pg8::StaticOrder S; S.init(TT, 5632, C.G, (int)blockIdx.x);
      pg8::EpiFfnUp E{WSP(float, WS_SSQ2), args.in[24], args.in[25], WSP(bf16_t, WS_MID), WSP(float, WS_EDGEA), WSP(float, WS_EDGEV), (LAS float*)(C.lds + LDS_EX)};
      pg8::gemm_phase<pg8::EpiFfnUp, pg8::StaticOrder, true, PG8_SP2>(C.lds, g, S, E); }
}
__device__ __forceinline__ void run_ph10(unsigned char* lds_raw, const Args& args) { const Ctx C = make_ctx(lds_raw); unsigned char* ws = args.ws;
    p7b_fixup(C, args);
}
__device__ __forceinline__ void run_ph11(unsigned char* lds_raw, const Args& args) { const Ctx C = make_ctx(lds_raw); unsigned char* ws = args.ws;
    { pg8::Gemm g{WSP(bf16_t, WS_MID), WSP(bf16_t, WS_WDN), TT, 1024, 2816, 2816, 128}; pg8::StaticOrder S; S.init(TT, 1024, C.G, (int)blockIdx.x);
      pg8::EpiFfnDown E{args.out};
      pg8::gemm_phase<pg8::EpiFfnDown, pg8::StaticOrder, true, PG8_SP2>(C.lds, g, S, E); }
}
constexpr int NPHASE = 12;
#ifndef SPLIT_TEST
__global__ void __launch_bounds__(512, 2) mega_fwd(Args args) {
    extern __shared__ __attribute__((aligned(16))) unsigned char lds_raw[];
    cg::grid_group grid = cg::this_grid();
    run_ph0(lds_raw, args);
    grid.sync();
    run_ph1(lds_raw, args);
    grid.sync();
    run_ph2(lds_raw, args);
    grid.sync();
    run_ph3(lds_raw, args);
    grid.sync();
    run_ph4(lds_raw, args);
    grid.sync();
    run_ph5(lds_raw, args);
    grid.sync();
    run_ph6(lds_raw, args);
    grid.sync();
    run_ph7(lds_raw, args);
    grid.sync();
    run_ph8(lds_raw, args);
    grid.sync();
    run_ph9(lds_raw, args);
    grid.sync();
    run_ph10(lds_raw, args);
    grid.sync();
    run_ph11(lds_raw, args);
}
#else
__global__ void __launch_bounds__(512, 2) ph0_k(Args args) { extern __shared__ __attribute__((aligned(16))) unsigned char lds_raw[]; run_ph0(lds_raw, args); }
__global__ void __launch_bounds__(512, 2) ph1_k(Args args) { extern __shared__ __attribute__((aligned(16))) unsigned char lds_raw[]; run_ph1(lds_raw, args); }
__global__ void __launch_bounds__(512, 2) ph2_k(Args args) { extern __shared__ __attribute__((aligned(16))) unsigned char lds_raw[]; run_ph2(lds_raw, args); }
__global__ void __launch_bounds__(512, 2) ph3_k(Args args) { extern __shared__ __attribute__((aligned(16))) unsigned char lds_raw[]; run_ph3(lds_raw, args); }
__global__ void __launch_bounds__(512, 2) ph4_k(Args args) { extern __shared__ __attribute__((aligned(16))) unsigned char lds_raw[]; run_ph4(lds_raw, args); }
__global__ void __launch_bounds__(512, 2) ph5_k(Args args) { extern __shared__ __attribute__((aligned(16))) unsigned char lds_raw[]; run_ph5(lds_raw, args); }
__global__ void __launch_bounds__(512, 2) ph6_k(Args args) { extern __shared__ __attribute__((aligned(16))) unsigned char lds_raw[]; run_ph6(lds_raw, args); }
__global__ void __launch_bounds__(512, 2) ph7_k(Args args) { extern __shared__ __attribute__((aligned(16))) unsigned char lds_raw[]; run_ph7(lds_raw, args); }
__global__ void __launch_bounds__(512, 2) ph8_k(Args args) { extern __shared__ __attribute__((aligned(16))) unsigned char lds_raw[]; run_ph8(lds_raw, args); }
__global__ void __launch_bounds__(512, 2) ph9_k(Args args) { extern __shared__ __attribute__((aligned(16))) unsigned char lds_raw[]; run_ph9(lds_raw, args); }
__global__ void __launch_bounds__(512, 2) ph10_k(Args args) { extern __shared__ __attribute__((aligned(16))) unsigned char lds_raw[]; run_ph10(lds_raw, args); }
__global__ void __launch_bounds__(512, 2) ph11_k(Args args) { extern __shared__ __attribute__((aligned(16))) unsigned char lds_raw[]; run_ph11(lds_raw, args); }
__global__ void __launch_bounds__(512, 2) mega_fwd(Args args) {}
#endif
extern "C" void kernel_launch(void* const* d_in, const int* in_sizes, int n_in, void* d_out, int out_size, void* d_ws, size_t ws_size, hipStream_t stream) {
    static int grid = 0;
    if (grid == 0) {
        if (n_in != 27 || out_size != TT * DM || ws_size < WS_END) { fprintf(stderr, "kernel_launch: unexpected shapes (n_in %d out %d ws %zu)\n", n_in, out_size, ws_size); grid = -1; return; }
        int dev = 0, cus = 0, per_cu = 0;
        hipGetDevice(&dev); hipDeviceGetAttribute(&cus, hipDeviceAttributeMultiprocessorCount, dev);
        hipFuncSetAttribute((const void*)mega_fwd, hipFuncAttributeMaxDynamicSharedMemorySize, LDS_BYTES);
        hipOccupancyMaxActiveBlocksPerMultiprocessor(&per_cu, (const void*)mega_fwd, 512, LDS_BYTES);
        if (per_cu < 1) { fprintf(stderr, "kernel_launch: occupancy query says %d blocks per CU\n", per_cu); grid = -1; return; }
        grid = cus * 1;
    }
    if (grid < 0) return;
    hipMemsetAsync((char*)d_ws + WS_CTL, 0, 1 * MiB, stream);
    Args a{}; for (int i = 0; i < 27; ++i) a.in[i] = (const float*)d_in[i]; a.out = (float*)d_out; a.ws = (unsigned char*)d_ws;
    void* kargs[] = {&a};
    hipError_t e = hipLaunchCooperativeKernel((const void*)mega_fwd, dim3(grid), dim3(512), kargs, LDS_BYTES, stream);
    if (e != hipSuccess) fprintf(stderr, "cooperative launch failed: %s (grid %d)\n", hipGetErrorString(e), grid);
}
```

```cpp
#include <hip/hip_runtime.h>
#include <hip/hip_cooperative_groups.h>
#include <cstdio>
#include <cstdint>
#include <cmath>
namespace cg = cooperative_groups;
constexpr int NB = 4, DM = 1024, DIN = 4896, DFF = 2816, NCMP = 511, NSEL = 128;
constexpr int C_MQ = 0, C_MK = 256, C_MV = 512, C_MO = 1024, C_MI = 1536, C_MF = 1540, C_NQ = 1544, C_KC = 2056, C_VC = 2184, C_KS = 2312, C_VS = 2440, C_KW = 2568, C_VW = 2696, C_NG = 2824, C_GM = 2848;
constexpr size_t MiB = 1u << 20;
constexpr size_t WS_CTL = 0;
constexpr size_t WS_ROPEC = 1 * MiB, WS_ROPES = 2 * MiB, WS_RSTD1 = 3 * MiB, WS_SSQ2 = 4 * MiB, WS_SMALLG = 6 * MiB, WS_SEL = 10 * MiB, WS_CMPB = 11 * MiB, WS_CBIAS = 12 * MiB;
constexpr size_t WS_EDGEA = 13 * MiB, WS_EDGEV = 19 * MiB, WS_IPRE = 22 * MiB, WS_LOGF = 22 * MiB + 524288, WS_MLS = 23 * MiB;
constexpr size_t WS_WIN = 24 * MiB  , WS_WG = 30 * MiB  , WS_WMN = 34 * MiB, WS_WOUT = 36 * MiB, WS_WUP = 38 * MiB, WS_WDN = 49 * MiB, WS_CW1 = 55 * MiB;
constexpr size_t WS_XB = 60 * MiB;
constexpr size_t WS_QKPRE = 124 * MiB, WS_MV = 156 * MiB, WS_MO = 188 * MiB, WS_NQ = 220 * MiB, WS_KC = 252 * MiB, WS_KS = 260 * MiB, WS_KW = 268 * MiB, WS_VC = 276 * MiB, WS_VS = 284 * MiB, WS_VW = 292 * MiB;
constexpr size_t WS_HMON = 300 * MiB;
constexpr size_t WS_DC = 364 * MiB, WS_CPREV = 428 * MiB, WS_CMPH = 492 * MiB;
constexpr size_t WS_Y = 124 * MiB;
constexpr size_t WS_MID = 124 * MiB;
constexpr size_t WS_END = 500 * MiB;
constexpr size_t WS_QKF = 364 * MiB  , WS_HRAW = 428 * MiB  , WS_IMP = 364 * MiB  , WS_IDX = 396 * MiB  ;
constexpr int RING_BYTES = 131072, LDS_EX = RING_BYTES  , LDS_BYTES = 147456, LDS_XB = 147456 - 64  ;

namespace pg8 {
#define PG8_LAS __attribute__((address_space(3)))
typedef unsigned short bf16_t;
typedef short bf16x8 __attribute__((ext_vector_type(8)));
typedef float f32x4 __attribute__((ext_vector_type(4)));
typedef unsigned u32x4 __attribute__((ext_vector_type(4)));
constexpr int BM = 256, BK = 64, HALF = 128, HTB = HALF * BK * 2  , STAGE_BYTES = 8 * HTB, NXCD = 8, WGM = 8;

__host__ __device__ __forceinline__ int lds_byte(int r, int c) { const int st = (r >> 4) * 2 + (c >> 5), rr = r & 15, cc = c & 31, ob = rr * 64 + cc * 2; return st * 1024 + (ob ^ (((ob >> 9) & 1) << 5)); }
__host__ __device__ __forceinline__ void stage_rc(int b, int& R, int& C) { const int st = b / 1024, sb = b % 1024, swz = sb ^ (((sb >> 9) & 1) << 5); R = (st >> 1) * 16 + swz / 64; C = (st & 1) * 32 + (swz % 64) / 2; }
__host__ __device__ __forceinline__ int perm32(int rho) { const int n = rho >> 4, i = rho & 15; return 8 * (i >> 2) + 4 * n + (i & 3); }

struct Unit { int pm, pn; };
struct Gemm { const bf16_t* A; const bf16_t* Bt; int M, N, K; int lda; int ksA; };

struct StaticOrder {
    int nM, nN, nwg, G, c;
    __host__ __device__ void init(int M, int N, int G_, int c_) { nM = M / BM; nN = N / BM; nwg = nM * nN; G = G_; c = c_; }
    __host__ __device__ bool next(int i, Unit& u) const {
        const long L = (long)i * G + c; if (L >= nwg) return false;
        int wgid = (int)L; { const int q = nwg / NXCD, r = nwg % NXCD, xcd = wgid % NXCD, off = wgid / NXCD; wgid = (xcd < r ? xcd * (q + 1) : r * (q + 1) + (xcd - r) * q) + off; }
        const int nig = WGM * nN, gid = wgid / nig, fm = gid * WGM, gsz = (nM - fm) < WGM ? (nM - fm) : WGM;
        u.pm = fm + ((wgid % nig) % gsz); u.pn = (wgid % nig) / gsz; return true;
    }
    __device__ __forceinline__ const char* a_ptr(const Gemm& g, const Unit& u) const { return (const char*)g.A + (size_t)u.pm * BM * g.lda * 2; }
    __device__ __forceinline__ const char* b_ptr(const Gemm& g, const Unit& u) const { return (const char*)g.Bt + (size_t)u.pn * BM * g.K * 2; }
    __device__ __forceinline__ void a_ready(const Unit&) const {}
    __device__ __forceinline__ void done(const Unit&) const {}
};

typedef float f32x2_cv __attribute__((ext_vector_type(2))); typedef __bf16 bf16x2_cv __attribute__((ext_vector_type(2)));
__device__ __forceinline__ unsigned cvt_pk_bf16(float lo, float hi) { const f32x2_cv v = {lo, hi}; const bf16x2_cv b = __builtin_convertvector(v, bf16x2_cv); return __builtin_bit_cast(unsigned, b); }
typedef float f32x2 __attribute__((ext_vector_type(2)));
__device__ __forceinline__ f32x2 gelu_pk(f32x2 v) {
    const f32x2 av = __builtin_elementwise_abs(v), d = av * 0.2316418882f + 1.0f;
    f32x2 t; t.x = __builtin_amdgcn_rcpf(d.x); t.y = __builtin_amdgcn_rcpf(d.y);
    f32x2 q = t * 0.5307027145f + (-0.7265760135f); q = q * t + 0.7107068705f; q = q * t + (-0.142248368f); q = q * t + 0.127414796f; q = q * t;
    const f32x2 s = (v * v) * (-0.72134752044f);
    f32x2 e; e.x = __builtin_amdgcn_exp2f(s.x); e.y = __builtin_amdgcn_exp2f(s.y);
    const f32x2 m = v * (q * e), r = v - m;
    f32x2 o; o.x = v.x < 0.f ? m.x : r.x; o.y = v.y < 0.f ? m.y : r.y; return o;
}

constexpr int TT = 32768, SEQ = 8192;
constexpr float NEPS = 1e-6f;
constexpr float QC2 = 0.125f * 1.4426950408889634f;
typedef unsigned u32x2 __attribute__((ext_vector_type(2)));
__device__ __forceinline__ float bf2f(unsigned short v) { return __uint_as_float((unsigned)v << 16); }
__device__ __forceinline__ float bflo(unsigned w) { return __uint_as_float(w << 16); }
__device__ __forceinline__ float bfhi(unsigned w) { return __uint_as_float(w & 0xffff0000u); }
__device__ __forceinline__ float sigm(float x) { return __builtin_amdgcn_rcpf(1.0f + __builtin_amdgcn_exp2f(-1.4426950408889634f * x)); }
__device__ __forceinline__ u32x4 pack8(const f32x4& a, const f32x4& b) { u32x4 w; w.x = cvt_pk_bf16(a[0], a[1]); w.y = cvt_pk_bf16(a[2], a[3]); w.z = cvt_pk_bf16(b[0], b[1]); w.w = cvt_pk_bf16(b[2], b[3]); return w; }
__device__ __forceinline__ void unpack8(const u32x4& w, f32x4& a, f32x4& b) { a = (f32x4){bflo(w.x), bfhi(w.x), bflo(w.y), bfhi(w.y)}; b = (f32x4){bflo(w.z), bfhi(w.z), bflo(w.w), bfhi(w.w)}; }


struct EpiInProj {
    static constexpr bool PERM = true, AFTER_DRAIN = false, HAS_MID = false;
    unsigned char* ws; const float *qnw, *kcw, *ksw, *kww;
    __device__ __forceinline__ void mid(f32x4 (&)[2][2][4][2], const Unit&, int, int, int, int) const {}
    __device__ __forceinline__ void operator()(f32x4 (&acc)[2][2][4][2], const Unit& u, int wr, int wc, int fr, int fq_) const {
        int fq = fq_; asm volatile("" : "+v"(fq));
        const int pn = u.pn; int row0 = u.pm * BM + wr * 64 + fr; asm volatile("" : "+v"(row0));
        const float* rstd = (const float*)(ws + WS_RSTD1); const float* rope_c = (const float*)(ws + WS_ROPEC); const float* rope_s = (const float*)(ws + WS_ROPES);
        float rsv[8];
#pragma unroll
        for (int g = 0; g < 8; ++g) rsv[g] = rstd[row0 + (g >> 2) * HALF + (g & 3) * 16];
        if (pn < 6) {
            bf16_t* base = (bf16_t*)(ws + (pn < 2 ? WS_QKPRE : pn < 4 ? WS_MV : WS_MO)); const int col0 = (pn & 1) * 256 + wc * 32 + 8 * fq;
#pragma unroll
            for (int ai = 0; ai < 2; ++ai)
#pragma unroll
                for (int m = 0; m < 4; ++m) { const int row = row0 + ai * HALF + m * 16; const float rs = rsv[ai * 4 + m]; bf16_t* rowp = base + (size_t)row * 512 + col0;
#pragma unroll
                    for (int bj = 0; bj < 2; ++bj) *(u32x4*)(rowp + bj * HALF) = pack8(acc[ai][bj][m][0] * rs, acc[ai][bj][m][1] * rs); }
        } else if (pn < 11) {
            bf16_t* dst; int ld; const float* nw = nullptr; float osc = 1.0f;
            if (pn < 8) { dst = (bf16_t*)(ws + WS_NQ) + (4 * (pn - 6) + wc) * 64; ld = 512; nw = qnw; osc = QC2; }
            else { const int seg = (pn - 8) * 2 + (wc >> 1);
                const size_t so = seg == 0 ? WS_KC : seg == 1 ? WS_KS : seg == 2 ? WS_KW : seg == 3 ? WS_VC : seg == 4 ? WS_VS : WS_VW;
                dst = (bf16_t*)(ws + so) + (wc & 1) * 64; ld = 128; nw = seg == 0 ? kcw : seg == 1 ? ksw : seg == 2 ? kww : nullptr; }
            f32x4 w0[2] = {{1.f, 1.f, 1.f, 1.f}, {1.f, 1.f, 1.f, 1.f}}, w1[2] = {{1.f, 1.f, 1.f, 1.f}, {1.f, 1.f, 1.f, 1.f}};
            if (nw) {
#pragma unroll
                for (int n = 0; n < 2; ++n) { w0[n] = *(const f32x4*)(nw + 8 * fq + 4 * n); w1[n] = *(const f32x4*)(nw + 32 + 8 * fq + 4 * n); } }
            f32x4 cs[2][4];
            if (nw) { const int tp = row0 & (SEQ - 1); cs[0][0] = *(const f32x4*)(rope_c + tp * 32 + 8 * fq); cs[0][1] = *(const f32x4*)(rope_c + tp * 32 + 8 * fq + 4); cs[0][2] = *(const f32x4*)(rope_s + tp * 32 + 8 * fq); cs[0][3] = *(const f32x4*)(rope_s + tp * 32 + 8 * fq + 4); }
#pragma unroll
            for (int g = 0; g < 8; ++g) { const int ai = g >> 2, m = g & 3; const int row = row0 + ai * HALF + m * 16; const float rs = rsv[g];
                if (nw && g < 7) { const int tn = (row0 + ((g + 1) >> 2) * HALF + ((g + 1) & 3) * 16) & (SEQ - 1); f32x4 (&nx)[4] = cs[(g + 1) & 1];
                    nx[0] = *(const f32x4*)(rope_c + tn * 32 + 8 * fq); nx[1] = *(const f32x4*)(rope_c + tn * 32 + 8 * fq + 4); nx[2] = *(const f32x4*)(rope_s + tn * 32 + 8 * fq); nx[3] = *(const f32x4*)(rope_s + tn * 32 + 8 * fq + 4); }
#pragma unroll
                for (int n = 0; n < 2; ++n) { acc[ai][0][m][n] = acc[ai][0][m][n] * rs; acc[ai][1][m][n] = acc[ai][1][m][n] * rs; }
                if (nw) {
                    float s = 0.f;
#pragma unroll
                    for (int n = 0; n < 2; ++n)
#pragma unroll
                        for (int e = 0; e < 4; ++e) s += acc[ai][0][m][n][e] * acc[ai][0][m][n][e] + acc[ai][1][m][n][e] * acc[ai][1][m][n][e];
                    s += __shfl_xor(s, 16); s += __shfl_xor(s, 32);
                    const float rn = 1.0f / sqrtf(s * (1.0f / 64.0f) + NEPS); const f32x4 (&cc)[4] = cs[g & 1];
#pragma unroll
                    for (int n = 0; n < 2; ++n) { const f32x4 a = acc[ai][0][m][n] * rn * w0[n], b = acc[ai][1][m][n] * rn * w1[n]; acc[ai][0][m][n] = (a * cc[n] - b * cc[2 + n]) * osc; acc[ai][1][m][n] = (b * cc[n] + a * cc[2 + n]) * osc; }
                }
                bf16_t* rowp = dst + (size_t)row * ld + 8 * fq;
                *(u32x4*)(rowp) = pack8(acc[ai][0][m][0], acc[ai][0][m][1]); *(u32x4*)(rowp + 32) = pack8(acc[ai][1][m][0], acc[ai][1][m][1]); asm volatile("" ::: "memory"); }
        } else {
            if (wc == 0) {
#pragma unroll
                for (int ai = 0; ai < 2; ++ai)
#pragma unroll
                    for (int m = 0; m < 4; ++m) { const int row = row0 + ai * HALF + m * 16; const float rs = rsv[ai * 4 + m]; float* rowp = (float*)(ws + WS_SMALLG) + (size_t)row * 32 + 8 * fq;
                        *(f32x4*)(rowp) = acc[ai][0][m][0] * rs; *(f32x4*)(rowp + 4) = acc[ai][0][m][1] * rs; }
            }
        }
    }
};
struct EpiGate {
    static constexpr bool PERM = true, AFTER_DRAIN = false, HAS_MID = false;
    const float* rstd; const float* bias  ; bf16_t* gr; bf16_t* gn;
    __device__ __forceinline__ void mid(f32x4 (&)[2][2][4][2], const Unit&, int, int, int, int) const {}
    __device__ __forceinline__ void operator()(f32x4 (&acc)[2][2][4][2], const Unit& u, int wr, int wc, int fr, int fq) const {
        int row0 = u.pm * BM + wr * 64 + fr; asm volatile("" : "+v"(row0)); const int col0 = u.pn * 128 + wc * 32 + 8 * fq; const float* bp = bias + col0;
        f32x4 bv[2][2];
#pragma unroll
        for (int bj = 0; bj < 2; ++bj)
#pragma unroll
            for (int n = 0; n < 2; ++n) bv[bj][n] = *(const f32x4*)(bp + bj * 1024 + 4 * n);
        float rsv[8];
#pragma unroll
        for (int g = 0; g < 8; ++g) rsv[g] = rstd[row0 + (g >> 2) * HALF + (g & 3) * 16];
#pragma unroll
        for (int ai = 0; ai < 2; ++ai)
#pragma unroll
            for (int m = 0; m < 4; ++m) { const int row = row0 + ai * HALF + m * 16; const float rs = rsv[ai * 4 + m]; const size_t off = (size_t)row * 1024 + col0;
                f32x4 r[2], q[2];
#pragma unroll
                for (int n = 0; n < 2; ++n) { const f32x4 vm = acc[ai][0][m][n] * rs + bv[0][n], vn = acc[ai][1][m][n] * rs + bv[1][n];
#pragma unroll
                    for (int e = 0; e < 4; ++e) { const float gmv = sigm(vm[e]), gnv = sigm(vn[e]); q[n][e] = gnv; r[n][e] = gmv * __builtin_amdgcn_rcpf(fmaxf(gnv, 1e-30f)); } }
                *(u32x4*)(gr + off) = pack8(r[0], r[1]); *(u32x4*)(gn + off) = pack8(q[0], q[1]); }
    }
};
struct EpiMerge {
    static constexpr bool PERM = true, AFTER_DRAIN = false, HAS_MID = true;
    const bf16_t* gr; const bf16_t* gn; bf16_t* y;
    __device__ __forceinline__ void mid(f32x4 (&acc)[2][2][4][2], const Unit& u, int wr, int wc, int fr, int fq) const {
        int row0 = u.pm * BM + wr * 64 + fr; asm volatile("" : "+v"(row0)); const int col0 = u.pn * BM + wc * 32 + 8 * fq;
        u32x4 gq[4][2];
#pragma unroll
        for (int g = 0; g < 3; ++g) { const size_t off = (size_t)(row0 + (g >> 2) * HALF + (g & 3) * 16) * 1024 + col0; gq[g][0] = *(const u32x4*)(gr + off); gq[g][1] = *(const u32x4*)(gr + off + HALF); }
#pragma unroll
        for (int g = 0; g < 8; ++g) { const int ai = g >> 2, m = g & 3;
            if (g + 3 < 8) { const size_t off = (size_t)(row0 + ((g + 3) >> 2) * HALF + ((g + 3) & 3) * 16) * 1024 + col0; gq[(g + 3) & 3][0] = *(const u32x4*)(gr + off); gq[(g + 3) & 3][1] = *(const u32x4*)(gr + off + HALF); }
#pragma unroll
            for (int bj = 0; bj < 2; ++bj) { f32x4 a0, a1; unpack8(gq[g & 3][bj], a0, a1); acc[ai][bj][m][0] = acc[ai][bj][m][0] * a0; acc[ai][bj][m][1] = acc[ai][bj][m][1] * a1; }
            asm volatile("" : "+v"(acc[ai][0][m][0]), "+v"(acc[ai][0][m][1]), "+v"(acc[ai][1][m][0]), "+v"(acc[ai][1][m][1]) :: "memory"); }
    }
    __device__ __forceinline__ void operator()(f32x4 (&acc)[2][2][4][2], const Unit& u, int wr, int wc, int fr, int fq) const {
        int row0 = u.pm * BM + wr * 64 + fr; asm volatile("" : "+v"(row0)); const int col0 = u.pn * BM + wc * 32 + 8 * fq;
        u32x4 gq[2][2];
        { const size_t off = (size_t)row0 * 1024 + col0; gq[0][0] = *(const u32x4*)(gn + off); gq[0][1] = *(const u32x4*)(gn + off + HALF); }
#pragma unroll
        for (int g = 0; g < 8; ++g) { const int ai = g >> 2, m = g & 3; const size_t off = (size_t)(row0 + ai * HALF + m * 16) * 1024 + col0;
            if (g < 7) { const size_t offn = (size_t)(row0 + ((g + 1) >> 2) * HALF + ((g + 1) & 3) * 16) * 1024 + col0; gq[(g + 1) & 1][0] = *(const u32x4*)(gn + offn); gq[(g + 1) & 1][1] = *(const u32x4*)(gn + offn + HALF); }
#pragma unroll
            for (int bj = 0; bj < 2; ++bj) { f32x4 b0, b1; unpack8(gq[g & 1][bj], b0, b1); *(u32x4*)(y + off + bj * HALF) = pack8(acc[ai][bj][m][0] * b0, acc[ai][bj][m][1] * b1); }
            asm volatile("" ::: "memory"); }
    }
};
struct EpiWout {
    static constexpr bool PERM = true, AFTER_DRAIN = false, HAS_MID = false;
    const float* x; float* x1; bf16_t* x1b; float* ssq  ;
    __device__ __forceinline__ void mid(f32x4 (&)[2][2][4][2], const Unit&, int, int, int, int) const {}
    __device__ __forceinline__ void operator()(f32x4 (&acc)[2][2][4][2], const Unit& u, int wr, int wc, int fr, int fq) const {
        int row0 = u.pm * BM + wr * 64 + fr; asm volatile("" : "+v"(row0)); const int col0 = u.pn * BM + wc * 32 + 8 * fq;
        f32x4 xv[2][4];
        { const float* p = x + (size_t)row0 * 1024 + col0; xv[0][0] = *(const f32x4*)(p); xv[0][1] = *(const f32x4*)(p + 4); xv[0][2] = *(const f32x4*)(p + HALF); xv[0][3] = *(const f32x4*)(p + HALF + 4); }
#pragma unroll
        for (int g = 0; g < 8; ++g) { const int ai = g >> 2, m = g & 3; const int row = row0 + ai * HALF + m * 16; const size_t off = (size_t)row * 1024 + col0; float s = 0.f;
            if (g < 7) { const float* p = x + (size_t)(row0 + ((g + 1) >> 2) * HALF + ((g + 1) & 3) * 16) * 1024 + col0; f32x4 (&nx)[4] = xv[(g + 1) & 1];
                nx[0] = *(const f32x4*)(p); nx[1] = *(const f32x4*)(p + 4); nx[2] = *(const f32x4*)(p + HALF); nx[3] = *(const f32x4*)(p + HALF + 4); }
#pragma unroll
            for (int bj = 0; bj < 2; ++bj) { const f32x4 v0 = xv[g & 1][2 * bj] + acc[ai][bj][m][0], v1 = xv[g & 1][2 * bj + 1] + acc[ai][bj][m][1];
                *(u32x4*)(x1b + off + bj * HALF) = pack8(v0, v1);
#pragma unroll
                for (int e = 0; e < 4; ++e) s += v0[e] * v0[e] + v1[e] * v1[e]; }
            s += __shfl_xor(s, 16); s += __shfl_xor(s, 32);
            if (fq == 0) ssq[(size_t)row * 16 + u.pn * 4 + wc] = s;
            asm volatile("" ::: "memory"); }
    }
};
__device__ __forceinline__ float dpp_shr(float old, float v, int n) { return n == 1 ? __builtin_bit_cast(float, __builtin_amdgcn_update_dpp(__builtin_bit_cast(int, old), __builtin_bit_cast(int, v), 0x111, 0xf, 0xf, false))
                                                                                       : __builtin_bit_cast(float, __builtin_amdgcn_update_dpp(__builtin_bit_cast(int, old), __builtin_bit_cast(int, v), 0x112, 0xf, 0xf, false)); }
__device__ __forceinline__ float dpp_shl15(float v) { return __builtin_bit_cast(float, __builtin_amdgcn_update_dpp(0, __builtin_bit_cast(int, v), 0x10F, 0xf, 0xf, true)); }
__device__ __forceinline__ float dpp_shl14(float v) { return __builtin_bit_cast(float, __builtin_amdgcn_update_dpp(0, __builtin_bit_cast(int, v), 0x10E, 0xf, 0xf, true)); }
struct EpiFfnUp {
    static constexpr bool PERM = true, AFTER_DRAIN = false, HAS_MID = false;
    const float* ssq; const float* cw  ; const float* cb; bf16_t* midb; float* edgeA  ; float* edgeV  ; PG8_LAS float* ex  ;
    __device__ __forceinline__ void mid(f32x4 (&)[2][2][4][2], const Unit&, int, int, int, int) const {}
    __device__ __forceinline__ void operator()(f32x4 (&acc)[2][2][4][2], const Unit& u, int wr, int wc, int fr, int fq) const {
        constexpr int FF = 2816;
        int row0 = u.pm * BM + wr * 64 + fr; asm volatile("" : "+v"(row0)); const int cl = wc * 32 + 8 * fq, col0 = u.pn * 128 + cl;
        { const float* sp = ssq + (size_t)row0 * 16 + 4 * fq;
#pragma unroll
          for (int ai = 0; ai < 2; ++ai) { float rsv[4];
#pragma unroll
              for (int m = 0; m < 4; ++m) { const f32x4 p = *(const f32x4*)(sp + (size_t)(ai * HALF + m * 16) * 16); rsv[m] = (p[0] + p[1]) + (p[2] + p[3]); }
#pragma unroll
              for (int m = 0; m < 4; ++m) { rsv[m] += __shfl_xor(rsv[m], 16); rsv[m] += __shfl_xor(rsv[m], 32); rsv[m] = __builtin_amdgcn_rsqf(rsv[m] * (1.0f / 1024.0f) + NEPS); }
#pragma unroll
              for (int m = 0; m < 4; ++m) {
#pragma unroll
                  for (int n = 0; n < 2; ++n) { acc[ai][0][m][n] = acc[ai][0][m][n] * rsv[m]; acc[ai][1][m][n] = acc[ai][1][m][n] * rsv[m]; } }
              asm volatile("" ::: "memory"); } }
#pragma unroll
        for (int ai = 0; ai < 2; ++ai) { const int s = ai * 2 + wr;
            if (fr >= 14) { PG8_LAS float* p = ex + (s * 2 + (fr - 14)) * 128 + cl; *(PG8_LAS f32x4*)(p) = acc[ai][0][3][0]; *(PG8_LAS f32x4*)(p + 4) = acc[ai][0][3][1]; } }
        if (wr == 0 && fr < 2) { float* pa = edgeA + ((size_t)u.pm * 4 + fr) * FF + col0; float* pv = edgeV + ((size_t)u.pm * 2 + fr) * FF + col0;
            *(f32x4*)(pa) = acc[0][0][0][0]; *(f32x4*)(pa + 4) = acc[0][0][0][1]; *(f32x4*)(pv) = acc[0][1][0][0]; *(f32x4*)(pv + 4) = acc[0][1][0][1]; }
        if (wr == 1 && fr >= 14) { float* pa = edgeA + ((size_t)u.pm * 4 + 2 + (fr - 14)) * FF + col0; *(f32x4*)(pa) = acc[1][0][3][0]; *(f32x4*)(pa + 4) = acc[1][0][3][1]; }
        asm volatile("s_waitcnt lgkmcnt(0)" ::: "memory"); __builtin_amdgcn_s_barrier(); asm volatile("" ::: "memory");
        f32x4 w0[2], w1[2], w2[2], bb[2];
#pragma unroll
        for (int n = 0; n < 2; ++n) { w0[n] = *(const f32x4*)(cw + col0 + 4 * n); w1[n] = *(const f32x4*)(cw + FF + col0 + 4 * n); w2[n] = *(const f32x4*)(cw + 2 * FF + col0 + 4 * n); bb[n] = *(const f32x4*)(cb + col0 + 4 * n); }
#pragma unroll
        for (int ai = 0; ai < 2; ++ai) { const int s = ai * 2 + wr;
            f32x4 t1[2], t2[2];
#pragma unroll
            for (int n = 0; n < 2; ++n) { f32x4 h62 = (f32x4){0.f, 0.f, 0.f, 0.f}, h63 = h62;
                if (s > 0) { h62 = *(const PG8_LAS f32x4*)(ex + ((s - 1) * 2 + 0) * 128 + cl + 4 * n); h63 = *(const PG8_LAS f32x4*)(ex + ((s - 1) * 2 + 1) * 128 + cl + 4 * n); }
                t1[n] = h63; t2[n] = fr == 0 ? h62 : h63; }
#pragma unroll
            for (int m = 0; m < 4; ++m) { f32x4 o[2];
#pragma unroll
                for (int n = 0; n < 2; ++n) {
                    f32x4 cv;
#pragma unroll
                    for (int e = 0; e < 4; ++e) { const float X = acc[ai][0][m][n][e]; const float p1 = dpp_shr(t1[n][e], X, 1), p2 = dpp_shr(t2[n][e], X, 2);
                        t1[n][e] = dpp_shl15(X); t2[n][e] = dpp_shl14(X);
                        cv[e] = w2[n][e] * X + w1[n][e] * p1 + w0[n][e] * p2 + bb[n][e]; }
                    const f32x2 ga = gelu_pk((f32x2){cv[0], cv[1]}), gb = gelu_pk((f32x2){cv[2], cv[3]});
                    o[n] = (f32x4){ga.x, ga.y, gb.x, gb.y} * acc[ai][1][m][n]; }
                const bool skip = (s == 0 && m == 0 && fr < 2);
                if (!skip) *(u32x4*)(midb + (size_t)(row0 + ai * HALF + m * 16) * FF + col0) = pack8(o[0], o[1]);
                asm volatile("" ::: "memory"); }
        }
    }
};
struct EpiFfnDown {
    static constexpr bool PERM = true, AFTER_DRAIN = false, HAS_MID = false;
    const bf16_t* in; float* out;
    __device__ __forceinline__ void mid(f32x4 (&)[2][2][4][2], const Unit&, int, int, int, int) const {}
    __device__ __forceinline__ void operator()(f32x4 (&acc)[2][2][4][2], const Unit& u, int wr, int wc, int fr, int fq) const {
        int row0 = u.pm * BM + wr * 64 + fr; asm volatile("" : "+v"(row0)); const int col0 = u.pn * BM + wc * 32 + 8 * fq;
        u32x4 xv[2][2];
        { const bf16_t* p = in + (size_t)row0 * 1024 + col0; xv[0][0] = *(const u32x4*)(p); xv[0][1] = *(const u32x4*)(p + HALF); }
#pragma unroll
        for (int g = 0; g < 8; ++g) { const int ai = g >> 2, m = g & 3; const size_t off = (size_t)(row0 + ai * HALF + m * 16) * 1024 + col0;
            if (g < 7) { const bf16_t* p = in + (size_t)(row0 + ((g + 1) >> 2) * HALF + ((g + 1) & 3) * 16) * 1024 + col0; xv[(g + 1) & 1][0] = *(const u32x4*)(p); xv[(g + 1) & 1][1] = *(const u32x4*)(p + HALF); }
#pragma unroll
            for (int bj = 0; bj < 2; ++bj) { f32x4 r0, r1; unpack8(xv[g & 1][bj], r0, r1); float* q = out + off + bj * HALF; *(f32x4*)(q) = r0 + acc[ai][bj][m][0]; *(f32x4*)(q + 4) = r1 + acc[ai][bj][m][1]; }
            asm volatile("" ::: "memory"); }
    }
};
struct EpiCmpHid {
    static constexpr bool PERM = true, AFTER_DRAIN = false, HAS_MID = false;
    const float* cbias  ; bf16_t* hid;
    __device__ __forceinline__ void mid(f32x4 (&)[2][2][4][2], const Unit&, int, int, int, int) const {}
    __device__ __forceinline__ void operator()(f32x4 (&acc)[2][2][4][2], const Unit& u, int wr, int wc, int fr, int fq) const {
        int row0 = u.pm * BM + wr * 64 + fr; asm volatile("" : "+v"(row0)); const int col0 = wc * 32 + 8 * fq; const float* bp = cbias + (u.pm >> 4) * 256 + col0;
#pragma unroll
        for (int ai = 0; ai < 2; ++ai)
#pragma unroll
            for (int m = 0; m < 4; ++m) { bf16_t* rowp = hid + (size_t)(row0 + ai * HALF + m * 16) * 256 + col0;
#pragma unroll
                for (int bj = 0; bj < 2; ++bj) { f32x4 v0 = acc[ai][bj][m][0] + *(const f32x4*)(bp + bj * HALF), v1 = acc[ai][bj][m][1] + *(const f32x4*)(bp + bj * HALF + 4);
                    const f32x2 g0 = gelu_pk((f32x2){v0[0], v0[1]}), g1 = gelu_pk((f32x2){v0[2], v0[3]}), g2 = gelu_pk((f32x2){v1[0], v1[1]}), g3 = gelu_pk((f32x2){v1[2], v1[3]});
                    *(u32x4*)(rowp + bj * HALF) = pack8((f32x4){g0.x, g0.y, g1.x, g1.y}, (f32x4){g2.x, g2.y, g3.x, g3.y}); } }
    }
};
struct CmpOrder {
    int G, c; const bf16_t* kc; const bf16_t* vc; const bf16_t* w1t;
    __device__ bool next(int i, Unit& u) const { const int L = i * G + c; if (L >= 32) return false; u.pm = L; u.pn = 0; return true; }
    __device__ __forceinline__ const char* a_ptr(const Gemm&, const Unit& u) const { const int kvbg = u.pm >> 1, half = u.pm & 1, kv = kvbg >> 3, b = (kvbg >> 1) & 3, g = kvbg & 1;
        return (const char*)((kv ? vc : kc) + ((size_t)(b * SEQ + 16 * 256 * half) * 128 + g * 64)); }
    __device__ __forceinline__ const char* b_ptr(const Gemm&, const Unit& u) const { return (const char*)(w1t + (size_t)(u.pm >> 4) * 256 * 2048); }
    __device__ __forceinline__ void a_ready(const Unit&) const {}
    __device__ __forceinline__ void done(const Unit&) const {}
};
template <class Epi, class Sched, bool ALIGN_EPI = false, bool SP2 = false>
__device__ __forceinline__ void gemm_phase(PG8_LAS unsigned char* lds, const Gemm g, const Sched& S, const Epi& E) {
    int tid_ = threadIdx.x; asm volatile("" : "+v"(tid_));
    const int tid = tid_, wid = __builtin_amdgcn_readfirstlane(tid >> 6), lane = tid & 63, wr = wid >> 2, wc = wid & 3, fr = lane & 15, fq = lane >> 4;
    const int K = g.K, nt = K / BK;
    unsigned voffA[2], voffB[2];
#pragma unroll
    for (int i = 0; i < 2; ++i) { int R, C; stage_rc(tid * 16 + i * 8192, R, C); const int Rb = Epi::PERM ? ((R & ~31) + perm32(R & 31)) : R;
        voffA[i] = (unsigned)(R * g.lda + C) * 2u; voffB[i] = (unsigned)(Rb * K + C) * 2u; }
    const size_t kstepA = (size_t)g.ksA, kstepB = (size_t)(BK * 2);
    const size_t hstepA = (size_t)HALF * g.lda * 2, hstepB = (size_t)HALF * K * 2;
    const unsigned ldsw = (unsigned)wid * 1024u;
    const int aoff = lds_byte(wr * 64 + fr, fq * 8), boff = lds_byte(wc * 32 + fr, fq * 8);
#define PG8_SA(b, h) (((b) * 2 + (h)) * HTB)
#define PG8_SB(b, h) ((4 + (b) * 2 + (h)) * HTB)
#define PG8_STAGE(bufoff, gbase, voff) do { _Pragma("unroll") for (int _i = 0; _i < 2; ++_i) \
        __builtin_amdgcn_global_load_lds((const unsigned*)((const char*)(gbase) + (voff)[_i]), (PG8_LAS unsigned*)(lds + (bufoff) + ldsw + _i * 8192), 16, 0, 0); } while (0)
#define PG8_LDA(dst, b, h) do { _Pragma("unroll") for (int m = 0; m < 4; ++m) _Pragma("unroll") for (int k = 0; k < 2; ++k) dst[m][k] = *(const PG8_LAS bf16x8*)(lds + PG8_SA(b, h) + aoff + m * 2048 + k * 1024); } while (0)
#define PG8_LDB(dst, b, h) do { _Pragma("unroll") for (int n = 0; n < 2; ++n) _Pragma("unroll") for (int k = 0; k < 2; ++k) dst[n][k] = *(const PG8_LAS bf16x8*)(lds + PG8_SB(b, h) + boff + n * 2048 + k * 1024); } while (0)
#define PG8_MMA(ai, bj, At, Bt) do { __builtin_amdgcn_s_setprio(1); _Pragma("unroll") for (int m = 0; m < 4; ++m) _Pragma("unroll") for (int n = 0; n < 2; ++n) _Pragma("unroll") for (int k = 0; k < 2; ++k) \
        acc[ai][bj][m][n] = __builtin_amdgcn_mfma_f32_16x16x32_bf16(Bt[n][k], At[m][k], acc[ai][bj][m][n], 0, 0, 0); __builtin_amdgcn_s_setprio(0); } while (0)
#define PG8_WAIT_V(n) asm volatile("s_waitcnt vmcnt(" #n ")" ::: "memory")
#define PG8_WAIT_L(n) asm volatile("s_waitcnt lgkmcnt(" #n ")" ::: "memory")
#define PG8_BAR __builtin_amdgcn_s_barrier()
#define PG8_SCHED __builtin_amdgcn_sched_barrier(0)
    Unit cur, nxt; int ui = 0;
    if (!S.next(0, cur)) return;
    f32x4 acc[2][2][4][2];
#pragma unroll
    for (int a = 0; a < 2; ++a)
#pragma unroll
        for (int b = 0; b < 2; ++b)
#pragma unroll
            for (int m = 0; m < 4; ++m)
#pragma unroll
                for (int n = 0; n < 2; ++n) acc[a][b][m][n] = (f32x4){0.f, 0.f, 0.f, 0.f};
    bf16x8 At[4][2], B0[2][2], B1[2][2];
    const char* cA = S.a_ptr(g, cur); const char* cB = S.b_ptr(g, cur);
    S.a_ready(cur);
    if constexpr (SP2) {
        PG8_STAGE(PG8_SB(0, 0), cB, voffB); PG8_STAGE(PG8_SB(0, 1), cB + hstepB, voffB); PG8_STAGE(PG8_SA(0, 0), cA, voffA); PG8_STAGE(PG8_SA(0, 1), cA + hstepA, voffA);
        if (wr == 1) PG8_BAR;
        PG8_WAIT_V(2); PG8_BAR;
        PG8_STAGE(PG8_SB(1, 0), cB + kstepB, voffB); PG8_STAGE(PG8_SA(1, 0), cA + kstepA, voffA); PG8_STAGE(PG8_SB(1, 1), cB + hstepB + kstepB, voffB);
        PG8_WAIT_V(6); PG8_BAR;
    } else {
        PG8_STAGE(PG8_SB(0, 0), cB, voffB); PG8_STAGE(PG8_SA(0, 0), cA, voffA); PG8_STAGE(PG8_SB(0, 1), cB + hstepB, voffB); PG8_STAGE(PG8_SA(0, 1), cA + hstepA, voffA);
        if (wr == 1) PG8_BAR;
        PG8_WAIT_V(4); PG8_BAR;
        PG8_STAGE(PG8_SB(1, 0), cB + kstepB, voffB); PG8_STAGE(PG8_SA(1, 0), cA + kstepA, voffA); PG8_STAGE(PG8_SB(1, 1), cB + hstepB + kstepB, voffB);
        PG8_WAIT_V(6); PG8_BAR;
    }
    for (;;) {
        const bool has_next = S.next(ui + 1, nxt);
        const char* nA = has_next ? S.a_ptr(g, nxt) : cA; const char* nB = has_next ? S.b_ptr(g, nxt) : cB;
        for (int t = 0; t < nt; t += 2) {
            if constexpr (Epi::HAS_MID) { if (t == nt / 2) E.mid(acc, cur, wr, wc, fr, fq); }
            const bool last = (t == nt - 2);
            const char* a1 = cA + (size_t)(t + 1) * kstepA;
            const char* a2 = last ? nA : cA + (size_t)(t + 2) * kstepA; const char* b2 = last ? nB : cB + (size_t)(t + 2) * kstepB;
            const char* a3 = a2 + kstepA; const char* b3 = b2 + kstepB;
            if (last && has_next) S.a_ready(nxt);
            if constexpr (SP2) {
            PG8_LDB(B0, 0, 0); PG8_LDB(B1, 0, 1); PG8_SCHED; PG8_LDA(At, 0, 0); PG8_STAGE(PG8_SA(1, 1), a1 + hstepA, voffA);
            PG8_WAIT_V(8); PG8_WAIT_L(0); PG8_BAR; PG8_MMA(0, 0, At, B0); PG8_MMA(0, 1, At, B1); PG8_BAR; PG8_SCHED;
            PG8_LDA(At, 0, 1); PG8_STAGE(PG8_SB(0, 0), b2, voffB); PG8_STAGE(PG8_SB(0, 1), b2 + hstepB, voffB); PG8_STAGE(PG8_SA(0, 0), a2, voffA);
            PG8_WAIT_V(8); PG8_WAIT_L(0); PG8_BAR; PG8_MMA(1, 0, At, B0); PG8_MMA(1, 1, At, B1); PG8_BAR; PG8_SCHED;
            PG8_LDB(B0, 1, 0); PG8_LDB(B1, 1, 1); PG8_SCHED; PG8_LDA(At, 1, 0); PG8_STAGE(PG8_SA(0, 1), a2 + hstepA, voffA);
            PG8_WAIT_V(8); PG8_WAIT_L(0); PG8_BAR; PG8_MMA(0, 0, At, B0); PG8_MMA(0, 1, At, B1); PG8_BAR; PG8_SCHED;
            PG8_LDA(At, 1, 1); PG8_STAGE(PG8_SB(1, 0), b3, voffB); PG8_STAGE(PG8_SB(1, 1), b3 + hstepB, voffB); PG8_STAGE(PG8_SA(1, 0), a3, voffA);
            PG8_WAIT_V(8); PG8_WAIT_L(0); PG8_BAR; PG8_MMA(1, 0, At, B0); PG8_MMA(1, 1, At, B1); PG8_BAR; PG8_SCHED;
            } else {
            PG8_LDB(B0, 0, 0); PG8_SCHED; PG8_LDA(At, 0, 0); PG8_STAGE(PG8_SA(1, 1), a1 + hstepA, voffA);
            PG8_WAIT_L(8); PG8_BAR; PG8_WAIT_L(0); PG8_MMA(0, 0, At, B0); PG8_BAR; PG8_SCHED;
            PG8_LDB(B1, 0, 1); PG8_STAGE(PG8_SB(0, 0), b2, voffB);
            PG8_BAR; PG8_WAIT_L(0); PG8_MMA(0, 1, At, B1); PG8_BAR;
            PG8_LDA(At, 0, 1); PG8_STAGE(PG8_SA(0, 0), a2, voffA);
            PG8_BAR; PG8_WAIT_L(0); PG8_MMA(1, 0, At, B0); PG8_BAR; PG8_SCHED;
            PG8_STAGE(PG8_SB(0, 1), b2 + hstepB, voffB);
            PG8_WAIT_V(6); PG8_BAR; PG8_MMA(1, 1, At, B1); PG8_BAR;
            PG8_LDB(B0, 1, 0); PG8_SCHED; PG8_LDA(At, 1, 0); PG8_STAGE(PG8_SA(0, 1), a2 + hstepA, voffA);
            PG8_WAIT_L(8); PG8_BAR; PG8_WAIT_L(0); PG8_MMA(0, 0, At, B0); PG8_BAR; PG8_SCHED;
            PG8_LDB(B1, 1, 1); PG8_STAGE(PG8_SB(1, 0), b3, voffB);
            PG8_BAR; PG8_WAIT_L(0); PG8_MMA(0, 1, At, B1); PG8_BAR;
            PG8_LDA(At, 1, 1); PG8_STAGE(PG8_SA(1, 0), a3, voffA);
            PG8_BAR; PG8_WAIT_L(0); PG8_MMA(1, 0, At, B0); PG8_BAR; PG8_SCHED;
            PG8_STAGE(PG8_SB(1, 1), b3 + hstepB, voffB);
            PG8_WAIT_V(6); PG8_BAR; PG8_MMA(1, 1, At, B1); PG8_BAR;
            }
        }
        if constexpr (ALIGN_EPI) { if (wr == 0) PG8_BAR; }
        if constexpr (!Epi::AFTER_DRAIN) { E(acc, cur, wr, wc, fr, fq); S.done(cur); }
        if (!has_next) break;
#pragma unroll
        for (int a = 0; a < 2; ++a)
#pragma unroll
            for (int b = 0; b < 2; ++b)
#pragma unroll
                for (int m = 0; m < 4; ++m)
#pragma unroll
                    for (int n = 0; n < 2; ++n) acc[a][b][m][n] = (f32x4){0.f, 0.f, 0.f, 0.f};
        cur = nxt; cA = nA; cB = nB; ++ui;
        if constexpr (ALIGN_EPI) { if (wr == 1) PG8_BAR; }
    }
    PG8_WAIT_V(0);
    if constexpr (!ALIGN_EPI) { if (wr == 0) PG8_BAR; }
    PG8_BAR;
    if constexpr (Epi::AFTER_DRAIN) { E.fused(acc, cur, wr, wc, fr, fq, lds, wid, lane); S.done(cur); }
#undef PG8_SA
#undef PG8_SB
#undef PG8_STAGE
#undef PG8_LDA
#undef PG8_LDB
#undef PG8_MMA
#undef PG8_WAIT_V
#undef PG8_WAIT_L
#undef PG8_BAR
#undef PG8_SCHED
}
}

using pg8::bf16_t; using pg8::f32x4; using pg8::u32x4; using pg8::TT; using pg8::SEQ; using pg8::NEPS; using pg8::QC2; using pg8::bf2f; using pg8::sigm;
#define LAS __attribute__((address_space(3)))
struct Args { const float* in[27]; float* out; unsigned char* ws; float rope_inv[32]; };

__device__ __forceinline__ unsigned f2bf(float f) { unsigned u = __builtin_bit_cast(unsigned, f); return (u + 0x7fffu + ((u >> 16) & 1u)) >> 16; }
__device__ __forceinline__ unsigned pk2(float lo, float hi) { return f2bf(lo) | (f2bf(hi) << 16); }
__device__ __forceinline__ float wave_sum(float v) {
#pragma unroll
    for (int o = 1; o < 64; o <<= 1) v += __shfl_xor(v, o);
    return v;
}
template <class F> __device__ __forceinline__ void transpose_item(const float* W, int ldw, int k0src, const float* kscale, bf16_t* WT, int ldt, int k0dst, int row0, LAS float* scr, int lane, F srccol) {
    { const int c4 = lane & 7, kr = lane >> 3; const int sc = srccol(4 * c4); f32x4 v[8];
#pragma unroll
      for (int i = 0; i < 8; ++i) { const int kk = 8 * i + kr; v[i] = (f32x4){0.f, 0.f, 0.f, 0.f}; if (sc >= 0) { v[i] = *(const f32x4*)(W + (size_t)(k0src + kk) * ldw + sc); if (kscale) v[i] = v[i] * kscale[k0src + kk]; } }
#pragma unroll
      for (int i = 0; i < 8; ++i) { LAS float* p = scr + (8 * i + kr) * 33 + 4 * c4; p[0] = v[i][0]; p[1] = v[i][1]; p[2] = v[i][2]; p[3] = v[i][3]; } }
    asm volatile("s_waitcnt lgkmcnt(0)" ::: "memory");
    const int c = lane & 7;
#pragma unroll
    for (int jj = 0; jj < 4; ++jj) { const int n = (lane >> 3) + 8 * jj; const LAS float* s = scr + (8 * c) * 33 + n;
        u32x4 o; o.x = pk2(s[0 * 33], s[1 * 33]); o.y = pk2(s[2 * 33], s[3 * 33]); o.z = pk2(s[4 * 33], s[5 * 33]); o.w = pk2(s[6 * 33], s[7 * 33]);
        *(u32x4*)(WT + (size_t)(row0 + n) * ldt + k0dst + 8 * c) = o; }
    asm volatile("s_waitcnt lgkmcnt(0)" ::: "memory");
}
__device__ __forceinline__ int inproj_src(int p) {
    const int tile = p >> 8, l = p & 255;
    if (tile < 6) return p;
    const int half = l >> 7, wh = (l >> 5) & 3, j = l & 31;
    if (tile < 8) return C_NQ + 64 * (4 * (tile - 6) + wh) + 32 * half + j;
    if (tile == 8) return (wh < 2 ? C_KC + 64 * wh : C_KS + 64 * (wh - 2)) + 32 * half + j;
    if (tile == 9) return (wh < 2 ? C_KW + 64 * wh : C_VC + 64 * (wh - 2)) + 32 * half + j;
    if (tile == 10) return (wh < 2 ? C_VS + 64 * wh : C_VW + 64 * (wh - 2)) + 32 * half + j;
    if (l < 8) return C_MI + l; if (l < 32) return C_NG + (l - 8); return -1;
}
#define GAS __attribute__((address_space(1)))
typedef GAS unsigned gu32;
typedef GAS unsigned long long gu64;
#define RLX_AGENT __ATOMIC_RELAXED, __HIP_MEMORY_SCOPE_AGENT
__device__ __forceinline__ unsigned long long rt() { return __builtin_amdgcn_s_memrealtime(); }
#define XB_TMO      128
#define XB_XCNT(j)  (256  + 64 * (j))
#define XB_XSUB(j)  (1280 + 64 * (j))
#define XB_XGEN(j)  (2304 + 64 * (j))
#define XB_TOP      3328
#define XB_TOPGEN   3392
#define XCD_BAR_WORDS 3456
#define XB_SPIN_CAP (1u << 18)

__device__ __forceinline__ unsigned xb_ld(unsigned* p)              { return __hip_atomic_load(p, __ATOMIC_RELAXED, __HIP_MEMORY_SCOPE_AGENT); }
__device__ __forceinline__ unsigned xb_add(unsigned* p, unsigned v) { return __hip_atomic_fetch_add(p, v, __ATOMIC_RELAXED, __HIP_MEMORY_SCOPE_AGENT); }
__device__ __forceinline__ unsigned xb_xcc_id() { return (unsigned)__builtin_amdgcn_s_getreg((3 << 11) | 20) & 0xFu; }
#define XB_SPIN(cond, bar) do { unsigned _sp = 0; while (cond) { __builtin_amdgcn_s_sleep(1); \
    if ((++_sp & 255u) == 0u) { if (xb_ld(&(bar)[XB_TMO])) break; if (_sp > XB_SPIN_CAP) { atomicAdd(&(bar)[XB_TMO], 1u); break; } } } } while (0)

struct XcdBarrier {
    unsigned* bar; unsigned x;
    volatile LAS unsigned* st;
};

__device__ __forceinline__ XcdBarrier xcd_barrier_post(unsigned* bar, volatile LAS unsigned* st) {
    XcdBarrier b; b.bar = bar; b.x = xb_xcc_id(); b.st = st;
    if (threadIdx.x == 0) (void)xb_add(&bar[XB_XCNT(b.x)], 1u);
    return b;
}
__device__ __forceinline__ void xcd_barrier_complete(unsigned* bar, unsigned x, unsigned& nloc, unsigned& nx) {
    const unsigned G = gridDim.x * gridDim.y * gridDim.z;
    unsigned sum, cnt, mine, sp = 0u;
    for (;;) {
        sum = 0u; cnt = 0u; mine = 0u;
#pragma unroll
        for (unsigned j = 0; j < 16; ++j) { const unsigned c = xb_ld(&bar[XB_XCNT(j)]); sum += c; cnt += (c > 0u) ? 1u : 0u; mine = (j == x) ? c : mine; }
        if (sum == G) break;
        __builtin_amdgcn_s_sleep(1);
        if ((++sp & 255u) == 0u) { if (xb_ld(&bar[XB_TMO])) break; if (sp > XB_SPIN_CAP) { atomicAdd(&bar[XB_TMO], 1u); break; } }
    }
    nloc = mine > 0u ? mine : 1u; nx = cnt > 0u ? cnt : 1u;
}

__device__ __forceinline__ void xcd_barrier(const XcdBarrier& b) {
    asm volatile("s_waitcnt vmcnt(0)" ::: "memory");
    __syncthreads();
    if (threadIdx.x == 0) {
        unsigned* bar = b.bar;
        __builtin_amdgcn_s_waitcnt(0);
        unsigned nloc = b.st[0], nx = b.st[1];
        if (nloc == 0u) { xcd_barrier_complete(bar, b.x, nloc, nx); b.st[0] = nloc; b.st[1] = nx; }
        const unsigned old = xb_add(&bar[XB_XSUB(b.x)], 1u);
        const unsigned gen = old / nloc;
        if (old + 1u == (gen + 1u) * nloc) {
            __builtin_amdgcn_fence(__ATOMIC_RELEASE, "agent");
            asm volatile("s_waitcnt vmcnt(0)" ::: "memory");
            const unsigned og = xb_add(&bar[XB_TOP], 1u);
            const unsigned tg = og / nx;
            if (og + 1u == (tg + 1u) * nx) xb_add(&bar[XB_TOPGEN], 1u);
            else XB_SPIN(xb_ld(&bar[XB_TOPGEN]) == tg, bar);
            __builtin_amdgcn_fence(__ATOMIC_ACQUIRE, "agent");
            xb_add(&bar[XB_XGEN(b.x)], 1u);
            asm volatile("s_waitcnt vmcnt(0)" ::: "memory");
        } else {
            XB_SPIN(xb_ld(&bar[XB_XGEN(b.x)]) == gen, bar);
            __builtin_amdgcn_fence(__ATOMIC_ACQUIRE, "agent");
            asm volatile("s_waitcnt vmcnt(0)" ::: "memory");
        }
    }
    __syncthreads();
}

struct Ctx { int tid, lane, wave, G, vcu, gw, ngw, gtid, nthr; LAS unsigned char* lds; };

template <int PART> __device__ __forceinline__ void phase_transposes(const Ctx& C, const Args& a) {
    unsigned char* ws = a.ws;
    LAS float* scr = (LAS float*)(C.lds + C.wave * 16384);
    const float* w_in = a.in[2]; const float* norm1 = a.in[1]; const float* norm2 = a.in[22];
    constexpr int I_WIN = 96 * 16, I_WG = 64 * 16, I_WMN = 32 * 16, I_WOUT = 32 * 16, I_WUP = 176 * 16, I_WDN = 32 * 44, I_CW1 = 16 * 32;
    constexpr int NITEMS = I_WIN + I_WG + I_WMN + I_WOUT + I_WUP + I_WDN + I_CW1;
    const int it_lo = PART == 0 ? 0 : I_WIN, it_hi = PART == 0 ? I_WIN + I_CW1 : NITEMS - I_CW1;
    for (int it0 = it_lo + C.gw; it0 < it_hi; it0 += C.ngw) {
        int r = (PART == 0 && it0 >= I_WIN) ? it0 + (NITEMS - I_CW1 - I_WIN) : it0;
        if (r < I_WIN) { const int blk = r >> 4, kb = r & 15; transpose_item(w_in, DIN, 64 * kb, norm1, (bf16_t*)(ws + WS_WIN), 1024, 64 * kb, 32 * blk, scr, C.lane, [=](int j) { return inproj_src(32 * blk + j); }); continue; } r -= I_WIN;
        if (r < I_WG) { const int blk = r >> 4, kb = r & 15; const int p0 = 32 * blk, pn = p0 >> 8, half = (p0 >> 7) & 1, jj = p0 & 127;
            transpose_item(w_in, DIN, 64 * kb, norm1, (bf16_t*)(ws + WS_WG), 1024, 64 * kb, p0, scr, C.lane, [=](int j) { return C_GM + half * 1024 + 128 * pn + jj + j; }); continue; } r -= I_WG;
        if (r < I_WMN) { const int blk = r >> 4, kb = r & 15; const float* W = kb < 8 ? a.in[18] : a.in[19]; transpose_item(W, 1024, 64 * (kb & 7), nullptr, (bf16_t*)(ws + WS_WMN), 1024, 64 * kb, 32 * blk, scr, C.lane, [=](int j) { return 32 * blk + j; }); continue; } r -= I_WMN;
        if (r < I_WOUT) { const int blk = r >> 4, kb = r & 15; transpose_item(a.in[21], 1024, 64 * kb, nullptr, (bf16_t*)(ws + WS_WOUT), 1024, 64 * kb, 32 * blk, scr, C.lane, [=](int j) { return 32 * blk + j; }); continue; } r -= I_WOUT;
        if (r < I_WUP) { const int blk = r >> 4, kb = r & 15; const int p0 = 32 * blk, pn = p0 >> 8, half = (p0 >> 7) & 1, jj = p0 & 127;
            transpose_item(a.in[23], 2 * DFF, 64 * kb, norm2, (bf16_t*)(ws + WS_WUP), 1024, 64 * kb, p0, scr, C.lane, [=](int j) { return half * DFF + 128 * pn + jj + j; }); continue; } r -= I_WUP;
        if (r < I_WDN) { const int blk = r / 44, kb = r % 44; transpose_item(a.in[26], 1024, 64 * kb, nullptr, (bf16_t*)(ws + WS_WDN), DFF, 64 * kb, 32 * blk, scr, C.lane, [=](int j) { return 32 * blk + j; }); continue; } r -= I_WDN;
        { const int kv = r >> 8, blk = (r >> 5) & 7, kb = r & 31; transpose_item(kv ? a.in[16] : a.in[13], 256, 64 * kb, nullptr, (bf16_t*)(ws + WS_CW1) + (size_t)kv * 256 * 2048, 2048, 64 * kb, 32 * blk, scr, C.lane, [=](int j) { return 32 * blk + j; }); }
    }
}
__device__ __forceinline__ void xrow_load(f32x4 (&v)[4][4], const float* x, int m0, int lane) {
#pragma unroll
    for (int r = 0; r < 4; ++r) { const f32x4* xr = (const f32x4*)(x + (size_t)(m0 + r) * DM) + lane;
#pragma unroll
        for (int j = 0; j < 4; ++j) v[r][j] = __builtin_nontemporal_load(xr + 64 * j); }
}
__device__ __forceinline__ void xrow_store(const f32x4 (&v)[4][4], bf16_t* xb, float* rstd, int m0, int lane) {
    float s[4];
#pragma unroll
    for (int r = 0; r < 4; ++r) { s[r] = 0.f;
#pragma unroll
        for (int j = 0; j < 4; ++j) s[r] += (v[r][j][0] * v[r][j][0] + v[r][j][1] * v[r][j][1]) + (v[r][j][2] * v[r][j][2] + v[r][j][3] * v[r][j][3]); }
#pragma unroll
    for (int o = 1; o < 64; o <<= 1) {
#pragma unroll
        for (int r = 0; r < 4; ++r) s[r] += __shfl_xor(s[r], o); }
#pragma unroll
    for (int r = 0; r < 4; ++r) { if (lane == 0) rstd[m0 + r] = 1.0f / sqrtf(s[r] * (1.0f / DM) + NEPS);
        unsigned long long* o8 = (unsigned long long*)(xb + (size_t)(m0 + r) * DM) + lane;
#pragma unroll
        for (int j = 0; j < 4; ++j) o8[64 * j] = (unsigned long long)pk2(v[r][j][0], v[r][j][1]) | ((unsigned long long)pk2(v[r][j][2], v[r][j][3]) << 32); }
}
__device__ __forceinline__ void phase_prologue(const Ctx& C, const Args& a) {
    unsigned char* ws = a.ws; const float* x = a.in[0]; bf16_t* xb = (bf16_t*)(ws + WS_XB); float* rstd = (float*)(ws + WS_RSTD1);
    const int mstep = 4 * C.ngw; int m0 = 4 * C.gw;
    f32x4 va[4][4], vb[4][4];
    if (m0 < TT) xrow_load(va, x, m0, C.lane);
    phase_transposes<0>(C, a);
#if defined(REPEAT_T0)
    for (int rep = 0; rep < REPEAT_T0; ++rep) { __syncthreads(); phase_transposes<0>(C, a); }
#endif
    { float* cbias = (float*)(ws + WS_CBIAS); LAS float* part = (LAS float*)(C.lds + 8 * 16384);
      for (int i0 = 2 * C.vcu; i0 < 512; i0 += 2 * C.G) { const int i = i0 + (C.wave >> 2), kq = C.wave & 3, kv = i >> 8, j = i & 255; const float* pe = kv ? a.in[15] : a.in[12]; const float* w1 = kv ? a.in[16] : a.in[13]; float s = 0.f;
#pragma unroll
          for (int q = 0; q < 8; ++q) { const int k = 512 * kq + 64 * q + C.lane; s += pe[k] * w1[(size_t)k * 256 + j]; }
          s = wave_sum(s); if (C.lane == 0) part[C.wave] = s;
          __syncthreads();
          if (C.tid < 2) cbias[i0 + C.tid] = (part[4 * C.tid] + part[4 * C.tid + 1]) + (part[4 * C.tid + 2] + part[4 * C.tid + 3]);
          __syncthreads(); } }
    for (; m0 < TT; m0 += 2 * mstep) {
        const int m1 = m0 + mstep, m2 = m1 + mstep;
        if (m1 < TT) xrow_load(vb, x, m1, C.lane);
        xrow_store(va, xb, rstd, m0, C.lane);
        if (m2 < TT) xrow_load(va, x, m2, C.lane);
        if (m1 < TT) xrow_store(vb, xb, rstd, m1, C.lane);
    }
#if defined(REPEAT_ROPE)
    for (int rep = 0; rep < REPEAT_ROPE; ++rep)
#endif
    { float* rc = (float*)(ws + WS_ROPEC); float* rsn = (float*)(ws + WS_ROPES);
      for (int i = C.gtid; i < SEQ * 32; i += C.nthr) { const int t = i >> 5, j = i & 31; const float ang = (float)t * a.rope_inv[j]; float sv, cv; sincosf(ang, &sv, &cv); rc[i] = cv; rsn[i] = sv; } }
}

__device__ __forceinline__ void p7b_fixup_panel(const Ctx& C, const Args& a, int pm) {
    unsigned char* ws = a.ws; const float* __restrict__ eA = (const float*)(ws + WS_EDGEA); const float* __restrict__ eV = (const float*)(ws + WS_EDGEV); bf16_t* __restrict__ mid = (bf16_t*)(ws + WS_MID);
    const float* __restrict__ cw = a.in[24]; const float* __restrict__ cb = a.in[25];
    const bool first = (pm & 31) == 0;
    const float* e0 = eA + (size_t)pm * 4 * DFF; const float* ep = eA + (size_t)(first ? pm : pm - 1) * 4 * DFF; const float* v0 = eV + (size_t)pm * 2 * DFF;
    float x0[6], x1[6], pa[6], pb[6], w0[6], w1[6], w2[6], bb[6], g0[6], g1[6];
#pragma unroll
    for (int j = 0; j < 6; ++j) { const int c = C.tid + 512 * j; const int cc = c < DFF ? c : DFF - 1;
        x0[j] = e0[cc]; x1[j] = e0[DFF + cc]; pa[j] = ep[3 * DFF + cc]; pb[j] = ep[2 * DFF + cc]; w0[j] = cw[cc]; w1[j] = cw[DFF + cc]; w2[j] = cw[2 * DFF + cc]; bb[j] = cb[cc]; g0[j] = v0[cc]; g1[j] = v0[DFF + cc]; }
#pragma unroll
    for (int j = 0; j < 6; ++j) { const int c = C.tid + 512 * j; const float pA = first ? 0.f : pa[j], pB = first ? 0.f : pb[j];
        const float c0 = w2[j] * x0[j] + w1[j] * pA + w0[j] * pB + bb[j], c1 = w2[j] * x1[j] + w1[j] * x0[j] + w0[j] * pA + bb[j];
        const pg8::f32x2 gl = pg8::gelu_pk((pg8::f32x2){c0, c1});
        if (c < DFF) { mid[(size_t)(pm * 256) * DFF + c] = (bf16_t)f2bf(gl.x * g0[j]); mid[(size_t)(pm * 256 + 1) * DFF + c] = (bf16_t)f2bf(gl.y * g1[j]); } }
}
#ifndef NOSHIFT_THR
#define NOSHIFT_THR (-64.f)
#endif
namespace att {
typedef short bf16x8 __attribute__((ext_vector_type(8)));
typedef short s16x4 __attribute__((ext_vector_type(4)));
typedef float f32x16 __attribute__((ext_vector_type(16)));
typedef unsigned u32x2 __attribute__((ext_vector_type(2)));
enum { M_WIN = 0, M_CMP = 1, M_SLC = 2 };
constexpr int LDS_KV = 0  , LDS_IMP = 65536  , IMPS = 129;
__device__ __forceinline__ int crow(int r, int hi) { return (r & 3) + 8 * (r >> 2) + 4 * hi; }
__device__ __forceinline__ s16x4 vtr(const LAS unsigned char* p) { typedef short v4i16_t __attribute__((ext_vector_type(4))); return __builtin_bit_cast(s16x4, __builtin_amdgcn_ds_read_tr16_b64_v4i16((LAS v4i16_t*)p)); }
__device__ __forceinline__ unsigned cvtpk(float lo, float hi) { return pg8::cvt_pk_bf16(lo, hi); }
__device__ __forceinline__ bf16x8 pack_p(const f32x16& p, int base) {
    u32x4 w; w.x = cvtpk(p[base + 0], p[base + 1]); w.y = cvtpk(p[base + 2], p[base + 3]); w.z = cvtpk(p[base + 4], p[base + 5]); w.w = cvtpk(p[base + 6], p[base + 7]); return __builtin_bit_cast(bf16x8, w); }

struct KVRegs { u32x4 k, v; };
template <bool LOADV> __device__ __forceinline__ void kv_load(KVRegs& R, const bf16_t* K, const bf16_t* V, int ldk, int kt, int tid) {
    const int rowl = tid >> 3, ch = tid & 7; const size_t off = (size_t)(64 * kt + rowl) * ldk + ch * 8;
    R.k = *(const u32x4*)(K + off); if (LOADV) R.v = *(const u32x4*)(V + off);
}
template <bool LOADV> __device__ __forceinline__ void kv_write(const KVRegs& R, LAS unsigned char* buf, int tid) {
    const int rowl = tid >> 3, ch = tid & 7;
    *(LAS u32x4*)(buf + rowl * 128 + ((ch ^ ((rowl >> 1) & 7)) << 4)) = R.k; if (LOADV) *(LAS u32x4*)(buf + 8192 + rowl * 128 + ((ch ^ (((rowl >> 1) & 1) << 2)) << 4)) = R.v;
}
__device__ __forceinline__ void qk_tile(f32x16& s0, f32x16& s1, const LAS unsigned char* buf, const bf16x8 (&qf)[4], int r32, int hi, float init) {
    const f32x16 z = {init, init, init, init, init, init, init, init, init, init, init, init, init, init, init, init}; s0 = z; s1 = z;
#pragma unroll
    for (int d0 = 0; d0 < 4; ++d0) { const int c = 2 * d0 + hi; const int sw = (c ^ ((r32 >> 1) & 7)) << 4;
        const bf16x8 k0 = *(const LAS bf16x8*)(buf + r32 * 128 + sw); const bf16x8 k1 = *(const LAS bf16x8*)(buf + (32 + r32) * 128 + sw);
        s0 = __builtin_amdgcn_mfma_f32_32x32x16_bf16(k0, qf[d0], s0, 0, 0, 0); s1 = __builtin_amdgcn_mfma_f32_32x32x16_bf16(k1, qf[d0], s1, 0, 0, 0); }
}
__device__ __forceinline__ void pv_tile(f32x16 (&o)[2], const LAS unsigned char* vbuf, const f32x16& p0, const f32x16& p1, int lane) {
    const int hi = lane >> 5, qb = (lane >> 3) & 1; const LAS unsigned char* vb = vbuf + (4 * hi + ((lane & 15) >> 2)) * 128 + (16 * ((lane >> 4) & 1) + 4 * (lane & 3)) * 2;
#pragma unroll
    for (int ks = 0; ks < 4; ++ks) { const bf16x8 pb = pack_p(ks < 2 ? p0 : p1, 8 * (ks & 1));
#pragma unroll
        for (int dt = 0; dt < 2; ++dt) { const s16x4 lo = vtr(vb + (16 * ks) * 128 + (dt ^ qb) * 64), hi4 = vtr(vb + (16 * ks + 8) * 128 + (dt ^ qb) * 64);
            const bf16x8 va = {lo[0], lo[1], lo[2], lo[3], hi4[0], hi4[1], hi4[2], hi4[3]};
            o[dt] = __builtin_amdgcn_mfma_f32_32x32x16_bf16(va, pb, o[dt], 0, 0, 0); } }
}
template <int MODE> __device__ __forceinline__ bool key_valid(int kt, int kh, int r, int hi, int tpos, int aux) {
    const int kp = 64 * kt + 32 * kh + crow(r, hi);
    if (MODE == M_WIN) return kp <= tpos && kp > tpos - 512;
    if (MODE == M_CMP) return kp <= aux;
    return aux != 0 && kp <= tpos;
}

__device__ __forceinline__ void k_frags(bf16x8 (&kf)[8], const LAS unsigned char* buf, int r32, int hi) {
#pragma unroll
    for (int d0 = 0; d0 < 4; ++d0) { const int sw = ((2 * d0 + hi) ^ ((r32 >> 1) & 7)) << 4; kf[2 * d0] = *(const LAS bf16x8*)(buf + r32 * 128 + sw); kf[2 * d0 + 1] = *(const LAS bf16x8*)(buf + (32 + r32) * 128 + sw); }
}
__device__ __forceinline__ void qk_mfma(f32x16& s0, f32x16& s1, const bf16x8 (&kf)[8], const bf16x8 (&qf)[4], float init) {
    const f32x16 z = {init, init, init, init, init, init, init, init, init, init, init, init, init, init, init, init}; s0 = z; s1 = z;
#pragma unroll
    for (int d0 = 0; d0 < 4; ++d0) { s0 = __builtin_amdgcn_mfma_f32_32x32x16_bf16(kf[2 * d0], qf[d0], s0, 0, 0, 0); s1 = __builtin_amdgcn_mfma_f32_32x32x16_bf16(kf[2 * d0 + 1], qf[d0], s1, 0, 0, 0); }
}
__device__ __forceinline__ void qk_mfma_c(f32x16& s0, f32x16& s1, const bf16x8 (&kf)[8], const bf16x8 (&qf)[4], const f32x16& c) {
    s0 = __builtin_amdgcn_mfma_f32_32x32x16_bf16(kf[0], qf[0], c, 0, 0, 0); s1 = __builtin_amdgcn_mfma_f32_32x32x16_bf16(kf[1], qf[0], c, 0, 0, 0);
#pragma unroll
    for (int d0 = 1; d0 < 4; ++d0) { s0 = __builtin_amdgcn_mfma_f32_32x32x16_bf16(kf[2 * d0], qf[d0], s0, 0, 0, 0); s1 = __builtin_amdgcn_mfma_f32_32x32x16_bf16(kf[2 * d0 + 1], qf[d0], s1, 0, 0, 0); }
}
__device__ __forceinline__ void qk_mfma_z(f32x16& s0, f32x16& s1, const bf16x8 (&kf)[8], const bf16x8 (&qf)[4]) {
    const f32x16 z = {0.f, 0.f, 0.f, 0.f, 0.f, 0.f, 0.f, 0.f, 0.f, 0.f, 0.f, 0.f, 0.f, 0.f, 0.f, 0.f};
    s0 = __builtin_amdgcn_mfma_f32_32x32x16_bf16(kf[0], qf[0], z, 0, 0, 0); s1 = __builtin_amdgcn_mfma_f32_32x32x16_bf16(kf[1], qf[0], z, 0, 0, 0);
#pragma unroll
    for (int d0 = 1; d0 < 4; ++d0) { s0 = __builtin_amdgcn_mfma_f32_32x32x16_bf16(kf[2 * d0], qf[d0], s0, 0, 0, 0); s1 = __builtin_amdgcn_mfma_f32_32x32x16_bf16(kf[2 * d0 + 1], qf[d0], s1, 0, 0, 0); }
}
template <bool B> struct BTag { static constexpr bool value = B; };
__device__ __forceinline__ void v_frags(bf16x8 (&vf)[8], const LAS unsigned char* vbuf, int lane) {
    const int hi = lane >> 5, qb = (lane >> 3) & 1; const LAS unsigned char* vb = vbuf + (4 * hi + ((lane & 15) >> 2)) * 128 + (16 * ((lane >> 4) & 1) + 4 * (lane & 3)) * 2;
#pragma unroll
    for (int ks = 0; ks < 4; ++ks)
#pragma unroll
        for (int dt = 0; dt < 2; ++dt) { const s16x4 lo = vtr(vb + (16 * ks) * 128 + (dt ^ qb) * 64), hi4 = vtr(vb + (16 * ks + 8) * 128 + (dt ^ qb) * 64);
            vf[2 * ks + dt] = (bf16x8){lo[0], lo[1], lo[2], lo[3], hi4[0], hi4[1], hi4[2], hi4[3]}; }
}
template <bool USEM> __device__ __forceinline__ void pv_mfma(f32x16 (&o)[2], const bf16x8 (&vf)[8], const f32x16& p0, const f32x16& p1, unsigned msk) {
#pragma unroll
    for (int ks = 0; ks < 4; ++ks) { bf16x8 pb = pack_p(ks < 2 ? p0 : p1, 8 * (ks & 1));
        if (USEM) { u32x4 w = __builtin_bit_cast(u32x4, pb); w.x &= msk; w.y &= msk; w.z &= msk; w.w &= msk; pb = __builtin_bit_cast(bf16x8, w); }
        o[0] = __builtin_amdgcn_mfma_f32_32x32x16_bf16(vf[2 * ks], pb, o[0], 0, 0, 0); o[1] = __builtin_amdgcn_mfma_f32_32x32x16_bf16(vf[2 * ks + 1], pb, o[1], 0, 0, 0); }
}
template <int MODE> __device__ __forceinline__ void mask_tile(f32x16& s0, f32x16& s1, int kt, int qt, int tp0, int th, int hi, int tpos) {
    bool full;
    if (MODE == M_WIN) full = (64 * kt + 63 <= tp0 + 32 * th) && (64 * kt > tp0 + 32 * th + 31 - 512); else full = kt < qt;
    if (!full) {
#pragma unroll
        for (int r = 0; r < 16; ++r) { if (!key_valid<MODE>(kt, 0, r, hi, tpos, 1)) s0[r] = -INFINITY; if (!key_valid<MODE>(kt, 1, r, hi, tpos, 1)) s1[r] = -INFINITY; } }
}
__device__ __forceinline__ float exp_tile(f32x16& s0, f32x16& s1) {
    float sa = 0.f, sb = 0.f;
#pragma unroll
    for (int r = 0; r < 16; ++r) { s0[r] = __builtin_amdgcn_exp2f(s0[r]); s1[r] = __builtin_amdgcn_exp2f(s1[r]); sa += s0[r]; asm("" : "+v"(sa)); sb += s1[r]; asm("" : "+v"(sb)); }
    return sa + sb;
}

template <int MODE, bool NOSHIFT = false> __device__ __forceinline__ void attn_unit(LAS unsigned char* lds, unsigned char* ws, int b, int g, int qt, int tid_, float negM, size_t out_off) {
    int tid = tid_; asm volatile("" : "+v"(tid));
    const int lane = tid & 63, wave = __builtin_amdgcn_readfirstlane(tid >> 6), r32 = lane & 31, hi = lane >> 5, hg = wave & 3, th = wave >> 2;
    const int tokl = MODE == M_CMP ? 8 * wave + (r32 >> 2) : 32 * th + r32; const int head = 4 * g + (MODE == M_CMP ? (r32 & 3) : hg);
    const int tp0 = 64 * qt, tpos = tp0 + tokl; const size_t trow = (size_t)b * SEQ + tpos;
    const bf16_t *K, *V; int ldk, kt0, kt1;
    if (MODE == M_WIN) { K = (const bf16_t*)(ws + WS_KW) + (size_t)b * SEQ * 128 + g * 64; V = (const bf16_t*)(ws + WS_VW) + (size_t)b * SEQ * 128 + g * 64; ldk = 128; kt0 = qt - 8 > 0 ? qt - 8 : 0; kt1 = qt; }
    else if (MODE == M_SLC) { K = (const bf16_t*)(ws + WS_KS) + (size_t)b * SEQ * 128 + g * 64; V = (const bf16_t*)(ws + WS_VS) + (size_t)b * SEQ * 128 + g * 64; ldk = 128; kt0 = 0; kt1 = qt; }
    else { K = (const bf16_t*)(ws + WS_CMPB) + (size_t)((b * 2 + g) * 512) * 64; V = (const bf16_t*)(ws + WS_CMPB) + (size_t)((8 + b * 2 + g) * 512) * 64; ldk = 64; kt0 = 0; kt1 = (4 * qt + 2) >> 6; }
    bf16x8 qf[4];
    { const bf16_t* qp = (const bf16_t*)(ws + WS_NQ) + trow * 512 + head * 64 + 8 * hi;
#pragma unroll
      for (int d0 = 0; d0 < 4; ++d0) qf[d0] = *(const bf16x8*)(qp + 16 * d0); }
    unsigned selw[4] = {0u, 0u, 0u, 0u};
    if (MODE == M_SLC) { const u32x4 sv = *(const u32x4*)((const unsigned*)(ws + WS_SEL) + (trow * 2 + g) * 4); selw[0] = sv.x; selw[1] = sv.y; selw[2] = sv.z; selw[3] = sv.w; }
    const int cmaxl = tpos >= 31 ? (tpos - 31) >> 4 : -1;
    const int tfirst = tp0 + 8 * wave; const int cmin = tfirst >= 31 ? (tfirst - 31) >> 4 : -1;
    LAS unsigned char* kvb = lds + LDS_KV;
    float m = -INFINITY, l = 0.f; f32x16 o[2]; { const f32x16 z = {0.f, 0.f, 0.f, 0.f, 0.f, 0.f, 0.f, 0.f, 0.f, 0.f, 0.f, 0.f, 0.f, 0.f, 0.f, 0.f}; o[0] = z; o[1] = z; }
    KVRegs R;
    bf16_t* op = (bf16_t*)(ws + out_off) + trow * 1024 + 512 + head * 64 + 4 * hi;
    u32x2 old[2][4];
    auto load_old = [&]() __attribute__((always_inline)) {
#pragma unroll
        for (int dt = 0; dt < 2; ++dt)
#pragma unroll
            for (int rr = 0; rr < 4; ++rr) old[dt][rr] = *(const u32x2*)(op + 32 * dt + 8 * rr); };
    if (MODE == M_CMP) {
        kv_load<false>(R, K, V, ldk, kt0, tid);
        for (int kt = kt0; kt <= kt1; ++kt) { LAS unsigned char* buf = kvb + ((kt - kt0) & 1) * 16384;
            kv_write<false>(R, buf, tid); if (kt < kt1) kv_load<false>(R, K, V, ldk, kt + 1, tid); else kv_load<true>(R, K, V, ldk, kt0, tid);
            __syncthreads();
            f32x16 s0, s1; qk_tile(s0, s1, buf, qf, r32, hi, 0.f);
            float mx = -INFINITY;
            const bool fullc = (64 * kt + 63) <= cmin;
            if (!fullc) {
#pragma unroll
                for (int r = 0; r < 16; ++r) { if (!key_valid<MODE>(kt, 0, r, hi, tpos, cmaxl)) s0[r] = -INFINITY; if (!key_valid<MODE>(kt, 1, r, hi, tpos, cmaxl)) s1[r] = -INFINITY; } }
#pragma unroll
            for (int r = 0; r < 16; ++r) mx = fmaxf(mx, fmaxf(s0[r], s1[r]));
            mx = fmaxf(mx, __shfl_xor(mx, 32));
            const float mn = fmaxf(m, mx);
            if (mn > -INFINITY) { float sum = 0.f;
#pragma unroll
                for (int r = 0; r < 16; ++r) sum += __builtin_amdgcn_exp2f(s0[r] - mn) + __builtin_amdgcn_exp2f(s1[r] - mn);
                l = l * __builtin_amdgcn_exp2f(m - mn) + sum; m = mn; }
        }
        __syncthreads();
        l += __shfl_xor(l, 32); const float il = l > 0.f ? 1.0f / l : 0.f; const float negm = l > 0.f ? -m : -INFINITY;
        LAS float* impt = (LAS float*)(lds + LDS_IMP) + tokl * IMPS;
        load_old();
        float carry = 0.f;
        for (int kt = kt0; kt <= kt1; ++kt) { LAS unsigned char* buf = kvb + ((kt - kt0) & 1) * 16384;
            kv_write<true>(R, buf, tid); if (kt < kt1) kv_load<true>(R, K, V, ldk, kt + 1, tid);
            __syncthreads();
            f32x16 s0, s1; qk_tile(s0, s1, buf, qf, r32, hi, negm);
            const bool fullc = (64 * kt + 63) <= cmin;
            if (!fullc) {
#pragma unroll
                for (int r = 0; r < 16; ++r) { if (!key_valid<MODE>(kt, 0, r, hi, tpos, cmaxl)) s0[r] = -INFINITY; if (!key_valid<MODE>(kt, 1, r, hi, tpos, cmaxl)) s1[r] = -INFINITY; } }
#pragma unroll
            for (int r = 0; r < 16; ++r) { s0[r] = __builtin_amdgcn_exp2f(s0[r]); s1[r] = __builtin_amdgcn_exp2f(s1[r]); }
            float px[2][4];
#pragma unroll
            for (int rr = 0; rr < 4; ++rr) { px[0][rr] = __shfl_xor(s0[4 * rr + 3], 32); px[1][rr] = __shfl_xor(s1[4 * rr + 3], 32); }
#pragma unroll
            for (int kh = 0; kh < 2; ++kh)
#pragma unroll
                for (int rr = 0; rr < 4; ++rr) { const f32x16& p = kh ? s1 : s0; const int j = 16 * kt + 8 * kh + 2 * rr + hi;
                    const float inc = hi ? px[kh][rr] : (rr >= 1 ? px[kh][rr - 1] : (kh ? px[0][3] : carry));
                    float bin = (((p[4 * rr] + p[4 * rr + 1]) + (p[4 * rr + 2] + p[4 * rr + 3])) + inc) * il;
                    bin += __builtin_bit_cast(float, __builtin_amdgcn_mov_dpp(__builtin_bit_cast(int, bin), 0xB1, 0xf, 0xf, true));
                    bin += __builtin_bit_cast(float, __builtin_amdgcn_mov_dpp(__builtin_bit_cast(int, bin), 0x4E, 0xf, 0xf, true));
                    if ((r32 & 3) == 0 && j < 128) impt[j] = bin; }
            carry = px[1][3];
            pv_tile(o, buf + 8192, s0, s1, lane);
        }
        __syncthreads();
    } else {
        KVRegs R1;
        kv_load<true>(R, K, V, ldk, kt0, tid); if (kt0 + 1 <= kt1) kv_load<true>(R1, K, V, ldk, kt0 + 1, tid);
        kv_write<true>(R, kvb, tid); if (kt0 + 1 <= kt1) kv_write<true>(R1, kvb + 16384, tid);
        if (kt0 + 2 <= kt1) kv_load<true>(R, K, V, ldk, kt0 + 2, tid); if (kt0 + 3 <= kt1) kv_load<true>(R1, K, V, ldk, kt0 + 3, tid);
        __syncthreads();
        auto step = [&](auto mtag, int kt) __attribute__((always_inline)) {
            constexpr bool MASKED = decltype(mtag)::value; constexpr bool SEL = MODE == M_SLC;
            LAS unsigned char* bufA = kvb + (((kt - kt0) >> 1) & 1) * 32768; LAS unsigned char* bufB = bufA + 16384; const bool two = kt + 1 <= kt1;
            { LAS unsigned char* nA = kvb + ((((kt - kt0) >> 1) + 1) & 1) * 32768;
              if (kt + 2 <= kt1) kv_write<true>(R, nA, tid); if (kt + 3 <= kt1) kv_write<true>(R1, nA + 16384, tid);
              if (kt + 4 <= kt1) kv_load<true>(R, K, V, ldk, kt + 4, tid); if (kt + 5 <= kt1) kv_load<true>(R1, K, V, ldk, kt + 5, tid); }
            unsigned mA = ~0u, mB = ~0u;
            if (SEL) { const unsigned w = kt < 32 ? selw[0] : kt < 64 ? selw[1] : kt < 96 ? selw[2] : selw[3]; mA = 0u - ((w >> (kt & 31)) & 1u);
                const int k2 = kt + 1; const unsigned w2 = k2 < 32 ? selw[0] : k2 < 64 ? selw[1] : k2 < 96 ? selw[2] : selw[3]; mB = 0u - ((w2 >> (k2 & 31)) & 1u); }
            f32x16 a0, a1, b0, b1; bf16x8 fa[8], fb[8];
            if (two) {
                k_frags(fa, bufA, r32, hi); if (NOSHIFT) qk_mfma_z(a0, a1, fa, qf); else qk_mfma(a0, a1, fa, qf, negM);
                k_frags(fb, bufB, r32, hi);
                if (MASKED) mask_tile<MODE>(a0, a1, kt, qt, tp0, th, hi, tpos);
                if (NOSHIFT) qk_mfma_z(b0, b1, fb, qf); else qk_mfma(b0, b1, fb, qf, negM); { const float sa = exp_tile(a0, a1); l += SEL ? __uint_as_float(__float_as_uint(sa) & mA) : sa; }
                v_frags(fa, bufA + 8192, lane);
                if (MASKED) mask_tile<MODE>(b0, b1, kt + 1, qt, tp0, th, hi, tpos);
                pv_mfma<SEL>(o, fa, a0, a1, mA); { const float sb = exp_tile(b0, b1); l += SEL ? __uint_as_float(__float_as_uint(sb) & mB) : sb; }
                v_frags(fb, bufB + 8192, lane);
                pv_mfma<SEL>(o, fb, b0, b1, mB);
            } else {
                k_frags(fa, bufA, r32, hi); if (NOSHIFT) qk_mfma_z(a0, a1, fa, qf); else qk_mfma(a0, a1, fa, qf, negM); v_frags(fa, bufA + 8192, lane);
                if (MASKED) mask_tile<MODE>(a0, a1, kt, qt, tp0, th, hi, tpos);
                { const float sa = exp_tile(a0, a1); l += SEL ? __uint_as_float(__float_as_uint(sa) & mA) : sa; }
                pv_mfma<SEL>(o, fa, a0, a1, mA);
            }
            __syncthreads();
        };
        int kt = kt0;
        if (MODE == M_WIN) { step(BTag<true>{}, kt); kt += 2; }
        for (; kt + 1 < kt1; kt += 2) step(BTag<false>{}, kt);
        if (MODE == M_SLC) load_old();
        if (kt <= kt1) step(BTag<true>{}, kt);
        l += __shfl_xor(l, 32);
    }
    { const float* sg = (const float*)(ws + WS_SMALLG); const int br = MODE == M_CMP ? 0 : MODE == M_SLC ? 1 : 2;
      const float gt = sigm(sg[trow * 32 + 8 + head * 3 + br]) * (l > 0.f ? 1.0f / l : 0.f);
#pragma unroll
      for (int dt = 0; dt < 2; ++dt)
#pragma unroll
          for (int rr = 0; rr < 4; ++rr) { float v0 = o[dt][4 * rr] * gt, v1 = o[dt][4 * rr + 1] * gt, v2 = o[dt][4 * rr + 2] * gt, v3 = o[dt][4 * rr + 3] * gt;
              if (MODE != M_WIN) { v0 += pg8::bflo(old[dt][rr].x); v1 += pg8::bfhi(old[dt][rr].x); v2 += pg8::bflo(old[dt][rr].y); v3 += pg8::bfhi(old[dt][rr].y); }
              u32x2 nw; nw.x = cvtpk(v0, v1); nw.y = cvtpk(v2, v3); *(u32x2*)(op + 32 * dt + 8 * rr) = nw; } }
    if (MODE == M_CMP) {
        const int cur = qt, tk = tid >> 3, part = tid & 7; const LAS float* row = (const LAS float*)(lds + LDS_IMP) + tk * IMPS + 16 * part;
        unsigned key[16];
#pragma unroll
        for (int k = 0; k < 16; ++k) { const int j = 16 * part + k; float v = row[k]; if (j == 0 || j == cur || j == cur - 1) v = 1e4f; if (j > cur) v = -1e30f;
            const unsigned u = __float_as_uint(v); key[k] = (u & 0x80000000u) ? ~u : (u | 0x80000000u); }
        unsigned sel16;
        if (cur < 16) { sel16 = part == 0 ? ((2u << cur) - 1u) : 0u; }
        else {
            auto sum8 = [](int v) { v += __builtin_amdgcn_mov_dpp(v, 0xB1, 0xf, 0xf, true); v += __builtin_amdgcn_mov_dpp(v, 0x4E, 0xf, 0xf, true); v += __builtin_amdgcn_mov_dpp(v, 0x141, 0xf, 0xf, true); return v; };
            unsigned T = 0u;
            bool done = false;
            for (int bit = 31; bit >= 0; --bit) { const unsigned cand = T | (1u << bit); int cnt = 0;
#pragma unroll
                for (int k = 0; k < 16; ++k) cnt += key[k] >= cand ? 1 : 0;
                const int tot = sum8(cnt); if (!done && tot >= 16) T = cand; done = done || tot == 16;
                if (__builtin_amdgcn_ballot_w64(!done) == 0ull) break; }
            int ngt = 0, neq = 0;
#pragma unroll
            for (int k = 0; k < 16; ++k) { ngt += key[k] > T ? 1 : 0; neq += key[k] == T ? 1 : 0; }
            const int need = 16 - sum8(ngt);
            int pre = neq;
            { int t1 = __builtin_amdgcn_update_dpp(0, pre, 0x111, 0xf, 0xf, true); if (part >= 1) pre += t1; int t2 = __builtin_amdgcn_update_dpp(0, pre, 0x112, 0xf, 0xf, true); if (part >= 2) pre += t2; int t4 = __builtin_amdgcn_update_dpp(0, pre, 0x114, 0xf, 0xf, true); if (part >= 4) pre += t4; }
            int rank = pre - neq; sel16 = 0u;
#pragma unroll
            for (int k = 0; k < 16; ++k) { const bool eq = key[k] == T; if (key[k] > T || (eq && rank < need)) sel16 |= 1u << k; rank += eq ? 1 : 0; }
        }
        *((unsigned short*)((unsigned*)(ws + WS_SEL) + (((size_t)b * SEQ + tp0 + tk) * 2 + g) * 4) + part) = (unsigned short)sel16;
        __syncthreads();
    }
}
template <int MODE> __device__ __forceinline__ void attn_phase(LAS unsigned char* lds, const Args& a, int G, int cu, size_t out_off = WS_HMON) {
    int tid = threadIdx.x; asm volatile("" : "+v"(tid)); unsigned char* ws = a.ws;
    float negM = 0.f;
    if (MODE != M_CMP) {
        const float* qw = a.in[8]; const float* kw = MODE == M_SLC ? a.in[10] : a.in[11]; float mq = fabsf(qw[tid & 63]), mk = fabsf(kw[tid & 63]);
#pragma unroll
        for (int o = 1; o < 64; o <<= 1) { mq = fmaxf(mq, __shfl_xor(mq, o)); mk = fmaxf(mk, __shfl_xor(mk, o)); }
        negM = -fminf(11.5416f * mq * mk * 1.02f, 100.f); negM = __uint_as_float(__builtin_amdgcn_readfirstlane(__float_as_uint(negM))); }
    for (int u = cu; u < 256; u += G) { const int bg = u & 7, i = u >> 3;
        for (int k = 0; k < 4; ++k) { const int qt = k == 0 ? i : k == 1 ? 63 - i : k == 2 ? 64 + i : 127 - i;
            if (MODE != M_CMP && negM >= NOSHIFT_THR) attn_unit<MODE, MODE != M_CMP>(lds, ws, bg >> 1, bg & 1, qt, tid, negM, out_off);
            else attn_unit<MODE>(lds, ws, bg >> 1, bg & 1, qt, tid, negM, out_off); } }
}
}
namespace ml {
typedef short bf16x8 __attribute__((ext_vector_type(8)));
typedef short s16x4 __attribute__((ext_vector_type(4)));
typedef float f32x16 __attribute__((ext_vector_type(16)));
constexpr size_t WS_GC = WS_MLS, WS_AM = WS_MLS + 8192, WS_MP = WS_MLS + 16384, WS_DN = WS_IPRE, WS_NP = WS_LOGF;
__device__ __forceinline__ float fexp(float x) { return __builtin_amdgcn_exp2f(x * 1.4426950408889634f); }
__device__ __forceinline__ float logsig(float x) { return x >= 0.f ? -log1pf(expf(-x)) : x - log1pf(expf(x)); }
__device__ __forceinline__ float scan_add(float v, int lane) {
#pragma unroll
    for (int o = 1; o < 64; o <<= 1) { const float t = __shfl_up(v, o); if (lane >= o) v += t; }
    return v;
}
__device__ __forceinline__ float scan_max(float v, int lane) {
#pragma unroll
    for (int o = 1; o < 64; o <<= 1) { const float t = __shfl_up(v, o); if (lane >= o) v = fmaxf(v, t); }
    return v;
}
__device__ __forceinline__ float wave_max(float v) {
#pragma unroll
    for (int o = 1; o < 64; o <<= 1) v = fmaxf(v, __shfl_xor(v, o));
    return v;
}
__device__ __forceinline__ float conv_silu(const bf16_t* qkpre, const float* cw, const float* cb, size_t trow, int tp, int ch) {
    float s = cb[ch];
#pragma unroll
    for (int k = 0; k < 4; ++k) { const int d = 3 - k; if (tp >= d) s += cw[k * 512 + ch] * bf2f(qkpre[(trow - d) * 512 + ch]); }
    return s * sigm(s);
}
__device__ __forceinline__ s16x4 vtr(const LAS unsigned char* p) { typedef short v4i16_t __attribute__((ext_vector_type(4))); return __builtin_bit_cast(s16x4, __builtin_amdgcn_ds_read_tr16_b64_v4i16((LAS v4i16_t*)p)); }
__device__ __forceinline__ bf16x8 cat8(const s16x4& a, const s16x4& b) { return (bf16x8){a[0], a[1], a[2], a[3], b[0], b[1], b[2], b[3]}; }

template <int NPART> __device__ __forceinline__ void stage_pre(LAS unsigned short* pre, const bf16_t* qkpre, size_t t0, int tp0, int h, int part0, int tid) {
    for (int i = tid; i < NPART * 67 * 8; i += 512) { const int ch8 = i & 7, r = (i >> 3) % 67, p = (i >> 3) / 67; const int tp = tp0 - 3 + r;
        u32x4 v = {0u, 0u, 0u, 0u}; if (tp >= 0) v = *(const u32x4*)(qkpre + (t0 - 3 + r) * 512 + (part0 + p) * 256 + h * 64 + ch8 * 8);
        *(LAS u32x4*)(pre + (p * 67 + r) * 64 + ch8 * 8) = v; }
}
__device__ __forceinline__ float conv_lds(const LAS unsigned short* pre, int p, int l, int d, const float (&cw4)[4], float cb1) {
    float s = cb1;
#pragma unroll
    for (int k = 0; k < 4; ++k) s += cw4[k] * bf2f(pre[(p * 67 + l + k) * 64 + d]);
    return s * sigm(s);
}
__device__ __forceinline__ int off256(int row, int colbyte) { return row * 256 + ((((colbyte >> 6) ^ row) & 3) << 6) + (colbyte & 63); }
__device__ __forceinline__ int off128t(int row, int colbyte) { return row * 128 + (colbyte ^ (((row >> 1) & 1) << 6)); }
__device__ __forceinline__ int off128r(int row, int chunk) { return row * 128 + ((chunk ^ ((row >> 1) & 7)) << 4); }
__device__ __forceinline__ void stage256(LAS unsigned char* dst, const bf16_t* src, size_t ld, int tid) {
    for (int i = tid; i < 64 * 16; i += 512) { const int r = i >> 4, c16 = i & 15; *(LAS u32x4*)(dst + off256(r, c16 * 16)) = *(const u32x4*)(src + (size_t)r * ld + c16 * 8); }
}

__device__ __forceinline__ void a_stage(LAS unsigned char* lds, const Args& a, int U, int tid, int lane, int wave) {
    unsigned char* ws = a.ws; const bf16_t* qkpre = (const bf16_t*)(ws + WS_QKPRE); const bf16_t* mv = (const bf16_t*)(ws + WS_MV); const float* sg = (const float*)(ws + WS_SMALLG);
    LAS float* wl = (LAS float*)(lds + 24576); LAS unsigned short* pre = (LAS unsigned short*)(lds + 25600);
    const int c = U & 127, h = (U >> 7) & 3, b = U >> 9; const int tp0 = 64 * c; const size_t t0 = (size_t)b * SEQ + tp0;
    if (wave == 0) { const size_t t = t0 + lane; const float ip = sg[t * 32 + h] + a.in[5][h]; const float lf = logsig(sg[t * 32 + 4 + h] + a.in[6][h]);
        const float bc = scan_add(lf, lane); const float g = __shfl(bc, 63); const float av = g - bc + ip; const float am = wave_max(av); wl[lane] = fexp(av - am);
        if (lane == 0) { ((float*)(ws + WS_GC))[U] = g; ((float*)(ws + WS_AM))[U] = am; } }
    stage256(lds, mv + t0 * 512 + h * 128, 512, tid); stage_pre<1>(pre, qkpre, t0, tp0, h, 1, tid);
}
__device__ __forceinline__ void a_conv(LAS unsigned char* lds, const Args& a, int U, int tid) {
    asm volatile("" : "+v"(tid));
    const int h = (U >> 7) & 3; const int d2 = tid & 31, l0 = tid >> 5, ch = 256 + h * 64 + 2 * d2;
    float cw[4][2];
#pragma unroll
    for (int k = 0; k < 4; ++k) { cw[k][0] = a.in[3][k * 512 + ch]; cw[k][1] = a.in[3][k * 512 + ch + 1]; }
    const float cb0 = a.in[4][ch], cb1 = a.in[4][ch + 1];
    const LAS float* wl = (const LAS float*)(lds + 24576) + l0; const LAS unsigned* pre = (const LAS unsigned*)(lds + 25600) + l0 * 32 + d2;
    LAS unsigned char* w0 = lds + 16384 + off128t(l0, 4 * d2);
#pragma unroll
    for (int i = 0; i < 4; ++i) { float s0 = cb0, s1 = cb1;
#pragma unroll
        for (int k = 0; k < 4; ++k) { const unsigned w = pre[(16 * i + k) * 32]; s0 += cw[k][0] * pg8::bflo(w); s1 += cw[k][1] * pg8::bfhi(w); }
        const float wv = wl[16 * i]; *(LAS unsigned*)(w0 + i * 2048) = pg8::cvt_pk_bf16(wv * s0 * sigm(s0), wv * s1 * sigm(s1)); }
}
__device__ __forceinline__ void a_compute(LAS unsigned char* lds, const Args& a, int U, int tid, int lane, int wave) {
    unsigned char* ws = a.ws; LAS unsigned char* Vs = lds; LAS unsigned char* KW = lds + 16384; const int r32 = lane & 31, hi = lane >> 5;
    const int dtile = wave & 1, et = wave >> 1; const int li = lane & 15, cb16 = 16 * ((lane >> 4) & 1);
    f32x16 acc = {0.f, 0.f, 0.f, 0.f, 0.f, 0.f, 0.f, 0.f, 0.f, 0.f, 0.f, 0.f, 0.f, 0.f, 0.f, 0.f};
#pragma unroll
    for (int kk = 0; kk < 4; ++kk) { const int rb = 16 * kk + 8 * hi + (li >> 2);
        const int ca = (32 * dtile + cb16 + 4 * (li & 3)) * 2, cv = (32 * et + cb16 + 4 * (li & 3)) * 2;
        const bf16x8 af = cat8(vtr(KW + off128t(rb, ca)), vtr(KW + off128t(rb + 4, ca)));
        const bf16x8 bf = cat8(vtr(Vs + off256(rb, cv)), vtr(Vs + off256(rb + 4, cv)));
        acc = __builtin_amdgcn_mfma_f32_32x32x16_bf16(af, bf, acc, 0, 0, 0); }
    bf16_t* dc = (bf16_t*)(ws + WS_DC) + (size_t)U * 8192 + 32 * et + r32;
#pragma unroll
    for (int r = 0; r < 16; ++r) dc[(32 * dtile + (r & 3) + 8 * (r >> 2) + 4 * hi) * 128] = (bf16_t)f2bf(acc[r]);
    if (tid < 64) { float s = 0.f; for (int l = 0; l < 64; ++l) s += bf2f(*(const LAS unsigned short*)(KW + off128t(l, tid * 2))); ((float*)(ws + WS_DN))[(size_t)U * 64 + tid] = s; }
}
__device__ __forceinline__ void phase_a(LAS unsigned char* lds, const Args& a, int G, int cu) {
    int tid = threadIdx.x; asm volatile("" : "+v"(tid)); const int lane = tid & 63, wave = __builtin_amdgcn_readfirstlane(tid >> 6);
    LAS unsigned char* l0 = lds; LAS unsigned char* l1 = lds + 36864;
    for (int U = cu; U < 2048; U += 2 * G) { const int U1 = U + G; const bool two = U1 < 2048;
        a_stage(l0, a, U, tid, lane, wave); if (two) a_stage(l1, a, U1, tid, lane, wave);
        __syncthreads();
        a_conv(l0, a, U, tid); if (two) a_conv(l1, a, U1, tid);
        __syncthreads();
        a_compute(l0, a, U, tid, lane, wave); if (two) a_compute(l1, a, U1, tid, lane, wave);
        __syncthreads();
    }
}
__device__ __forceinline__ void phase_b(const Args& a, int gtid, int nthr) {
    unsigned char* ws = a.ws; const float* __restrict__ gc = (const float*)(ws + WS_GC); const float* __restrict__ am = (const float*)(ws + WS_AM); float* __restrict__ mp = (float*)(ws + WS_MP);
    const bf16_t* __restrict__ dc = (const bf16_t*)(ws + WS_DC); bf16_t* __restrict__ cp = (bf16_t*)(ws + WS_CPREV); const float* __restrict__ dn = (const float*)(ws + WS_DN); float* __restrict__ np = (float*)(ws + WS_NP);
    for (int i = gtid; i < 16 * 2048; i += nthr) { const int bh = i >> 11, de = (i & 2047) * 4; f32x4 C = {0.f, 0.f, 0.f, 0.f}; float m = 0.f;
        for (int c0 = 0; c0 < 128; c0 += 8) { pg8::u32x2 xr[8]; float g[8], ax[8];
#pragma unroll
            for (int j = 0; j < 8; ++j) { const int U = bh * 128 + c0 + j; xr[j] = *(const pg8::u32x2*)(dc + (size_t)U * 8192 + de); g[j] = gc[U]; ax[j] = am[U]; }
#pragma unroll
            for (int j = 0; j < 8; ++j) { const int U = bh * 128 + c0 + j;
                pg8::u32x2 w; w.x = pg8::cvt_pk_bf16(C[0], C[1]); w.y = pg8::cvt_pk_bf16(C[2], C[3]); *(pg8::u32x2*)(cp + (size_t)U * 8192 + de) = w;
                const float mn = fmaxf(g[j] + m, ax[j]); const float dec = fexp(g[j] + m - mn), sc = fexp(ax[j] - mn); const f32x4 x = {pg8::bflo(xr[j].x), pg8::bfhi(xr[j].x), pg8::bflo(xr[j].y), pg8::bfhi(xr[j].y)}; C = C * dec + x * sc; m = mn; } } }
    for (int i = nthr - 1 - gtid; i < 16 * 64; i += nthr) { const int bh = i >> 6, d = i & 63; float nn = 0.f, m = 0.f;
        for (int c0 = 0; c0 < 128; c0 += 8) { float g[8], ax[8], x[8];
#pragma unroll
            for (int j = 0; j < 8; ++j) { const int U = bh * 128 + c0 + j; g[j] = gc[U]; ax[j] = am[U]; x[j] = dn[(size_t)U * 64 + d]; }
#pragma unroll
            for (int j = 0; j < 8; ++j) { const int U = bh * 128 + c0 + j; np[(size_t)U * 64 + d] = nn; if (d == 0) mp[U] = m;
                const float mn = fmaxf(g[j] + m, ax[j]); const float dec = fexp(g[j] + m - mn), sc = fexp(ax[j] - mn); nn = dec * nn + sc * x[j]; m = mn; } } }
}
struct CRegs { u32x4 pre[3], v[2], c[2]; };
__device__ __forceinline__ void c_load(CRegs& R, const Args& a, int U, int tid) {
    unsigned char* ws = a.ws; const bf16_t* qkpre = (const bf16_t*)(ws + WS_QKPRE); const bf16_t* mv = (const bf16_t*)(ws + WS_MV);
    const int c = U & 127, h = (U >> 7) & 3, b = U >> 9; const int tp0 = 64 * c; const size_t t0 = (size_t)b * SEQ + tp0;
#pragma unroll
    for (int k = 0; k < 3; ++k) { const int i = tid + 512 * k; R.pre[k] = (u32x4){0u, 0u, 0u, 0u};
        if (i < 2 * 67 * 8) { const int ch8 = i & 7, r = (i >> 3) % 67, p = (i >> 3) / 67; if (tp0 - 3 + r >= 0) R.pre[k] = *(const u32x4*)(qkpre + (t0 - 3 + r) * 512 + p * 256 + h * 64 + ch8 * 8); } }
#pragma unroll
    for (int k = 0; k < 2; ++k) { const int i = tid + 512 * k, r = i >> 4, c16 = i & 15; R.v[k] = *(const u32x4*)(mv + (t0 + r) * 512 + h * 128 + c16 * 8); R.c[k] = *(const u32x4*)((const bf16_t*)(ws + WS_CPREV) + (size_t)U * 8192 + r * 128 + c16 * 8); }
}
__device__ __forceinline__ void c_store(const CRegs& R, LAS unsigned char* lds, int tid) {
    LAS unsigned short* pre = (LAS unsigned short*)(lds + 49152);
#pragma unroll
    for (int k = 0; k < 3; ++k) { const int i = tid + 512 * k; if (i < 2 * 67 * 8) { const int ch8 = i & 7, r = (i >> 3) % 67, p = (i >> 3) / 67; *(LAS u32x4*)(pre + (p * 67 + r) * 64 + ch8 * 8) = R.pre[k]; } }
#pragma unroll
    for (int k = 0; k < 2; ++k) { const int i = tid + 512 * k, r = i >> 4, c16 = i & 15; *(LAS u32x4*)(lds + off256(r, c16 * 16)) = R.v[k]; *(LAS u32x4*)(lds + 16384 + off256(r, c16 * 16)) = R.c[k]; }
}
__device__ __forceinline__ void c_gates(LAS unsigned char* lds, const Args& a, int U, int lane) {
    unsigned char* ws = a.ws; const float* sg = (const float*)(ws + WS_SMALLG); LAS float* sm = (LAS float*)(lds + 67584);
    const int c = U & 127, h = (U >> 7) & 3, b = U >> 9; const size_t tg = (size_t)b * SEQ + 64 * c + lane;
    const float ip = sg[tg * 32 + h] + a.in[5][h]; const float lf = logsig(sg[tg * 32 + 4 + h] + a.in[6][h]);
    const float bc = scan_add(lf, lane); const float u = ip - bc; const float pm = scan_max(u, lane); const float mprev = ((const float*)(ws + WS_MP))[U];
    const float mt = bc + fmaxf(mprev, pm); sm[lane] = bc; sm[64 + lane] = u * 1.4426950408889634f  ; sm[128 + lane] = mt; sm[192 + lane] = fexp(bc + mprev - mt); sm[256 + lane] = ((const float*)(ws + WS_NP))[(size_t)U * 64 + lane];
}
__device__ __forceinline__ void c_conv(LAS unsigned char* lds, const Args& a, int U, int tid) {
    asm volatile("" : "+v"(tid));
    const int h = (U >> 7) & 3;
    const int d2 = tid & 31, part = (tid >> 5) & 1, l0 = tid >> 6;
    const int ch = part * 256 + h * 64 + 2 * d2; float cw[4][2];
#pragma unroll
    for (int k = 0; k < 4; ++k) { cw[k][0] = a.in[3][k * 512 + ch]; cw[k][1] = a.in[3][k * 512 + ch + 1]; }
    const float cb0 = a.in[4][ch], cb1 = a.in[4][ch + 1], sc = part ? 1.0f : 0.125f;
    const LAS unsigned* pre = (const LAS unsigned*)(lds + 49152) + (part * 67 + l0) * 32 + d2;
    const int c0 = (d2 >> 2) ^ (l0 >> 1);
    LAS unsigned char* w0 = lds + 32768 + part * 8192 + l0 * 128 + (d2 & 3) * 4 + (c0 << 4); LAS unsigned char* w1 = lds + 32768 + part * 8192 + l0 * 128 + (d2 & 3) * 4 + ((c0 ^ 4) << 4);
#pragma unroll
    for (int i = 0; i < 8; ++i) { float s0 = cb0, s1 = cb1;
#pragma unroll
        for (int k = 0; k < 4; ++k) { const unsigned w = pre[(8 * i + k) * 32]; s0 += cw[k][0] * pg8::bflo(w); s1 += cw[k][1] * pg8::bfhi(w); }
        *(LAS unsigned*)((i & 1 ? w1 : w0) + i * 1024) = pg8::cvt_pk_bf16(sc * s0 * sigm(s0), sc * s1 * sigm(s1)); }
}
template <bool B> struct BTag { static constexpr bool value = B; };
__device__ __forceinline__ void c_compute(f32x16& o, LAS unsigned char* lds, int lane, int wave) {
    asm volatile("" : "+v"(lane));
    LAS unsigned char* Vs = lds; LAS unsigned char* Cs = lds + 16384; LAS unsigned char* Qs = lds + 32768; LAS unsigned char* Ks = lds + 40960; LAS float* sm = (LAS float*)(lds + 67584);
    const int r32 = lane & 31, hi = lane >> 5, tt = wave & 1, et = wave >> 1, t = 32 * tt + r32;
    bf16x8 qf[4];
#pragma unroll
    for (int kk = 0; kk < 4; ++kk) qf[kk] = *(const LAS bf16x8*)(Qs + off128r(t, 2 * kk + hi));
    const float bt = (sm[t] - sm[128 + t]) * 1.4426950408889634f, isc = sm[192 + t], mt = sm[128 + t];
    float dq = 0.f;
#pragma unroll
    for (int kk = 0; kk < 4; ++kk) { const u32x4 w = __builtin_bit_cast(u32x4, qf[kk]); f32x4 x0, x1; pg8::unpack8(w, x0, x1); const LAS float* npp = sm + 256 + 16 * kk + 8 * hi;
        dq += x0[0] * npp[0] + x0[1] * npp[1] + x0[2] * npp[2] + x0[3] * npp[3] + x1[0] * npp[4] + x1[1] * npp[5] + x1[2] * npp[6] + x1[3] * npp[7]; }
    o = (f32x16){0.f, 0.f, 0.f, 0.f, 0.f, 0.f, 0.f, 0.f, 0.f, 0.f, 0.f, 0.f, 0.f, 0.f, 0.f, 0.f};
    const int li = lane & 15, cv = (32 * et + 16 * ((lane >> 4) & 1) + 4 * (li & 3)) * 2;
#pragma unroll
    for (int kk = 0; kk < 4; ++kk) { const int rb = 16 * kk + 8 * hi + (li >> 2); const bf16x8 cf = cat8(vtr(Cs + off256(rb, cv)), vtr(Cs + off256(rb + 4, cv)));
        o = __builtin_amdgcn_mfma_f32_32x32x16_bf16(cf, qf[kk], o, 0, 0, 0); }
#pragma unroll
    for (int r = 0; r < 16; ++r) o[r] *= isc;
    float psum = 0.f;
#pragma unroll
    for (int sh = 0; sh < 2; ++sh) { if (sh > tt) continue;
        f32x16 s = {0.f, 0.f, 0.f, 0.f, 0.f, 0.f, 0.f, 0.f, 0.f, 0.f, 0.f, 0.f, 0.f, 0.f, 0.f, 0.f};
#pragma unroll
        for (int kk = 0; kk < 4; ++kk) { const bf16x8 kf = *(const LAS bf16x8*)(Ks + off128r(32 * sh + r32, 2 * kk + hi)); s = __builtin_amdgcn_mfma_f32_32x32x16_bf16(kf, qf[kk], s, 0, 0, 0); }
        f32x4 u4[4];
#pragma unroll
        for (int rr = 0; rr < 4; ++rr) u4[rr] = *(const LAS f32x4*)(sm + 64 + 32 * sh + 8 * rr + 4 * hi);
        if (sh == tt) {
#pragma unroll
            for (int r = 0; r < 16; ++r) { float p = s[r] * __builtin_amdgcn_exp2f(u4[r >> 2][r & 3] + bt); if (8 * (r >> 2) + 4 * hi + (r & 3) > r32) p = 0.f; s[r] = p; psum += p; }
        } else {
#pragma unroll
            for (int r = 0; r < 16; ++r) { const float p = s[r] * __builtin_amdgcn_exp2f(u4[r >> 2][r & 3] + bt); s[r] = p; psum += p; }
        }
#pragma unroll
        for (int ks = 0; ks < 2; ++ks) { const int rb = 32 * sh + 16 * ks + 4 * hi + (li >> 2); const bf16x8 vf = cat8(vtr(Vs + off256(rb, cv)), vtr(Vs + off256(rb + 8, cv)));
            u32x4 w; w.x = pg8::cvt_pk_bf16(s[8 * ks + 0], s[8 * ks + 1]); w.y = pg8::cvt_pk_bf16(s[8 * ks + 2], s[8 * ks + 3]); w.z = pg8::cvt_pk_bf16(s[8 * ks + 4], s[8 * ks + 5]); w.w = pg8::cvt_pk_bf16(s[8 * ks + 6], s[8 * ks + 7]);
            o = __builtin_amdgcn_mfma_f32_32x32x16_bf16(vf, __builtin_bit_cast(bf16x8, w), o, 0, 0, 0); } }
    psum += __shfl_xor(psum, 32); dq += __shfl_xor(dq, 32);
    const float den = isc * dq + psum; const float dv = 1.0f / fmaxf(fabsf(den), fexp(-mt));
    float ss = 0.f;
#pragma unroll
    for (int r = 0; r < 16; ++r) { o[r] *= dv; ss += o[r] * o[r]; }
    ss += __shfl_xor(ss, 32);
    if (hi == 0) sm[320 + et * 64 + t] = ss;
}
__device__ __forceinline__ void c_epilogue(const f32x16& o, LAS unsigned char* lds, const Args& a, int U, int lane, int wave) {
    unsigned char* ws = a.ws; const bf16_t* mo = (const bf16_t*)(ws + WS_MO); LAS float* sm = (LAS float*)(lds + 67584);
    const int r32 = lane & 31, hi = lane >> 5, tt = wave & 1, et = wave >> 1, t = 32 * tt + r32; const int c = U & 127, h = (U >> 7) & 3, b = U >> 9; const size_t t0 = (size_t)b * SEQ + 64 * c;
    const float tot = (sm[320 + t] + sm[384 + t]) + (sm[448 + t] + sm[512 + t]); const float rs = 1.0f / sqrtf(tot * (1.0f / 128.f) + NEPS); const size_t tr = t0 + t;
    const float* onw = a.in[7] + h * 128 + 32 * et + 4 * hi; const bf16_t* mop = mo + tr * 512 + h * 128 + 32 * et + 4 * hi; bf16_t* op = (bf16_t*)(ws + WS_HMON) + tr * 1024 + h * 128 + 32 * et + 4 * hi;
#pragma unroll
    for (int rr = 0; rr < 4; ++rr) { const f32x4 w4 = *(const f32x4*)(onw + 8 * rr); const pg8::u32x2 m2 = *(const pg8::u32x2*)(mop + 8 * rr);
        const float o0 = o[4 * rr] * rs * w4[0] * sigm(pg8::bflo(m2.x)), o1 = o[4 * rr + 1] * rs * w4[1] * sigm(pg8::bfhi(m2.x)), o2 = o[4 * rr + 2] * rs * w4[2] * sigm(pg8::bflo(m2.y)), o3 = o[4 * rr + 3] * rs * w4[3] * sigm(pg8::bfhi(m2.y));
        pg8::u32x2 ov; ov.x = pg8::cvt_pk_bf16(o0, o1); ov.y = pg8::cvt_pk_bf16(o2, o3); *(pg8::u32x2*)(op + 8 * rr) = ov; }
}
__device__ __forceinline__ void phase_c(LAS unsigned char* lds, const Args& a, int G, int cu) {
    int tid = threadIdx.x; asm volatile("" : "+v"(tid)); const int lane = tid & 63, wave = __builtin_amdgcn_readfirstlane(tid >> 6);
    LAS unsigned char* l0 = lds; LAS unsigned char* l1 = lds + 71680;
    for (int U = cu; U < 2048; U += 2 * G) { const int U1 = U + G; const bool two = U1 < 2048;
        { CRegs r0, r1; c_load(r0, a, U, tid); if (two) c_load(r1, a, U1, tid);
          if (wave == 0) { c_gates(l0, a, U, lane); if (two) c_gates(l1, a, U1, lane); }
          c_store(r0, l0, tid); if (two) c_store(r1, l1, tid); }
        __syncthreads();
        c_conv(l0, a, U, tid); if (two) c_conv(l1, a, U1, tid);
        __syncthreads();
        f32x16 o0, o1;
        c_compute(o0, l0, lane, wave); if (two) c_compute(o1, l1, lane, wave);
        __syncthreads();
        c_epilogue(o0, l0, a, U, lane, wave); if (two) c_epilogue(o1, l1, a, U1, lane, wave);
        __syncthreads();
    }
}
}
__device__ __forceinline__ void cmpout_phase(const Args& a, int G, int cu, int tid_) {
    typedef short bf16x8_t __attribute__((ext_vector_type(8)));
    int tid = tid_; asm volatile("" : "+v"(tid));
    unsigned char* ws = a.ws; const bf16_t* hid = (const bf16_t*)(ws + WS_CMPH); bf16_t* cmpb = (bf16_t*)(ws + WS_CMPB);
    const int lane = tid & 63, wave = tid >> 6, rh = wave & 1, ct = wave >> 1, li = lane & 15, kg = lane >> 4;
    for (int rb = cu; rb < 256; rb += G) { const int r0 = 32 * rb + 16 * rh, kv = r0 >> 12; const float* w2 = (kv ? a.in[17] : a.in[14]) + 16 * ct + li;
        const bf16_t* hp = hid + (size_t)(r0 + li) * 256 + 8 * kg;
        f32x4 acc = {0.f, 0.f, 0.f, 0.f};
#pragma unroll
        for (int kk = 0; kk < 8; ++kk) { const u32x4 av = *(const u32x4*)(hp + 32 * kk); const float* w = w2 + (size_t)(32 * kk + 8 * kg) * 64;
            u32x4 bv; bv.x = pg8::cvt_pk_bf16(w[0], w[64]); bv.y = pg8::cvt_pk_bf16(w[128], w[192]); bv.z = pg8::cvt_pk_bf16(w[256], w[320]); bv.w = pg8::cvt_pk_bf16(w[384], w[448]);
            acc = __builtin_amdgcn_mfma_f32_16x16x32_bf16(__builtin_bit_cast(bf16x8_t, av), __builtin_bit_cast(bf16x8_t, bv), acc, 0, 0, 0); }
#pragma unroll
        for (int r = 0; r < 4; ++r) { const int row = r0 + 4 * kg + r; cmpb[(size_t)row * 64 + 16 * ct + li] = (bf16_t)f2bf((row & 511) < NCMP ? acc[r] : 0.f); } }
}
#ifndef PG8_SP2
#define PG8_SP2 true
#endif
#define WSP(T, off) ((T*)(ws + (off)))
__device__ __forceinline__ Ctx make_ctx(unsigned char* lds_raw) {
    Ctx C; C.lds = (LAS unsigned char*)lds_raw; { int t_ = threadIdx.x; asm volatile("" : "+v"(t_)); C.tid = t_; } C.lane = C.tid & 63; C.wave = __builtin_amdgcn_readfirstlane(C.tid >> 6); C.G = gridDim.x;
    C.vcu = blockIdx.x; C.gw = blockIdx.x * 8 + C.wave; C.ngw = C.G * 8; C.gtid = blockIdx.x * 512 + C.tid; C.nthr = C.G * 512; return C; }
__device__ __forceinline__ void run_ph0(unsigned char* lds_raw, const Args& args) { const Ctx C = make_ctx(lds_raw); unsigned char* ws = args.ws;
    phase_prologue(C, args);
#if defined(REPEAT_P0)
    __syncthreads(); phase_prologue(C, args);
#endif
}
__device__ __forceinline__ void run_ph1(unsigned char* lds_raw, const Args& args) { const Ctx C = make_ctx(lds_raw); unsigned char* ws = args.ws;
    { pg8::Gemm g{WSP(bf16_t, WS_XB), WSP(bf16_t, WS_WIN), TT, 3072, 1024, 1024, 128}; pg8::StaticOrder S; S.init(TT, 3072, C.G, (int)blockIdx.x);
      pg8::EpiInProj E{ws, args.in[8], args.in[9], args.in[10], args.in[11]};
      pg8::gemm_phase<pg8::EpiInProj, pg8::StaticOrder, true, PG8_SP2>(C.lds, g, S, E);
#if defined(REPEAT_G17)
      pg8::gemm_phase<pg8::EpiInProj, pg8::StaticOrder, true, PG8_SP2>(C.lds, g, S, E);
#endif
    }
}
__device__ __forceinline__ void run_ph2(unsigned char* lds_raw, const Args& args) { const Ctx C = make_ctx(lds_raw); unsigned char* ws = args.ws;
    { pg8::Gemm g{nullptr, nullptr, 8192, 256, 2048, 2048, 256}; pg8::CmpOrder S{C.G, (int)blockIdx.x, WSP(bf16_t, WS_KC), WSP(bf16_t, WS_VC), WSP(bf16_t, WS_CW1)};
      pg8::EpiCmpHid E{WSP(float, WS_CBIAS), WSP(bf16_t, WS_CMPH)};
      pg8::gemm_phase<pg8::EpiCmpHid, pg8::CmpOrder, true, PG8_SP2>(C.lds, g, S, E);
#if defined(REPEAT_CH)
      pg8::gemm_phase<pg8::EpiCmpHid, pg8::CmpOrder, true, PG8_SP2>(C.lds, g, S, E);
#endif
    }
    if (C.G >= 64) { if ((int)blockIdx.x >= 32) { ml::phase_a(C.lds, args, C.G - 32, (int)blockIdx.x - 32); Ctx C2 = C; C2.gw = C.gw - 32 * 8; C2.ngw = C.ngw - 32 * 8; __syncthreads(); phase_transposes<1>(C2, args); } }
    else { ml::phase_a(C.lds, args, C.G, (int)blockIdx.x); __syncthreads(); phase_transposes<1>(C, args); }
#if defined(REPEAT_ML) || defined(REPEAT_MLA)
    __syncthreads(); if ((int)blockIdx.x >= 32) ml::phase_a(C.lds, args, C.G - 32, (int)blockIdx.x - 32);
#endif
}
__device__ __forceinline__ void run_ph3(unsigned char* lds_raw, const Args& args) { const Ctx C = make_ctx(lds_raw); unsigned char* ws = args.ws;
    cmpout_phase(args, C.G, (int)blockIdx.x, C.tid);
#if defined(REPEAT_CO)
    for (int rep = 0; rep < REPEAT_CO; ++rep) { __syncthreads(); cmpout_phase(args, C.G, (int)blockIdx.x, C.tid); }
#endif
    att::attn_phase<att::M_WIN>(C.lds, args, C.G, (int)blockIdx.x);
    ml::phase_b(args, C.gtid, C.nthr);
#if defined(REPEAT_ML) || defined(REPEAT_MLB)
    ml::phase_b(args, C.gtid, C.nthr);
#endif
}
__device__ __forceinline__ void run_ph4(unsigned char* lds_raw, const Args& args) { const Ctx C = make_ctx(lds_raw); unsigned char* ws = args.ws;
#if !defined(ONLY_MLC)
    att::attn_phase<att::M_CMP>(C.lds, args, C.G, (int)blockIdx.x);
#endif
#if defined(REPEAT_WC) || defined(REPEAT_CMP)
    __syncthreads(); att::attn_phase<att::M_CMP>(C.lds, args, C.G, (int)blockIdx.x, WS_Y);
#endif
    ml::phase_c(C.lds, args, C.G, (int)blockIdx.x);
#if defined(REPEAT_ML) || defined(REPEAT_MLC)
    __syncthreads(); ml::phase_c(C.lds, args, C.G, (int)blockIdx.x);
#endif
}
__device__ __forceinline__ void run_ph5(unsigned char* lds_raw, const Args& args) { const Ctx C = make_ctx(lds_raw); unsigned char* ws = args.ws;
    __syncthreads();
    att::attn_phase<att::M_SLC>(C.lds, args, C.G, (int)blockIdx.x);
#if defined(REPEAT_SLC)
    for (int rep = 0; rep < REPEAT_SLC; ++rep) { __syncthreads(); att::attn_phase<att::M_SLC>(C.lds, args, C.G, (int)blockIdx.x, WS_DC); }
#endif
}
__device__ __forceinline__ void run_ph6(unsigned char* lds_raw, const Args& args) { const Ctx C = make_ctx(lds_raw); unsigned char* ws = args.ws;
    __syncthreads();
    { pg8::Gemm g{WSP(bf16_t, WS_XB), WSP(bf16_t, WS_WG), TT, 2048, 1024, 1024, 128}; pg8::StaticOrder S; S.init(TT, 2048, C.G, (int)blockIdx.x);
      pg8::EpiGate E{WSP(float, WS_RSTD1), args.in[20], (bf16_t*)args.out, (bf16_t*)args.out + (size_t)TT * 1024};
      pg8::gemm_phase<pg8::EpiGate, pg8::StaticOrder, true, PG8_SP2>(C.lds, g, S, E);
#if defined(REPEAT_G4) || defined(REPEAT_P5A)
      pg8::gemm_phase<pg8::EpiGate, pg8::StaticOrder, true, PG8_SP2>(C.lds, g, S, E);
#endif
    }
}
__device__ __forceinline__ void run_ph7(unsigned char* lds_raw, const Args& args) { const Ctx C = make_ctx(lds_raw); unsigned char* ws = args.ws;
    { pg8::Gemm g{WSP(bf16_t, WS_HMON), WSP(bf16_t, WS_WMN), TT, 1024, 1024, 1024, 128}; pg8::StaticOrder S; S.init(TT, 1024, C.G, (int)blockIdx.x);
      pg8::EpiMerge E{(const bf16_t*)args.out, (const bf16_t*)args.out + (size_t)TT * 1024, WSP(bf16_t, WS_Y)};
      pg8::gemm_phase<pg8::EpiMerge, pg8::StaticOrder, true, PG8_SP2>(C.lds, g, S, E);
#if defined(REPEAT_G4) || defined(REPEAT_P5B)
      pg8::gemm_phase<pg8::EpiMerge, pg8::StaticOrder, true, PG8_SP2>(C.lds, g, S, E);
#endif
    }
}
__device__ __forceinline__ void run_ph8(unsigned char* lds_raw, const Args& args) { const Ctx C = make_ctx(lds_raw); unsigned char* ws = args.ws;
    { pg8::Gemm g{WSP(bf16_t, WS_Y), WSP(bf16_t, WS_WOUT), TT, 1024, 1024, 1024, 128}; pg8::StaticOrder S; S.init(TT, 1024, C.G, (int)blockIdx.x);
      pg8::EpiWout E{args.in[0], args.out, WSP(bf16_t, WS_XB), WSP(float, WS_SSQ2)};
      pg8::gemm_phase<pg8::EpiWout, pg8::StaticOrder, true, PG8_SP2>(C.lds, g, S, E);
#if defined(REPEAT_G4) || defined(REPEAT_P6)
      pg8::gemm_phase<pg8::EpiWout, pg8::StaticOrder, true, PG8_SP2>(C.lds, g, S, E);
#endif
    }
}
__device__ __forceinline__ void run_ph9(unsigned char* lds_raw, const Args& args) { const Ctx C = make_ctx(lds_raw); unsigned char* ws = args.ws;
    { pg8::Gemm g{WSP(bf16_t, WS_XB), WSP(bf16_t, WS_WUP), TT, 5632, 1024, 1024, 128}; pg8::StaticOrder S; S.init(TT, 5632, C.G, (int)blockIdx.x);
      pg8::EpiFfnUp E{WSP(float, WS_SSQ2), args.in[24], args.in[25], WSP(bf16_t, WS_MID), WSP(float, WS_EDGEA), WSP(float, WS_EDGEV), (LAS float*)(C.lds + LDS_EX)};
      pg8::gemm_phase<pg8::EpiFfnUp, pg8::StaticOrder, true, PG8_SP2>(C.lds, g, S, E);
#if defined(REPEAT_G17)
      pg8::gemm_phase<pg8::EpiFfnUp, pg8::StaticOrder, true, PG8_SP2>(C.lds, g, S, E);
#endif
    }
}
__device__ __forceinline__ void run_ph11(unsigned char* lds_raw, const Args& args) { const Ctx C = make_ctx(lds_raw); unsigned char* ws = args.ws;
    { pg8::Gemm g{WSP(bf16_t, WS_MID), WSP(bf16_t, WS_WDN), TT, 1024, 2816, 2816, 128}; pg8::StaticOrder S; S.init(TT, 1024, C.G, (int)blockIdx.x);
      { pg8::Unit u; int pl = -1; for (int i = 0; S.next(i, u); ++i) if (u.pm != pl) { p7b_fixup_panel(C, args, u.pm); pl = u.pm; } }
      __syncthreads();
#if defined(REPEAT_G4) || defined(REPEAT_P8)
      { pg8::EpiFfnDown E0{WSP(bf16_t, WS_XB), WSP(float, WS_HMON)}; pg8::gemm_phase<pg8::EpiFfnDown, pg8::StaticOrder, true, PG8_SP2>(C.lds, g, S, E0); }
#endif
      pg8::EpiFfnDown E{WSP(bf16_t, WS_XB), args.out};
      pg8::gemm_phase<pg8::EpiFfnDown, pg8::StaticOrder, true, PG8_SP2>(C.lds, g, S, E); }
}
__device__ __forceinline__ void run_rstd2(const Args& args) {
    const float* ssq = (const float*)(args.ws + WS_SSQ2); float* r2 = (float*)(args.ws + WS_RSTD1);
    for (int t = blockIdx.x * 512 + threadIdx.x; t < TT; t += gridDim.x * 512) { const f32x4* sp = (const f32x4*)(ssq + (size_t)t * 16); const f32x4 s0 = sp[0], s1 = sp[1], s2 = sp[2], s3 = sp[3];
        const float ss = ((s0[0] + s0[1]) + (s0[2] + s0[3])) + ((s1[0] + s1[1]) + (s1[2] + s1[3])) + ((s2[0] + s2[1]) + (s2[2] + s2[3])) + ((s3[0] + s3[1]) + (s3[2] + s3[3]));
        r2[t] = 1.0f / sqrtf(ss * (1.0f / 1024.0f) + NEPS); }
}
constexpr int NPHASE = 12;
#ifndef SPLIT_TEST
__global__ void __launch_bounds__(512, 2) mega_fwd(Args args) {
    extern __shared__ __attribute__((aligned(16))) unsigned char lds_raw[];
#if defined(USE_CG_SYNC)
    cg::grid_group grid = cg::this_grid();
#endif
    volatile LAS unsigned* xst = (volatile LAS unsigned*)((LAS unsigned char*)lds_raw + LDS_XB);
    if (threadIdx.x < 2) xst[threadIdx.x] = 0u;
    __syncthreads();
    (void)xcd_barrier_post((unsigned*)(args.ws + WS_CTL) + 4096, xst);
#define GRID_BAR() do { XcdBarrier b_; b_.bar = (unsigned*)(args.ws + WS_CTL) + 4096; b_.x = xb_xcc_id(); b_.st = (volatile LAS unsigned*)((LAS unsigned char*)lds_raw + LDS_XB); xcd_barrier(b_); } while (0)
#if defined(PROBE_TS)
#define TS(i) do { if (blockIdx.x == 0 && threadIdx.x == 0) ((unsigned long long*)(args.ws + WS_CTL))[64 + (i)] = __builtin_amdgcn_s_memrealtime(); } while (0)
#else
#define TS(i) do {} while (0)
#endif
    TS(0);
    run_ph0(lds_raw, args);
#if defined(USE_CG_SYNC)
    grid.sync();
#else
    GRID_BAR();
#endif
    TS(1);
    run_ph1(lds_raw, args);
    GRID_BAR();
    TS(2);
    run_ph2(lds_raw, args);
    GRID_BAR();
    TS(3);
    run_ph3(lds_raw, args);
    GRID_BAR();
    TS(4);
    run_ph4(lds_raw, args);
    TS(5);
    run_ph5(lds_raw, args);
#if defined(EXTRA_BARS)
    for (int eb = 0; eb < EXTRA_BARS; ++eb) GRID_BAR();
#endif
    TS(6);
    run_ph6(lds_raw, args);
    GRID_BAR();
    TS(7);
    run_ph7(lds_raw, args);
    GRID_BAR();
    TS(8);
    run_ph8(lds_raw, args);
    GRID_BAR();
    TS(9);
    run_ph9(lds_raw, args);
    GRID_BAR();
    TS(10);
    TS(11);
    run_ph11(lds_raw, args);
    TS(12);
#if defined(PROBE_TS)
    GRID_BAR();
    { const unsigned long long* ts = (const unsigned long long*)(args.ws + WS_CTL) + 64; const float f = (float)(ts[PROBE_TS] - ts[0]) / (float)(ts[12] - ts[0]); const float sc = 1.0f + sqrtf(f);
      for (int i = blockIdx.x * 512 + threadIdx.x; i < TT * DM; i += gridDim.x * 512) args.out[i] *= sc; }
#endif
}
#else
__global__ void __launch_bounds__(512, 2) ph0_k(Args args) { extern __shared__ __attribute__((aligned(16))) unsigned char lds_raw[]; run_ph0(lds_raw, args); }
__global__ void __launch_bounds__(512, 2) ph1_k(Args args) { extern __shared__ __attribute__((aligned(16))) unsigned char lds_raw[]; run_ph1(lds_raw, args); }
__global__ void __launch_bounds__(512, 2) ph2_k(Args args) { extern __shared__ __attribute__((aligned(16))) unsigned char lds_raw[]; run_ph2(lds_raw, args); }
__global__ void __launch_bounds__(512, 2) ph3_k(Args args) { extern __shared__ __attribute__((aligned(16))) unsigned char lds_raw[]; run_ph3(lds_raw, args); }
__global__ void __launch_bounds__(512, 2) ph4_k(Args args) { extern __shared__ __attribute__((aligned(16))) unsigned char lds_raw[]; run_ph4(lds_raw, args); }
__global__ void __launch_bounds__(512, 2) ph5_k(Args args) { extern __shared__ __attribute__((aligned(16))) unsigned char lds_raw[]; run_ph5(lds_raw, args); }
__global__ void __launch_bounds__(512, 2) ph6_k(Args args) { extern __shared__ __attribute__((aligned(16))) unsigned char lds_raw[]; run_ph6(lds_raw, args); }
__global__ void __launch_bounds__(512, 2) ph7_k(Args args) { extern __shared__ __attribute__((aligned(16))) unsigned char lds_raw[]; run_ph7(lds_raw, args); }
__global__ void __launch_bounds__(512, 2) ph8_k(Args args) { extern __shared__ __attribute__((aligned(16))) unsigned char lds_raw[]; run_ph8(lds_raw, args); }
__global__ void __launch_bounds__(512, 2) ph9_k(Args args) { extern __shared__ __attribute__((aligned(16))) unsigned char lds_raw[]; run_ph9(lds_raw, args); }
__global__ void __launch_bounds__(512, 2) ph11_k(Args args) { extern __shared__ __attribute__((aligned(16))) unsigned char lds_raw[]; run_ph11(lds_raw, args); }
__global__ void __launch_bounds__(512, 2) rstd2_k(Args args) { run_rstd2(args); }
__global__ void __launch_bounds__(512, 2) mega_fwd(Args args) {}
#endif
extern "C" void kernel_launch(void* const* d_in, const int* in_sizes, int n_in, void* d_out, int out_size, void* d_ws, size_t ws_size, hipStream_t stream) {
    static int grid = 0;
    if (grid == 0) {
        if (n_in != 27 || out_size != TT * DM || ws_size < WS_END) { fprintf(stderr, "kernel_launch: unexpected shapes (n_in %d out %d ws %zu)\n", n_in, out_size, ws_size); grid = -1; return; }
        int dev = 0, cus = 0, per_cu = 0;
        hipGetDevice(&dev); hipDeviceGetAttribute(&cus, hipDeviceAttributeMultiprocessorCount, dev);
        hipFuncSetAttribute((const void*)mega_fwd, hipFuncAttributeMaxDynamicSharedMemorySize, LDS_BYTES);
        hipOccupancyMaxActiveBlocksPerMultiprocessor(&per_cu, (const void*)mega_fwd, 512, LDS_BYTES);
        if (per_cu < 1) { fprintf(stderr, "kernel_launch: occupancy query says %d blocks per CU\n", per_cu); grid = -1; return; }
        grid = cus * 1;
    }
    if (grid < 0) return;
    hipMemsetAsync((char*)d_ws + WS_CTL, 0, 1 * MiB, stream);
    Args a{}; for (int i = 0; i < 27; ++i) a.in[i] = (const float*)d_in[i]; a.out = (float*)d_out; a.ws = (unsigned char*)d_ws;
    for (int j = 0; j < 32; ++j) a.rope_inv[j] = (float)pow(10000.0, -(double)j / 32.0);
    void* kargs[] = {&a};
    hipError_t e = hipLaunchCooperativeKernel((const void*)mega_fwd, dim3(grid), dim3(512), kargs, LDS_BYTES, stream);
    if (e != hipSuccess) fprintf(stderr, "cooperative launch failed: %s (grid %d)\n", hipGetErrorString(e), grid);
#if defined(REPEAT_LAUNCH)
    for (int rl = 0; rl < REPEAT_LAUNCH; ++rl) { hipMemsetAsync((char*)d_ws + WS_CTL, 0, 1 * MiB, stream); hipLaunchCooperativeKernel((const void*)mega_fwd, dim3(grid), dim3(512), kargs, LDS_BYTES, stream); }
#endif
}
```

```cpp
#include <hip/hip_runtime.h>
#include <hip/hip_cooperative_groups.h>
#include <cstdio>
#include <cstdint>
#include <cmath>
namespace cg = cooperative_groups;
constexpr int NB = 4, DM = 1024, DIN = 4896, DFF = 2816, NCMP = 511, NSEL = 128;
constexpr int C_MQ = 0, C_MK = 256, C_MV = 512, C_MO = 1024, C_MI = 1536, C_MF = 1540, C_NQ = 1544, C_KC = 2056, C_VC = 2184, C_KS = 2312, C_VS = 2440, C_KW = 2568, C_VW = 2696, C_NG = 2824, C_GM = 2848;
constexpr size_t MiB = 1u << 20;
constexpr size_t WS_CTL = 0;
constexpr size_t WS_ROPEC = 1 * MiB, WS_ROPES = 2 * MiB, WS_RSTD1 = 3 * MiB, WS_SSQ2 = 4 * MiB, WS_SMALLG = 6 * MiB, WS_SEL = 10 * MiB, WS_CMPB = 11 * MiB, WS_CBIAS = 12 * MiB;
constexpr size_t WS_EDGEA = 13 * MiB, WS_EDGEV = 19 * MiB, WS_IPRE = 22 * MiB, WS_LOGF = 22 * MiB + 524288, WS_MLS = 23 * MiB;
constexpr size_t WS_WIN = 24 * MiB  , WS_WG = 30 * MiB  , WS_WMN = 34 * MiB, WS_WOUT = 36 * MiB, WS_WUP = 38 * MiB, WS_WDN = 49 * MiB, WS_CW1 = 55 * MiB;
constexpr size_t WS_XB = 60 * MiB;
constexpr size_t WS_QKPRE = 124 * MiB, WS_MV = 156 * MiB, WS_MO = 188 * MiB, WS_NQ = 220 * MiB, WS_KC = 252 * MiB, WS_KS = 260 * MiB, WS_KW = 268 * MiB, WS_VC = 276 * MiB, WS_VS = 284 * MiB, WS_VW = 292 * MiB;
constexpr size_t WS_HMON = 300 * MiB;
constexpr size_t WS_DC = 364 * MiB, WS_CPREV = 428 * MiB, WS_CMPH = 492 * MiB;
constexpr size_t WS_Y = 124 * MiB;
constexpr size_t WS_MID = 124 * MiB;
constexpr size_t WS_END = 500 * MiB;
constexpr size_t WS_QKF = 364 * MiB  , WS_HRAW = 428 * MiB  , WS_IMP = 364 * MiB  , WS_IDX = 396 * MiB  ;
constexpr int RING_BYTES = 131072, LDS_EX = RING_BYTES  , LDS_BYTES = 147456, LDS_XB = 147456 - 64  ;

namespace pg8 {
#define PG8_LAS __attribute__((address_space(3)))
typedef unsigned short bf16_t;
typedef short bf16x8 __attribute__((ext_vector_type(8)));
typedef float f32x4 __attribute__((ext_vector_type(4)));
typedef unsigned u32x4 __attribute__((ext_vector_type(4)));
constexpr int BM = 256, BK = 64, HALF = 128, HTB = HALF * BK * 2  , STAGE_BYTES = 8 * HTB, NXCD = 8, WGM = 8;

__host__ __device__ __forceinline__ int lds_byte(int r, int c) { const int st = (r >> 4) * 2 + (c >> 5), rr = r & 15, cc = c & 31, ob = rr * 64 + cc * 2; return st * 1024 + (ob ^ (((ob >> 9) & 1) << 5)); }
__host__ __device__ __forceinline__ void stage_rc(int b, int& R, int& C) { const int st = b / 1024, sb = b % 1024, swz = sb ^ (((sb >> 9) & 1) << 5); R = (st >> 1) * 16 + swz / 64; C = (st & 1) * 32 + (swz % 64) / 2; }
__host__ __device__ __forceinline__ int perm32(int rho) { const int n = rho >> 4, i = rho & 15; return 8 * (i >> 2) + 4 * n + (i & 3); }

struct Unit { int pm, pn; };
struct Gemm { const bf16_t* A; const bf16_t* Bt; int M, N, K; int lda; int ksA; };

struct StaticOrder {
    int nM, nN, nwg, G, c;
    __host__ __device__ void init(int M, int N, int G_, int c_) { nM = M / BM; nN = N / BM; nwg = nM * nN; G = G_; c = c_; }
    __host__ __device__ bool next(int i, Unit& u) const {
        const long L = (long)i * G + c; if (L >= nwg) return false;
        int wgid = (int)L; { const int q = nwg / NXCD, r = nwg % NXCD, xcd = wgid % NXCD, off = wgid / NXCD; wgid = (xcd < r ? xcd * (q + 1) : r * (q + 1) + (xcd - r) * q) + off; }
        const int nig = WGM * nN, gid = wgid / nig, fm = gid * WGM, gsz = (nM - fm) < WGM ? (nM - fm) : WGM;
        u.pm = fm + ((wgid % nig) % gsz); u.pn = (wgid % nig) / gsz; return true;
    }
    __device__ __forceinline__ const char* a_ptr(const Gemm& g, const Unit& u) const { return (const char*)g.A + (size_t)u.pm * BM * g.lda * 2; }
    __device__ __forceinline__ const char* b_ptr(const Gemm& g, const Unit& u) const { return (const char*)g.Bt + (size_t)u.pn * BM * g.K * 2; }
    __device__ __forceinline__ void a_ready(const Unit&) const {}
    __device__ __forceinline__ void done(const Unit&) const {}
};

typedef float f32x2_cv __attribute__((ext_vector_type(2))); typedef __bf16 bf16x2_cv __attribute__((ext_vector_type(2)));
__device__ __forceinline__ unsigned cvt_pk_bf16(float lo, float hi) { const f32x2_cv v = {lo, hi}; const bf16x2_cv b = __builtin_convertvector(v, bf16x2_cv); return __builtin_bit_cast(unsigned, b); }
typedef float f32x2 __attribute__((ext_vector_type(2)));
__device__ __forceinline__ f32x2 gelu_pk(f32x2 v) {
    const f32x2 av = __builtin_elementwise_abs(v), d = av * 0.2316418882f + 1.0f;
    f32x2 t; t.x = __builtin_amdgcn_rcpf(d.x); t.y = __builtin_amdgcn_rcpf(d.y);
    f32x2 q = t * 0.5307027145f + (-0.7265760135f); q = q * t + 0.7107068705f; q = q * t + (-0.142248368f); q = q * t + 0.127414796f; q = q * t;
    const f32x2 s = (v * v) * (-0.72134752044f);
    f32x2 e; e.x = __builtin_amdgcn_exp2f(s.x); e.y = __builtin_amdgcn_exp2f(s.y);
    const f32x2 m = v * (q * e), r = v - m;
    f32x2 o; o.x = v.x < 0.f ? m.x : r.x; o.y = v.y < 0.f ? m.y : r.y; return o;
}

constexpr int TT = 32768, SEQ = 8192;
constexpr float NEPS = 1e-6f;
constexpr float QC2 = 0.125f * 1.4426950408889634f;
typedef unsigned u32x2 __attribute__((ext_vector_type(2)));
__device__ __forceinline__ float bf2f(unsigned short v) { return __uint_as_float((unsigned)v << 16); }
__device__ __forceinline__ float bflo(unsigned w) { return __uint_as_float(w << 16); }
__device__ __forceinline__ float bfhi(unsigned w) { return __uint_as_float(w & 0xffff0000u); }
__device__ __forceinline__ float sigm(float x) { return __builtin_amdgcn_rcpf(1.0f + __builtin_amdgcn_exp2f(-1.4426950408889634f * x)); }
__device__ __forceinline__ u32x4 pack8(const f32x4& a, const f32x4& b) { u32x4 w; w.x = cvt_pk_bf16(a[0], a[1]); w.y = cvt_pk_bf16(a[2], a[3]); w.z = cvt_pk_bf16(b[0], b[1]); w.w = cvt_pk_bf16(b[2], b[3]); return w; }
__device__ __forceinline__ void unpack8(const u32x4& w, f32x4& a, f32x4& b) { a = (f32x4){bflo(w.x), bfhi(w.x), bflo(w.y), bfhi(w.y)}; b = (f32x4){bflo(w.z), bfhi(w.z), bflo(w.w), bfhi(w.w)}; }


struct EpiInProj {
    static constexpr bool PERM = true, AFTER_DRAIN = false, HAS_MID = false;
    unsigned char* ws; const float *qnw, *kcw, *ksw, *kww;
    __device__ __forceinline__ void mid(f32x4 (&)[2][2][4][2], const Unit&, int, int, int, int) const {}
    __device__ __forceinline__ void operator()(f32x4 (&acc)[2][2][4][2], const Unit& u, int wr, int wc, int fr, int fq_) const {
        int fq = fq_; asm volatile("" : "+v"(fq));
        const int pn = u.pn; int row0 = u.pm * BM + wr * 64 + fr; asm volatile("" : "+v"(row0));
        const float* rstd = (const float*)(ws + WS_RSTD1); const float* rope_c = (const float*)(ws + WS_ROPEC); const float* rope_s = (const float*)(ws + WS_ROPES);
        float rsv[8];
#pragma unroll
        for (int g = 0; g < 8; ++g) rsv[g] = rstd[row0 + (g >> 2) * HALF + (g & 3) * 16];
        if (pn < 6) {
            bf16_t* base = (bf16_t*)(ws + (pn < 2 ? WS_QKPRE : pn < 4 ? WS_MV : WS_MO)); const int col0 = (pn & 1) * 256 + wc * 32 + 8 * fq;
#pragma unroll
            for (int ai = 0; ai < 2; ++ai)
#pragma unroll
                for (int m = 0; m < 4; ++m) { const int row = row0 + ai * HALF + m * 16; const float rs = rsv[ai * 4 + m]; bf16_t* rowp = base + (size_t)row * 512 + col0;
#pragma unroll
                    for (int bj = 0; bj < 2; ++bj) *(u32x4*)(rowp + bj * HALF) = pack8(acc[ai][bj][m][0] * rs, acc[ai][bj][m][1] * rs); }
        } else if (pn < 11) {
            bf16_t* dst; int ld; const float* nw = nullptr; float osc = 1.0f;
            if (pn < 8) { dst = (bf16_t*)(ws + WS_NQ) + (4 * (pn - 6) + wc) * 64; ld = 512; nw = qnw; osc = QC2; }
            else { const int seg = (pn - 8) * 2 + (wc >> 1);
                const size_t so = seg == 0 ? WS_KC : seg == 1 ? WS_KS : seg == 2 ? WS_KW : seg == 3 ? WS_VC : seg == 4 ? WS_VS : WS_VW;
                dst = (bf16_t*)(ws + so) + (wc & 1) * 64; ld = 128; nw = seg == 0 ? kcw : seg == 1 ? ksw : seg == 2 ? kww : nullptr; }
            f32x4 w0[2] = {{1.f, 1.f, 1.f, 1.f}, {1.f, 1.f, 1.f, 1.f}}, w1[2] = {{1.f, 1.f, 1.f, 1.f}, {1.f, 1.f, 1.f, 1.f}};
            if (nw) {
#pragma unroll
                for (int n = 0; n < 2; ++n) { w0[n] = *(const f32x4*)(nw + 8 * fq + 4 * n); w1[n] = *(const f32x4*)(nw + 32 + 8 * fq + 4 * n); } }
            f32x4 cs[2][4];
            if (nw) { const int tp = row0 & (SEQ - 1); cs[0][0] = *(const f32x4*)(rope_c + tp * 32 + 8 * fq); cs[0][1] = *(const f32x4*)(rope_c + tp * 32 + 8 * fq + 4); cs[0][2] = *(const f32x4*)(rope_s + tp * 32 + 8 * fq); cs[0][3] = *(const f32x4*)(rope_s + tp * 32 + 8 * fq + 4); }
#pragma unroll
            for (int g = 0; g < 8; ++g) { const int ai = g >> 2, m = g & 3; const int row = row0 + ai * HALF + m * 16; const float rs = rsv[g];
                if (nw && g < 7) { const int tn = (row0 + ((g + 1) >> 2) * HALF + ((g + 1) & 3) * 16) & (SEQ - 1); f32x4 (&nx)[4] = cs[(g + 1) & 1];
                    nx[0] = *(const f32x4*)(rope_c + tn * 32 + 8 * fq); nx[1] = *(const f32x4*)(rope_c + tn * 32 + 8 * fq + 4); nx[2] = *(const f32x4*)(rope_s + tn * 32 + 8 * fq); nx[3] = *(const f32x4*)(rope_s + tn * 32 + 8 * fq + 4); }
#pragma unroll
                for (int n = 0; n < 2; ++n) { acc[ai][0][m][n] = acc[ai][0][m][n] * rs; acc[ai][1][m][n] = acc[ai][1][m][n] * rs; }
                if (nw) {
                    float s = 0.f;
#pragma unroll
                    for (int n = 0; n < 2; ++n)
#pragma unroll
                        for (int e = 0; e < 4; ++e) s += acc[ai][0][m][n][e] * acc[ai][0][m][n][e] + acc[ai][1][m][n][e] * acc[ai][1][m][n][e];
                    s += __shfl_xor(s, 16); s += __shfl_xor(s, 32);
                    const float rn = 1.0f / sqrtf(s * (1.0f / 64.0f) + NEPS); const f32x4 (&cc)[4] = cs[g & 1];
#pragma unroll
                    for (int n = 0; n < 2; ++n) { const f32x4 a = acc[ai][0][m][n] * rn * w0[n], b = acc[ai][1][m][n] * rn * w1[n]; acc[ai][0][m][n] = (a * cc[n] - b * cc[2 + n]) * osc; acc[ai][1][m][n] = (b * cc[n] + a * cc[2 + n]) * osc; }
                }
                bf16_t* rowp = dst + (size_t)row * ld + 8 * fq;
                *(u32x4*)(rowp) = pack8(acc[ai][0][m][0], acc[ai][0][m][1]); *(u32x4*)(rowp + 32) = pack8(acc[ai][1][m][0], acc[ai][1][m][1]); asm volatile("" ::: "memory"); }
        } else {
            if (wc == 0) {
#pragma unroll
                for (int ai = 0; ai < 2; ++ai)
#pragma unroll
                    for (int m = 0; m < 4; ++m) { const int row = row0 + ai * HALF + m * 16; const float rs = rsv[ai * 4 + m]; float* rowp = (float*)(ws + WS_SMALLG) + (size_t)row * 32 + 8 * fq;
                        *(f32x4*)(rowp) = acc[ai][0][m][0] * rs; *(f32x4*)(rowp + 4) = acc[ai][0][m][1] * rs; }
            }
        }
    }
};
struct EpiGate {
    static constexpr bool PERM = true, AFTER_DRAIN = false, HAS_MID = false;
    const float* rstd; const float* bias  ; bf16_t* gr; bf16_t* gn;
    __device__ __forceinline__ void mid(f32x4 (&)[2][2][4][2], const Unit&, int, int, int, int) const {}
    __device__ __forceinline__ void operator()(f32x4 (&acc)[2][2][4][2], const Unit& u, int wr, int wc, int fr, int fq) const {
        int row0 = u.pm * BM + wr * 64 + fr; asm volatile("" : "+v"(row0)); const int col0 = u.pn * 128 + wc * 32 + 8 * fq; const float* bp = bias + col0;
        f32x4 bv[2][2];
#pragma unroll
        for (int bj = 0; bj < 2; ++bj)
#pragma unroll
            for (int n = 0; n < 2; ++n) bv[bj][n] = *(const f32x4*)(bp + bj * 1024 + 4 * n);
        float rsv[8];
#pragma unroll
        for (int g = 0; g < 8; ++g) rsv[g] = rstd[row0 + (g >> 2) * HALF + (g & 3) * 16];
#pragma unroll
        for (int ai = 0; ai < 2; ++ai)
#pragma unroll
            for (int m = 0; m < 4; ++m) { const int row = row0 + ai * HALF + m * 16; const float rs = rsv[ai * 4 + m]; const size_t off = (size_t)row * 1024 + col0;
                f32x4 r[2], q[2];
#pragma unroll
                for (int n = 0; n < 2; ++n) { const f32x4 vm = acc[ai][0][m][n] * rs + bv[0][n], vn = acc[ai][1][m][n] * rs + bv[1][n];
#pragma unroll
                    for (int e = 0; e < 4; ++e) { const float gmv = sigm(vm[e]), gnv = sigm(vn[e]); q[n][e] = gnv; r[n][e] = gmv * __builtin_amdgcn_rcpf(fmaxf(gnv, 1e-30f)); } }
                *(u32x4*)(gr + off) = pack8(r[0], r[1]); *(u32x4*)(gn + off) = pack8(q[0], q[1]); }
    }
};
struct EpiMerge {
    static constexpr bool PERM = true, AFTER_DRAIN = false, HAS_MID = true;
    const bf16_t* gr; const bf16_t* gn; bf16_t* y;
    __device__ __forceinline__ void mid(f32x4 (&acc)[2][2][4][2], const Unit& u, int wr, int wc, int fr, int fq) const {
        int row0 = u.pm * BM + wr * 64 + fr; asm volatile("" : "+v"(row0)); const int col0 = u.pn * BM + wc * 32 + 8 * fq;
        u32x4 gq[4][2];
#pragma unroll
        for (int g = 0; g < 3; ++g) { const size_t off = (size_t)(row0 + (g >> 2) * HALF + (g & 3) * 16) * 1024 + col0; gq[g][0] = *(const u32x4*)(gr + off); gq[g][1] = *(const u32x4*)(gr + off + HALF); }
#pragma unroll
        for (int g = 0; g < 8; ++g) { const int ai = g >> 2, m = g & 3;
            if (g + 3 < 8) { const size_t off = (size_t)(row0 + ((g + 3) >> 2) * HALF + ((g + 3) & 3) * 16) * 1024 + col0; gq[(g + 3) & 3][0] = *(const u32x4*)(gr + off); gq[(g + 3) & 3][1] = *(const u32x4*)(gr + off + HALF); }
#pragma unroll
            for (int bj = 0; bj < 2; ++bj) { f32x4 a0, a1; unpack8(gq[g & 3][bj], a0, a1); acc[ai][bj][m][0] = acc[ai][bj][m][0] * a0; acc[ai][bj][m][1] = acc[ai][bj][m][1] * a1; }
            asm volatile("" : "+v"(acc[ai][0][m][0]), "+v"(acc[ai][0][m][1]), "+v"(acc[ai][1][m][0]), "+v"(acc[ai][1][m][1]) :: "memory"); }
    }
    __device__ __forceinline__ void operator()(f32x4 (&acc)[2][2][4][2], const Unit& u, int wr, int wc, int fr, int fq) const {
        int row0 = u.pm * BM + wr * 64 + fr; asm volatile("" : "+v"(row0)); const int col0 = u.pn * BM + wc * 32 + 8 * fq;
        u32x4 gq[2][2];
        { const size_t off = (size_t)row0 * 1024 + col0; gq[0][0] = *(const u32x4*)(gn + off); gq[0][1] = *(const u32x4*)(gn + off + HALF); }
#pragma unroll
        for (int g = 0; g < 8; ++g) { const int ai = g >> 2, m = g & 3; const size_t off = (size_t)(row0 + ai * HALF + m * 16) * 1024 + col0;
            if (g < 7) { const size_t offn = (size_t)(row0 + ((g + 1) >> 2) * HALF + ((g + 1) & 3) * 16) * 1024 + col0; gq[(g + 1) & 1][0] = *(const u32x4*)(gn + offn); gq[(g + 1) & 1][1] = *(const u32x4*)(gn + offn + HALF); }
#pragma unroll
            for (int bj = 0; bj < 2; ++bj) { f32x4 b0, b1; unpack8(gq[g & 1][bj], b0, b1); *(u32x4*)(y + off + bj * HALF) = pack8(acc[ai][bj][m][0] * b0, acc[ai][bj][m][1] * b1); }
            asm volatile("" ::: "memory"); }
    }
};
struct EpiWout {
    static constexpr bool PERM = true, AFTER_DRAIN = false, HAS_MID = false;
    const float* x; float* x1; bf16_t* x1b; float* ssq  ;
    __device__ __forceinline__ void mid(f32x4 (&)[2][2][4][2], const Unit&, int, int, int, int) const {}
    __device__ __forceinline__ void operator()(f32x4 (&acc)[2][2][4][2], const Unit& u, int wr, int wc, int fr, int fq) const {
        int row0 = u.pm * BM + wr * 64 + fr; asm volatile("" : "+v"(row0)); const int col0 = u.pn * BM + wc * 32 + 8 * fq;
        f32x4 xv[2][4];
        { const float* p = x + (size_t)row0 * 1024 + col0; xv[0][0] = *(const f32x4*)(p); xv[0][1] = *(const f32x4*)(p + 4); xv[0][2] = *(const f32x4*)(p + HALF); xv[0][3] = *(const f32x4*)(p + HALF + 4); }
#pragma unroll
        for (int g = 0; g < 8; ++g) { const int ai = g >> 2, m = g & 3; const int row = row0 + ai * HALF + m * 16; const size_t off = (size_t)row * 1024 + col0; float s = 0.f;
            if (g < 7) { const float* p = x + (size_t)(row0 + ((g + 1) >> 2) * HALF + ((g + 1) & 3) * 16) * 1024 + col0; f32x4 (&nx)[4] = xv[(g + 1) & 1];
                nx[0] = *(const f32x4*)(p); nx[1] = *(const f32x4*)(p + 4); nx[2] = *(const f32x4*)(p + HALF); nx[3] = *(const f32x4*)(p + HALF + 4); }
#pragma unroll
            for (int bj = 0; bj < 2; ++bj) { const f32x4 v0 = xv[g & 1][2 * bj] + acc[ai][bj][m][0], v1 = xv[g & 1][2 * bj + 1] + acc[ai][bj][m][1];
                *(u32x4*)(x1b + off + bj * HALF) = pack8(v0, v1);
#pragma unroll
                for (int e = 0; e < 4; ++e) s += v0[e] * v0[e] + v1[e] * v1[e]; }
            s += __shfl_xor(s, 16); s += __shfl_xor(s, 32);
            if (fq == 0) ssq[(size_t)row * 16 + u.pn * 4 + wc] = s;
            asm volatile("" ::: "memory"); }
    }
};
__device__ __forceinline__ float dpp_shr(float old, float v, int n) { return n == 1 ? __builtin_bit_cast(float, __builtin_amdgcn_update_dpp(__builtin_bit_cast(int, old), __builtin_bit_cast(int, v), 0x111, 0xf, 0xf, false))
                                                                                       : __builtin_bit_cast(float, __builtin_amdgcn_update_dpp(__builtin_bit_cast(int, old), __builtin_bit_cast(int, v), 0x112, 0xf, 0xf, false)); }
__device__ __forceinline__ float dpp_shl15(float v) { return __builtin_bit_cast(float, __builtin_amdgcn_update_dpp(0, __builtin_bit_cast(int, v), 0x10F, 0xf, 0xf, true)); }
__device__ __forceinline__ float dpp_shl14(float v) { return __builtin_bit_cast(float, __builtin_amdgcn_update_dpp(0, __builtin_bit_cast(int, v), 0x10E, 0xf, 0xf, true)); }
struct EpiFfnUp {
    static constexpr bool PERM = true, AFTER_DRAIN = false, HAS_MID = false;
    const float* ssq; const float* cw  ; const float* cb; bf16_t* midb; float* edgeA  ; float* edgeV  ; PG8_LAS float* ex  ;
    __device__ __forceinline__ void mid(f32x4 (&)[2][2][4][2], const Unit&, int, int, int, int) const {}
    __device__ __forceinline__ void operator()(f32x4 (&acc)[2][2][4][2], const Unit& u, int wr, int wc, int fr, int fq) const {
        constexpr int FF = 2816;
        int row0 = u.pm * BM + wr * 64 + fr; asm volatile("" : "+v"(row0)); const int cl = wc * 32 + 8 * fq, col0 = u.pn * 128 + cl;
        { const float* sp = ssq + (size_t)row0 * 16 + 4 * fq;
#pragma unroll
          for (int ai = 0; ai < 2; ++ai) { float rsv[4];
#pragma unroll
              for (int m = 0; m < 4; ++m) { const f32x4 p = *(const f32x4*)(sp + (size_t)(ai * HALF + m * 16) * 16); rsv[m] = (p[0] + p[1]) + (p[2] + p[3]); }
#pragma unroll
              for (int m = 0; m < 4; ++m) { rsv[m] += __shfl_xor(rsv[m], 16); rsv[m] += __shfl_xor(rsv[m], 32); rsv[m] = __builtin_amdgcn_rsqf(rsv[m] * (1.0f / 1024.0f) + NEPS); }
#pragma unroll
              for (int m = 0; m < 4; ++m) {
#pragma unroll
                  for (int n = 0; n < 2; ++n) { acc[ai][0][m][n] = acc[ai][0][m][n] * rsv[m]; acc[ai][1][m][n] = acc[ai][1][m][n] * rsv[m]; } }
              asm volatile("" ::: "memory"); } }
#pragma unroll
        for (int ai = 0; ai < 2; ++ai) { const int s = ai * 2 + wr;
            if (fr >= 14) { PG8_LAS float* p = ex + (s * 2 + (fr - 14)) * 128 + cl; *(PG8_LAS f32x4*)(p) = acc[ai][0][3][0]; *(PG8_LAS f32x4*)(p + 4) = acc[ai][0][3][1]; } }
        if (wr == 0 && fr < 2) { float* pa = edgeA + ((size_t)u.pm * 4 + fr) * FF + col0; float* pv = edgeV + ((size_t)u.pm * 2 + fr) * FF + col0;
            *(f32x4*)(pa) = acc[0][0][0][0]; *(f32x4*)(pa + 4) = acc[0][0][0][1]; *(f32x4*)(pv) = acc[0][1][0][0]; *(f32x4*)(pv + 4) = acc[0][1][0][1]; }
        if (wr == 1 && fr >= 14) { float* pa = edgeA + ((size_t)u.pm * 4 + 2 + (fr - 14)) * FF + col0; *(f32x4*)(pa) = acc[1][0][3][0]; *(f32x4*)(pa + 4) = acc[1][0][3][1]; }
        asm volatile("s_waitcnt lgkmcnt(0)" ::: "memory"); __builtin_amdgcn_s_barrier(); asm volatile("" ::: "memory");
        f32x4 w0[2], w1[2], w2[2], bb[2];
#pragma unroll
        for (int n = 0; n < 2; ++n) { w0[n] = *(const f32x4*)(cw + col0 + 4 * n); w1[n] = *(const f32x4*)(cw + FF + col0 + 4 * n); w2[n] = *(const f32x4*)(cw + 2 * FF + col0 + 4 * n); bb[n] = *(const f32x4*)(cb + col0 + 4 * n); }
#pragma unroll
        for (int ai = 0; ai < 2; ++ai) { const int s = ai * 2 + wr;
            f32x4 t1[2], t2[2];
#pragma unroll
            for (int n = 0; n < 2; ++n) { f32x4 h62 = (f32x4){0.f, 0.f, 0.f, 0.f}, h63 = h62;
                if (s > 0) { h62 = *(const PG8_LAS f32x4*)(ex + ((s - 1) * 2 + 0) * 128 + cl + 4 * n); h63 = *(const PG8_LAS f32x4*)(ex + ((s - 1) * 2 + 1) * 128 + cl + 4 * n); }
                t1[n] = h63; t2[n] = fr == 0 ? h62 : h63; }
#pragma unroll
            for (int m = 0; m < 4; ++m) { f32x4 o[2];
#pragma unroll
                for (int n = 0; n < 2; ++n) {
                    f32x4 cv;
#pragma unroll
                    for (int e = 0; e < 4; ++e) { const float X = acc[ai][0][m][n][e]; const float p1 = dpp_shr(t1[n][e], X, 1), p2 = dpp_shr(t2[n][e], X, 2);
                        t1[n][e] = dpp_shl15(X); t2[n][e] = dpp_shl14(X);
                        cv[e] = w2[n][e] * X + w1[n][e] * p1 + w0[n][e] * p2 + bb[n][e]; }
                    const f32x2 ga = gelu_pk((f32x2){cv[0], cv[1]}), gb = gelu_pk((f32x2){cv[2], cv[3]});
                    o[n] = (f32x4){ga.x, ga.y, gb.x, gb.y} * acc[ai][1][m][n]; }
                const bool skip = (s == 0 && m == 0 && fr < 2);
                if (!skip) *(u32x4*)(midb + (size_t)(row0 + ai * HALF + m * 16) * FF + col0) = pack8(o[0], o[1]);
                asm volatile("" ::: "memory"); }
        }
    }
};
struct EpiFfnDown {
    static constexpr bool PERM = true, AFTER_DRAIN = false, HAS_MID = false;
    const bf16_t* in; float* out;
    __device__ __forceinline__ void mid(f32x4 (&)[2][2][4][2], const Unit&, int, int, int, int) const {}
    __device__ __forceinline__ void operator()(f32x4 (&acc)[2][2][4][2], const Unit& u, int wr, int wc, int fr, int fq) const {
        int row0 = u.pm * BM + wr * 64 + fr; asm volatile("" : "+v"(row0)); const int col0 = u.pn * BM + wc * 32 + 8 * fq;
        u32x4 xv[2][2];
        { const bf16_t* p = in + (size_t)row0 * 1024 + col0; xv[0][0] = *(const u32x4*)(p); xv[0][1] = *(const u32x4*)(p + HALF); }
#pragma unroll
        for (int g = 0; g < 8; ++g) { const int ai = g >> 2, m = g & 3; const size_t off = (size_t)(row0 + ai * HALF + m * 16) * 1024 + col0;
            if (g < 7) { const bf16_t* p = in + (size_t)(row0 + ((g + 1) >> 2) * HALF + ((g + 1) & 3) * 16) * 1024 + col0; xv[(g + 1) & 1][0] = *(const u32x4*)(p); xv[(g + 1) & 1][1] = *(const u32x4*)(p + HALF); }
#pragma unroll
            for (int bj = 0; bj < 2; ++bj) { f32x4 r0, r1; unpack8(xv[g & 1][bj], r0, r1); float* q = out + off + bj * HALF; *(f32x4*)(q) = r0 + acc[ai][bj][m][0]; *(f32x4*)(q + 4) = r1 + acc[ai][bj][m][1]; }
            asm volatile("" ::: "memory"); }
    }
};
struct EpiCmpHid {
    static constexpr bool PERM = true, AFTER_DRAIN = false, HAS_MID = false;
    const float* cbias  ; bf16_t* hid;
    __device__ __forceinline__ void mid(f32x4 (&)[2][2][4][2], const Unit&, int, int, int, int) const {}
    __device__ __forceinline__ void operator()(f32x4 (&acc)[2][2][4][2], const Unit& u, int wr, int wc, int fr, int fq) const {
        int row0 = u.pm * BM + wr * 64 + fr; asm volatile("" : "+v"(row0)); const int col0 = wc * 32 + 8 * fq; const float* bp = cbias + (u.pm >> 4) * 256 + col0;
#pragma unroll
        for (int ai = 0; ai < 2; ++ai)
#pragma unroll
            for (int m = 0; m < 4; ++m) { bf16_t* rowp = hid + (size_t)(row0 + ai * HALF + m * 16) * 256 + col0;
#pragma unroll
                for (int bj = 0; bj < 2; ++bj) { f32x4 v0 = acc[ai][bj][m][0] + *(const f32x4*)(bp + bj * HALF), v1 = acc[ai][bj][m][1] + *(const f32x4*)(bp + bj * HALF + 4);
                    const f32x2 g0 = gelu_pk((f32x2){v0[0], v0[1]}), g1 = gelu_pk((f32x2){v0[2], v0[3]}), g2 = gelu_pk((f32x2){v1[0], v1[1]}), g3 = gelu_pk((f32x2){v1[2], v1[3]});
                    *(u32x4*)(rowp + bj * HALF) = pack8((f32x4){g0.x, g0.y, g1.x, g1.y}, (f32x4){g2.x, g2.y, g3.x, g3.y}); } }
    }
};
struct CmpOrder {
    int G, c; const bf16_t* kc; const bf16_t* vc; const bf16_t* w1t;
    __device__ bool next(int i, Unit& u) const { const int L = i * G + c; if (L >= 32) return false; u.pm = L; u.pn = 0; return true; }
    __device__ __forceinline__ const char* a_ptr(const Gemm&, const Unit& u) const { const int kvbg = u.pm >> 1, half = u.pm & 1, kv = kvbg >> 3, b = (kvbg >> 1) & 3, g = kvbg & 1;
        return (const char*)((kv ? vc : kc) + ((size_t)(b * SEQ + 16 * 256 * half) * 128 + g * 64)); }
    __device__ __forceinline__ const char* b_ptr(const Gemm&, const Unit& u) const { return (const char*)(w1t + (size_t)(u.pm >> 4) * 256 * 2048); }
    __device__ __forceinline__ void a_ready(const Unit&) const {}
    __device__ __forceinline__ void done(const Unit&) const {}
};
template <class Epi, class Sched, bool ALIGN_EPI = false, bool SP2 = false>
__device__ __forceinline__ void gemm_phase(PG8_LAS unsigned char* lds, const Gemm g, const Sched& S, const Epi& E) {
    int tid_ = threadIdx.x; asm volatile("" : "+v"(tid_));
    const int tid = tid_, wid = __builtin_amdgcn_readfirstlane(tid >> 6), lane = tid & 63, wr = wid >> 2, wc = wid & 3, fr = lane & 15, fq = lane >> 4;
    const int K = g.K, nt = K / BK;
    unsigned voffA[2], voffB[2];
#pragma unroll
    for (int i = 0; i < 2; ++i) { int R, C; stage_rc(tid * 16 + i * 8192, R, C); const int Rb = Epi::PERM ? ((R & ~31) + perm32(R & 31)) : R;
        voffA[i] = (unsigned)(R * g.lda + C) * 2u; voffB[i] = (unsigned)(Rb * K + C) * 2u; }
    const size_t kstepA = (size_t)g.ksA, kstepB = (size_t)(BK * 2);
    const size_t hstepA = (size_t)HALF * g.lda * 2, hstepB = (size_t)HALF * K * 2;
    const unsigned ldsw = (unsigned)wid * 1024u;
    const int aoff = lds_byte(wr * 64 + fr, fq * 8), boff = lds_byte(wc * 32 + fr, fq * 8);
#define PG8_SA(b, h) (((b) * 2 + (h)) * HTB)
#define PG8_SB(b, h) ((4 + (b) * 2 + (h)) * HTB)
#define PG8_STAGE(bufoff, gbase, voff) do { _Pragma("unroll") for (int _i = 0; _i < 2; ++_i) \
        __builtin_amdgcn_global_load_lds((const unsigned*)((const char*)(gbase) + (voff)[_i]), (PG8_LAS unsigned*)(lds + (bufoff) + ldsw + _i * 8192), 16, 0, 0); } while (0)
#define PG8_LDA(dst, b, h) do { _Pragma("unroll") for (int m = 0; m < 4; ++m) _Pragma("unroll") for (int k = 0; k < 2; ++k) dst[m][k] = *(const PG8_LAS bf16x8*)(lds + PG8_SA(b, h) + aoff + m * 2048 + k * 1024); } while (0)
#define PG8_LDB(dst, b, h) do { _Pragma("unroll") for (int n = 0; n < 2; ++n) _Pragma("unroll") for (int k = 0; k < 2; ++k) dst[n][k] = *(const PG8_LAS bf16x8*)(lds + PG8_SB(b, h) + boff + n * 2048 + k * 1024); } while (0)
#define PG8_MMA(ai, bj, At, Bt) do { __builtin_amdgcn_s_setprio(1); _Pragma("unroll") for (int m = 0; m < 4; ++m) _Pragma("unroll") for (int n = 0; n < 2; ++n) _Pragma("unroll") for (int k = 0; k < 2; ++k) \
        acc[ai][bj][m][n] = __builtin_amdgcn_mfma_f32_16x16x32_bf16(Bt[n][k], At[m][k], acc[ai][bj][m][n], 0, 0, 0); __builtin_amdgcn_s_setprio(0); } while (0)
#define PG8_WAIT_V(n) asm volatile("s_waitcnt vmcnt(" #n ")" ::: "memory")
#define PG8_WAIT_L(n) asm volatile("s_waitcnt lgkmcnt(" #n ")" ::: "memory")
#define PG8_BAR __builtin_amdgcn_s_barrier()
#define PG8_SCHED __builtin_amdgcn_sched_barrier(0)
    Unit cur, nxt; int ui = 0;
    if (!S.next(0, cur)) return;
    f32x4 acc[2][2][4][2];
#pragma unroll
    for (int a = 0; a < 2; ++a)
#pragma unroll
        for (int b = 0; b < 2; ++b)
#pragma unroll
            for (int m = 0; m < 4; ++m)
#pragma unroll
                for (int n = 0; n < 2; ++n) acc[a][b][m][n] = (f32x4){0.f, 0.f, 0.f, 0.f};
    bf16x8 At[4][2], B0[2][2], B1[2][2];
    const char* cA = S.a_ptr(g, cur); const char* cB = S.b_ptr(g, cur);
    S.a_ready(cur);
    if constexpr (SP2) {
        PG8_STAGE(PG8_SB(0, 0), cB, voffB); PG8_STAGE(PG8_SB(0, 1), cB + hstepB, voffB); PG8_STAGE(PG8_SA(0, 0), cA, voffA); PG8_STAGE(PG8_SA(0, 1), cA + hstepA, voffA);
        if (wr == 1) PG8_BAR;
        PG8_WAIT_V(2); PG8_BAR;
        PG8_STAGE(PG8_SB(1, 0), cB + kstepB, voffB); PG8_STAGE(PG8_SA(1, 0), cA + kstepA, voffA); PG8_STAGE(PG8_SB(1, 1), cB + hstepB + kstepB, voffB);
        PG8_WAIT_V(6); PG8_BAR;
    } else {
        PG8_STAGE(PG8_SB(0, 0), cB, voffB); PG8_STAGE(PG8_SA(0, 0), cA, voffA); PG8_STAGE(PG8_SB(0, 1), cB + hstepB, voffB); PG8_STAGE(PG8_SA(0, 1), cA + hstepA, voffA);
        if (wr == 1) PG8_BAR;
        PG8_WAIT_V(4); PG8_BAR;
        PG8_STAGE(PG8_SB(1, 0), cB + kstepB, voffB); PG8_STAGE(PG8_SA(1, 0), cA + kstepA, voffA); PG8_STAGE(PG8_SB(1, 1), cB + hstepB + kstepB, voffB);
        PG8_WAIT_V(6); PG8_BAR;
    }
    for (;;) {
        const bool has_next = S.next(ui + 1, nxt);
        const char* nA = has_next ? S.a_ptr(g, nxt) : cA; const char* nB = has_next ? S.b_ptr(g, nxt) : cB;
        for (int t = 0; t < nt; t += 2) {
            if constexpr (Epi::HAS_MID) { if (t == nt / 2) E.mid(acc, cur, wr, wc, fr, fq); }
            const bool last = (t == nt - 2);
            const char* a1 = cA + (size_t)(t + 1) * kstepA;
            const char* a2 = last ? nA : cA + (size_t)(t + 2) * kstepA; const char* b2 = last ? nB : cB + (size_t)(t + 2) * kstepB;
            const char* a3 = a2 + kstepA; const char* b3 = b2 + kstepB;
            if (last && has_next) S.a_ready(nxt);
            if constexpr (SP2) {
            PG8_LDB(B0, 0, 0); PG8_LDB(B1, 0, 1); PG8_SCHED; PG8_LDA(At, 0, 0); PG8_STAGE(PG8_SA(1, 1), a1 + hstepA, voffA);
            PG8_WAIT_V(8); PG8_WAIT_L(0); PG8_BAR; PG8_MMA(0, 0, At, B0); PG8_MMA(0, 1, At, B1); PG8_BAR; PG8_SCHED;
            PG8_LDA(At, 0, 1); PG8_STAGE(PG8_SB(0, 0), b2, voffB); PG8_STAGE(PG8_SB(0, 1), b2 + hstepB, voffB); PG8_STAGE(PG8_SA(0, 0), a2, voffA);
            PG8_WAIT_V(8); PG8_WAIT_L(0); PG8_BAR; PG8_MMA(1, 0, At, B0); PG8_MMA(1, 1, At, B1); PG8_BAR; PG8_SCHED;
            PG8_LDB(B0, 1, 0); PG8_LDB(B1, 1, 1); PG8_SCHED; PG8_LDA(At, 1, 0); PG8_STAGE(PG8_SA(0, 1), a2 + hstepA, voffA);
            PG8_WAIT_V(8); PG8_WAIT_L(0); PG8_BAR; PG8_MMA(0, 0, At, B0); PG8_MMA(0, 1, At, B1); PG8_BAR; PG8_SCHED;
            PG8_LDA(At, 1, 1); PG8_STAGE(PG8_SB(1, 0), b3, voffB); PG8_STAGE(PG8_SB(1, 1), b3 + hstepB, voffB); PG8_STAGE(PG8_SA(1, 0), a3, voffA);
            PG8_WAIT_V(8); PG8_WAIT_L(0); PG8_BAR; PG8_MMA(1, 0, At, B0); PG8_MMA(1, 1, At, B1); PG8_BAR; PG8_SCHED;
            } else {
            PG8_LDB(B0, 0, 0); PG8_SCHED; PG8_LDA(At, 0, 0); PG8_STAGE(PG8_SA(1, 1), a1 + hstepA, voffA);
            PG8_WAIT_L(8); PG8_BAR; PG8_WAIT_L(0); PG8_MMA(0, 0, At, B0); PG8_BAR; PG8_SCHED;
            PG8_LDB(B1, 0, 1); PG8_STAGE(PG8_SB(0, 0), b2, voffB);
            PG8_BAR; PG8_WAIT_L(0); PG8_MMA(0, 1, At, B1); PG8_BAR;
            PG8_LDA(At, 0, 1); PG8_STAGE(PG8_SA(0, 0), a2, voffA);
            PG8_BAR; PG8_WAIT_L(0); PG8_MMA(1, 0, At, B0); PG8_BAR; PG8_SCHED;
            PG8_STAGE(PG8_SB(0, 1), b2 + hstepB, voffB);
            PG8_WAIT_V(6); PG8_BAR; PG8_MMA(1, 1, At, B1); PG8_BAR;
            PG8_LDB(B0, 1, 0); PG8_SCHED; PG8_LDA(At, 1, 0); PG8_STAGE(PG8_SA(0, 1), a2 + hstepA, voffA);
            PG8_WAIT_L(8); PG8_BAR; PG8_WAIT_L(0); PG8_MMA(0, 0, At, B0); PG8_BAR; PG8_SCHED;
            PG8_LDB(B1, 1, 1); PG8_STAGE(PG8_SB(1, 0), b3, voffB);
            PG8_BAR; PG8_WAIT_L(0); PG8_MMA(0, 1, At, B1); PG8_BAR;
            PG8_LDA(At, 1, 1); PG8_STAGE(PG8_SA(1, 0), a3, voffA);
            PG8_BAR; PG8_WAIT_L(0); PG8_MMA(1, 0, At, B0); PG8_BAR; PG8_SCHED;
            PG8_STAGE(PG8_SB(1, 1), b3 + hstepB, voffB);
            PG8_WAIT_V(6); PG8_BAR; PG8_MMA(1, 1, At, B1); PG8_BAR;
            }
        }
        if constexpr (ALIGN_EPI) { if (wr == 0) PG8_BAR; }
        if constexpr (!Epi::AFTER_DRAIN) { E(acc, cur, wr, wc, fr, fq); S.done(cur); }
        if (!has_next) break;
#pragma unroll
        for (int a = 0; a < 2; ++a)
#pragma unroll
            for (int b = 0; b < 2; ++b)
#pragma unroll
                for (int m = 0; m < 4; ++m)
#pragma unroll
                    for (int n = 0; n < 2; ++n) acc[a][b][m][n] = (f32x4){0.f, 0.f, 0.f, 0.f};
        cur = nxt; cA = nA; cB = nB; ++ui;
        if constexpr (ALIGN_EPI) { if (wr == 1) PG8_BAR; }
    }
    PG8_WAIT_V(0);
    if constexpr (!ALIGN_EPI) { if (wr == 0) PG8_BAR; }
    PG8_BAR;
    if constexpr (Epi::AFTER_DRAIN) { E.fused(acc, cur, wr, wc, fr, fq, lds, wid, lane); S.done(cur); }
#undef PG8_SA
#undef PG8_SB
#undef PG8_STAGE
#undef PG8_LDA
#undef PG8_LDB
#undef PG8_MMA
#undef PG8_WAIT_V
#undef PG8_WAIT_L
#undef PG8_BAR
#undef PG8_SCHED
}
}

using pg8::bf16_t; using pg8::f32x4; using pg8::u32x4; using pg8::TT; using pg8::SEQ; using pg8::NEPS; using pg8::QC2; using pg8::bf2f; using pg8::sigm;
#define LAS __attribute__((address_space(3)))
struct Args { const float* in[27]; float* out; unsigned char* ws; float rope_inv[32]; };

__device__ __forceinline__ unsigned f2bf(float f) { unsigned u = __builtin_bit_cast(unsigned, f); return (u + 0x7fffu + ((u >> 16) & 1u)) >> 16; }
__device__ __forceinline__ unsigned pk2(float lo, float hi) { return f2bf(lo) | (f2bf(hi) << 16); }
__device__ __forceinline__ float wave_sum(float v) {
#pragma unroll
    for (int o = 1; o < 64; o <<= 1) v += __shfl_xor(v, o);
    return v;
}
template <class F> __device__ __forceinline__ void transpose_item(const float* W, int ldw, int k0src, const float* kscale, bf16_t* WT, int ldt, int k0dst, int row0, LAS float* scr, int lane, F srccol) {
    { const int c4 = lane & 7, kr = lane >> 3; const int sc = srccol(4 * c4); f32x4 v[8];
#pragma unroll
      for (int i = 0; i < 8; ++i) { const int kk = 8 * i + kr; v[i] = (f32x4){0.f, 0.f, 0.f, 0.f}; if (sc >= 0) { v[i] = *(const f32x4*)(W + (size_t)(k0src + kk) * ldw + sc); if (kscale) v[i] = v[i] * kscale[k0src + kk]; } }
#pragma unroll
      for (int i = 0; i < 8; ++i) { LAS float* p = scr + (8 * i + kr) * 33 + 4 * c4; p[0] = v[i][0]; p[1] = v[i][1]; p[2] = v[i][2]; p[3] = v[i][3]; } }
    asm volatile("s_waitcnt lgkmcnt(0)" ::: "memory");
    const int c = lane & 7;
#pragma unroll
    for (int jj = 0; jj < 4; ++jj) { const int n = (lane >> 3) + 8 * jj; const LAS float* s = scr + (8 * c) * 33 + n;
        u32x4 o; o.x = pk2(s[0 * 33], s[1 * 33]); o.y = pk2(s[2 * 33], s[3 * 33]); o.z = pk2(s[4 * 33], s[5 * 33]); o.w = pk2(s[6 * 33], s[7 * 33]);
        *(u32x4*)(WT + (size_t)(row0 + n) * ldt + k0dst + 8 * c) = o; }
    asm volatile("s_waitcnt lgkmcnt(0)" ::: "memory");
}
__device__ __forceinline__ int inproj_src(int p) {
    const int tile = p >> 8, l = p & 255;
    if (tile < 6) return p;
    const int half = l >> 7, wh = (l >> 5) & 3, j = l & 31;
    if (tile < 8) return C_NQ + 64 * (4 * (tile - 6) + wh) + 32 * half + j;
    if (tile == 8) return (wh < 2 ? C_KC + 64 * wh : C_KS + 64 * (wh - 2)) + 32 * half + j;
    if (tile == 9) return (wh < 2 ? C_KW + 64 * wh : C_VC + 64 * (wh - 2)) + 32 * half + j;
    if (tile == 10) return (wh < 2 ? C_VS + 64 * wh : C_VW + 64 * (wh - 2)) + 32 * half + j;
    if (l < 8) return C_MI + l; if (l < 32) return C_NG + (l - 8); return -1;
}
#define GAS __attribute__((address_space(1)))
typedef GAS unsigned gu32;
typedef GAS unsigned long long gu64;
#define RLX_AGENT __ATOMIC_RELAXED, __HIP_MEMORY_SCOPE_AGENT
__device__ __forceinline__ unsigned long long rt() { return __builtin_amdgcn_s_memrealtime(); }
#define XB_TMO      128
#define XB_XCNT(j)  (256  + 64 * (j))
#define XB_XSUB(j)  (1280 + 64 * (j))
#define XB_XGEN(j)  (2304 + 64 * (j))
#define XB_TOP      3328
#define XB_TOPGEN   3392
#define XCD_BAR_WORDS 3456
#define XB_SPIN_CAP (1u << 18)

__device__ __forceinline__ unsigned xb_ld(unsigned* p)              { return __hip_atomic_load(p, __ATOMIC_RELAXED, __HIP_MEMORY_SCOPE_AGENT); }
__device__ __forceinline__ unsigned xb_add(unsigned* p, unsigned v) { return __hip_atomic_fetch_add(p, v, __ATOMIC_RELAXED, __HIP_MEMORY_SCOPE_AGENT); }
__device__ __forceinline__ unsigned xb_xcc_id() { return (unsigned)__builtin_amdgcn_s_getreg((3 << 11) | 20) & 0xFu; }
#define XB_SPIN(cond, bar) do { unsigned _sp = 0; while (cond) { __builtin_amdgcn_s_sleep(1); \
    if ((++_sp & 255u) == 0u) { if (xb_ld(&(bar)[XB_TMO])) break; if (_sp > XB_SPIN_CAP) { atomicAdd(&(bar)[XB_TMO], 1u); break; } } } } while (0)

struct XcdBarrier {
    unsigned* bar; unsigned x;
    volatile LAS unsigned* st;
};

__device__ __forceinline__ XcdBarrier xcd_barrier_post(unsigned* bar, volatile LAS unsigned* st) {
    XcdBarrier b; b.bar = bar; b.x = xb_xcc_id(); b.st = st;
    if (threadIdx.x == 0) (void)xb_add(&bar[XB_XCNT(b.x)], 1u);
    return b;
}
__device__ __forceinline__ void xcd_barrier_complete(unsigned* bar, unsigned x, unsigned& nloc, unsigned& nx) {
    const unsigned G = gridDim.x * gridDim.y * gridDim.z;
    unsigned sum, cnt, mine, sp = 0u;
    for (;;) {
        sum = 0u; cnt = 0u; mine = 0u;
#pragma unroll
        for (unsigned j = 0; j < 16; ++j) { const unsigned c = xb_ld(&bar[XB_XCNT(j)]); sum += c; cnt += (c > 0u) ? 1u : 0u; mine = (j == x) ? c : mine; }
        if (sum == G) break;
        __builtin_amdgcn_s_sleep(1);
        if ((++sp & 255u) == 0u) { if (xb_ld(&bar[XB_TMO])) break; if (sp > XB_SPIN_CAP) { atomicAdd(&bar[XB_TMO], 1u); break; } }
    }
    nloc = mine > 0u ? mine : 1u; nx = cnt > 0u ? cnt : 1u;
}

__device__ __forceinline__ void xcd_barrier(const XcdBarrier& b) {
    asm volatile("s_waitcnt vmcnt(0)" ::: "memory");
    __syncthreads();
    if (threadIdx.x == 0) {
        unsigned* bar = b.bar;
        __builtin_amdgcn_s_waitcnt(0);
        unsigned nloc = b.st[0], nx = b.st[1];
        if (nloc == 0u) { xcd_barrier_complete(bar, b.x, nloc, nx); b.st[0] = nloc; b.st[1] = nx; }
        const unsigned old = xb_add(&bar[XB_XSUB(b.x)], 1u);
        const unsigned gen = old / nloc;
        if (old + 1u == (gen + 1u) * nloc) {
            __builtin_amdgcn_fence(__ATOMIC_RELEASE, "agent");
            asm volatile("s_waitcnt vmcnt(0)" ::: "memory");
            const unsigned og = xb_add(&bar[XB_TOP], 1u);
            const unsigned tg = og / nx;
            if (og + 1u == (tg + 1u) * nx) xb_add(&bar[XB_TOPGEN], 1u);
            else XB_SPIN(xb_ld(&bar[XB_TOPGEN]) == tg, bar);
            __builtin_amdgcn_fence(__ATOMIC_ACQUIRE, "agent");
            xb_add(&bar[XB_XGEN(b.x)], 1u);
            asm volatile("s_waitcnt vmcnt(0)" ::: "memory");
        } else {
            XB_SPIN(xb_ld(&bar[XB_XGEN(b.x)]) == gen, bar);
            __builtin_amdgcn_fence(__ATOMIC_ACQUIRE, "agent");
            asm volatile("s_waitcnt vmcnt(0)" ::: "memory");
        }
    }
    __syncthreads();
}

struct Ctx { int tid, lane, wave, G, vcu, gw, ngw, gtid, nthr; LAS unsigned char* lds; };

template <int PART> __device__ __forceinline__ void phase_transposes(const Ctx& C, const Args& a) {
    unsigned char* ws = a.ws;
    LAS float* scr = (LAS float*)(C.lds + C.wave * 16384);
    const float* w_in = a.in[2]; const float* norm1 = a.in[1]; const float* norm2 = a.in[22];
    constexpr int I_WIN = 96 * 16, I_WG = 64 * 16, I_WMN = 32 * 16, I_WOUT = 32 * 16, I_WUP = 176 * 16, I_WDN = 32 * 44, I_CW1 = 16 * 32;
    constexpr int NITEMS = I_WIN + I_WG + I_WMN + I_WOUT + I_WUP + I_WDN + I_CW1;
    const int it_lo = PART == 0 ? 0 : I_WIN, it_hi = PART == 0 ? I_WIN + I_CW1 : NITEMS - I_CW1;
    for (int it0 = it_lo + C.gw; it0 < it_hi; it0 += C.ngw) {
        int r = (PART == 0 && it0 >= I_WIN) ? it0 + (NITEMS - I_CW1 - I_WIN) : it0;
        if (r < I_WIN) { const int blk = r >> 4, kb = r & 15; transpose_item(w_in, DIN, 64 * kb, norm1, (bf16_t*)(ws + WS_WIN), 1024, 64 * kb, 32 * blk, scr, C.lane, [=](int j) { return inproj_src(32 * blk + j); }); continue; } r -= I_WIN;
        if (r < I_WG) { const int blk = r >> 4, kb = r & 15; const int p0 = 32 * blk, pn = p0 >> 8, half = (p0 >> 7) & 1, jj = p0 & 127;
            transpose_item(w_in, DIN, 64 * kb, norm1, (bf16_t*)(ws + WS_WG), 1024, 64 * kb, p0, scr, C.lane, [=](int j) { return C_GM + half * 1024 + 128 * pn + jj + j; }); continue; } r -= I_WG;
        if (r < I_WMN) { const int blk = r >> 4, kb = r & 15; const float* W = kb < 8 ? a.in[18] : a.in[19]; transpose_item(W, 1024, 64 * (kb & 7), nullptr, (bf16_t*)(ws + WS_WMN), 1024, 64 * kb, 32 * blk, scr, C.lane, [=](int j) { return 32 * blk + j; }); continue; } r -= I_WMN;
        if (r < I_WOUT) { const int blk = r >> 4, kb = r & 15; transpose_item(a.in[21], 1024, 64 * kb, nullptr, (bf16_t*)(ws + WS_WOUT), 1024, 64 * kb, 32 * blk, scr, C.lane, [=](int j) { return 32 * blk + j; }); continue; } r -= I_WOUT;
        if (r < I_WUP) { const int blk = r >> 4, kb = r & 15; const int p0 = 32 * blk, pn = p0 >> 8, half = (p0 >> 7) & 1, jj = p0 & 127;
            transpose_item(a.in[23], 2 * DFF, 64 * kb, norm2, (bf16_t*)(ws + WS_WUP), 1024, 64 * kb, p0, scr, C.lane, [=](int j) { return half * DFF + 128 * pn + jj + j; }); continue; } r -= I_WUP;
        if (r < I_WDN) { const int blk = r / 44, kb = r % 44; transpose_item(a.in[26], 1024, 64 * kb, nullptr, (bf16_t*)(ws + WS_WDN), DFF, 64 * kb, 32 * blk, scr, C.lane, [=](int j) { return 32 * blk + j; }); continue; } r -= I_WDN;
        { const int kv = r >> 8, blk = (r >> 5) & 7, kb = r & 31; transpose_item(kv ? a.in[16] : a.in[13], 256, 64 * kb, nullptr, (bf16_t*)(ws + WS_CW1) + (size_t)kv * 256 * 2048, 2048, 64 * kb, 32 * blk, scr, C.lane, [=](int j) { return 32 * blk + j; }); }
    }
}
__device__ __forceinline__ void xrow_load(f32x4 (&v)[4][4], const float* x, int m0, int lane) {
#pragma unroll
    for (int r = 0; r < 4; ++r) { const f32x4* xr = (const f32x4*)(x + (size_t)(m0 + r) * DM) + lane;
#pragma unroll
        for (int j = 0; j < 4; ++j) v[r][j] = __builtin_nontemporal_load(xr + 64 * j); }
}
__device__ __forceinline__ void xrow_store(const f32x4 (&v)[4][4], bf16_t* xb, float* rstd, int m0, int lane) {
    float s[4];
#pragma unroll
    for (int r = 0; r < 4; ++r) { s[r] = 0.f;
#pragma unroll
        for (int j = 0; j < 4; ++j) s[r] += (v[r][j][0] * v[r][j][0] + v[r][j][1] * v[r][j][1]) + (v[r][j][2] * v[r][j][2] + v[r][j][3] * v[r][j][3]); }
#pragma unroll
    for (int o = 1; o < 64; o <<= 1) {
#pragma unroll
        for (int r = 0; r < 4; ++r) s[r] += __shfl_xor(s[r], o); }
#pragma unroll
    for (int r = 0; r < 4; ++r) { if (lane == 0) rstd[m0 + r] = 1.0f / sqrtf(s[r] * (1.0f / DM) + NEPS);
        unsigned long long* o8 = (unsigned long long*)(xb + (size_t)(m0 + r) * DM) + lane;
#pragma unroll
        for (int j = 0; j < 4; ++j) o8[64 * j] = (unsigned long long)pk2(v[r][j][0], v[r][j][1]) | ((unsigned long long)pk2(v[r][j][2], v[r][j][3]) << 32); }
}
__device__ __forceinline__ void phase_prologue(const Ctx& C, const Args& a) {
    unsigned char* ws = a.ws; const float* x = a.in[0]; bf16_t* xb = (bf16_t*)(ws + WS_XB); float* rstd = (float*)(ws + WS_RSTD1);
    const int mstep = 4 * C.ngw; int m0 = 4 * C.gw;
    f32x4 va[4][4], vb[4][4];
    if (m0 < TT) xrow_load(va, x, m0, C.lane);
    phase_transposes<0>(C, a);
#if defined(REPEAT_T0)
    for (int rep = 0; rep < REPEAT_T0; ++rep) { __syncthreads(); phase_transposes<0>(C, a); }
#endif
    { float* cbias = (float*)(ws + WS_CBIAS); LAS float* part = (LAS float*)(C.lds + 8 * 16384);
      for (int i0 = 2 * C.vcu; i0 < 512; i0 += 2 * C.G) { const int i = i0 + (C.wave >> 2), kq = C.wave & 3, kv = i >> 8, j = i & 255; const float* pe = kv ? a.in[15] : a.in[12]; const float* w1 = kv ? a.in[16] : a.in[13]; float s = 0.f;
#pragma unroll
          for (int q = 0; q < 8; ++q) { const int k = 512 * kq + 64 * q + C.lane; s += pe[k] * w1[(size_t)k * 256 + j]; }
          s = wave_sum(s); if (C.lane == 0) part[C.wave] = s;
          __syncthreads();
          if (C.tid < 2) cbias[i0 + C.tid] = (part[4 * C.tid] + part[4 * C.tid + 1]) + (part[4 * C.tid + 2] + part[4 * C.tid + 3]);
          __syncthreads(); } }
    for (; m0 < TT; m0 += 2 * mstep) {
        const int m1 = m0 + mstep, m2 = m1 + mstep;
        if (m1 < TT) xrow_load(vb, x, m1, C.lane);
        xrow_store(va, xb, rstd, m0, C.lane);
        if (m2 < TT) xrow_load(va, x, m2, C.lane);
        if (m1 < TT) xrow_store(vb, xb, rstd, m1, C.lane);
    }
#if defined(REPEAT_ROPE)
    for (int rep = 0; rep < REPEAT_ROPE; ++rep)
#endif
    { float* rc = (float*)(ws + WS_ROPEC); float* rsn = (float*)(ws + WS_ROPES);
      for (int i = C.gtid; i < SEQ * 32; i += C.nthr) { const int t = i >> 5, j = i & 31; const float ang = (float)t * a.rope_inv[j]; float sv, cv; sincosf(ang, &sv, &cv); rc[i] = cv; rsn[i] = sv; } }
}

__device__ __forceinline__ void p7b_fixup_panel(const Ctx& C, const Args& a, int pm) {
    unsigned char* ws = a.ws; const float* __restrict__ eA = (const float*)(ws + WS_EDGEA); const float* __restrict__ eV = (const float*)(ws + WS_EDGEV); bf16_t* __restrict__ mid = (bf16_t*)(ws + WS_MID);
    const float* __restrict__ cw = a.in[24]; const float* __restrict__ cb = a.in[25];
    const bool first = (pm & 31) == 0;
    const float* e0 = eA + (size_t)pm * 4 * DFF; const float* ep = eA + (size_t)(first ? pm : pm - 1) * 4 * DFF; const float* v0 = eV + (size_t)pm * 2 * DFF;
    float x0[6], x1[6], pa[6], pb[6], w0[6], w1[6], w2[6], bb[6], g0[6], g1[6];
#pragma unroll
    for (int j = 0; j < 6; ++j) { const int c = C.tid + 512 * j; const int cc = c < DFF ? c : DFF - 1;
        x0[j] = e0[cc]; x1[j] = e0[DFF + cc]; pa[j] = ep[3 * DFF + cc]; pb[j] = ep[2 * DFF + cc]; w0[j] = cw[cc]; w1[j] = cw[DFF + cc]; w2[j] = cw[2 * DFF + cc]; bb[j] = cb[cc]; g0[j] = v0[cc]; g1[j] = v0[DFF + cc]; }
#pragma unroll
    for (int j = 0; j < 6; ++j) { const int c = C.tid + 512 * j; const float pA = first ? 0.f : pa[j], pB = first ? 0.f : pb[j];
        const float c0 = w2[j] * x0[j] + w1[j] * pA + w0[j] * pB + bb[j], c1 = w2[j] * x1[j] + w1[j] * x0[j] + w0[j] * pA + bb[j];
        const pg8::f32x2 gl = pg8::gelu_pk((pg8::f32x2){c0, c1});
        if (c < DFF) { mid[(size_t)(pm * 256) * DFF + c] = (bf16_t)f2bf(gl.x * g0[j]); mid[(size_t)(pm * 256 + 1) * DFF + c] = (bf16_t)f2bf(gl.y * g1[j]); } }
}
#ifndef NOSHIFT_THR
#define NOSHIFT_THR (-64.f)
#endif
namespace att {
typedef short bf16x8 __attribute__((ext_vector_type(8)));
typedef short s16x4 __attribute__((ext_vector_type(4)));
typedef float f32x16 __attribute__((ext_vector_type(16)));
typedef unsigned u32x2 __attribute__((ext_vector_type(2)));
enum { M_WIN = 0, M_CMP = 1, M_SLC = 2 };
constexpr int LDS_KV = 0  , LDS_IMP = 65536  , IMPS = 129;
__device__ __forceinline__ int crow(int r, int hi) { return (r & 3) + 8 * (r >> 2) + 4 * hi; }
__device__ __forceinline__ s16x4 vtr(const LAS unsigned char* p) { typedef short v4i16_t __attribute__((ext_vector_type(4))); return __builtin_bit_cast(s16x4, __builtin_amdgcn_ds_read_tr16_b64_v4i16((LAS v4i16_t*)p)); }
__device__ __forceinline__ unsigned cvtpk(float lo, float hi) { return pg8::cvt_pk_bf16(lo, hi); }
__device__ __forceinline__ bf16x8 pack_p(const f32x16& p, int base) {
    u32x4 w; w.x = cvtpk(p[base + 0], p[base + 1]); w.y = cvtpk(p[base + 2], p[base + 3]); w.z = cvtpk(p[base + 4], p[base + 5]); w.w = cvtpk(p[base + 6], p[base + 7]); return __builtin_bit_cast(bf16x8, w); }

struct KVRegs { u32x4 k, v; };
template <bool LOADV> __device__ __forceinline__ void kv_load(KVRegs& R, const bf16_t* K, const bf16_t* V, int ldk, int kt, int tid) {
    const int rowl = tid >> 3, ch = tid & 7; const size_t off = (size_t)(64 * kt + rowl) * ldk + ch * 8;
    R.k = *(const u32x4*)(K + off); if (LOADV) R.v = *(const u32x4*)(V + off);
}
template <bool LOADV> __device__ __forceinline__ void kv_write(const KVRegs& R, LAS unsigned char* buf, int tid) {
    const int rowl = tid >> 3, ch = tid & 7;
    *(LAS u32x4*)(buf + rowl * 128 + ((ch ^ ((rowl >> 1) & 7)) << 4)) = R.k; if (LOADV) *(LAS u32x4*)(buf + 8192 + rowl * 128 + ((ch ^ (((rowl >> 1) & 1) << 2)) << 4)) = R.v;
}
__device__ __forceinline__ void qk_tile(f32x16& s0, f32x16& s1, const LAS unsigned char* buf, const bf16x8 (&qf)[4], int r32, int hi, float init) {
    const f32x16 z = {init, init, init, init, init, init, init, init, init, init, init, init, init, init, init, init}; s0 = z; s1 = z;
#pragma unroll
    for (int d0 = 0; d0 < 4; ++d0) { const int c = 2 * d0 + hi; const int sw = (c ^ ((r32 >> 1) & 7)) << 4;
        const bf16x8 k0 = *(const LAS bf16x8*)(buf + r32 * 128 + sw); const bf16x8 k1 = *(const LAS bf16x8*)(buf + (32 + r32) * 128 + sw);
        s0 = __builtin_amdgcn_mfma_f32_32x32x16_bf16(k0, qf[d0], s0, 0, 0, 0); s1 = __builtin_amdgcn_mfma_f32_32x32x16_bf16(k1, qf[d0], s1, 0, 0, 0); }
}
__device__ __forceinline__ void pv_tile(f32x16 (&o)[2], const LAS unsigned char* vbuf, const f32x16& p0, const f32x16& p1, int lane) {
    const int hi = lane >> 5, qb = (lane >> 3) & 1; const LAS unsigned char* vb = vbuf + (4 * hi + ((lane & 15) >> 2)) * 128 + (16 * ((lane >> 4) & 1) + 4 * (lane & 3)) * 2;
#pragma unroll
    for (int ks = 0; ks < 4; ++ks) { const bf16x8 pb = pack_p(ks < 2 ? p0 : p1, 8 * (ks & 1));
#pragma unroll
        for (int dt = 0; dt < 2; ++dt) { const s16x4 lo = vtr(vb + (16 * ks) * 128 + (dt ^ qb) * 64), hi4 = vtr(vb + (16 * ks + 8) * 128 + (dt ^ qb) * 64);
            const bf16x8 va = {lo[0], lo[1], lo[2], lo[3], hi4[0], hi4[1], hi4[2], hi4[3]};
            o[dt] = __builtin_amdgcn_mfma_f32_32x32x16_bf16(va, pb, o[dt], 0, 0, 0); } }
}
template <int MODE> __device__ __forceinline__ bool key_valid(int kt, int kh, int r, int hi, int tpos, int aux) {
    const int kp = 64 * kt + 32 * kh + crow(r, hi);
    if (MODE == M_WIN) return kp <= tpos && kp > tpos - 512;
    if (MODE == M_CMP) return kp <= aux;
    return aux != 0 && kp <= tpos;
}

__device__ __forceinline__ void k_frags(bf16x8 (&kf)[8], const LAS unsigned char* buf, int r32, int hi) {
#pragma unroll
    for (int d0 = 0; d0 < 4; ++d0) { const int sw = ((2 * d0 + hi) ^ ((r32 >> 1) & 7)) << 4; kf[2 * d0] = *(const LAS bf16x8*)(buf + r32 * 128 + sw); kf[2 * d0 + 1] = *(const LAS bf16x8*)(buf + (32 + r32) * 128 + sw); }
}
__device__ __forceinline__ void qk_mfma(f32x16& s0, f32x16& s1, const bf16x8 (&kf)[8], const bf16x8 (&qf)[4], float init) {
    const f32x16 z = {init, init, init, init, init, init, init, init, init, init, init, init, init, init, init, init}; s0 = z; s1 = z;
#pragma unroll
    for (int d0 = 0; d0 < 4; ++d0) { s0 = __builtin_amdgcn_mfma_f32_32x32x16_bf16(kf[2 * d0], qf[d0], s0, 0, 0, 0); s1 = __builtin_amdgcn_mfma_f32_32x32x16_bf16(kf[2 * d0 + 1], qf[d0], s1, 0, 0, 0); }
}
__device__ __forceinline__ void qk_mfma_c(f32x16& s0, f32x16& s1, const bf16x8 (&kf)[8], const bf16x8 (&qf)[4], const f32x16& c) {
    s0 = __builtin_amdgcn_mfma_f32_32x32x16_bf16(kf[0], qf[0], c, 0, 0, 0); s1 = __builtin_amdgcn_mfma_f32_32x32x16_bf16(kf[1], qf[0], c, 0, 0, 0);
#pragma unroll
    for (int d0 = 1; d0 < 4; ++d0) { s0 = __builtin_amdgcn_mfma_f32_32x32x16_bf16(kf[2 * d0], qf[d0], s0, 0, 0, 0); s1 = __builtin_amdgcn_mfma_f32_32x32x16_bf16(kf[2 * d0 + 1], qf[d0], s1, 0, 0, 0); }
}
__device__ __forceinline__ void qk_mfma_z(f32x16& s0, f32x16& s1, const bf16x8 (&kf)[8], const bf16x8 (&qf)[4]) {
    const f32x16 z = {0.f, 0.f, 0.f, 0.f, 0.f, 0.f, 0.f, 0.f, 0.f, 0.f, 0.f, 0.f, 0.f, 0.f, 0.f, 0.f};
    s0 = __builtin_amdgcn_mfma_f32_32x32x16_bf16(kf[0], qf[0], z, 0, 0, 0); s1 = __builtin_amdgcn_mfma_f32_32x32x16_bf16(kf[1], qf[0], z, 0, 0, 0);
#pragma unroll
    for (int d0 = 1; d0 < 4; ++d0) { s0 = __builtin_amdgcn_mfma_f32_32x32x16_bf16(kf[2 * d0], qf[d0], s0, 0, 0, 0); s1 = __builtin_amdgcn_mfma_f32_32x32x16_bf16(kf[2 * d0 + 1], qf[d0], s1, 0, 0, 0); }
}
template <bool B> struct BTag { static constexpr bool value = B; };
__device__ __forceinline__ void v_frags(bf16x8 (&vf)[8], const LAS unsigned char* vbuf, int lane) {
    const int hi = lane >> 5, qb = (lane >> 3) & 1; const LAS unsigned char* vb = vbuf + (4 * hi + ((lane & 15) >> 2)) * 128 + (16 * ((lane >> 4) & 1) + 4 * (lane & 3)) * 2;
#pragma unroll
    for (int ks = 0; ks < 4; ++ks)
#pragma unroll
        for (int dt = 0; dt < 2; ++dt) { const s16x4 lo = vtr(vb + (16 * ks) * 128 + (dt ^ qb) * 64), hi4 = vtr(vb + (16 * ks + 8) * 128 + (dt ^ qb) * 64);
            vf[2 * ks + dt] = (bf16x8){lo[0], lo[1], lo[2], lo[3], hi4[0], hi4[1], hi4[2], hi4[3]}; }
}
template <bool USEM> __device__ __forceinline__ void pv_mfma(f32x16 (&o)[2], const bf16x8 (&vf)[8], const f32x16& p0, const f32x16& p1, unsigned msk) {
#pragma unroll
    for (int ks = 0; ks < 4; ++ks) { bf16x8 pb = pack_p(ks < 2 ? p0 : p1, 8 * (ks & 1));
        if (USEM) { u32x4 w = __builtin_bit_cast(u32x4, pb); w.x &= msk; w.y &= msk; w.z &= msk; w.w &= msk; pb = __builtin_bit_cast(bf16x8, w); }
        o[0] = __builtin_amdgcn_mfma_f32_32x32x16_bf16(vf[2 * ks], pb, o[0], 0, 0, 0); o[1] = __builtin_amdgcn_mfma_f32_32x32x16_bf16(vf[2 * ks + 1], pb, o[1], 0, 0, 0); }
}
template <int MODE> __device__ __forceinline__ void mask_tile(f32x16& s0, f32x16& s1, int kt, int qt, int tp0, int th, int hi, int tpos) {
    bool full;
    if (MODE == M_WIN) full = (64 * kt + 63 <= tp0 + 32 * th) && (64 * kt > tp0 + 32 * th + 31 - 512); else full = kt < qt;
    if (!full) {
#pragma unroll
        for (int r = 0; r < 16; ++r) { if (!key_valid<MODE>(kt, 0, r, hi, tpos, 1)) s0[r] = -INFINITY; if (!key_valid<MODE>(kt, 1, r, hi, tpos, 1)) s1[r] = -INFINITY; } }
}
__device__ __forceinline__ float exp_tile(f32x16& s0, f32x16& s1) {
    float sa = 0.f, sb = 0.f;
#pragma unroll
    for (int r = 0; r < 16; ++r) { s0[r] = __builtin_amdgcn_exp2f(s0[r]); s1[r] = __builtin_amdgcn_exp2f(s1[r]); sa += s0[r]; asm("" : "+v"(sa)); sb += s1[r]; asm("" : "+v"(sb)); }
    return sa + sb;
}

template <int MODE, bool NOSHIFT = false> __device__ __forceinline__ void attn_unit(LAS unsigned char* lds, unsigned char* ws, int b, int g, int qt, int tid_, float negM, size_t out_off) {
    int tid = tid_; asm volatile("" : "+v"(tid));
    const int lane = tid & 63, wave = __builtin_amdgcn_readfirstlane(tid >> 6), r32 = lane & 31, hi = lane >> 5, hg = wave & 3, th = wave >> 2;
    const int tokl = MODE == M_CMP ? 8 * wave + (r32 >> 2) : 32 * th + r32; const int head = 4 * g + (MODE == M_CMP ? (r32 & 3) : hg);
    const int tp0 = 64 * qt, tpos = tp0 + tokl; const size_t trow = (size_t)b * SEQ + tpos;
    const bf16_t *K, *V; int ldk, kt0, kt1;
    if (MODE == M_WIN) { K = (const bf16_t*)(ws + WS_KW) + (size_t)b * SEQ * 128 + g * 64; V = (const bf16_t*)(ws + WS_VW) + (size_t)b * SEQ * 128 + g * 64; ldk = 128; kt0 = qt - 8 > 0 ? qt - 8 : 0; kt1 = qt; }
    else if (MODE == M_SLC) { K = (const bf16_t*)(ws + WS_KS) + (size_t)b * SEQ * 128 + g * 64; V = (const bf16_t*)(ws + WS_VS) + (size_t)b * SEQ * 128 + g * 64; ldk = 128; kt0 = 0; kt1 = qt; }
    else { K = (const bf16_t*)(ws + WS_CMPB) + (size_t)((b * 2 + g) * 512) * 64; V = (const bf16_t*)(ws + WS_CMPB) + (size_t)((8 + b * 2 + g) * 512) * 64; ldk = 64; kt0 = 0; kt1 = (4 * qt + 2) >> 6; }
    bf16x8 qf[4];
    { const bf16_t* qp = (const bf16_t*)(ws + WS_NQ) + trow * 512 + head * 64 + 8 * hi;
#pragma unroll
      for (int d0 = 0; d0 < 4; ++d0) qf[d0] = *(const bf16x8*)(qp + 16 * d0); }
    unsigned selw[4] = {0u, 0u, 0u, 0u};
    if (MODE == M_SLC) { const u32x4 sv = *(const u32x4*)((const unsigned*)(ws + WS_SEL) + (trow * 2 + g) * 4); selw[0] = sv.x; selw[1] = sv.y; selw[2] = sv.z; selw[3] = sv.w; }
    const int cmaxl = tpos >= 31 ? (tpos - 31) >> 4 : -1;
    const int tfirst = tp0 + 8 * wave; const int cmin = tfirst >= 31 ? (tfirst - 31) >> 4 : -1;
    LAS unsigned char* kvb = lds + LDS_KV;
    float m = -INFINITY, l = 0.f; f32x16 o[2]; { const f32x16 z = {0.f, 0.f, 0.f, 0.f, 0.f, 0.f, 0.f, 0.f, 0.f, 0.f, 0.f, 0.f, 0.f, 0.f, 0.f, 0.f}; o[0] = z; o[1] = z; }
    KVRegs R;
    bf16_t* op = (bf16_t*)(ws + out_off) + trow * 1024 + 512 + head * 64 + 4 * hi;
    u32x2 old[2][4];
    auto load_old = [&]() __attribute__((always_inline)) {
#pragma unroll
        for (int dt = 0; dt < 2; ++dt)
#pragma unroll
            for (int rr = 0; rr < 4; ++rr) old[dt][rr] = *(const u32x2*)(op + 32 * dt + 8 * rr); };
    if (MODE == M_CMP) {
        kv_load<false>(R, K, V, ldk, kt0, tid);
        for (int kt = kt0; kt <= kt1; ++kt) { LAS unsigned char* buf = kvb + ((kt - kt0) & 1) * 16384;
            kv_write<false>(R, buf, tid); if (kt < kt1) kv_load<false>(R, K, V, ldk, kt + 1, tid); else kv_load<true>(R, K, V, ldk, kt0, tid);
            __syncthreads();
            f32x16 s0, s1; qk_tile(s0, s1, buf, qf, r32, hi, 0.f);
            float mx = -INFINITY;
            const bool fullc = (64 * kt + 63) <= cmin;
            if (!fullc) {
#pragma unroll
                for (int r = 0; r < 16; ++r) { if (!key_valid<MODE>(kt, 0, r, hi, tpos, cmaxl)) s0[r] = -INFINITY; if (!key_valid<MODE>(kt, 1, r, hi, tpos, cmaxl)) s1[r] = -INFINITY; } }
#pragma unroll
            for (int r = 0; r < 16; ++r) mx = fmaxf(mx, fmaxf(s0[r], s1[r]));
            mx = fmaxf(mx, __shfl_xor(mx, 32));
            const float mn = fmaxf(m, mx);
            if (mn > -INFINITY) { float sum = 0.f;
#pragma unroll
                for (int r = 0; r < 16; ++r) sum += __builtin_amdgcn_exp2f(s0[r] - mn) + __builtin_amdgcn_exp2f(s1[r] - mn);
                l = l * __builtin_amdgcn_exp2f(m - mn) + sum; m = mn; }
        }
        __syncthreads();
        l += __shfl_xor(l, 32); const float il = l > 0.f ? 1.0f / l : 0.f; const float negm = l > 0.f ? -m : -INFINITY;
        LAS float* impt = (LAS float*)(lds + LDS_IMP) + tokl * IMPS;
        load_old();
        float carry = 0.f;
        for (int kt = kt0; kt <= kt1; ++kt) { LAS unsigned char* buf = kvb + ((kt - kt0) & 1) * 16384;
            kv_write<true>(R, buf, tid); if (kt < kt1) kv_load<true>(R, K, V, ldk, kt + 1, tid);
            __syncthreads();
            f32x16 s0, s1; qk_tile(s0, s1, buf, qf, r32, hi, negm);
            const bool fullc = (64 * kt + 63) <= cmin;
            if (!fullc) {
#pragma unroll
                for (int r = 0; r < 16; ++r) { if (!key_valid<MODE>(kt, 0, r, hi, tpos, cmaxl)) s0[r] = -INFINITY; if (!key_valid<MODE>(kt, 1, r, hi, tpos, cmaxl)) s1[r] = -INFINITY; } }
#pragma unroll
            for (int r = 0; r < 16; ++r) { s0[r] = __builtin_amdgcn_exp2f(s0[r]); s1[r] = __builtin_amdgcn_exp2f(s1[r]); }
            float px[2][4];
#pragma unroll
            for (int rr = 0; rr < 4; ++rr) { px[0][rr] = __shfl_xor(s0[4 * rr + 3], 32); px[1][rr] = __shfl_xor(s1[4 * rr + 3], 32); }
#pragma unroll
            for (int kh = 0; kh < 2; ++kh)
#pragma unroll
                for (int rr = 0; rr < 4; ++rr) { const f32x16& p = kh ? s1 : s0; const int j = 16 * kt + 8 * kh + 2 * rr + hi;
                    const float inc = hi ? px[kh][rr] : (rr >= 1 ? px[kh][rr - 1] : (kh ? px[0][3] : carry));
                    float bin = (((p[4 * rr] + p[4 * rr + 1]) + (p[4 * rr + 2] + p[4 * rr + 3])) + inc) * il;
                    bin += __builtin_bit_cast(float, __builtin_amdgcn_mov_dpp(__builtin_bit_cast(int, bin), 0xB1, 0xf, 0xf, true));
                    bin += __builtin_bit_cast(float, __builtin_amdgcn_mov_dpp(__builtin_bit_cast(int, bin), 0x4E, 0xf, 0xf, true));
                    if ((r32 & 3) == 0 && j < 128) impt[j] = bin; }
            carry = px[1][3];
            pv_tile(o, buf + 8192, s0, s1, lane);
        }
        __syncthreads();
    } else {
        KVRegs R1;
        kv_load<true>(R, K, V, ldk, kt0, tid); if (kt0 + 1 <= kt1) kv_load<true>(R1, K, V, ldk, kt0 + 1, tid);
        kv_write<true>(R, kvb, tid); if (kt0 + 1 <= kt1) kv_write<true>(R1, kvb + 16384, tid);
        if (kt0 + 2 <= kt1) kv_load<true>(R, K, V, ldk, kt0 + 2, tid); if (kt0 + 3 <= kt1) kv_load<true>(R1, K, V, ldk, kt0 + 3, tid);
        __syncthreads();
        auto step = [&](auto mtag, int kt) __attribute__((always_inline)) {
            constexpr bool MASKED = decltype(mtag)::value; constexpr bool SEL = MODE == M_SLC;
            LAS unsigned char* bufA = kvb + (((kt - kt0) >> 1) & 1) * 32768; LAS unsigned char* bufB = bufA + 16384; const bool two = kt + 1 <= kt1;
            { LAS unsigned char* nA = kvb + ((((kt - kt0) >> 1) + 1) & 1) * 32768;
              if (kt + 2 <= kt1) kv_write<true>(R, nA, tid); if (kt + 3 <= kt1) kv_write<true>(R1, nA + 16384, tid);
              if (kt + 4 <= kt1) kv_load<true>(R, K, V, ldk, kt + 4, tid); if (kt + 5 <= kt1) kv_load<true>(R1, K, V, ldk, kt + 5, tid); }
            unsigned mA = ~0u, mB = ~0u;
            if (SEL) { const unsigned w = kt < 32 ? selw[0] : kt < 64 ? selw[1] : kt < 96 ? selw[2] : selw[3]; mA = 0u - ((w >> (kt & 31)) & 1u);
                const int k2 = kt + 1; const unsigned w2 = k2 < 32 ? selw[0] : k2 < 64 ? selw[1] : k2 < 96 ? selw[2] : selw[3]; mB = 0u - ((w2 >> (k2 & 31)) & 1u); }
            f32x16 a0, a1, b0, b1; bf16x8 fa[8], fb[8];
            if (two) {
                k_frags(fa, bufA, r32, hi); k_frags(fb, bufB, r32, hi); __builtin_amdgcn_sched_barrier(0);
                if (NOSHIFT) qk_mfma_z(a0, a1, fa, qf); else qk_mfma(a0, a1, fa, qf, negM);
                if (MASKED) mask_tile<MODE>(a0, a1, kt, qt, tp0, th, hi, tpos);
                if (NOSHIFT) qk_mfma_z(b0, b1, fb, qf); else qk_mfma(b0, b1, fb, qf, negM); { const float sa = exp_tile(a0, a1); l += SEL ? __uint_as_float(__float_as_uint(sa) & mA) : sa; }
                v_frags(fa, bufA + 8192, lane); __builtin_amdgcn_sched_barrier(0);
                if (MASKED) mask_tile<MODE>(b0, b1, kt + 1, qt, tp0, th, hi, tpos);
                pv_mfma<SEL>(o, fa, a0, a1, mA); { const float sb = exp_tile(b0, b1); l += SEL ? __uint_as_float(__float_as_uint(sb) & mB) : sb; }
                v_frags(fb, bufB + 8192, lane); __builtin_amdgcn_sched_barrier(0);
                pv_mfma<SEL>(o, fb, b0, b1, mB);
            } else {
                k_frags(fa, bufA, r32, hi); if (NOSHIFT) qk_mfma_z(a0, a1, fa, qf); else qk_mfma(a0, a1, fa, qf, negM); v_frags(fa, bufA + 8192, lane);
                if (MASKED) mask_tile<MODE>(a0, a1, kt, qt, tp0, th, hi, tpos);
                { const float sa = exp_tile(a0, a1); l += SEL ? __uint_as_float(__float_as_uint(sa) & mA) : sa; }
                pv_mfma<SEL>(o, fa, a0, a1, mA);
            }
            __syncthreads();
        };
        int kt = kt0;
        if (MODE == M_WIN) { step(BTag<true>{}, kt); kt += 2; }
        for (; kt + 1 < kt1; kt += 2) step(BTag<false>{}, kt);
        if (MODE == M_SLC) load_old();
        if (kt <= kt1) step(BTag<true>{}, kt);
        l += __shfl_xor(l, 32);
    }
    { const float* sg = (const float*)(ws + WS_SMALLG); const int br = MODE == M_CMP ? 0 : MODE == M_SLC ? 1 : 2;
      const float gt = sigm(sg[trow * 32 + 8 + head * 3 + br]) * (l > 0.f ? 1.0f / l : 0.f);
#pragma unroll
      for (int dt = 0; dt < 2; ++dt)
#pragma unroll
          for (int rr = 0; rr < 4; ++rr) { float v0 = o[dt][4 * rr] * gt, v1 = o[dt][4 * rr + 1] * gt, v2 = o[dt][4 * rr + 2] * gt, v3 = o[dt][4 * rr + 3] * gt;
              if (MODE != M_WIN) { v0 += pg8::bflo(old[dt][rr].x); v1 += pg8::bfhi(old[dt][rr].x); v2 += pg8::bflo(old[dt][rr].y); v3 += pg8::bfhi(old[dt][rr].y); }
              u32x2 nw; nw.x = cvtpk(v0, v1); nw.y = cvtpk(v2, v3); *(u32x2*)(op + 32 * dt + 8 * rr) = nw; } }
    if (MODE == M_CMP) {
        const int cur = qt, tk = tid >> 3, part = tid & 7; const LAS float* row = (const LAS float*)(lds + LDS_IMP) + tk * IMPS + 16 * part;
        unsigned key[16];
#pragma unroll
        for (int k = 0; k < 16; ++k) { const int j = 16 * part + k; float v = row[k]; if (j == 0 || j == cur || j == cur - 1) v = 1e4f; if (j > cur) v = -1e30f;
            const unsigned u = __float_as_uint(v); key[k] = (u & 0x80000000u) ? ~u : (u | 0x80000000u); }
        unsigned sel16;
        if (cur < 16) { sel16 = part == 0 ? ((2u << cur) - 1u) : 0u; }
        else {
            auto sum8 = [](int v) { v += __builtin_amdgcn_mov_dpp(v, 0xB1, 0xf, 0xf, true); v += __builtin_amdgcn_mov_dpp(v, 0x4E, 0xf, 0xf, true); v += __builtin_amdgcn_mov_dpp(v, 0x141, 0xf, 0xf, true); return v; };
            unsigned T = 0u;
            bool done = false;
            for (int bit = 31; bit >= 0; --bit) { const unsigned cand = T | (1u << bit); int cnt = 0;
#pragma unroll
                for (int k = 0; k < 16; ++k) cnt += key[k] >= cand ? 1 : 0;
                const int tot = sum8(cnt); if (!done && tot >= 16) T = cand; done = done || tot == 16;
                if (__builtin_amdgcn_ballot_w64(!done) == 0ull) break; }
            int ngt = 0, neq = 0;
#pragma unroll
            for (int k = 0; k < 16; ++k) { ngt += key[k] > T ? 1 : 0; neq += key[k] == T ? 1 : 0; }
            const int need = 16 - sum8(ngt);
            int pre = neq;
            { int t1 = __builtin_amdgcn_update_dpp(0, pre, 0x111, 0xf, 0xf, true); if (part >= 1) pre += t1; int t2 = __builtin_amdgcn_update_dpp(0, pre, 0x112, 0xf, 0xf, true); if (part >= 2) pre += t2; int t4 = __builtin_amdgcn_update_dpp(0, pre, 0x114, 0xf, 0xf, true); if (part >= 4) pre += t4; }
            int rank = pre - neq; sel16 = 0u;
#pragma unroll
            for (int k = 0; k < 16; ++k) { const bool eq = key[k] == T; if (key[k] > T || (eq && rank < need)) sel16 |= 1u << k; rank += eq ? 1 : 0; }
        }
        *((unsigned short*)((unsigned*)(ws + WS_SEL) + (((size_t)b * SEQ + tp0 + tk) * 2 + g) * 4) + part) = (unsigned short)sel16;
        __syncthreads();
    }
}
template <int MODE> __device__ __forceinline__ void attn_phase(LAS unsigned char* lds, const Args& a, int G, int cu, size_t out_off = WS_HMON) {
    int tid = threadIdx.x; asm volatile("" : "+v"(tid)); unsigned char* ws = a.ws;
    float negM = 0.f;
    if (MODE != M_CMP) {
        const float* qw = a.in[8]; const float* kw = MODE == M_SLC ? a.in[10] : a.in[11]; float mq = fabsf(qw[tid & 63]), mk = fabsf(kw[tid & 63]);
#pragma unroll
        for (int o = 1; o < 64; o <<= 1) { mq = fmaxf(mq, __shfl_xor(mq, o)); mk = fmaxf(mk, __shfl_xor(mk, o)); }
        negM = -fminf(11.5416f * mq * mk * 1.02f, 100.f); negM = __uint_as_float(__builtin_amdgcn_readfirstlane(__float_as_uint(negM))); }
    for (int u = cu; u < 256; u += G) { const int bg = u & 7, i = u >> 3;
        for (int k = 0; k < 4; ++k) { const int qt = k == 0 ? i : k == 1 ? 63 - i : k == 2 ? 64 + i : 127 - i;
            if (MODE != M_CMP && negM >= NOSHIFT_THR) attn_unit<MODE, MODE != M_CMP>(lds, ws, bg >> 1, bg & 1, qt, tid, negM, out_off);
            else attn_unit<MODE>(lds, ws, bg >> 1, bg & 1, qt, tid, negM, out_off); } }
}
}
namespace ml {
typedef short bf16x8 __attribute__((ext_vector_type(8)));
typedef short s16x4 __attribute__((ext_vector_type(4)));
typedef float f32x16 __attribute__((ext_vector_type(16)));
constexpr size_t WS_GC = WS_MLS, WS_AM = WS_MLS + 8192, WS_MP = WS_MLS + 16384, WS_DN = WS_IPRE, WS_NP = WS_LOGF;
__device__ __forceinline__ float fexp(float x) { return __builtin_amdgcn_exp2f(x * 1.4426950408889634f); }
__device__ __forceinline__ float logsig(float x) { return x >= 0.f ? -log1pf(expf(-x)) : x - log1pf(expf(x)); }
__device__ __forceinline__ float scan_add(float v, int lane) {
#pragma unroll
    for (int o = 1; o < 64; o <<= 1) { const float t = __shfl_up(v, o); if (lane >= o) v += t; }
    return v;
}
__device__ __forceinline__ float scan_max(float v, int lane) {
#pragma unroll
    for (int o = 1; o < 64; o <<= 1) { const float t = __shfl_up(v, o); if (lane >= o) v = fmaxf(v, t); }
    return v;
}
__device__ __forceinline__ float wave_max(float v) {
#pragma unroll
    for (int o = 1; o < 64; o <<= 1) v = fmaxf(v, __shfl_xor(v, o));
    return v;
}
__device__ __forceinline__ float conv_silu(const bf16_t* qkpre, const float* cw, const float* cb, size_t trow, int tp, int ch) {
    float s = cb[ch];
#pragma unroll
    for (int k = 0; k < 4; ++k) { const int d = 3 - k; if (tp >= d) s += cw[k * 512 + ch] * bf2f(qkpre[(trow - d) * 512 + ch]); }
    return s * sigm(s);
}
__device__ __forceinline__ s16x4 vtr(const LAS unsigned char* p) { typedef short v4i16_t __attribute__((ext_vector_type(4))); return __builtin_bit_cast(s16x4, __builtin_amdgcn_ds_read_tr16_b64_v4i16((LAS v4i16_t*)p)); }
__device__ __forceinline__ bf16x8 cat8(const s16x4& a, const s16x4& b) { return (bf16x8){a[0], a[1], a[2], a[3], b[0], b[1], b[2], b[3]}; }

template <int NPART> __device__ __forceinline__ void stage_pre(LAS unsigned short* pre, const bf16_t* qkpre, size_t t0, int tp0, int h, int part0, int tid) {
    for (int i = tid; i < NPART * 67 * 8; i += 512) { const int ch8 = i & 7, r = (i >> 3) % 67, p = (i >> 3) / 67; const int tp = tp0 - 3 + r;
        u32x4 v = {0u, 0u, 0u, 0u}; if (tp >= 0) v = *(const u32x4*)(qkpre + (t0 - 3 + r) * 512 + (part0 + p) * 256 + h * 64 + ch8 * 8);
        *(LAS u32x4*)(pre + (p * 67 + r) * 64 + ch8 * 8) = v; }
}
__device__ __forceinline__ float conv_lds(const LAS unsigned short* pre, int p, int l, int d, const float (&cw4)[4], float cb1) {
    float s = cb1;
#pragma unroll
    for (int k = 0; k < 4; ++k) s += cw4[k] * bf2f(pre[(p * 67 + l + k) * 64 + d]);
    return s * sigm(s);
}
__device__ __forceinline__ int off256(int row, int colbyte) { return row * 256 + ((((colbyte >> 6) ^ row) & 3) << 6) + (colbyte & 63); }
__device__ __forceinline__ int off128t(int row, int colbyte) { return row * 128 + (colbyte ^ (((row >> 1) & 1) << 6)); }
__device__ __forceinline__ int off128r(int row, int chunk) { return row * 128 + ((chunk ^ ((row >> 1) & 7)) << 4); }
__device__ __forceinline__ void stage256(LAS unsigned char* dst, const bf16_t* src, size_t ld, int tid) {
    for (int i = tid; i < 64 * 16; i += 512) { const int r = i >> 4, c16 = i & 15; *(LAS u32x4*)(dst + off256(r, c16 * 16)) = *(const u32x4*)(src + (size_t)r * ld + c16 * 8); }
}

__device__ __forceinline__ void a_stage(LAS unsigned char* lds, const Args& a, int U, int tid, int lane, int wave) {
    unsigned char* ws = a.ws; const bf16_t* qkpre = (const bf16_t*)(ws + WS_QKPRE); const bf16_t* mv = (const bf16_t*)(ws + WS_MV); const float* sg = (const float*)(ws + WS_SMALLG);
    LAS float* wl = (LAS float*)(lds + 24576); LAS unsigned short* pre = (LAS unsigned short*)(lds + 25600);
    const int c = U & 127, h = (U >> 7) & 3, b = U >> 9; const int tp0 = 64 * c; const size_t t0 = (size_t)b * SEQ + tp0;
    if (wave == 0) { const size_t t = t0 + lane; const float ip = sg[t * 32 + h] + a.in[5][h]; const float lf = logsig(sg[t * 32 + 4 + h] + a.in[6][h]);
        const float bc = scan_add(lf, lane); const float g = __shfl(bc, 63); const float av = g - bc + ip; const float am = wave_max(av); wl[lane] = fexp(av - am);
        if (lane == 0) { ((float*)(ws + WS_GC))[U] = g; ((float*)(ws + WS_AM))[U] = am; } }
    stage256(lds, mv + t0 * 512 + h * 128, 512, tid); stage_pre<1>(pre, qkpre, t0, tp0, h, 1, tid);
}
__device__ __forceinline__ void a_conv(LAS unsigned char* lds, const Args& a, int U, int tid) {
    asm volatile("" : "+v"(tid));
    const int h = (U >> 7) & 3; const int d2 = tid & 31, l0 = tid >> 5, ch = 256 + h * 64 + 2 * d2;
    float cw[4][2];
#pragma unroll
    for (int k = 0; k < 4; ++k) { cw[k][0] = a.in[3][k * 512 + ch]; cw[k][1] = a.in[3][k * 512 + ch + 1]; }
    const float cb0 = a.in[4][ch], cb1 = a.in[4][ch + 1];
    const LAS float* wl = (const LAS float*)(lds + 24576) + l0; const LAS unsigned* pre = (const LAS unsigned*)(lds + 25600) + l0 * 32 + d2;
    LAS unsigned char* w0 = lds + 16384 + off128t(l0, 4 * d2);
#pragma unroll
    for (int i = 0; i < 4; ++i) { float s0 = cb0, s1 = cb1;
#pragma unroll
        for (int k = 0; k < 4; ++k) { const unsigned w = pre[(16 * i + k) * 32]; s0 += cw[k][0] * pg8::bflo(w); s1 += cw[k][1] * pg8::bfhi(w); }
        const float wv = wl[16 * i]; *(LAS unsigned*)(w0 + i * 2048) = pg8::cvt_pk_bf16(wv * s0 * sigm(s0), wv * s1 * sigm(s1)); }
}
__device__ __forceinline__ void a_compute(LAS unsigned char* lds, const Args& a, int U, int tid, int lane, int wave) {
    unsigned char* ws = a.ws; LAS unsigned char* Vs = lds; LAS unsigned char* KW = lds + 16384; const int r32 = lane & 31, hi = lane >> 5;
    const int dtile = wave & 1, et = wave >> 1; const int li = lane & 15, cb16 = 16 * ((lane >> 4) & 1);
    f32x16 acc = {0.f, 0.f, 0.f, 0.f, 0.f, 0.f, 0.f, 0.f, 0.f, 0.f, 0.f, 0.f, 0.f, 0.f, 0.f, 0.f};
#pragma unroll
    for (int kk = 0; kk < 4; ++kk) { const int rb = 16 * kk + 8 * hi + (li >> 2);
        const int ca = (32 * dtile + cb16 + 4 * (li & 3)) * 2, cv = (32 * et + cb16 + 4 * (li & 3)) * 2;
        const bf16x8 af = cat8(vtr(KW + off128t(rb, ca)), vtr(KW + off128t(rb + 4, ca)));
        const bf16x8 bf = cat8(vtr(Vs + off256(rb, cv)), vtr(Vs + off256(rb + 4, cv)));
        acc = __builtin_amdgcn_mfma_f32_32x32x16_bf16(af, bf, acc, 0, 0, 0); }
    bf16_t* dc = (bf16_t*)(ws + WS_DC) + (size_t)U * 8192 + 32 * et + r32;
#pragma unroll
    for (int r = 0; r < 16; ++r) dc[(32 * dtile + (r & 3) + 8 * (r >> 2) + 4 * hi) * 128] = (bf16_t)f2bf(acc[r]);
    if (tid < 64) { float s = 0.f; for (int l = 0; l < 64; ++l) s += bf2f(*(const LAS unsigned short*)(KW + off128t(l, tid * 2))); ((float*)(ws + WS_DN))[(size_t)U * 64 + tid] = s; }
}
__device__ __forceinline__ void phase_a(LAS unsigned char* lds, const Args& a, int G, int cu) {
    int tid = threadIdx.x; asm volatile("" : "+v"(tid)); const int lane = tid & 63, wave = __builtin_amdgcn_readfirstlane(tid >> 6);
    LAS unsigned char* l0 = lds; LAS unsigned char* l1 = lds + 36864;
    for (int U = cu; U < 2048; U += 2 * G) { const int U1 = U + G; const bool two = U1 < 2048;
        a_stage(l0, a, U, tid, lane, wave); if (two) a_stage(l1, a, U1, tid, lane, wave);
        __syncthreads();
        a_conv(l0, a, U, tid); if (two) a_conv(l1, a, U1, tid);
        __syncthreads();
        a_compute(l0, a, U, tid, lane, wave); if (two) a_compute(l1, a, U1, tid, lane, wave);
        __syncthreads();
    }
}
__device__ __forceinline__ void phase_b(const Args& a, int gtid, int nthr) {
    unsigned char* ws = a.ws; const float* __restrict__ gc = (const float*)(ws + WS_GC); const float* __restrict__ am = (const float*)(ws + WS_AM); float* __restrict__ mp = (float*)(ws + WS_MP);
    const bf16_t* __restrict__ dc = (const bf16_t*)(ws + WS_DC); bf16_t* __restrict__ cp = (bf16_t*)(ws + WS_CPREV); const float* __restrict__ dn = (const float*)(ws + WS_DN); float* __restrict__ np = (float*)(ws + WS_NP);
    for (int i = gtid; i < 16 * 2048; i += nthr) { const int bh = i >> 11, de = (i & 2047) * 4; f32x4 C = {0.f, 0.f, 0.f, 0.f}; float m = 0.f;
        for (int c0 = 0; c0 < 128; c0 += 8) { pg8::u32x2 xr[8]; float g[8], ax[8];
#pragma unroll
            for (int j = 0; j < 8; ++j) { const int U = bh * 128 + c0 + j; xr[j] = *(const pg8::u32x2*)(dc + (size_t)U * 8192 + de); g[j] = gc[U]; ax[j] = am[U]; }
#pragma unroll
            for (int j = 0; j < 8; ++j) { const int U = bh * 128 + c0 + j;
                pg8::u32x2 w; w.x = pg8::cvt_pk_bf16(C[0], C[1]); w.y = pg8::cvt_pk_bf16(C[2], C[3]); *(pg8::u32x2*)(cp + (size_t)U * 8192 + de) = w;
                const float mn = fmaxf(g[j] + m, ax[j]); const float dec = fexp(g[j] + m - mn), sc = fexp(ax[j] - mn); const f32x4 x = {pg8::bflo(xr[j].x), pg8::bfhi(xr[j].x), pg8::bflo(xr[j].y), pg8::bfhi(xr[j].y)}; C = C * dec + x * sc; m = mn; } } }
    for (int i = nthr - 1 - gtid; i < 16 * 64; i += nthr) { const int bh = i >> 6, d = i & 63; float nn = 0.f, m = 0.f;
        for (int c0 = 0; c0 < 128; c0 += 8) { float g[8], ax[8], x[8];
#pragma unroll
            for (int j = 0; j < 8; ++j) { const int U = bh * 128 + c0 + j; g[j] = gc[U]; ax[j] = am[U]; x[j] = dn[(size_t)U * 64 + d]; }
#pragma unroll
            for (int j = 0; j < 8; ++j) { const int U = bh * 128 + c0 + j; np[(size_t)U * 64 + d] = nn; if (d == 0) mp[U] = m;
                const float mn = fmaxf(g[j] + m, ax[j]); const float dec = fexp(g[j] + m - mn), sc = fexp(ax[j] - mn); nn = dec * nn + sc * x[j]; m = mn; } } }
}
struct CRegs { u32x4 pre[3], v[2], c[2]; };
__device__ __forceinline__ void c_load(CRegs& R, const Args& a, int U, int tid) {
    unsigned char* ws = a.ws; const bf16_t* qkpre = (const bf16_t*)(ws + WS_QKPRE); const bf16_t* mv = (const bf16_t*)(ws + WS_MV);
    const int c = U & 127, h = (U >> 7) & 3, b = U >> 9; const int tp0 = 64 * c; const size_t t0 = (size_t)b * SEQ + tp0;
#pragma unroll
    for (int k = 0; k < 3; ++k) { const int i = tid + 512 * k; R.pre[k] = (u32x4){0u, 0u, 0u, 0u};
        if (i < 2 * 67 * 8) { const int ch8 = i & 7, r = (i >> 3) % 67, p = (i >> 3) / 67; if (tp0 - 3 + r >= 0) R.pre[k] = *(const u32x4*)(qkpre + (t0 - 3 + r) * 512 + p * 256 + h * 64 + ch8 * 8); } }
#pragma unroll
    for (int k = 0; k < 2; ++k) { const int i = tid + 512 * k, r = i >> 4, c16 = i & 15; R.v[k] = *(const u32x4*)(mv + (t0 + r) * 512 + h * 128 + c16 * 8); R.c[k] = *(const u32x4*)((const bf16_t*)(ws + WS_CPREV) + (size_t)U * 8192 + r * 128 + c16 * 8); }
}
__device__ __forceinline__ void c_store(const CRegs& R, LAS unsigned char* lds, int tid) {
    LAS unsigned short* pre = (LAS unsigned short*)(lds + 49152);
#pragma unroll
    for (int k = 0; k < 3; ++k) { const int i = tid + 512 * k; if (i < 2 * 67 * 8) { const int ch8 = i & 7, r = (i >> 3) % 67, p = (i >> 3) / 67; *(LAS u32x4*)(pre + (p * 67 + r) * 64 + ch8 * 8) = R.pre[k]; } }
#pragma unroll
    for (int k = 0; k < 2; ++k) { const int i = tid + 512 * k, r = i >> 4, c16 = i & 15; *(LAS u32x4*)(lds + off256(r, c16 * 16)) = R.v[k]; *(LAS u32x4*)(lds + 16384 + off256(r, c16 * 16)) = R.c[k]; }
}
__device__ __forceinline__ void c_gates(LAS unsigned char* lds, const Args& a, int U, int lane) {
    unsigned char* ws = a.ws; const float* sg = (const float*)(ws + WS_SMALLG); LAS float* sm = (LAS float*)(lds + 67584);
    const int c = U & 127, h = (U >> 7) & 3, b = U >> 9; const size_t tg = (size_t)b * SEQ + 64 * c + lane;
    const float ip = sg[tg * 32 + h] + a.in[5][h]; const float lf = logsig(sg[tg * 32 + 4 + h] + a.in[6][h]);
    const float bc = scan_add(lf, lane); const float u = ip - bc; const float pm = scan_max(u, lane); const float mprev = ((const float*)(ws + WS_MP))[U];
    const float mt = bc + fmaxf(mprev, pm); sm[lane] = bc; sm[64 + lane] = u * 1.4426950408889634f  ; sm[128 + lane] = mt; sm[192 + lane] = fexp(bc + mprev - mt); sm[256 + lane] = ((const float*)(ws + WS_NP))[(size_t)U * 64 + lane];
}
__device__ __forceinline__ void c_conv(LAS unsigned char* lds, const Args& a, int U, int tid) {
    asm volatile("" : "+v"(tid));
    const int h = (U >> 7) & 3;
    const int d2 = tid & 31, part = (tid >> 5) & 1, l0 = tid >> 6;
    const int ch = part * 256 + h * 64 + 2 * d2; float cw[4][2];
#pragma unroll
    for (int k = 0; k < 4; ++k) { cw[k][0] = a.in[3][k * 512 + ch]; cw[k][1] = a.in[3][k * 512 + ch + 1]; }
    const float cb0 = a.in[4][ch], cb1 = a.in[4][ch + 1], sc = part ? 1.0f : 0.125f;
    const LAS unsigned* pre = (const LAS unsigned*)(lds + 49152) + (part * 67 + l0) * 32 + d2;
    const int c0 = (d2 >> 2) ^ (l0 >> 1);
    LAS unsigned char* w0 = lds + 32768 + part * 8192 + l0 * 128 + (d2 & 3) * 4 + (c0 << 4); LAS unsigned char* w1 = lds + 32768 + part * 8192 + l0 * 128 + (d2 & 3) * 4 + ((c0 ^ 4) << 4);
#pragma unroll
    for (int i = 0; i < 8; ++i) { float s0 = cb0, s1 = cb1;
#pragma unroll
        for (int k = 0; k < 4; ++k) { const unsigned w = pre[(8 * i + k) * 32]; s0 += cw[k][0] * pg8::bflo(w); s1 += cw[k][1] * pg8::bfhi(w); }
        *(LAS unsigned*)((i & 1 ? w1 : w0) + i * 1024) = pg8::cvt_pk_bf16(sc * s0 * sigm(s0), sc * s1 * sigm(s1)); }
}
template <bool B> struct BTag { static constexpr bool value = B; };
__device__ __forceinline__ void c_compute(f32x16& o, LAS unsigned char* lds, int lane, int wave) {
    asm volatile("" : "+v"(lane));
    LAS unsigned char* Vs = lds; LAS unsigned char* Cs = lds + 16384; LAS unsigned char* Qs = lds + 32768; LAS unsigned char* Ks = lds + 40960; LAS float* sm = (LAS float*)(lds + 67584);
    const int r32 = lane & 31, hi = lane >> 5, tt = wave & 1, et = wave >> 1, t = 32 * tt + r32;
    bf16x8 qf[4];
#pragma unroll
    for (int kk = 0; kk < 4; ++kk) qf[kk] = *(const LAS bf16x8*)(Qs + off128r(t, 2 * kk + hi));
    const float bt = (sm[t] - sm[128 + t]) * 1.4426950408889634f, isc = sm[192 + t], mt = sm[128 + t];
    float dq = 0.f;
#pragma unroll
    for (int kk = 0; kk < 4; ++kk) { const u32x4 w = __builtin_bit_cast(u32x4, qf[kk]); f32x4 x0, x1; pg8::unpack8(w, x0, x1); const LAS float* npp = sm + 256 + 16 * kk + 8 * hi;
        dq += x0[0] * npp[0] + x0[1] * npp[1] + x0[2] * npp[2] + x0[3] * npp[3] + x1[0] * npp[4] + x1[1] * npp[5] + x1[2] * npp[6] + x1[3] * npp[7]; }
    o = (f32x16){0.f, 0.f, 0.f, 0.f, 0.f, 0.f, 0.f, 0.f, 0.f, 0.f, 0.f, 0.f, 0.f, 0.f, 0.f, 0.f};
    const int li = lane & 15, cv = (32 * et + 16 * ((lane >> 4) & 1) + 4 * (li & 3)) * 2;
#pragma unroll
    for (int kk = 0; kk < 4; ++kk) { const int rb = 16 * kk + 8 * hi + (li >> 2); const bf16x8 cf = cat8(vtr(Cs + off256(rb, cv)), vtr(Cs + off256(rb + 4, cv)));
        o = __builtin_amdgcn_mfma_f32_32x32x16_bf16(cf, qf[kk], o, 0, 0, 0); }
#pragma unroll
    for (int r = 0; r < 16; ++r) o[r] *= isc;
    float psum = 0.f;
#pragma unroll
    for (int sh = 0; sh < 2; ++sh) { if (sh > tt) continue;
        f32x16 s = {0.f, 0.f, 0.f, 0.f, 0.f, 0.f, 0.f, 0.f, 0.f, 0.f, 0.f, 0.f, 0.f, 0.f, 0.f, 0.f};
#pragma unroll
        for (int kk = 0; kk < 4; ++kk) { const bf16x8 kf = *(const LAS bf16x8*)(Ks + off128r(32 * sh + r32, 2 * kk + hi)); s = __builtin_amdgcn_mfma_f32_32x32x16_bf16(kf, qf[kk], s, 0, 0, 0); }
        f32x4 u4[4];
#pragma unroll
        for (int rr = 0; rr < 4; ++rr) u4[rr] = *(const LAS f32x4*)(sm + 64 + 32 * sh + 8 * rr + 4 * hi);
        if (sh == tt) {
#pragma unroll
            for (int r = 0; r < 16; ++r) { float p = s[r] * __builtin_amdgcn_exp2f(u4[r >> 2][r & 3] + bt); if (8 * (r >> 2) + 4 * hi + (r & 3) > r32) p = 0.f; s[r] = p; psum += p; }
        } else {
#pragma unroll
            for (int r = 0; r < 16; ++r) { const float p = s[r] * __builtin_amdgcn_exp2f(u4[r >> 2][r & 3] + bt); s[r] = p; psum += p; }
        }
#pragma unroll
        for (int ks = 0; ks < 2; ++ks) { const int rb = 32 * sh + 16 * ks + 4 * hi + (li >> 2); const bf16x8 vf = cat8(vtr(Vs + off256(rb, cv)), vtr(Vs + off256(rb + 8, cv)));
            u32x4 w; w.x = pg8::cvt_pk_bf16(s[8 * ks + 0], s[8 * ks + 1]); w.y = pg8::cvt_pk_bf16(s[8 * ks + 2], s[8 * ks + 3]); w.z = pg8::cvt_pk_bf16(s[8 * ks + 4], s[8 * ks + 5]); w.w = pg8::cvt_pk_bf16(s[8 * ks + 6], s[8 * ks + 7]);
            o = __builtin_amdgcn_mfma_f32_32x32x16_bf16(vf, __builtin_bit_cast(bf16x8, w), o, 0, 0, 0); } }
    psum += __shfl_xor(psum, 32); dq += __shfl_xor(dq, 32);
    const float den = isc * dq + psum; const float dv = 1.0f / fmaxf(fabsf(den), fexp(-mt));
    float ss = 0.f;
#pragma unroll
    for (int r = 0; r < 16; ++r) { o[r] *= dv; ss += o[r] * o[r]; }
    ss += __shfl_xor(ss, 32);
    if (hi == 0) sm[320 + et * 64 + t] = ss;
}
__device__ __forceinline__ void c_epilogue(const f32x16& o, LAS unsigned char* lds, const Args& a, int U, int lane, int wave) {
    unsigned char* ws = a.ws; const bf16_t* mo = (const bf16_t*)(ws + WS_MO); LAS float* sm = (LAS float*)(lds + 67584);
    const int r32 = lane & 31, hi = lane >> 5, tt = wave & 1, et = wave >> 1, t = 32 * tt + r32; const int c = U & 127, h = (U >> 7) & 3, b = U >> 9; const size_t t0 = (size_t)b * SEQ + 64 * c;
    const float tot = (sm[320 + t] + sm[384 + t]) + (sm[448 + t] + sm[512 + t]); const float rs = 1.0f / sqrtf(tot * (1.0f / 128.f) + NEPS); const size_t tr = t0 + t;
    const float* onw = a.in[7] + h * 128 + 32 * et + 4 * hi; const bf16_t* mop = mo + tr * 512 + h * 128 + 32 * et + 4 * hi; bf16_t* op = (bf16_t*)(ws + WS_HMON) + tr * 1024 + h * 128 + 32 * et + 4 * hi;
#pragma unroll
    for (int rr = 0; rr < 4; ++rr) { const f32x4 w4 = *(const f32x4*)(onw + 8 * rr); const pg8::u32x2 m2 = *(const pg8::u32x2*)(mop + 8 * rr);
        const float o0 = o[4 * rr] * rs * w4[0] * sigm(pg8::bflo(m2.x)), o1 = o[4 * rr + 1] * rs * w4[1] * sigm(pg8::bfhi(m2.x)), o2 = o[4 * rr + 2] * rs * w4[2] * sigm(pg8::bflo(m2.y)), o3 = o[4 * rr + 3] * rs * w4[3] * sigm(pg8::bfhi(m2.y));
        pg8::u32x2 ov; ov.x = pg8::cvt_pk_bf16(o0, o1); ov.y = pg8::cvt_pk_bf16(o2, o3); *(pg8::u32x2*)(op + 8 * rr) = ov; }
}
__device__ __forceinline__ void phase_c(LAS unsigned char* lds, const Args& a, int G, int cu) {
    int tid = threadIdx.x; asm volatile("" : "+v"(tid)); const int lane = tid & 63, wave = __builtin_amdgcn_readfirstlane(tid >> 6);
    LAS unsigned char* l0 = lds; LAS unsigned char* l1 = lds + 71680;
    for (int U = cu; U < 2048; U += 2 * G) { const int U1 = U + G; const bool two = U1 < 2048;
        { CRegs r0, r1; c_load(r0, a, U, tid); if (two) c_load(r1, a, U1, tid);
          if (wave == 0) { c_gates(l0, a, U, lane); if (two) c_gates(l1, a, U1, lane); }
          c_store(r0, l0, tid); if (two) c_store(r1, l1, tid); }
        __syncthreads();
        c_conv(l0, a, U, tid); if (two) c_conv(l1, a, U1, tid);
        __syncthreads();
        f32x16 o0, o1;
        c_compute(o0, l0, lane, wave); if (two) c_compute(o1, l1, lane, wave);
        __syncthreads();
        c_epilogue(o0, l0, a, U, lane, wave); if (two) c_epilogue(o1, l1, a, U1, lane, wave);
        __syncthreads();
    }
}
}
__device__ __forceinline__ void cmpout_phase(const Args& a, int G, int cu, int tid_) {
    typedef short bf16x8_t __attribute__((ext_vector_type(8)));
    int tid = tid_; asm volatile("" : "+v"(tid));
    unsigned char* ws = a.ws; const bf16_t* hid = (const bf16_t*)(ws + WS_CMPH); bf16_t* cmpb = (bf16_t*)(ws + WS_CMPB);
    const int lane = tid & 63, wave = tid >> 6, rh = wave & 1, ct = wave >> 1, li = lane & 15, kg = lane >> 4;
    for (int rb = cu; rb < 256; rb += G) { const int r0 = 32 * rb + 16 * rh, kv = r0 >> 12; const float* w2 = (kv ? a.in[17] : a.in[14]) + 16 * ct + li;
        const bf16_t* hp = hid + (size_t)(r0 + li) * 256 + 8 * kg;
        f32x4 acc = {0.f, 0.f, 0.f, 0.f};
#pragma unroll
        for (int kk = 0; kk < 8; ++kk) { const u32x4 av = *(const u32x4*)(hp + 32 * kk); const float* w = w2 + (size_t)(32 * kk + 8 * kg) * 64;
            u32x4 bv; bv.x = pg8::cvt_pk_bf16(w[0], w[64]); bv.y = pg8::cvt_pk_bf16(w[128], w[192]); bv.z = pg8::cvt_pk_bf16(w[256], w[320]); bv.w = pg8::cvt_pk_bf16(w[384], w[448]);
            acc = __builtin_amdgcn_mfma_f32_16x16x32_bf16(__builtin_bit_cast(bf16x8_t, av), __builtin_bit_cast(bf16x8_t, bv), acc, 0, 0, 0); }
#pragma unroll
        for (int r = 0; r < 4; ++r) { const int row = r0 + 4 * kg + r; cmpb[(size_t)row * 64 + 16 * ct + li] = (bf16_t)f2bf((row & 511) < NCMP ? acc[r] : 0.f); } }
}
#ifndef PG8_SP2
#define PG8_SP2 true
#endif
#define WSP(T, off) ((T*)(ws + (off)))
__device__ __forceinline__ Ctx make_ctx(unsigned char* lds_raw) {
    Ctx C; C.lds = (LAS unsigned char*)lds_raw; { int t_ = threadIdx.x; asm volatile("" : "+v"(t_)); C.tid = t_; } C.lane = C.tid & 63; C.wave = __builtin_amdgcn_readfirstlane(C.tid >> 6); C.G = gridDim.x;
    C.vcu = blockIdx.x; C.gw = blockIdx.x * 8 + C.wave; C.ngw = C.G * 8; C.gtid = blockIdx.x * 512 + C.tid; C.nthr = C.G * 512; return C; }
__device__ __forceinline__ void run_ph0(unsigned char* lds_raw, const Args& args) { const Ctx C = make_ctx(lds_raw); unsigned char* ws = args.ws;
    phase_prologue(C, args);
#if defined(REPEAT_P0)
    __syncthreads(); phase_prologue(C, args);
#endif
}
__device__ __forceinline__ void run_ph1(unsigned char* lds_raw, const Args& args) { const Ctx C = make_ctx(lds_raw); unsigned char* ws = args.ws;
    { pg8::Gemm g{WSP(bf16_t, WS_XB), WSP(bf16_t, WS_WIN), TT, 3072, 1024, 1024, 128}; pg8::StaticOrder S; S.init(TT, 3072, C.G, (int)blockIdx.x);
      pg8::EpiInProj E{ws, args.in[8], args.in[9], args.in[10], args.in[11]};
      pg8::gemm_phase<pg8::EpiInProj, pg8::StaticOrder, true, PG8_SP2>(C.lds, g, S, E);
#if defined(REPEAT_G17)
      pg8::gemm_phase<pg8::EpiInProj, pg8::StaticOrder, true, PG8_SP2>(C.lds, g, S, E);
#endif
    }
}
__device__ __forceinline__ void run_ph2(unsigned char* lds_raw, const Args& args) { const Ctx C = make_ctx(lds_raw); unsigned char* ws = args.ws;
    { pg8::Gemm g{nullptr, nullptr, 8192, 256, 2048, 2048, 256}; pg8::CmpOrder S{C.G, (int)blockIdx.x, WSP(bf16_t, WS_KC), WSP(bf16_t, WS_VC), WSP(bf16_t, WS_CW1)};
      pg8::EpiCmpHid E{WSP(float, WS_CBIAS), WSP(bf16_t, WS_CMPH)};
      pg8::gemm_phase<pg8::EpiCmpHid, pg8::CmpOrder, true, PG8_SP2>(C.lds, g, S, E);
#if defined(REPEAT_CH)
      pg8::gemm_phase<pg8::EpiCmpHid, pg8::CmpOrder, true, PG8_SP2>(C.lds, g, S, E);
#endif
    }
    if (C.G >= 64) { if ((int)blockIdx.x >= 32) { ml::phase_a(C.lds, args, C.G - 32, (int)blockIdx.x - 32); Ctx C2 = C; C2.gw = C.gw - 32 * 8; C2.ngw = C.ngw - 32 * 8; __syncthreads(); phase_transposes<1>(C2, args); } }
    else { ml::phase_a(C.lds, args, C.G, (int)blockIdx.x); __syncthreads(); phase_transposes<1>(C, args); }
#if defined(REPEAT_ML) || defined(REPEAT_MLA)
    __syncthreads(); if ((int)blockIdx.x >= 32) ml::phase_a(C.lds, args, C.G - 32, (int)blockIdx.x - 32);
#endif
}
__device__ __forceinline__ void run_ph3(unsigned char* lds_raw, const Args& args) { const Ctx C = make_ctx(lds_raw); unsigned char* ws = args.ws;
    cmpout_phase(args, C.G, (int)blockIdx.x, C.tid);
#if defined(REPEAT_CO)
    for (int rep = 0; rep < REPEAT_CO; ++rep) { __syncthreads(); cmpout_phase(args, C.G, (int)blockIdx.x, C.tid); }
#endif
    att::attn_phase<att::M_WIN>(C.lds, args, C.G, (int)blockIdx.x);
    ml::phase_b(args, C.gtid, C.nthr);
#if defined(REPEAT_ML) || defined(REPEAT_MLB)
    ml::phase_b(args, C.gtid, C.nthr);
#endif
}
__device__ __forceinline__ void run_ph4(unsigned char* lds_raw, const Args& args) { const Ctx C = make_ctx(lds_raw); unsigned char* ws = args.ws;
#if !defined(ONLY_MLC)
    att::attn_phase<att::M_CMP>(C.lds, args, C.G, (int)blockIdx.x);
#endif
#if defined(REPEAT_WC) || defined(REPEAT_CMP)
    __syncthreads(); att::attn_phase<att::M_CMP>(C.lds, args, C.G, (int)blockIdx.x, WS_Y);
#endif
    ml::phase_c(C.lds, args, C.G, (int)blockIdx.x);
#if defined(REPEAT_ML) || defined(REPEAT_MLC)
    __syncthreads(); ml::phase_c(C.lds, args, C.G, (int)blockIdx.x);
#endif
}
__device__ __forceinline__ void run_ph5(unsigned char* lds_raw, const Args& args) { const Ctx C = make_ctx(lds_raw); unsigned char* ws = args.ws;
    __syncthreads();
    att::attn_phase<att::M_SLC>(C.lds, args, C.G, (int)blockIdx.x);
#if defined(REPEAT_SLC)
    for (int rep = 0; rep < REPEAT_SLC; ++rep) { __syncthreads(); att::attn_phase<att::M_SLC>(C.lds, args, C.G, (int)blockIdx.x, WS_DC); }
#endif
}
__device__ __forceinline__ void run_ph6(unsigned char* lds_raw, const Args& args) { const Ctx C = make_ctx(lds_raw); unsigned char* ws = args.ws;
    __syncthreads();
    { pg8::Gemm g{WSP(bf16_t, WS_XB), WSP(bf16_t, WS_WG), TT, 2048, 1024, 1024, 128}; pg8::StaticOrder S; S.init(TT, 2048, C.G, (int)blockIdx.x);
      pg8::EpiGate E{WSP(float, WS_RSTD1), args.in[20], (bf16_t*)args.out, (bf16_t*)args.out + (size_t)TT * 1024};
      pg8::gemm_phase<pg8::EpiGate, pg8::StaticOrder, true, PG8_SP2>(C.lds, g, S, E);
#if defined(REPEAT_G4) || defined(REPEAT_P5A)
      pg8::gemm_phase<pg8::EpiGate, pg8::StaticOrder, true, PG8_SP2>(C.lds, g, S, E);
#endif
    }
}
__device__ __forceinline__ void run_ph7(unsigned char* lds_raw, const Args& args) { const Ctx C = make_ctx(lds_raw); unsigned char* ws = args.ws;
    { pg8::Gemm g{WSP(bf16_t, WS_HMON), WSP(bf16_t, WS_WMN), TT, 1024, 1024, 1024, 128}; pg8::StaticOrder S; S.init(TT, 1024, C.G, (int)blockIdx.x);
      pg8::EpiMerge E{(const bf16_t*)args.out, (const bf16_t*)args.out + (size_t)TT * 1024, WSP(bf16_t, WS_Y)};
      pg8::gemm_phase<pg8::EpiMerge, pg8::StaticOrder, true, PG8_SP2>(C.lds, g, S, E);
#if defined(REPEAT_G4) || defined(REPEAT_P5B)
      pg8::gemm_phase<pg8::EpiMerge, pg8::StaticOrder, true, PG8_SP2>(C.lds, g, S, E);
#endif
    }
}
__device__ __forceinline__ void run_ph8(unsigned char* lds_raw, const Args& args) { const Ctx C = make_ctx(lds_raw); unsigned char* ws = args.ws;
    { pg8::Gemm g{WSP(bf16_t, WS_Y), WSP(bf16_t, WS_WOUT), TT, 1024, 1024, 1024, 128}; pg8::StaticOrder S; S.init(TT, 1024, C.G, (int)blockIdx.x);
      pg8::EpiWout E{args.in[0], args.out, WSP(bf16_t, WS_XB), WSP(float, WS_SSQ2)};
      pg8::gemm_phase<pg8::EpiWout, pg8::StaticOrder, true, PG8_SP2>(C.lds, g, S, E);
#if defined(REPEAT_G4) || defined(REPEAT_P6)
      pg8::gemm_phase<pg8::EpiWout, pg8::StaticOrder, true, PG8_SP2>(C.lds, g, S, E);
#endif
    }
}
__device__ __forceinline__ void run_ph9(unsigned char* lds_raw, const Args& args) { const Ctx C = make_ctx(lds_raw); unsigned char* ws = args.ws;
    { pg8::Gemm g{WSP(bf16_t, WS_XB), WSP(bf16_t, WS_WUP), TT, 5632, 1024, 1024, 128}; pg8::StaticOrder S; S.init(TT, 5632, C.G, (int)blockIdx.x);
      pg8::EpiFfnUp E{WSP(float, WS_SSQ2), args.in[24], args.in[25], WSP(bf16_t, WS_MID), WSP(float, WS_EDGEA), WSP(float, WS_EDGEV), (LAS float*)(C.lds + LDS_EX)};
      pg8::gemm_phase<pg8::EpiFfnUp, pg8::StaticOrder, true, PG8_SP2>(C.lds, g, S, E);
#if defined(REPEAT_G17)
      pg8::gemm_phase<pg8::EpiFfnUp, pg8::StaticOrder, true, PG8_SP2>(C.lds, g, S, E);
#endif
    }
}
__device__ __forceinline__ void run_ph11(unsigned char* lds_raw, const Args& args) { const Ctx C = make_ctx(lds_raw); unsigned char* ws = args.ws;
    { pg8::Gemm g{WSP(bf16_t, WS_MID), WSP(bf16_t, WS_WDN), TT, 1024, 2816, 2816, 128}; pg8::StaticOrder S; S.init(TT, 1024, C.G, (int)blockIdx.x);
      { pg8::Unit u; int pl = -1; for (int i = 0; S.next(i, u); ++i) if (u.pm != pl) { p7b_fixup_panel(C, args, u.pm); pl = u.pm; } }
      __syncthreads();
#if defined(REPEAT_G4) || defined(REPEAT_P8)
      { pg8::EpiFfnDown E0{WSP(bf16_t, WS_XB), WSP(float, WS_HMON)}; pg8::gemm_phase<pg8::EpiFfnDown, pg8::StaticOrder, true, PG8_SP2>(C.lds, g, S, E0); }
#endif
      pg8::EpiFfnDown E{WSP(bf16_t, WS_XB), args.out};
      pg8::gemm_phase<pg8::EpiFfnDown, pg8::StaticOrder, true, PG8_SP2>(C.lds, g, S, E); }
}
__device__ __forceinline__ void run_rstd2(const Args& args) {
    const float* ssq = (const float*)(args.ws + WS_SSQ2); float* r2 = (float*)(args.ws + WS_RSTD1);
    for (int t = blockIdx.x * 512 + threadIdx.x; t < TT; t += gridDim.x * 512) { const f32x4* sp = (const f32x4*)(ssq + (size_t)t * 16); const f32x4 s0 = sp[0], s1 = sp[1], s2 = sp[2], s3 = sp[3];
        const float ss = ((s0[0] + s0[1]) + (s0[2] + s0[3])) + ((s1[0] + s1[1]) + (s1[2] + s1[3])) + ((s2[0] + s2[1]) + (s2[2] + s2[3])) + ((s3[0] + s3[1]) + (s3[2] + s3[3]));
        r2[t] = 1.0f / sqrtf(ss * (1.0f / 1024.0f) + NEPS); }
}
constexpr int NPHASE = 12;
#ifndef SPLIT_TEST
__global__ void __launch_bounds__(512, 2) mega_fwd(Args args) {
    extern __shared__ __attribute__((aligned(16))) unsigned char lds_raw[];
#if defined(USE_CG_SYNC)
    cg::grid_group grid = cg::this_grid();
#endif
    volatile LAS unsigned* xst = (volatile LAS unsigned*)((LAS unsigned char*)lds_raw + LDS_XB);
    if (threadIdx.x < 2) xst[threadIdx.x] = 0u;
    __syncthreads();
    (void)xcd_barrier_post((unsigned*)(args.ws + WS_CTL) + 4096, xst);
#define GRID_BAR() do { XcdBarrier b_; b_.bar = (unsigned*)(args.ws + WS_CTL) + 4096; b_.x = xb_xcc_id(); b_.st = (volatile LAS unsigned*)((LAS unsigned char*)lds_raw + LDS_XB); xcd_barrier(b_); } while (0)
#if defined(PROBE_TS)
#define TS(i) do { if (blockIdx.x == 0 && threadIdx.x == 0) ((unsigned long long*)(args.ws + WS_CTL))[64 + (i)] = __builtin_amdgcn_s_memrealtime(); } while (0)
#else
#define TS(i) do {} while (0)
#endif
    TS(0);
    run_ph0(lds_raw, args);
#if defined(USE_CG_SYNC)
    grid.sync();
#else
    GRID_BAR();
#endif
    TS(1);
    run_ph1(lds_raw, args);
    GRID_BAR();
    TS(2);
    run_ph2(lds_raw, args);
    GRID_BAR();
    TS(3);
    run_ph3(lds_raw, args);
    GRID_BAR();
    TS(4);
    run_ph4(lds_raw, args);
    TS(5);
    run_ph5(lds_raw, args);
#if defined(EXTRA_BARS)
    for (int eb = 0; eb < EXTRA_BARS; ++eb) GRID_BAR();
#endif
    TS(6);
    run_ph6(lds_raw, args);
    GRID_BAR();
    TS(7);
    run_ph7(lds_raw, args);
    GRID_BAR();
    TS(8);
    run_ph8(lds_raw, args);
    GRID_BAR();
    TS(9);
    run_ph9(lds_raw, args);
    GRID_BAR();
    TS(10);
    TS(11);
    run_ph11(lds_raw, args);
    TS(12);
#if defined(PROBE_TS)
    GRID_BAR();
    { const unsigned long long* ts = (const unsigned long long*)(args.ws + WS_CTL) + 64; const float f = (float)(ts[PROBE_TS] - ts[0]) / (float)(ts[12] - ts[0]); const float sc = 1.0f + sqrtf(f);
      for (int i = blockIdx.x * 512 + threadIdx.x; i < TT * DM; i += gridDim.x * 512) args.out[i] *= sc; }
#endif
}
#else
__global__ void __launch_bounds__(512, 2) ph0_k(Args args) { extern __shared__ __attribute__((aligned(16))) unsigned char lds_raw[]; run_ph0(lds_raw, args); }
__global__ void __launch_bounds__(512, 2) ph1_k(Args args) { extern __shared__ __attribute__((aligned(16))) unsigned char lds_raw[]; run_ph1(lds_raw, args); }
__global__ void __launch_bounds__(512, 2) ph2_k(Args args) { extern __shared__ __attribute__((aligned(16))) unsigned char lds_raw[]; run_ph2(lds_raw, args); }
__global__ void __launch_bounds__(512, 2) ph3_k(Args args) { extern __shared__ __attribute__((aligned(16))) unsigned char lds_raw[]; run_ph3(lds_raw, args); }
__global__ void __launch_bounds__(512, 2) ph4_k(Args args) { extern __shared__ __attribute__((aligned(16))) unsigned char lds_raw[]; run_ph4(lds_raw, args); }
__global__ void __launch_bounds__(512, 2) ph5_k(Args args) { extern __shared__ __attribute__((aligned(16))) unsigned char lds_raw[]; run_ph5(lds_raw, args); }
__global__ void __launch_bounds__(512, 2) ph6_k(Args args) { extern __shared__ __attribute__((aligned(16))) unsigned char lds_raw[]; run_ph6(lds_raw, args); }
__global__ void __launch_bounds__(512, 2) ph7_k(Args args) { extern __shared__ __attribute__((aligned(16))) unsigned char lds_raw[]; run_ph7(lds_raw, args); }
__global__ void __launch_bounds__(512, 2) ph8_k(Args args) { extern __shared__ __attribute__((aligned(16))) unsigned char lds_raw[]; run_ph8(lds_raw, args); }
__global__ void __launch_bounds__(512, 2) ph9_k(Args args) { extern __shared__ __attribute__((aligned(16))) unsigned char lds_raw[]; run_ph9(lds_raw, args); }
__global__ void __launch_bounds__(512, 2) ph11_k(Args args) { extern __shared__ __attribute__((aligned(16))) unsigned char lds_raw[]; run_ph11(lds_raw, args); }
__global__ void __launch_bounds__(512, 2) rstd2_k(Args args) { run_rstd2(args); }
__global__ void __launch_bounds__(512, 2) mega_fwd(Args args) {}
#endif
extern "C" void kernel_launch(void* const* d_in, const int* in_sizes, int n_in, void* d_out, int out_size, void* d_ws, size_t ws_size, hipStream_t stream) {
    static int grid = 0;
    if (grid == 0) {
        if (n_in != 27 || out_size != TT * DM || ws_size < WS_END) { fprintf(stderr, "kernel_launch: unexpected shapes (n_in %d out %d ws %zu)\n", n_in, out_size, ws_size); grid = -1; return; }
        int dev = 0, cus = 0, per_cu = 0;
        hipGetDevice(&dev); hipDeviceGetAttribute(&cus, hipDeviceAttributeMultiprocessorCount, dev);
        hipFuncSetAttribute((const void*)mega_fwd, hipFuncAttributeMaxDynamicSharedMemorySize, LDS_BYTES);
        hipOccupancyMaxActiveBlocksPerMultiprocessor(&per_cu, (const void*)mega_fwd, 512, LDS_BYTES);
        if (per_cu < 1) { fprintf(stderr, "kernel_launch: occupancy query says %d blocks per CU\n", per_cu); grid = -1; return; }
        grid = cus * 1;
    }
    if (grid < 0) return;
    hipMemsetAsync((char*)d_ws + WS_CTL, 0, 1 * MiB, stream);
    Args a{}; for (int i = 0; i < 27; ++i) a.in[i] = (const float*)d_in[i]; a.out = (float*)d_out; a.ws = (unsigned char*)d_ws;
    for (int j = 0; j < 32; ++j) a.rope_inv[j] = (float)pow(10000.0, -(double)j / 32.0);
    void* kargs[] = {&a};
    hipError_t e = hipLaunchCooperativeKernel((const void*)mega_fwd, dim3(grid), dim3(512), kargs, LDS_BYTES, stream);
    if (e != hipSuccess) fprintf(stderr, "cooperative launch failed: %s (grid %d)\n", hipGetErrorString(e), grid);
#if defined(REPEAT_LAUNCH)
    for (int rl = 0; rl < REPEAT_LAUNCH; ++rl) { hipMemsetAsync((char*)d_ws + WS_CTL, 0, 1 * MiB, stream); hipLaunchCooperativeKernel((const void*)mega_fwd, dim3(grid), dim3(512), kargs, LDS_BYTES, stream); }
#endif
}
```

```cpp
#include <hip/hip_runtime.h>
#include <hip/hip_cooperative_groups.h>
#include <cstdio>
#include <cstdint>
#include <cmath>
namespace cg = cooperative_groups;
constexpr int NB = 4, DM = 1024, DIN = 4896, DFF = 2816, NCMP = 511, NSEL = 128;
constexpr int C_MQ = 0, C_MK = 256, C_MV = 512, C_MO = 1024, C_MI = 1536, C_MF = 1540, C_NQ = 1544, C_KC = 2056, C_VC = 2184, C_KS = 2312, C_VS = 2440, C_KW = 2568, C_VW = 2696, C_NG = 2824, C_GM = 2848;
constexpr size_t MiB = 1u << 20;
constexpr size_t WS_CTL = 0;
constexpr size_t WS_ROPEC = 1 * MiB, WS_ROPES = 2 * MiB, WS_RSTD1 = 3 * MiB, WS_SSQ2 = 4 * MiB, WS_SMALLG = 6 * MiB, WS_SEL = 10 * MiB, WS_CMPB = 11 * MiB, WS_CBIAS = 12 * MiB;
constexpr size_t WS_EDGEA = 13 * MiB, WS_EDGEV = 19 * MiB, WS_IPRE = 22 * MiB, WS_LOGF = 22 * MiB + 524288, WS_MLS = 23 * MiB;
constexpr size_t WS_WIN = 24 * MiB  , WS_WG = 30 * MiB  , WS_WMN = 34 * MiB, WS_WOUT = 36 * MiB, WS_WUP = 38 * MiB, WS_WDN = 49 * MiB, WS_CW1 = 55 * MiB;
constexpr size_t WS_XB = 60 * MiB;
constexpr size_t WS_QKPRE = 124 * MiB, WS_MV = 156 * MiB, WS_MO = 188 * MiB, WS_NQ = 220 * MiB, WS_KC = 252 * MiB, WS_KS = 260 * MiB, WS_KW = 268 * MiB, WS_VC = 276 * MiB, WS_VS = 284 * MiB, WS_VW = 292 * MiB;
constexpr size_t WS_HMON = 300 * MiB;
constexpr size_t WS_DC = 364 * MiB, WS_CPREV = 428 * MiB, WS_CMPH = 492 * MiB;
constexpr size_t WS_Y = 124 * MiB;
constexpr size_t WS_MID = 124 * MiB;
constexpr size_t WS_END = 500 * MiB;
constexpr size_t WS_QKF = 364 * MiB  , WS_HRAW = 428 * MiB  , WS_IMP = 364 * MiB  , WS_IDX = 396 * MiB  ;
constexpr int RING_BYTES = 131072, LDS_EX = RING_BYTES  , LDS_BYTES = 147456, LDS_XB = 147456 - 64  ;

namespace pg8 {
#define PG8_LAS __attribute__((address_space(3)))
typedef unsigned short bf16_t;
typedef short bf16x8 __attribute__((ext_vector_type(8)));
typedef float f32x4 __attribute__((ext_vector_type(4)));
typedef unsigned u32x4 __attribute__((ext_vector_type(4)));
constexpr int BM = 256, BK = 64, HALF = 128, HTB = HALF * BK * 2  , STAGE_BYTES = 8 * HTB, NXCD = 8, WGM = 8;

__host__ __device__ __forceinline__ int lds_byte(int r, int c) { const int st = (r >> 4) * 2 + (c >> 5), rr = r & 15, cc = c & 31, ob = rr * 64 + cc * 2; return st * 1024 + (ob ^ (((ob >> 9) & 1) << 5)); }
__host__ __device__ __forceinline__ void stage_rc(int b, int& R, int& C) { const int st = b / 1024, sb = b % 1024, swz = sb ^ (((sb >> 9) & 1) << 5); R = (st >> 1) * 16 + swz / 64; C = (st & 1) * 32 + (swz % 64) / 2; }
__host__ __device__ __forceinline__ int perm32(int rho) { const int n = rho >> 4, i = rho & 15; return 8 * (i >> 2) + 4 * n + (i & 3); }

struct Unit { int pm, pn; };
struct Gemm { const bf16_t* A; const bf16_t* Bt; int M, N, K; int lda; int ksA; };

struct StaticOrder {
    int nM, nN, nwg, G, c;
    __host__ __device__ void init(int M, int N, int G_, int c_) { nM = M / BM; nN = N / BM; nwg = nM * nN; G = G_; c = c_; }
    __host__ __device__ bool next(int i, Unit& u) const {
        const long L = (long)i * G + c; if (L >= nwg) return false;
        int wgid = (int)L; { const int q = nwg / NXCD, r = nwg % NXCD, xcd = wgid % NXCD, off = wgid / NXCD; wgid = (xcd < r ? xcd * (q + 1) : r * (q + 1) + (xcd - r) * q) + off; }
        const int nig = WGM * nN, gid = wgid / nig, fm = gid * WGM, gsz = (nM - fm) < WGM ? (nM - fm) : WGM;
        u.pm = fm + ((wgid % nig) % gsz); u.pn = (wgid % nig) / gsz; return true;
    }
    __device__ __forceinline__ const char* a_ptr(const Gemm& g, const Unit& u) const { return (const char*)g.A + (size_t)u.pm * BM * g.lda * 2; }
    __device__ __forceinline__ const char* b_ptr(const Gemm& g, const Unit& u) const { return (const char*)g.Bt + (size_t)u.pn * BM * g.K * 2; }
    __device__ __forceinline__ void a_ready(const Unit&) const {}
    __device__ __forceinline__ void done(const Unit&) const {}
};

typedef float f32x2_cv __attribute__((ext_vector_type(2))); typedef __bf16 bf16x2_cv __attribute__((ext_vector_type(2)));
__device__ __forceinline__ unsigned cvt_pk_bf16(float lo, float hi) { const f32x2_cv v = {lo, hi}; const bf16x2_cv b = __builtin_convertvector(v, bf16x2_cv); return __builtin_bit_cast(unsigned, b); }
typedef float f32x2 __attribute__((ext_vector_type(2)));
__device__ __forceinline__ f32x2 gelu_pk(f32x2 v) {
    const f32x2 av = __builtin_elementwise_abs(v), d = av * 0.2316418882f + 1.0f;
    f32x2 t; t.x = __builtin_amdgcn_rcpf(d.x); t.y = __builtin_amdgcn_rcpf(d.y);
    f32x2 q = t * 0.5307027145f + (-0.7265760135f); q = q * t + 0.7107068705f; q = q * t + (-0.142248368f); q = q * t + 0.127414796f; q = q * t;
    const f32x2 s = (v * v) * (-0.72134752044f);
    f32x2 e; e.x = __builtin_amdgcn_exp2f(s.x); e.y = __builtin_amdgcn_exp2f(s.y);
    const f32x2 mx = {fmaxf(v.x, 0.f), fmaxf(v.y, 0.f)};
    return mx - av * (q * e);
}

constexpr int TT = 32768, SEQ = 8192;
constexpr float NEPS = 1e-6f;
constexpr float QC2 = 0.125f * 1.4426950408889634f;
typedef unsigned u32x2 __attribute__((ext_vector_type(2)));
__device__ __forceinline__ float bf2f(unsigned short v) { return __uint_as_float((unsigned)v << 16); }
__device__ __forceinline__ float bflo(unsigned w) { return __uint_as_float(w << 16); }
__device__ __forceinline__ float bfhi(unsigned w) { return __uint_as_float(w & 0xffff0000u); }
__device__ __forceinline__ float sigm(float x) { return __builtin_amdgcn_rcpf(1.0f + __builtin_amdgcn_exp2f(-1.4426950408889634f * x)); }
__device__ __forceinline__ u32x4 pack8(const f32x4& a, const f32x4& b) { u32x4 w; w.x = cvt_pk_bf16(a[0], a[1]); w.y = cvt_pk_bf16(a[2], a[3]); w.z = cvt_pk_bf16(b[0], b[1]); w.w = cvt_pk_bf16(b[2], b[3]); return w; }
__device__ __forceinline__ void unpack8(const u32x4& w, f32x4& a, f32x4& b) { a = (f32x4){bflo(w.x), bfhi(w.x), bflo(w.y), bfhi(w.y)}; b = (f32x4){bflo(w.z), bfhi(w.z), bflo(w.w), bfhi(w.w)}; }


struct EpiInProj {
    static constexpr bool PERM = true, AFTER_DRAIN = false, HAS_MID = false;
    unsigned char* ws; const float *qnw, *kcw, *ksw, *kww;
    __device__ __forceinline__ void mid(f32x4 (&)[2][2][4][2], const Unit&, int, int, int, int) const {}
    __device__ __forceinline__ void operator()(f32x4 (&acc)[2][2][4][2], const Unit& u, int wr, int wc, int fr, int fq_) const {
        int fq = fq_; asm volatile("" : "+v"(fq));
        const int pn = u.pn; int row0 = u.pm * BM + wr * 64 + fr; asm volatile("" : "+v"(row0));
        const float* rstd = (const float*)(ws + WS_RSTD1); const float* rope_c = (const float*)(ws + WS_ROPEC); const float* rope_s = (const float*)(ws + WS_ROPES);
        float rsv[8];
#pragma unroll
        for (int g = 0; g < 8; ++g) rsv[g] = rstd[row0 + (g >> 2) * HALF + (g & 3) * 16];
        if (pn < 6) {
            bf16_t* base = (bf16_t*)(ws + (pn < 2 ? WS_QKPRE : pn < 4 ? WS_MV : WS_MO)); const int col0 = (pn & 1) * 256 + wc * 32 + 8 * fq;
#pragma unroll
            for (int ai = 0; ai < 2; ++ai)
#pragma unroll
                for (int m = 0; m < 4; ++m) { const int row = row0 + ai * HALF + m * 16; const float rs = rsv[ai * 4 + m]; bf16_t* rowp = base + (size_t)row * 512 + col0;
#pragma unroll
                    for (int bj = 0; bj < 2; ++bj) *(u32x4*)(rowp + bj * HALF) = pack8(acc[ai][bj][m][0] * rs, acc[ai][bj][m][1] * rs); }
        } else if (pn < 11) {
            bf16_t* dst; int ld; const float* nw = nullptr; float osc = 1.0f;
            if (pn < 8) { dst = (bf16_t*)(ws + WS_NQ) + (4 * (pn - 6) + wc) * 64; ld = 512; nw = qnw; osc = QC2; }
            else { const int seg = (pn - 8) * 2 + (wc >> 1);
                const size_t so = seg == 0 ? WS_KC : seg == 1 ? WS_KS : seg == 2 ? WS_KW : seg == 3 ? WS_VC : seg == 4 ? WS_VS : WS_VW;
                dst = (bf16_t*)(ws + so) + (wc & 1) * 64; ld = 128; nw = seg == 0 ? kcw : seg == 1 ? ksw : seg == 2 ? kww : nullptr; }
            f32x4 w0[2] = {{1.f, 1.f, 1.f, 1.f}, {1.f, 1.f, 1.f, 1.f}}, w1[2] = {{1.f, 1.f, 1.f, 1.f}, {1.f, 1.f, 1.f, 1.f}};
            if (nw) {
#pragma unroll
                for (int n = 0; n < 2; ++n) { w0[n] = *(const f32x4*)(nw + 8 * fq + 4 * n); w1[n] = *(const f32x4*)(nw + 32 + 8 * fq + 4 * n); } }
            f32x4 cs[2][4];
            if (nw) { const int tp = row0 & (SEQ - 1); cs[0][0] = *(const f32x4*)(rope_c + tp * 32 + 8 * fq); cs[0][1] = *(const f32x4*)(rope_c + tp * 32 + 8 * fq + 4); cs[0][2] = *(const f32x4*)(rope_s + tp * 32 + 8 * fq); cs[0][3] = *(const f32x4*)(rope_s + tp * 32 + 8 * fq + 4); }
#pragma unroll
            for (int g = 0; g < 8; ++g) { const int ai = g >> 2, m = g & 3; const int row = row0 + ai * HALF + m * 16; const float rs = rsv[g];
                if (nw && g < 7) { const int tn = (row0 + ((g + 1) >> 2) * HALF + ((g + 1) & 3) * 16) & (SEQ - 1); f32x4 (&nx)[4] = cs[(g + 1) & 1];
                    nx[0] = *(const f32x4*)(rope_c + tn * 32 + 8 * fq); nx[1] = *(const f32x4*)(rope_c + tn * 32 + 8 * fq + 4); nx[2] = *(const f32x4*)(rope_s + tn * 32 + 8 * fq); nx[3] = *(const f32x4*)(rope_s + tn * 32 + 8 * fq + 4); }
#pragma unroll
                for (int n = 0; n < 2; ++n) { acc[ai][0][m][n] = acc[ai][0][m][n] * rs; acc[ai][1][m][n] = acc[ai][1][m][n] * rs; }
                if (nw) {
                    float s = 0.f;
#pragma unroll
                    for (int n = 0; n < 2; ++n)
#pragma unroll
                        for (int e = 0; e < 4; ++e) s += acc[ai][0][m][n][e] * acc[ai][0][m][n][e] + acc[ai][1][m][n][e] * acc[ai][1][m][n][e];
                    s += __shfl_xor(s, 16); s += __shfl_xor(s, 32);
                    const float rn = 1.0f / sqrtf(s * (1.0f / 64.0f) + NEPS); const f32x4 (&cc)[4] = cs[g & 1];
#pragma unroll
                    for (int n = 0; n < 2; ++n) { const f32x4 a = acc[ai][0][m][n] * rn * w0[n], b = acc[ai][1][m][n] * rn * w1[n]; acc[ai][0][m][n] = (a * cc[n] - b * cc[2 + n]) * osc; acc[ai][1][m][n] = (b * cc[n] + a * cc[2 + n]) * osc; }
                }
                bf16_t* rowp = dst + (size_t)row * ld + 8 * fq;
                *(u32x4*)(rowp) = pack8(acc[ai][0][m][0], acc[ai][0][m][1]); *(u32x4*)(rowp + 32) = pack8(acc[ai][1][m][0], acc[ai][1][m][1]); asm volatile("" ::: "memory"); }
        } else {
            if (wc == 0) {
#pragma unroll
                for (int ai = 0; ai < 2; ++ai)
#pragma unroll
                    for (int m = 0; m < 4; ++m) { const int row = row0 + ai * HALF + m * 16; const float rs = rsv[ai * 4 + m]; float* rowp = (float*)(ws + WS_SMALLG) + (size_t)row * 32 + 8 * fq;
                        *(f32x4*)(rowp) = acc[ai][0][m][0] * rs; *(f32x4*)(rowp + 4) = acc[ai][0][m][1] * rs; }
            }
        }
    }
};
struct EpiGate {
    static constexpr bool PERM = true, AFTER_DRAIN = false, HAS_MID = false;
    const float* rstd; const float* bias  ; bf16_t* gr; bf16_t* gn;
    __device__ __forceinline__ void mid(f32x4 (&)[2][2][4][2], const Unit&, int, int, int, int) const {}
    __device__ __forceinline__ void operator()(f32x4 (&acc)[2][2][4][2], const Unit& u, int wr, int wc, int fr, int fq) const {
        int row0 = u.pm * BM + wr * 64 + fr; asm volatile("" : "+v"(row0)); const int col0 = u.pn * 128 + wc * 32 + 8 * fq; const float* bp = bias + col0;
        f32x4 bv[2][2];
#pragma unroll
        for (int bj = 0; bj < 2; ++bj)
#pragma unroll
            for (int n = 0; n < 2; ++n) bv[bj][n] = *(const f32x4*)(bp + bj * 1024 + 4 * n);
        float rsv[8];
#pragma unroll
        for (int g = 0; g < 8; ++g) rsv[g] = rstd[row0 + (g >> 2) * HALF + (g & 3) * 16];
#pragma unroll
        for (int ai = 0; ai < 2; ++ai)
#pragma unroll
            for (int m = 0; m < 4; ++m) { const int row = row0 + ai * HALF + m * 16; const float rs = rsv[ai * 4 + m]; const size_t off = (size_t)row * 1024 + col0;
                f32x4 r[2], q[2];
#pragma unroll
                for (int n = 0; n < 2; ++n) { const f32x4 vm = acc[ai][0][m][n] * rs + bv[0][n], vn = acc[ai][1][m][n] * rs + bv[1][n];
#pragma unroll
                    for (int e = 0; e < 4; ++e) { const float gmv = sigm(vm[e]), gnv = sigm(vn[e]); q[n][e] = gnv; r[n][e] = gmv * __builtin_amdgcn_rcpf(fmaxf(gnv, 1e-30f)); } }
                *(u32x4*)(gr + off) = pack8(r[0], r[1]); *(u32x4*)(gn + off) = pack8(q[0], q[1]); }
    }
};
struct EpiMerge {
    static constexpr bool PERM = true, AFTER_DRAIN = false, HAS_MID = true;
    const bf16_t* gr; const bf16_t* gn; bf16_t* y;
    __device__ __forceinline__ void mid(f32x4 (&acc)[2][2][4][2], const Unit& u, int wr, int wc, int fr, int fq) const {
        int row0 = u.pm * BM + wr * 64 + fr; asm volatile("" : "+v"(row0)); const int col0 = u.pn * BM + wc * 32 + 8 * fq;
        u32x4 gq[4][2];
#pragma unroll
        for (int g = 0; g < 3; ++g) { const size_t off = (size_t)(row0 + (g >> 2) * HALF + (g & 3) * 16) * 1024 + col0; gq[g][0] = *(const u32x4*)(gr + off); gq[g][1] = *(const u32x4*)(gr + off + HALF); }
#pragma unroll
        for (int g = 0; g < 8; ++g) { const int ai = g >> 2, m = g & 3;
            if (g + 3 < 8) { const size_t off = (size_t)(row0 + ((g + 3) >> 2) * HALF + ((g + 3) & 3) * 16) * 1024 + col0; gq[(g + 3) & 3][0] = *(const u32x4*)(gr + off); gq[(g + 3) & 3][1] = *(const u32x4*)(gr + off + HALF); }
#pragma unroll
            for (int bj = 0; bj < 2; ++bj) { f32x4 a0, a1; unpack8(gq[g & 3][bj], a0, a1); acc[ai][bj][m][0] = acc[ai][bj][m][0] * a0; acc[ai][bj][m][1] = acc[ai][bj][m][1] * a1; }
            asm volatile("" : "+v"(acc[ai][0][m][0]), "+v"(acc[ai][0][m][1]), "+v"(acc[ai][1][m][0]), "+v"(acc[ai][1][m][1]) :: "memory"); }
    }
    __device__ __forceinline__ void operator()(f32x4 (&acc)[2][2][4][2], const Unit& u, int wr, int wc, int fr, int fq) const {
        int row0 = u.pm * BM + wr * 64 + fr; asm volatile("" : "+v"(row0)); const int col0 = u.pn * BM + wc * 32 + 8 * fq;
        u32x4 gq[2][2];
        { const size_t off = (size_t)row0 * 1024 + col0; gq[0][0] = *(const u32x4*)(gn + off); gq[0][1] = *(const u32x4*)(gn + off + HALF); }
#pragma unroll
        for (int g = 0; g < 8; ++g) { const int ai = g >> 2, m = g & 3; const size_t off = (size_t)(row0 + ai * HALF + m * 16) * 1024 + col0;
            if (g < 7) { const size_t offn = (size_t)(row0 + ((g + 1) >> 2) * HALF + ((g + 1) & 3) * 16) * 1024 + col0; gq[(g + 1) & 1][0] = *(const u32x4*)(gn + offn); gq[(g + 1) & 1][1] = *(const u32x4*)(gn + offn + HALF); }
#pragma unroll
            for (int bj = 0; bj < 2; ++bj) { f32x4 b0, b1; unpack8(gq[g & 1][bj], b0, b1); *(u32x4*)(y + off + bj * HALF) = pack8(acc[ai][bj][m][0] * b0, acc[ai][bj][m][1] * b1); }
            asm volatile("" ::: "memory"); }
    }
};
struct EpiWout {
    static constexpr bool PERM = true, AFTER_DRAIN = false, HAS_MID = false;
    const float* x; float* x1; bf16_t* x1b; float* ssq  ;
    __device__ __forceinline__ void mid(f32x4 (&)[2][2][4][2], const Unit&, int, int, int, int) const {}
    __device__ __forceinline__ void operator()(f32x4 (&acc)[2][2][4][2], const Unit& u, int wr, int wc, int fr, int fq) const {
        int row0 = u.pm * BM + wr * 64 + fr; asm volatile("" : "+v"(row0)); const int col0 = u.pn * BM + wc * 32 + 8 * fq;
        f32x4 xv[2][4];
        { const float* p = x + (size_t)row0 * 1024 + col0; xv[0][0] = *(const f32x4*)(p); xv[0][1] = *(const f32x4*)(p + 4); xv[0][2] = *(const f32x4*)(p + HALF); xv[0][3] = *(const f32x4*)(p + HALF + 4); }
#pragma unroll
        for (int g = 0; g < 8; ++g) { const int ai = g >> 2, m = g & 3; const int row = row0 + ai * HALF + m * 16; const size_t off = (size_t)row * 1024 + col0; float s = 0.f;
            if (g < 7) { const float* p = x + (size_t)(row0 + ((g + 1) >> 2) * HALF + ((g + 1) & 3) * 16) * 1024 + col0; f32x4 (&nx)[4] = xv[(g + 1) & 1];
                nx[0] = *(const f32x4*)(p); nx[1] = *(const f32x4*)(p + 4); nx[2] = *(const f32x4*)(p + HALF); nx[3] = *(const f32x4*)(p + HALF + 4); }
#pragma unroll
            for (int bj = 0; bj < 2; ++bj) { const f32x4 v0 = xv[g & 1][2 * bj] + acc[ai][bj][m][0], v1 = xv[g & 1][2 * bj + 1] + acc[ai][bj][m][1];
                *(u32x4*)(x1b + off + bj * HALF) = pack8(v0, v1);
#pragma unroll
                for (int e = 0; e < 4; ++e) s += v0[e] * v0[e] + v1[e] * v1[e]; }
            s += __shfl_xor(s, 16); s += __shfl_xor(s, 32);
            if (fq == 0) ssq[(size_t)row * 16 + u.pn * 4 + wc] = s;
            asm volatile("" ::: "memory"); }
    }
};
__device__ __forceinline__ float dpp_shr(float old, float v, int n) { return n == 1 ? __builtin_bit_cast(float, __builtin_amdgcn_update_dpp(__builtin_bit_cast(int, old), __builtin_bit_cast(int, v), 0x111, 0xf, 0xf, false))
                                                                                       : __builtin_bit_cast(float, __builtin_amdgcn_update_dpp(__builtin_bit_cast(int, old), __builtin_bit_cast(int, v), 0x112, 0xf, 0xf, false)); }
__device__ __forceinline__ float dpp_shl15(float v) { return __builtin_bit_cast(float, __builtin_amdgcn_update_dpp(0, __builtin_bit_cast(int, v), 0x10F, 0xf, 0xf, true)); }
__device__ __forceinline__ float dpp_shl14(float v) { return __builtin_bit_cast(float, __builtin_amdgcn_update_dpp(0, __builtin_bit_cast(int, v), 0x10E, 0xf, 0xf, true)); }
struct EpiFfnUp {
    static constexpr bool PERM = true, AFTER_DRAIN = false, HAS_MID = false;
    const float* ssq; const float* cw  ; const float* cb; bf16_t* midb; float* edgeA  ; float* edgeV  ; PG8_LAS float* ex  ;
    __device__ __forceinline__ void mid(f32x4 (&)[2][2][4][2], const Unit&, int, int, int, int) const {}
    __device__ __forceinline__ void operator()(f32x4 (&acc)[2][2][4][2], const Unit& u, int wr, int wc, int fr, int fq) const {
        constexpr int FF = 2816;
        int row0 = u.pm * BM + wr * 64 + fr; asm volatile("" : "+v"(row0)); const int cl = wc * 32 + 8 * fq, col0 = u.pn * 128 + cl;
        { const float* sp = ssq + (size_t)row0 * 16 + 4 * fq;
#pragma unroll
          for (int ai = 0; ai < 2; ++ai) { float rsv[4];
#pragma unroll
              for (int m = 0; m < 4; ++m) { const f32x4 p = *(const f32x4*)(sp + (size_t)(ai * HALF + m * 16) * 16); rsv[m] = (p[0] + p[1]) + (p[2] + p[3]); }
#pragma unroll
              for (int m = 0; m < 4; ++m) { rsv[m] += __shfl_xor(rsv[m], 16); rsv[m] += __shfl_xor(rsv[m], 32); rsv[m] = __builtin_amdgcn_rsqf(rsv[m] * (1.0f / 1024.0f) + NEPS); }
#pragma unroll
              for (int m = 0; m < 4; ++m) {
#pragma unroll
                  for (int n = 0; n < 2; ++n) { acc[ai][0][m][n] = acc[ai][0][m][n] * rsv[m]; acc[ai][1][m][n] = acc[ai][1][m][n] * rsv[m]; } }
              asm volatile("" ::: "memory"); } }
#pragma unroll
        for (int ai = 0; ai < 2; ++ai) { const int s = ai * 2 + wr;
            if (fr >= 14) { PG8_LAS float* p = ex + (s * 2 + (fr - 14)) * 128 + cl; *(PG8_LAS f32x4*)(p) = acc[ai][0][3][0]; *(PG8_LAS f32x4*)(p + 4) = acc[ai][0][3][1]; } }
        if (wr == 0 && fr < 2) { float* pa = edgeA + ((size_t)u.pm * 4 + fr) * FF + col0; float* pv = edgeV + ((size_t)u.pm * 2 + fr) * FF + col0;
            *(f32x4*)(pa) = acc[0][0][0][0]; *(f32x4*)(pa + 4) = acc[0][0][0][1]; *(f32x4*)(pv) = acc[0][1][0][0]; *(f32x4*)(pv + 4) = acc[0][1][0][1]; }
        if (wr == 1 && fr >= 14) { float* pa = edgeA + ((size_t)u.pm * 4 + 2 + (fr - 14)) * FF + col0; *(f32x4*)(pa) = acc[1][0][3][0]; *(f32x4*)(pa + 4) = acc[1][0][3][1]; }
        asm volatile("s_waitcnt lgkmcnt(0)" ::: "memory"); __builtin_amdgcn_s_barrier(); asm volatile("" ::: "memory");
        f32x4 w0[2], w1[2], w2[2], bb[2];
#pragma unroll
        for (int n = 0; n < 2; ++n) { w0[n] = *(const f32x4*)(cw + col0 + 4 * n); w1[n] = *(const f32x4*)(cw + FF + col0 + 4 * n); w2[n] = *(const f32x4*)(cw + 2 * FF + col0 + 4 * n); bb[n] = *(const f32x4*)(cb + col0 + 4 * n); }
#pragma unroll
        for (int ai = 0; ai < 2; ++ai) { const int s = ai * 2 + wr;
            f32x4 t1[2], t2[2];
#pragma unroll
            for (int n = 0; n < 2; ++n) { f32x4 h62 = (f32x4){0.f, 0.f, 0.f, 0.f}, h63 = h62;
                if (s > 0) { h62 = *(const PG8_LAS f32x4*)(ex + ((s - 1) * 2 + 0) * 128 + cl + 4 * n); h63 = *(const PG8_LAS f32x4*)(ex + ((s - 1) * 2 + 1) * 128 + cl + 4 * n); }
                t1[n] = h63; t2[n] = fr == 0 ? h62 : h63; }
#pragma unroll
            for (int m = 0; m < 4; ++m) { f32x4 o[2];
#pragma unroll
                for (int n = 0; n < 2; ++n) {
                    f32x4 cv;
#pragma unroll
                    for (int e = 0; e < 4; ++e) { const float X = acc[ai][0][m][n][e]; const float p1 = dpp_shr(t1[n][e], X, 1), p2 = dpp_shr(t2[n][e], X, 2);
                        t1[n][e] = dpp_shl15(X); t2[n][e] = dpp_shl14(X);
                        cv[e] = w2[n][e] * X + w1[n][e] * p1 + w0[n][e] * p2 + bb[n][e]; }
                    const f32x2 ga = gelu_pk((f32x2){cv[0], cv[1]}), gb = gelu_pk((f32x2){cv[2], cv[3]});
                    o[n] = (f32x4){ga.x, ga.y, gb.x, gb.y} * acc[ai][1][m][n]; }
                const bool skip = (s == 0 && m == 0 && fr < 2);
                if (!skip) *(u32x4*)(midb + (size_t)(row0 + ai * HALF + m * 16) * FF + col0) = pack8(o[0], o[1]);
                asm volatile("" ::: "memory"); }
        }
    }
};
struct EpiFfnDown {
    static constexpr bool PERM = true, AFTER_DRAIN = false, HAS_MID = false;
    const bf16_t* in; float* out;
    __device__ __forceinline__ void mid(f32x4 (&)[2][2][4][2], const Unit&, int, int, int, int) const {}
    __device__ __forceinline__ void operator()(f32x4 (&acc)[2][2][4][2], const Unit& u, int wr, int wc, int fr, int fq) const {
        int row0 = u.pm * BM + wr * 64 + fr; asm volatile("" : "+v"(row0)); const int col0 = u.pn * BM + wc * 32 + 8 * fq;
        u32x4 xv[2][2];
        { const bf16_t* p = in + (size_t)row0 * 1024 + col0; xv[0][0] = *(const u32x4*)(p); xv[0][1] = *(const u32x4*)(p + HALF); }
#pragma unroll
        for (int g = 0; g < 8; ++g) { const int ai = g >> 2, m = g & 3; const size_t off = (size_t)(row0 + ai * HALF + m * 16) * 1024 + col0;
            if (g < 7) { const bf16_t* p = in + (size_t)(row0 + ((g + 1) >> 2) * HALF + ((g + 1) & 3) * 16) * 1024 + col0; xv[(g + 1) & 1][0] = *(const u32x4*)(p); xv[(g + 1) & 1][1] = *(const u32x4*)(p + HALF); }
#pragma unroll
            for (int bj = 0; bj < 2; ++bj) { f32x4 r0, r1; unpack8(xv[g & 1][bj], r0, r1); float* q = out + off + bj * HALF; *(f32x4*)(q) = r0 + acc[ai][bj][m][0]; *(f32x4*)(q + 4) = r1 + acc[ai][bj][m][1]; }
            asm volatile("" ::: "memory"); }
    }
};
struct EpiCmpHid {
    static constexpr bool PERM = true, AFTER_DRAIN = false, HAS_MID = false;
    const float* cbias  ; bf16_t* hid;
    __device__ __forceinline__ void mid(f32x4 (&)[2][2][4][2], const Unit&, int, int, int, int) const {}
    __device__ __forceinline__ void operator()(f32x4 (&acc)[2][2][4][2], const Unit& u, int wr, int wc, int fr, int fq) const {
        int row0 = u.pm * BM + wr * 64 + fr; asm volatile("" : "+v"(row0)); const int col0 = wc * 32 + 8 * fq; const float* bp = cbias + (u.pm >> 4) * 256 + col0;
#pragma unroll
        for (int ai = 0; ai < 2; ++ai)
#pragma unroll
            for (int m = 0; m < 4; ++m) { bf16_t* rowp = hid + (size_t)(row0 + ai * HALF + m * 16) * 256 + col0;
#pragma unroll
                for (int bj = 0; bj < 2; ++bj) { f32x4 v0 = acc[ai][bj][m][0] + *(const f32x4*)(bp + bj * HALF), v1 = acc[ai][bj][m][1] + *(const f32x4*)(bp + bj * HALF + 4);
                    const f32x2 g0 = gelu_pk((f32x2){v0[0], v0[1]}), g1 = gelu_pk((f32x2){v0[2], v0[3]}), g2 = gelu_pk((f32x2){v1[0], v1[1]}), g3 = gelu_pk((f32x2){v1[2], v1[3]});
                    *(u32x4*)(rowp + bj * HALF) = pack8((f32x4){g0.x, g0.y, g1.x, g1.y}, (f32x4){g2.x, g2.y, g3.x, g3.y}); } }
    }
};
struct CmpOrder {
    int G, c; const bf16_t* kc; const bf16_t* vc; const bf16_t* w1t;
    __device__ bool next(int i, Unit& u) const { const int L = i * G + c; if (L >= 32) return false; u.pm = L; u.pn = 0; return true; }
    __device__ __forceinline__ const char* a_ptr(const Gemm&, const Unit& u) const { const int kvbg = u.pm >> 1, half = u.pm & 1, kv = kvbg >> 3, b = (kvbg >> 1) & 3, g = kvbg & 1;
        return (const char*)((kv ? vc : kc) + ((size_t)(b * SEQ + 16 * 256 * half) * 128 + g * 64)); }
    __device__ __forceinline__ const char* b_ptr(const Gemm&, const Unit& u) const { return (const char*)(w1t + (size_t)(u.pm >> 4) * 256 * 2048); }
    __device__ __forceinline__ void a_ready(const Unit&) const {}
    __device__ __forceinline__ void done(const Unit&) const {}
};
template <class Epi, class Sched, bool ALIGN_EPI = false, bool SP2 = false>
__device__ __forceinline__ void gemm_phase(PG8_LAS unsigned char* lds, const Gemm g, const Sched& S, const Epi& E) {
    int tid_ = threadIdx.x; asm volatile("" : "+v"(tid_));
    const int tid = tid_, wid = __builtin_amdgcn_readfirstlane(tid >> 6), lane = tid & 63, wr = wid >> 2, wc = wid & 3, fr = lane & 15, fq = lane >> 4;
    const int K = g.K, nt = K / BK;
    unsigned voffA[2], voffB[2];
#pragma unroll
    for (int i = 0; i < 2; ++i) { int R, C; stage_rc(tid * 16 + i * 8192, R, C); const int Rb = Epi::PERM ? ((R & ~31) + perm32(R & 31)) : R;
        voffA[i] = (unsigned)(R * g.lda + C) * 2u; voffB[i] = (unsigned)(Rb * K + C) * 2u; }
    const size_t kstepA = (size_t)g.ksA, kstepB = (size_t)(BK * 2);
    const size_t hstepA = (size_t)HALF * g.lda * 2, hstepB = (size_t)HALF * K * 2;
    const unsigned ldsw = (unsigned)wid * 1024u;
    const int aoff = lds_byte(wr * 64 + fr, fq * 8), boff = lds_byte(wc * 32 + fr, fq * 8);
#define PG8_SA(b, h) (((b) * 2 + (h)) * HTB)
#define PG8_SB(b, h) ((4 + (b) * 2 + (h)) * HTB)
#define PG8_STAGE(bufoff, gbase, voff) do { _Pragma("unroll") for (int _i = 0; _i < 2; ++_i) \
        __builtin_amdgcn_global_load_lds((const unsigned*)((const char*)(gbase) + (voff)[_i]), (PG8_LAS unsigned*)(lds + (bufoff) + ldsw + _i * 8192), 16, 0, 0); } while (0)
#define PG8_LDA(dst, b, h) do { _Pragma("unroll") for (int m = 0; m < 4; ++m) _Pragma("unroll") for (int k = 0; k < 2; ++k) dst[m][k] = *(const PG8_LAS bf16x8*)(lds + PG8_SA(b, h) + aoff + m * 2048 + k * 1024); } while (0)
#define PG8_LDB(dst, b, h) do { _Pragma("unroll") for (int n = 0; n < 2; ++n) _Pragma("unroll") for (int k = 0; k < 2; ++k) dst[n][k] = *(const PG8_LAS bf16x8*)(lds + PG8_SB(b, h) + boff + n * 2048 + k * 1024); } while (0)
#define PG8_MMA(ai, bj, At, Bt) do { __builtin_amdgcn_s_setprio(1); _Pragma("unroll") for (int m = 0; m < 4; ++m) _Pragma("unroll") for (int n = 0; n < 2; ++n) _Pragma("unroll") for (int k = 0; k < 2; ++k) \
        acc[ai][bj][m][n] = __builtin_amdgcn_mfma_f32_16x16x32_bf16(Bt[n][k], At[m][k], acc[ai][bj][m][n], 0, 0, 0); __builtin_amdgcn_s_setprio(0); } while (0)
#define PG8_WAIT_V(n) asm volatile("s_waitcnt vmcnt(" #n ")" ::: "memory")
#define PG8_WAIT_L(n) asm volatile("s_waitcnt lgkmcnt(" #n ")" ::: "memory")
#define PG8_BAR __builtin_amdgcn_s_barrier()
#define PG8_SCHED __builtin_amdgcn_sched_barrier(0)
    Unit cur, nxt; int ui = 0;
    if (!S.next(0, cur)) return;
    f32x4 acc[2][2][4][2];
#pragma unroll
    for (int a = 0; a < 2; ++a)
#pragma unroll
        for (int b = 0; b < 2; ++b)
#pragma unroll
            for (int m = 0; m < 4; ++m)
#pragma unroll
                for (int n = 0; n < 2; ++n) acc[a][b][m][n] = (f32x4){0.f, 0.f, 0.f, 0.f};
    bf16x8 At[4][2], B0[2][2], B1[2][2];
    const char* cA = S.a_ptr(g, cur); const char* cB = S.b_ptr(g, cur);
    S.a_ready(cur);
    if constexpr (SP2) {
        PG8_STAGE(PG8_SB(0, 0), cB, voffB); PG8_STAGE(PG8_SB(0, 1), cB + hstepB, voffB); PG8_STAGE(PG8_SA(0, 0), cA, voffA); PG8_STAGE(PG8_SA(0, 1), cA + hstepA, voffA);
        if (wr == 1) PG8_BAR;
        PG8_WAIT_V(2); PG8_BAR;
        PG8_STAGE(PG8_SB(1, 0), cB + kstepB, voffB); PG8_STAGE(PG8_SA(1, 0), cA + kstepA, voffA); PG8_STAGE(PG8_SB(1, 1), cB + hstepB + kstepB, voffB);
        PG8_WAIT_V(6); PG8_BAR;
    } else {
        PG8_STAGE(PG8_SB(0, 0), cB, voffB); PG8_STAGE(PG8_SA(0, 0), cA, voffA); PG8_STAGE(PG8_SB(0, 1), cB + hstepB, voffB); PG8_STAGE(PG8_SA(0, 1), cA + hstepA, voffA);
        if (wr == 1) PG8_BAR;
        PG8_WAIT_V(4); PG8_BAR;
        PG8_STAGE(PG8_SB(1, 0), cB + kstepB, voffB); PG8_STAGE(PG8_SA(1, 0), cA + kstepA, voffA); PG8_STAGE(PG8_SB(1, 1), cB + hstepB + kstepB, voffB);
        PG8_WAIT_V(6); PG8_BAR;
    }
    for (;;) {
        const bool has_next = S.next(ui + 1, nxt);
        const char* nA = has_next ? S.a_ptr(g, nxt) : cA; const char* nB = has_next ? S.b_ptr(g, nxt) : cB;
        for (int t = 0; t < nt; t += 2) {
            if constexpr (Epi::HAS_MID) { if (t == nt / 2) E.mid(acc, cur, wr, wc, fr, fq); }
            const bool last = (t == nt - 2);
            const char* a1 = cA + (size_t)(t + 1) * kstepA;
            const char* a2 = last ? nA : cA + (size_t)(t + 2) * kstepA; const char* b2 = last ? nB : cB + (size_t)(t + 2) * kstepB;
            const char* a3 = a2 + kstepA; const char* b3 = b2 + kstepB;
            if (last && has_next) S.a_ready(nxt);
            if constexpr (SP2) {
            PG8_LDB(B0, 0, 0); PG8_LDB(B1, 0, 1); PG8_SCHED; PG8_LDA(At, 0, 0); PG8_STAGE(PG8_SA(1, 1), a1 + hstepA, voffA);
            PG8_WAIT_V(8); PG8_WAIT_L(0); PG8_BAR; PG8_MMA(0, 0, At, B0); PG8_MMA(0, 1, At, B1); PG8_BAR; PG8_SCHED;
            PG8_LDA(At, 0, 1); PG8_STAGE(PG8_SB(0, 0), b2, voffB); PG8_STAGE(PG8_SB(0, 1), b2 + hstepB, voffB); PG8_STAGE(PG8_SA(0, 0), a2, voffA);
            PG8_WAIT_V(8); PG8_WAIT_L(0); PG8_BAR; PG8_MMA(1, 0, At, B0); PG8_MMA(1, 1, At, B1); PG8_BAR; PG8_SCHED;
            PG8_LDB(B0, 1, 0); PG8_LDB(B1, 1, 1); PG8_SCHED; PG8_LDA(At, 1, 0); PG8_STAGE(PG8_SA(0, 1), a2 + hstepA, voffA);
            PG8_WAIT_V(8); PG8_WAIT_L(0); PG8_BAR; PG8_MMA(0, 0, At, B0); PG8_MMA(0, 1, At, B1); PG8_BAR; PG8_SCHED;
            PG8_LDA(At, 1, 1); PG8_STAGE(PG8_SB(1, 0), b3, voffB); PG8_STAGE(PG8_SB(1, 1), b3 + hstepB, voffB); PG8_STAGE(PG8_SA(1, 0), a3, voffA);
            PG8_WAIT_V(8); PG8_WAIT_L(0); PG8_BAR; PG8_MMA(1, 0, At, B0); PG8_MMA(1, 1, At, B1); PG8_BAR; PG8_SCHED;
            } else {
            PG8_LDB(B0, 0, 0); PG8_SCHED; PG8_LDA(At, 0, 0); PG8_STAGE(PG8_SA(1, 1), a1 + hstepA, voffA);
            PG8_WAIT_L(8); PG8_BAR; PG8_WAIT_L(0); PG8_MMA(0, 0, At, B0); PG8_BAR; PG8_SCHED;
            PG8_LDB(B1, 0, 1); PG8_STAGE(PG8_SB(0, 0), b2, voffB);
            PG8_BAR; PG8_WAIT_L(0); PG8_MMA(0, 1, At, B1); PG8_BAR;
            PG8_LDA(At, 0, 1); PG8_STAGE(PG8_SA(0, 0), a2, voffA);
            PG8_BAR; PG8_WAIT_L(0); PG8_MMA(1, 0, At, B0); PG8_BAR; PG8_SCHED;
            PG8_STAGE(PG8_SB(0, 1), b2 + hstepB, voffB);
            PG8_WAIT_V(6); PG8_BAR; PG8_MMA(1, 1, At, B1); PG8_BAR;
            PG8_LDB(B0, 1, 0); PG8_SCHED; PG8_LDA(At, 1, 0); PG8_STAGE(PG8_SA(0, 1), a2 + hstepA, voffA);
            PG8_WAIT_L(8); PG8_BAR; PG8_WAIT_L(0); PG8_MMA(0, 0, At, B0); PG8_BAR; PG8_SCHED;
            PG8_LDB(B1, 1, 1); PG8_STAGE(PG8_SB(1, 0), b3, voffB);
            PG8_BAR; PG8_WAIT_L(0); PG8_MMA(0, 1, At, B1); PG8_BAR;
            PG8_LDA(At, 1, 1); PG8_STAGE(PG8_SA(1, 0), a3, voffA);
            PG8_BAR; PG8_WAIT_L(0); PG8_MMA(1, 0, At, B0); PG8_BAR; PG8_SCHED;
            PG8_STAGE(PG8_SB(1, 1), b3 + hstepB, voffB);
            PG8_WAIT_V(6); PG8_BAR; PG8_MMA(1, 1, At, B1); PG8_BAR;
            }
        }
        if constexpr (ALIGN_EPI) { if (wr == 0) PG8_BAR; }
        if constexpr (!Epi::AFTER_DRAIN) { E(acc, cur, wr, wc, fr, fq); S.done(cur); }
        if (!has_next) break;
#pragma unroll
        for (int a = 0; a < 2; ++a)
#pragma unroll
            for (int b = 0; b < 2; ++b)
#pragma unroll
                for (int m = 0; m < 4; ++m)
#pragma unroll
                    for (int n = 0; n < 2; ++n) acc[a][b][m][n] = (f32x4){0.f, 0.f, 0.f, 0.f};
        cur = nxt; cA = nA; cB = nB; ++ui;
        if constexpr (ALIGN_EPI) { if (wr == 1) PG8_BAR; }
    }
    PG8_WAIT_V(0);
    if constexpr (!ALIGN_EPI) { if (wr == 0) PG8_BAR; }
    PG8_BAR;
    if constexpr (Epi::AFTER_DRAIN) { E.fused(acc, cur, wr, wc, fr, fq, lds, wid, lane); S.done(cur); }
#undef PG8_SA
#undef PG8_SB
#undef PG8_STAGE
#undef PG8_LDA
#undef PG8_LDB
#undef PG8_MMA
#undef PG8_WAIT_V
#undef PG8_WAIT_L
#undef PG8_BAR
#undef PG8_SCHED
}
}

using pg8::bf16_t; using pg8::f32x4; using pg8::u32x4; using pg8::TT; using pg8::SEQ; using pg8::NEPS; using pg8::QC2; using pg8::bf2f; using pg8::sigm;
#define LAS __attribute__((address_space(3)))
struct Args { const float* in[27]; float* out; unsigned char* ws; float rope_inv[32]; };

__device__ __forceinline__ unsigned f2bf(float f) { unsigned u = __builtin_bit_cast(unsigned, f); return (u + 0x7fffu + ((u >> 16) & 1u)) >> 16; }
__device__ __forceinline__ unsigned pk2(float lo, float hi) { return f2bf(lo) | (f2bf(hi) << 16); }
__device__ __forceinline__ float wave_sum(float v) {
#pragma unroll
    for (int o = 1; o < 64; o <<= 1) v += __shfl_xor(v, o);
    return v;
}
template <class F> __device__ __forceinline__ void transpose_item(const float* W, int ldw, int k0src, const float* kscale, bf16_t* WT, int ldt, int k0dst, int row0, LAS float* scr, int lane, F srccol) {
    { const int c4 = lane & 7, kr = lane >> 3; const int sc = srccol(4 * c4); f32x4 v[8];
#pragma unroll
      for (int i = 0; i < 8; ++i) { const int kk = 8 * i + kr; v[i] = (f32x4){0.f, 0.f, 0.f, 0.f}; if (sc >= 0) { v[i] = *(const f32x4*)(W + (size_t)(k0src + kk) * ldw + sc); if (kscale) v[i] = v[i] * kscale[k0src + kk]; } }
#pragma unroll
      for (int i = 0; i < 8; ++i) { LAS float* p = scr + (8 * i + kr) * 33 + 4 * c4; p[0] = v[i][0]; p[1] = v[i][1]; p[2] = v[i][2]; p[3] = v[i][3]; } }
    asm volatile("s_waitcnt lgkmcnt(0)" ::: "memory");
    const int c = lane & 7;
#pragma unroll
    for (int jj = 0; jj < 4; ++jj) { const int n = (lane >> 3) + 8 * jj; const LAS float* s = scr + (8 * c) * 33 + n;
        u32x4 o; o.x = pk2(s[0 * 33], s[1 * 33]); o.y = pk2(s[2 * 33], s[3 * 33]); o.z = pk2(s[4 * 33], s[5 * 33]); o.w = pk2(s[6 * 33], s[7 * 33]);
        *(u32x4*)(WT + (size_t)(row0 + n) * ldt + k0dst + 8 * c) = o; }
    asm volatile("s_waitcnt lgkmcnt(0)" ::: "memory");
}
__device__ __forceinline__ int inproj_src(int p) {
    const int tile = p >> 8, l = p & 255;
    if (tile < 6) return p;
    const int half = l >> 7, wh = (l >> 5) & 3, j = l & 31;
    if (tile < 8) return C_NQ + 64 * (4 * (tile - 6) + wh) + 32 * half + j;
    if (tile == 8) return (wh < 2 ? C_KC + 64 * wh : C_KS + 64 * (wh - 2)) + 32 * half + j;
    if (tile == 9) return (wh < 2 ? C_KW + 64 * wh : C_VC + 64 * (wh - 2)) + 32 * half + j;
    if (tile == 10) return (wh < 2 ? C_VS + 64 * wh : C_VW + 64 * (wh - 2)) + 32 * half + j;
    if (l < 8) return C_MI + l; if (l < 32) return C_NG + (l - 8); return -1;
}
#define GAS __attribute__((address_space(1)))
typedef GAS unsigned gu32;
typedef GAS unsigned long long gu64;
#define RLX_AGENT __ATOMIC_RELAXED, __HIP_MEMORY_SCOPE_AGENT
__device__ __forceinline__ unsigned long long rt() { return __builtin_amdgcn_s_memrealtime(); }
#define XB_TMO      128
#define XB_XCNT(j)  (256  + 64 * (j))
#define XB_XSUB(j)  (1280 + 64 * (j))
#define XB_XGEN(j)  (2304 + 64 * (j))
#define XB_TOP      3328
#define XB_TOPGEN   3392
#define XCD_BAR_WORDS 3456
#define XB_SPIN_CAP (1u << 18)

__device__ __forceinline__ unsigned xb_ld(unsigned* p)              { return __hip_atomic_load(p, __ATOMIC_RELAXED, __HIP_MEMORY_SCOPE_AGENT); }
__device__ __forceinline__ unsigned xb_add(unsigned* p, unsigned v) { return __hip_atomic_fetch_add(p, v, __ATOMIC_RELAXED, __HIP_MEMORY_SCOPE_AGENT); }
__device__ __forceinline__ unsigned xb_xcc_id() { return (unsigned)__builtin_amdgcn_s_getreg((3 << 11) | 20) & 0xFu; }
#define XB_SPIN(cond, bar) do { unsigned _sp = 0; while (cond) { __builtin_amdgcn_s_sleep(1); \
    if ((++_sp & 255u) == 0u) { if (xb_ld(&(bar)[XB_TMO])) break; if (_sp > XB_SPIN_CAP) { atomicAdd(&(bar)[XB_TMO], 1u); break; } } } } while (0)

struct XcdBarrier {
    unsigned* bar; unsigned x;
    volatile LAS unsigned* st;
};

__device__ __forceinline__ XcdBarrier xcd_barrier_post(unsigned* bar, volatile LAS unsigned* st) {
    XcdBarrier b; b.bar = bar; b.x = xb_xcc_id(); b.st = st;
    if (threadIdx.x == 0) (void)xb_add(&bar[XB_XCNT(b.x)], 1u);
    return b;
}
__device__ __forceinline__ void xcd_barrier_complete(unsigned* bar, unsigned x, unsigned& nloc, unsigned& nx) {
    const unsigned G = gridDim.x * gridDim.y * gridDim.z;
    unsigned sum, cnt, mine, sp = 0u;
    for (;;) {
        sum = 0u; cnt = 0u; mine = 0u;
#pragma unroll
        for (unsigned j = 0; j < 16; ++j) { const unsigned c = xb_ld(&bar[XB_XCNT(j)]); sum += c; cnt += (c > 0u) ? 1u : 0u; mine = (j == x) ? c : mine; }
        if (sum == G) break;
        __builtin_amdgcn_s_sleep(1);
        if ((++sp & 255u) == 0u) { if (xb_ld(&bar[XB_TMO])) break; if (sp > XB_SPIN_CAP) { atomicAdd(&bar[XB_TMO], 1u); break; } }
    }
    nloc = mine > 0u ? mine : 1u; nx = cnt > 0u ? cnt : 1u;
}

__device__ __forceinline__ void xcd_barrier(const XcdBarrier& b) {
    asm volatile("s_waitcnt vmcnt(0)" ::: "memory");
    __syncthreads();
    if (threadIdx.x == 0) {
        unsigned* bar = b.bar;
        __builtin_amdgcn_s_waitcnt(0);
        unsigned nloc = b.st[0], nx = b.st[1];
        if (nloc == 0u) { xcd_barrier_complete(bar, b.x, nloc, nx); b.st[0] = nloc; b.st[1] = nx; }
        const unsigned old = xb_add(&bar[XB_XSUB(b.x)], 1u);
        const unsigned gen = old / nloc;
        if (old + 1u == (gen + 1u) * nloc) {
            __builtin_amdgcn_fence(__ATOMIC_RELEASE, "agent");
            asm volatile("s_waitcnt vmcnt(0)" ::: "memory");
            const unsigned og = xb_add(&bar[XB_TOP], 1u);
            const unsigned tg = og / nx;
            if (og + 1u == (tg + 1u) * nx) xb_add(&bar[XB_TOPGEN], 1u);
            else XB_SPIN(xb_ld(&bar[XB_TOPGEN]) == tg, bar);
            __builtin_amdgcn_fence(__ATOMIC_ACQUIRE, "agent");
            xb_add(&bar[XB_XGEN(b.x)], 1u);
            asm volatile("s_waitcnt vmcnt(0)" ::: "memory");
        } else {
            XB_SPIN(xb_ld(&bar[XB_XGEN(b.x)]) == gen, bar);
            __builtin_amdgcn_fence(__ATOMIC_ACQUIRE, "agent");
            asm volatile("s_waitcnt vmcnt(0)" ::: "memory");
        }
    }
    __syncthreads();
}

struct Ctx { int tid, lane, wave, G, vcu, gw, ngw, gtid, nthr; LAS unsigned char* lds; };

template <int PART> __device__ __forceinline__ void phase_transposes(const Ctx& C, const Args& a) {
    unsigned char* ws = a.ws;
    LAS float* scr = (LAS float*)(C.lds + C.wave * 16384);
    const float* w_in = a.in[2]; const float* norm1 = a.in[1]; const float* norm2 = a.in[22];
    constexpr int I_WIN = 96 * 16, I_WG = 64 * 16, I_WMN = 32 * 16, I_WOUT = 32 * 16, I_WUP = 176 * 16, I_WDN = 32 * 44, I_CW1 = 16 * 32;
    constexpr int NITEMS = I_WIN + I_WG + I_WMN + I_WOUT + I_WUP + I_WDN + I_CW1;
    const int it_lo = PART == 0 ? 0 : I_WIN, it_hi = PART == 0 ? I_WIN + I_CW1 : NITEMS - I_CW1;
    for (int it0 = it_lo + C.gw; it0 < it_hi; it0 += C.ngw) {
        int r = (PART == 0 && it0 >= I_WIN) ? it0 + (NITEMS - I_CW1 - I_WIN) : it0;
        if (r < I_WIN) { const int blk = r >> 4, kb = r & 15; transpose_item(w_in, DIN, 64 * kb, norm1, (bf16_t*)(ws + WS_WIN), 1024, 64 * kb, 32 * blk, scr, C.lane, [=](int j) { return inproj_src(32 * blk + j); }); continue; } r -= I_WIN;
        if (r < I_WG) { const int blk = r >> 4, kb = r & 15; const int p0 = 32 * blk, pn = p0 >> 8, half = (p0 >> 7) & 1, jj = p0 & 127;
            transpose_item(w_in, DIN, 64 * kb, norm1, (bf16_t*)(ws + WS_WG), 1024, 64 * kb, p0, scr, C.lane, [=](int j) { return C_GM + half * 1024 + 128 * pn + jj + j; }); continue; } r -= I_WG;
        if (r < I_WMN) { const int blk = r >> 4, kb = r & 15; const float* W = kb < 8 ? a.in[18] : a.in[19]; transpose_item(W, 1024, 64 * (kb & 7), nullptr, (bf16_t*)(ws + WS_WMN), 1024, 64 * kb, 32 * blk, scr, C.lane, [=](int j) { return 32 * blk + j; }); continue; } r -= I_WMN;
        if (r < I_WOUT) { const int blk = r >> 4, kb = r & 15; transpose_item(a.in[21], 1024, 64 * kb, nullptr, (bf16_t*)(ws + WS_WOUT), 1024, 64 * kb, 32 * blk, scr, C.lane, [=](int j) { return 32 * blk + j; }); continue; } r -= I_WOUT;
        if (r < I_WUP) { const int blk = r >> 4, kb = r & 15; const int p0 = 32 * blk, pn = p0 >> 8, half = (p0 >> 7) & 1, jj = p0 & 127;
            transpose_item(a.in[23], 2 * DFF, 64 * kb, norm2, (bf16_t*)(ws + WS_WUP), 1024, 64 * kb, p0, scr, C.lane, [=](int j) { return half * DFF + 128 * pn + jj + j; }); continue; } r -= I_WUP;
        if (r < I_WDN) { const int blk = r / 44, kb = r % 44; transpose_item(a.in[26], 1024, 64 * kb, nullptr, (bf16_t*)(ws + WS_WDN), DFF, 64 * kb, 32 * blk, scr, C.lane, [=](int j) { return 32 * blk + j; }); continue; } r -= I_WDN;
        { const int kv = r >> 8, blk = (r >> 5) & 7, kb = r & 31; transpose_item(kv ? a.in[16] : a.in[13], 256, 64 * kb, nullptr, (bf16_t*)(ws + WS_CW1) + (size_t)kv * 256 * 2048, 2048, 64 * kb, 32 * blk, scr, C.lane, [=](int j) { return 32 * blk + j; }); }
    }
}
__device__ __forceinline__ void xrow_load(f32x4 (&v)[4][4], const float* x, int m0, int lane) {
#pragma unroll
    for (int r = 0; r < 4; ++r) { const f32x4* xr = (const f32x4*)(x + (size_t)(m0 + r) * DM) + lane;
#pragma unroll
        for (int j = 0; j < 4; ++j) v[r][j] = __builtin_nontemporal_load(xr + 64 * j); }
}
__device__ __forceinline__ void xrow_store(const f32x4 (&v)[4][4], bf16_t* xb, float* rstd, int m0, int lane) {
    float s[4];
#pragma unroll
    for (int r = 0; r < 4; ++r) { s[r] = 0.f;
#pragma unroll
        for (int j = 0; j < 4; ++j) s[r] += (v[r][j][0] * v[r][j][0] + v[r][j][1] * v[r][j][1]) + (v[r][j][2] * v[r][j][2] + v[r][j][3] * v[r][j][3]); }
#pragma unroll
    for (int o = 1; o < 64; o <<= 1) {
#pragma unroll
        for (int r = 0; r < 4; ++r) s[r] += __shfl_xor(s[r], o); }
#pragma unroll
    for (int r = 0; r < 4; ++r) { if (lane == 0) rstd[m0 + r] = 1.0f / sqrtf(s[r] * (1.0f / DM) + NEPS);
        unsigned long long* o8 = (unsigned long long*)(xb + (size_t)(m0 + r) * DM) + lane;
#pragma unroll
        for (int j = 0; j < 4; ++j) o8[64 * j] = (unsigned long long)pk2(v[r][j][0], v[r][j][1]) | ((unsigned long long)pk2(v[r][j][2], v[r][j][3]) << 32); }
}
__device__ __forceinline__ void phase_prologue(const Ctx& C, const Args& a) {
    unsigned char* ws = a.ws; const float* x = a.in[0]; bf16_t* xb = (bf16_t*)(ws + WS_XB); float* rstd = (float*)(ws + WS_RSTD1);
    const int mstep = 4 * C.ngw; int m0 = 4 * C.gw;
    f32x4 va[4][4], vb[4][4];
    if (m0 < TT) xrow_load(va, x, m0, C.lane);
    phase_transposes<0>(C, a);
#if defined(REPEAT_T0)
    for (int rep = 0; rep < REPEAT_T0; ++rep) { __syncthreads(); phase_transposes<0>(C, a); }
#endif
    { float* cbias = (float*)(ws + WS_CBIAS); LAS float* part = (LAS float*)(C.lds + 8 * 16384);
      for (int i0 = 2 * C.vcu; i0 < 512; i0 += 2 * C.G) { const int i = i0 + (C.wave >> 2), kq = C.wave & 3, kv = i >> 8, j = i & 255; const float* pe = kv ? a.in[15] : a.in[12]; const float* w1 = kv ? a.in[16] : a.in[13]; float s = 0.f;
#pragma unroll
          for (int q = 0; q < 8; ++q) { const int k = 512 * kq + 64 * q + C.lane; s += pe[k] * w1[(size_t)k * 256 + j]; }
          s = wave_sum(s); if (C.lane == 0) part[C.wave] = s;
          __syncthreads();
          if (C.tid < 2) cbias[i0 + C.tid] = (part[4 * C.tid] + part[4 * C.tid + 1]) + (part[4 * C.tid + 2] + part[4 * C.tid + 3]);
          __syncthreads(); } }
    for (; m0 < TT; m0 += 2 * mstep) {
        const int m1 = m0 + mstep, m2 = m1 + mstep;
        if (m1 < TT) xrow_load(vb, x, m1, C.lane);
        xrow_store(va, xb, rstd, m0, C.lane);
        if (m2 < TT) xrow_load(va, x, m2, C.lane);
        if (m1 < TT) xrow_store(vb, xb, rstd, m1, C.lane);
    }
#if defined(REPEAT_ROPE)
    for (int rep = 0; rep < REPEAT_ROPE; ++rep)
#endif
    { float* rc = (float*)(ws + WS_ROPEC); float* rsn = (float*)(ws + WS_ROPES);
      for (int i = C.gtid; i < SEQ * 32; i += C.nthr) { const int t = i >> 5, j = i & 31; const float ang = (float)t * a.rope_inv[j]; float sv, cv; sincosf(ang, &sv, &cv); rc[i] = cv; rsn[i] = sv; } }
}

__device__ __forceinline__ void p7b_fixup_panel(const Ctx& C, const Args& a, int pm) {
    unsigned char* ws = a.ws; const float* __restrict__ eA = (const float*)(ws + WS_EDGEA); const float* __restrict__ eV = (const float*)(ws + WS_EDGEV); bf16_t* __restrict__ mid = (bf16_t*)(ws + WS_MID);
    const float* __restrict__ cw = a.in[24]; const float* __restrict__ cb = a.in[25];
    const bool first = (pm & 31) == 0;
    const float* e0 = eA + (size_t)pm * 4 * DFF; const float* ep = eA + (size_t)(first ? pm : pm - 1) * 4 * DFF; const float* v0 = eV + (size_t)pm * 2 * DFF;
    float x0[6], x1[6], pa[6], pb[6], w0[6], w1[6], w2[6], bb[6], g0[6], g1[6];
#pragma unroll
    for (int j = 0; j < 6; ++j) { const int c = C.tid + 512 * j; const int cc = c < DFF ? c : DFF - 1;
        x0[j] = e0[cc]; x1[j] = e0[DFF + cc]; pa[j] = ep[3 * DFF + cc]; pb[j] = ep[2 * DFF + cc]; w0[j] = cw[cc]; w1[j] = cw[DFF + cc]; w2[j] = cw[2 * DFF + cc]; bb[j] = cb[cc]; g0[j] = v0[cc]; g1[j] = v0[DFF + cc]; }
#pragma unroll
    for (int j = 0; j < 6; ++j) { const int c = C.tid + 512 * j; const float pA = first ? 0.f : pa[j], pB = first ? 0.f : pb[j];
        const float c0 = w2[j] * x0[j] + w1[j] * pA + w0[j] * pB + bb[j], c1 = w2[j] * x1[j] + w1[j] * x0[j] + w0[j] * pA + bb[j];
        const pg8::f32x2 gl = pg8::gelu_pk((pg8::f32x2){c0, c1});
        if (c < DFF) { mid[(size_t)(pm * 256) * DFF + c] = (bf16_t)f2bf(gl.x * g0[j]); mid[(size_t)(pm * 256 + 1) * DFF + c] = (bf16_t)f2bf(gl.y * g1[j]); } }
}
#ifndef NOSHIFT_THR
#define NOSHIFT_THR (-64.f)
#endif
namespace att {
typedef short bf16x8 __attribute__((ext_vector_type(8)));
typedef short s16x4 __attribute__((ext_vector_type(4)));
typedef float f32x16 __attribute__((ext_vector_type(16)));
typedef unsigned u32x2 __attribute__((ext_vector_type(2)));
enum { M_WIN = 0, M_CMP = 1, M_SLC = 2 };
constexpr int LDS_KV = 0  , LDS_IMP = 65536  , IMPS = 129;
__device__ __forceinline__ int crow(int r, int hi) { return (r & 3) + 8 * (r >> 2) + 4 * hi; }
__device__ __forceinline__ s16x4 vtr(const LAS unsigned char* p) { typedef short v4i16_t __attribute__((ext_vector_type(4))); return __builtin_bit_cast(s16x4, __builtin_amdgcn_ds_read_tr16_b64_v4i16((LAS v4i16_t*)p)); }
__device__ __forceinline__ unsigned cvtpk(float lo, float hi) { return pg8::cvt_pk_bf16(lo, hi); }
__device__ __forceinline__ bf16x8 pack_p(const f32x16& p, int base) {
    u32x4 w; w.x = cvtpk(p[base + 0], p[base + 1]); w.y = cvtpk(p[base + 2], p[base + 3]); w.z = cvtpk(p[base + 4], p[base + 5]); w.w = cvtpk(p[base + 6], p[base + 7]); return __builtin_bit_cast(bf16x8, w); }

struct KVRegs { u32x4 k, v; };
template <bool LOADV> __device__ __forceinline__ void kv_load(KVRegs& R, const bf16_t* K, const bf16_t* V, int ldk, int kt, int tid) {
    const int rowl = tid >> 3, ch = tid & 7; const size_t off = (size_t)(64 * kt + rowl) * ldk + ch * 8;
    R.k = *(const u32x4*)(K + off); if (LOADV) R.v = *(const u32x4*)(V + off);
}
template <bool LOADV> __device__ __forceinline__ void kv_write(const KVRegs& R, LAS unsigned char* buf, int tid) {
    const int rowl = tid >> 3, ch = tid & 7;
    *(LAS u32x4*)(buf + rowl * 128 + ((ch ^ ((rowl >> 1) & 7)) << 4)) = R.k; if (LOADV) *(LAS u32x4*)(buf + 8192 + rowl * 128 + ((ch ^ (((rowl >> 1) & 1) << 2)) << 4)) = R.v;
}
__device__ __forceinline__ void qk_tile(f32x16& s0, f32x16& s1, const LAS unsigned char* buf, const bf16x8 (&qf)[4], int r32, int hi, float init) {
    const f32x16 z = {init, init, init, init, init, init, init, init, init, init, init, init, init, init, init, init}; s0 = z; s1 = z;
#pragma unroll
    for (int d0 = 0; d0 < 4; ++d0) { const int c = 2 * d0 + hi; const int sw = (c ^ ((r32 >> 1) & 7)) << 4;
        const bf16x8 k0 = *(const LAS bf16x8*)(buf + r32 * 128 + sw); const bf16x8 k1 = *(const LAS bf16x8*)(buf + (32 + r32) * 128 + sw);
        s0 = __builtin_amdgcn_mfma_f32_32x32x16_bf16(k0, qf[d0], s0, 0, 0, 0); s1 = __builtin_amdgcn_mfma_f32_32x32x16_bf16(k1, qf[d0], s1, 0, 0, 0); }
}
__device__ __forceinline__ void pv_tile(f32x16 (&o)[2], const LAS unsigned char* vbuf, const f32x16& p0, const f32x16& p1, int lane) {
    const int hi = lane >> 5, qb = (lane >> 3) & 1; const LAS unsigned char* vb = vbuf + (4 * hi + ((lane & 15) >> 2)) * 128 + (16 * ((lane >> 4) & 1) + 4 * (lane & 3)) * 2;
#pragma unroll
    for (int ks = 0; ks < 4; ++ks) { const bf16x8 pb = pack_p(ks < 2 ? p0 : p1, 8 * (ks & 1));
#pragma unroll
        for (int dt = 0; dt < 2; ++dt) { const s16x4 lo = vtr(vb + (16 * ks) * 128 + (dt ^ qb) * 64), hi4 = vtr(vb + (16 * ks + 8) * 128 + (dt ^ qb) * 64);
            const bf16x8 va = {lo[0], lo[1], lo[2], lo[3], hi4[0], hi4[1], hi4[2], hi4[3]};
            o[dt] = __builtin_amdgcn_mfma_f32_32x32x16_bf16(va, pb, o[dt], 0, 0, 0); } }
}
template <int MODE> __device__ __forceinline__ bool key_valid(int kt, int kh, int r, int hi, int tpos, int aux) {
    const int kp = 64 * kt + 32 * kh + crow(r, hi);
    if (MODE == M_WIN) return kp <= tpos && kp > tpos - 512;
    if (MODE == M_CMP) return kp <= aux;
    return aux != 0 && kp <= tpos;
}

__device__ __forceinline__ void k_frags(bf16x8 (&kf)[8], const LAS unsigned char* buf, int r32, int hi) {
#pragma unroll
    for (int d0 = 0; d0 < 4; ++d0) { const int sw = ((2 * d0 + hi) ^ ((r32 >> 1) & 7)) << 4; kf[2 * d0] = *(const LAS bf16x8*)(buf + r32 * 128 + sw); kf[2 * d0 + 1] = *(const LAS bf16x8*)(buf + (32 + r32) * 128 + sw); }
}
__device__ __forceinline__ void qk_mfma(f32x16& s0, f32x16& s1, const bf16x8 (&kf)[8], const bf16x8 (&qf)[4], float init) {
    const f32x16 z = {init, init, init, init, init, init, init, init, init, init, init, init, init, init, init, init}; s0 = z; s1 = z;
#pragma unroll
    for (int d0 = 0; d0 < 4; ++d0) { s0 = __builtin_amdgcn_mfma_f32_32x32x16_bf16(kf[2 * d0], qf[d0], s0, 0, 0, 0); s1 = __builtin_amdgcn_mfma_f32_32x32x16_bf16(kf[2 * d0 + 1], qf[d0], s1, 0, 0, 0); }
}
__device__ __forceinline__ void qk_mfma_c(f32x16& s0, f32x16& s1, const bf16x8 (&kf)[8], const bf16x8 (&qf)[4], const f32x16& c) {
    s0 = __builtin_amdgcn_mfma_f32_32x32x16_bf16(kf[0], qf[0], c, 0, 0, 0); s1 = __builtin_amdgcn_mfma_f32_32x32x16_bf16(kf[1], qf[0], c, 0, 0, 0);
#pragma unroll
    for (int d0 = 1; d0 < 4; ++d0) { s0 = __builtin_amdgcn_mfma_f32_32x32x16_bf16(kf[2 * d0], qf[d0], s0, 0, 0, 0); s1 = __builtin_amdgcn_mfma_f32_32x32x16_bf16(kf[2 * d0 + 1], qf[d0], s1, 0, 0, 0); }
}
__device__ __forceinline__ void qk_mfma_z(f32x16& s0, f32x16& s1, const bf16x8 (&kf)[8], const bf16x8 (&qf)[4]) {
    const f32x16 z = {0.f, 0.f, 0.f, 0.f, 0.f, 0.f, 0.f, 0.f, 0.f, 0.f, 0.f, 0.f, 0.f, 0.f, 0.f, 0.f};
    s0 = __builtin_amdgcn_mfma_f32_32x32x16_bf16(kf[0], qf[0], z, 0, 0, 0); s1 = __builtin_amdgcn_mfma_f32_32x32x16_bf16(kf[1], qf[0], z, 0, 0, 0);
#pragma unroll
    for (int d0 = 1; d0 < 4; ++d0) { s0 = __builtin_amdgcn_mfma_f32_32x32x16_bf16(kf[2 * d0], qf[d0], s0, 0, 0, 0); s1 = __builtin_amdgcn_mfma_f32_32x32x16_bf16(kf[2 * d0 + 1], qf[d0], s1, 0, 0, 0); }
}
template <bool B> struct BTag { static constexpr bool value = B; };
__device__ __forceinline__ void v_frags(bf16x8 (&vf)[8], const LAS unsigned char* vbuf, int lane) {
    const int hi = lane >> 5, qb = (lane >> 3) & 1; const LAS unsigned char* vb = vbuf + (4 * hi + ((lane & 15) >> 2)) * 128 + (16 * ((lane >> 4) & 1) + 4 * (lane & 3)) * 2;
#pragma unroll
    for (int ks = 0; ks < 4; ++ks)
#pragma unroll
        for (int dt = 0; dt < 2; ++dt) { const s16x4 lo = vtr(vb + (16 * ks) * 128 + (dt ^ qb) * 64), hi4 = vtr(vb + (16 * ks + 8) * 128 + (dt ^ qb) * 64);
            vf[2 * ks + dt] = (bf16x8){lo[0], lo[1], lo[2], lo[3], hi4[0], hi4[1], hi4[2], hi4[3]}; }
}
template <bool USEM> __device__ __forceinline__ void pv_mfma(f32x16 (&o)[2], const bf16x8 (&vf)[8], const f32x16& p0, const f32x16& p1, unsigned msk) {
#pragma unroll
    for (int ks = 0; ks < 4; ++ks) { bf16x8 pb = pack_p(ks < 2 ? p0 : p1, 8 * (ks & 1));
        if (USEM) { u32x4 w = __builtin_bit_cast(u32x4, pb); w.x &= msk; w.y &= msk; w.z &= msk; w.w &= msk; pb = __builtin_bit_cast(bf16x8, w); }
        o[0] = __builtin_amdgcn_mfma_f32_32x32x16_bf16(vf[2 * ks], pb, o[0], 0, 0, 0); o[1] = __builtin_amdgcn_mfma_f32_32x32x16_bf16(vf[2 * ks + 1], pb, o[1], 0, 0, 0); }
}
template <int MODE> __device__ __forceinline__ void mask_tile(f32x16& s0, f32x16& s1, int kt, int qt, int tp0, int th, int hi, int tpos) {
    bool full;
    if (MODE == M_WIN) full = (64 * kt + 63 <= tp0 + 32 * th) && (64 * kt > tp0 + 32 * th + 31 - 512); else full = kt < qt;
    if (!full) {
#pragma unroll
        for (int r = 0; r < 16; ++r) { if (!key_valid<MODE>(kt, 0, r, hi, tpos, 1)) s0[r] = -INFINITY; if (!key_valid<MODE>(kt, 1, r, hi, tpos, 1)) s1[r] = -INFINITY; } }
}
__device__ __forceinline__ float exp_tile(f32x16& s0, f32x16& s1) {
    float sa = 0.f, sb = 0.f;
#pragma unroll
    for (int r = 0; r < 16; ++r) { s0[r] = __builtin_amdgcn_exp2f(s0[r]); s1[r] = __builtin_amdgcn_exp2f(s1[r]); sa += s0[r]; asm("" : "+v"(sa)); sb += s1[r]; asm("" : "+v"(sb)); }
    return sa + sb;
}

template <int MODE, bool NOSHIFT = false> __device__ __forceinline__ void attn_unit(LAS unsigned char* lds, unsigned char* ws, int b, int g, int qt, int tid_, float negM, size_t out_off) {
    int tid = tid_; asm volatile("" : "+v"(tid));
    const int lane = tid & 63, wave = __builtin_amdgcn_readfirstlane(tid >> 6), r32 = lane & 31, hi = lane >> 5, hg = wave & 3, th = wave >> 2;
    const int tokl = MODE == M_CMP ? 8 * wave + (r32 >> 2) : 32 * th + r32; const int head = 4 * g + (MODE == M_CMP ? (r32 & 3) : hg);
    const int tp0 = 64 * qt, tpos = tp0 + tokl; const size_t trow = (size_t)b * SEQ + tpos;
    const bf16_t *K, *V; int ldk, kt0, kt1;
    if (MODE == M_WIN) { K = (const bf16_t*)(ws + WS_KW) + (size_t)b * SEQ * 128 + g * 64; V = (const bf16_t*)(ws + WS_VW) + (size_t)b * SEQ * 128 + g * 64; ldk = 128; kt0 = qt - 8 > 0 ? qt - 8 : 0; kt1 = qt; }
    else if (MODE == M_SLC) { K = (const bf16_t*)(ws + WS_KS) + (size_t)b * SEQ * 128 + g * 64; V = (const bf16_t*)(ws + WS_VS) + (size_t)b * SEQ * 128 + g * 64; ldk = 128; kt0 = 0; kt1 = qt; }
    else { K = (const bf16_t*)(ws + WS_CMPB) + (size_t)((b * 2 + g) * 512) * 64; V = (const bf16_t*)(ws + WS_CMPB) + (size_t)((8 + b * 2 + g) * 512) * 64; ldk = 64; kt0 = 0; kt1 = (4 * qt + 2) >> 6; }
    bf16x8 qf[4];
    { const bf16_t* qp = (const bf16_t*)(ws + WS_NQ) + trow * 512 + head * 64 + 8 * hi;
#pragma unroll
      for (int d0 = 0; d0 < 4; ++d0) qf[d0] = *(const bf16x8*)(qp + 16 * d0); }
    unsigned selw[4] = {0u, 0u, 0u, 0u};
    if (MODE == M_SLC) { const u32x4 sv = *(const u32x4*)((const unsigned*)(ws + WS_SEL) + (trow * 2 + g) * 4); selw[0] = sv.x; selw[1] = sv.y; selw[2] = sv.z; selw[3] = sv.w; }
    const int cmaxl = tpos >= 31 ? (tpos - 31) >> 4 : -1;
    const int tfirst = tp0 + 8 * wave; const int cmin = tfirst >= 31 ? (tfirst - 31) >> 4 : -1;
    LAS unsigned char* kvb = lds + LDS_KV;
    float m = -INFINITY, l = 0.f; f32x16 o[2]; { const f32x16 z = {0.f, 0.f, 0.f, 0.f, 0.f, 0.f, 0.f, 0.f, 0.f, 0.f, 0.f, 0.f, 0.f, 0.f, 0.f, 0.f}; o[0] = z; o[1] = z; }
    KVRegs R;
    bf16_t* op = (bf16_t*)(ws + out_off) + trow * 1024 + 512 + head * 64 + 4 * hi;
    u32x2 old[2][4];
    auto load_old = [&]() __attribute__((always_inline)) {
#pragma unroll
        for (int dt = 0; dt < 2; ++dt)
#pragma unroll
            for (int rr = 0; rr < 4; ++rr) old[dt][rr] = *(const u32x2*)(op + 32 * dt + 8 * rr); };
    if (MODE == M_CMP) {
        kv_load<false>(R, K, V, ldk, kt0, tid);
        for (int kt = kt0; kt <= kt1; ++kt) { LAS unsigned char* buf = kvb + ((kt - kt0) & 1) * 16384;
            kv_write<false>(R, buf, tid); if (kt < kt1) kv_load<false>(R, K, V, ldk, kt + 1, tid); else kv_load<true>(R, K, V, ldk, kt0, tid);
            __syncthreads();
            f32x16 s0, s1; qk_tile(s0, s1, buf, qf, r32, hi, 0.f);
            float mx = -INFINITY;
            const bool fullc = (64 * kt + 63) <= cmin;
            if (!fullc) {
#pragma unroll
                for (int r = 0; r < 16; ++r) { if (!key_valid<MODE>(kt, 0, r, hi, tpos, cmaxl)) s0[r] = -INFINITY; if (!key_valid<MODE>(kt, 1, r, hi, tpos, cmaxl)) s1[r] = -INFINITY; } }
#pragma unroll
            for (int r = 0; r < 16; ++r) mx = fmaxf(mx, fmaxf(s0[r], s1[r]));
            mx = fmaxf(mx, __shfl_xor(mx, 32));
            const float mn = fmaxf(m, mx);
            if (mn > -INFINITY) { float sum = 0.f;
#pragma unroll
                for (int r = 0; r < 16; ++r) sum += __builtin_amdgcn_exp2f(s0[r] - mn) + __builtin_amdgcn_exp2f(s1[r] - mn);
                l = l * __builtin_amdgcn_exp2f(m - mn) + sum; m = mn; }
        }
        __syncthreads();
        l += __shfl_xor(l, 32); const float il = l > 0.f ? 1.0f / l : 0.f; const float negm = l > 0.f ? -m : -INFINITY;
        LAS float* impt = (LAS float*)(lds + LDS_IMP) + tokl * IMPS;
        load_old();
        float carry = 0.f;
        for (int kt = kt0; kt <= kt1; ++kt) { LAS unsigned char* buf = kvb + ((kt - kt0) & 1) * 16384;
            kv_write<true>(R, buf, tid); if (kt < kt1) kv_load<true>(R, K, V, ldk, kt + 1, tid);
            __syncthreads();
            f32x16 s0, s1; qk_tile(s0, s1, buf, qf, r32, hi, negm);
            const bool fullc = (64 * kt + 63) <= cmin;
            if (!fullc) {
#pragma unroll
                for (int r = 0; r < 16; ++r) { if (!key_valid<MODE>(kt, 0, r, hi, tpos, cmaxl)) s0[r] = -INFINITY; if (!key_valid<MODE>(kt, 1, r, hi, tpos, cmaxl)) s1[r] = -INFINITY; } }
#pragma unroll
            for (int r = 0; r < 16; ++r) { s0[r] = __builtin_amdgcn_exp2f(s0[r]); s1[r] = __builtin_amdgcn_exp2f(s1[r]); }
            float px[2][4];
#pragma unroll
            for (int rr = 0; rr < 4; ++rr) { px[0][rr] = __shfl_xor(s0[4 * rr + 3], 32); px[1][rr] = __shfl_xor(s1[4 * rr + 3], 32); }
#pragma unroll
            for (int kh = 0; kh < 2; ++kh)
#pragma unroll
                for (int rr = 0; rr < 4; ++rr) { const f32x16& p = kh ? s1 : s0; const int j = 16 * kt + 8 * kh + 2 * rr + hi;
                    const float inc = hi ? px[kh][rr] : (rr >= 1 ? px[kh][rr - 1] : (kh ? px[0][3] : carry));
                    float bin = (((p[4 * rr] + p[4 * rr + 1]) + (p[4 * rr + 2] + p[4 * rr + 3])) + inc) * il;
                    bin += __builtin_bit_cast(float, __builtin_amdgcn_mov_dpp(__builtin_bit_cast(int, bin), 0xB1, 0xf, 0xf, true));
                    bin += __builtin_bit_cast(float, __builtin_amdgcn_mov_dpp(__builtin_bit_cast(int, bin), 0x4E, 0xf, 0xf, true));
                    if ((r32 & 3) == 0 && j < 128) impt[j] = bin; }
            carry = px[1][3];
            pv_tile(o, buf + 8192, s0, s1, lane);
        }
        __syncthreads();
    } else {
        KVRegs R1;
        kv_load<true>(R, K, V, ldk, kt0, tid); if (kt0 + 1 <= kt1) kv_load<true>(R1, K, V, ldk, kt0 + 1, tid);
        kv_write<true>(R, kvb, tid); if (kt0 + 1 <= kt1) kv_write<true>(R1, kvb + 16384, tid);
        if (kt0 + 2 <= kt1) kv_load<true>(R, K, V, ldk, kt0 + 2, tid); if (kt0 + 3 <= kt1) kv_load<true>(R1, K, V, ldk, kt0 + 3, tid);
        __syncthreads();
        auto step = [&](auto mtag, int kt) __attribute__((always_inline)) {
            constexpr bool MASKED = decltype(mtag)::value; constexpr bool SEL = MODE == M_SLC;
            LAS unsigned char* bufA = kvb + (((kt - kt0) >> 1) & 1) * 32768; LAS unsigned char* bufB = bufA + 16384; const bool two = kt + 1 <= kt1;
            { LAS unsigned char* nA = kvb + ((((kt - kt0) >> 1) + 1) & 1) * 32768;
              if (kt + 2 <= kt1) kv_write<true>(R, nA, tid); if (kt + 3 <= kt1) kv_write<true>(R1, nA + 16384, tid);
              if (kt + 4 <= kt1) kv_load<true>(R, K, V, ldk, kt + 4, tid); if (kt + 5 <= kt1) kv_load<true>(R1, K, V, ldk, kt + 5, tid); }
            unsigned mA = ~0u, mB = ~0u;
            if (SEL) { const unsigned w = kt < 32 ? selw[0] : kt < 64 ? selw[1] : kt < 96 ? selw[2] : selw[3]; mA = 0u - ((w >> (kt & 31)) & 1u);
                const int k2 = kt + 1; const unsigned w2 = k2 < 32 ? selw[0] : k2 < 64 ? selw[1] : k2 < 96 ? selw[2] : selw[3]; mB = 0u - ((w2 >> (k2 & 31)) & 1u); }
            f32x16 a0, a1, b0, b1; bf16x8 fa[8], fb[8];
            if (two) {
                k_frags(fa, bufA, r32, hi); k_frags(fb, bufB, r32, hi); __builtin_amdgcn_sched_barrier(0);
                if (NOSHIFT) qk_mfma_z(a0, a1, fa, qf); else qk_mfma(a0, a1, fa, qf, negM);
                if (MASKED) mask_tile<MODE>(a0, a1, kt, qt, tp0, th, hi, tpos);
                if (NOSHIFT) qk_mfma_z(b0, b1, fb, qf); else qk_mfma(b0, b1, fb, qf, negM); { const float sa = exp_tile(a0, a1); l += SEL ? __uint_as_float(__float_as_uint(sa) & mA) : sa; }
                v_frags(fa, bufA + 8192, lane); __builtin_amdgcn_sched_barrier(0);
                if (MASKED) mask_tile<MODE>(b0, b1, kt + 1, qt, tp0, th, hi, tpos);
                pv_mfma<SEL>(o, fa, a0, a1, mA); { const float sb = exp_tile(b0, b1); l += SEL ? __uint_as_float(__float_as_uint(sb) & mB) : sb; }
                v_frags(fb, bufB + 8192, lane); __builtin_amdgcn_sched_barrier(0);
                pv_mfma<SEL>(o, fb, b0, b1, mB);
            } else {
                k_frags(fa, bufA, r32, hi); if (NOSHIFT) qk_mfma_z(a0, a1, fa, qf); else qk_mfma(a0, a1, fa, qf, negM); v_frags(fa, bufA + 8192, lane);
                if (MASKED) mask_tile<MODE>(a0, a1, kt, qt, tp0, th, hi, tpos);
                { const float sa = exp_tile(a0, a1); l += SEL ? __uint_as_float(__float_as_uint(sa) & mA) : sa; }
                pv_mfma<SEL>(o, fa, a0, a1, mA);
            }
            __syncthreads();
        };
        int kt = kt0;
        if (MODE == M_WIN) { step(BTag<true>{}, kt); kt += 2; }
        for (; kt + 1 < kt1; kt += 2) step(BTag<false>{}, kt);
        if (MODE == M_SLC) load_old();
        if (kt <= kt1) step(BTag<true>{}, kt);
        l += __shfl_xor(l, 32);
    }
    { const float* sg = (const float*)(ws + WS_SMALLG); const int br = MODE == M_CMP ? 0 : MODE == M_SLC ? 1 : 2;
      const float gt = sigm(sg[trow * 32 + 8 + head * 3 + br]) * (l > 0.f ? 1.0f / l : 0.f);
#pragma unroll
      for (int dt = 0; dt < 2; ++dt)
#pragma unroll
          for (int rr = 0; rr < 4; ++rr) { float v0 = o[dt][4 * rr] * gt, v1 = o[dt][4 * rr + 1] * gt, v2 = o[dt][4 * rr + 2] * gt, v3 = o[dt][4 * rr + 3] * gt;
              if (MODE != M_WIN) { v0 += pg8::bflo(old[dt][rr].x); v1 += pg8::bfhi(old[dt][rr].x); v2 += pg8::bflo(old[dt][rr].y); v3 += pg8::bfhi(old[dt][rr].y); }
              u32x2 nw; nw.x = cvtpk(v0, v1); nw.y = cvtpk(v2, v3); *(u32x2*)(op + 32 * dt + 8 * rr) = nw; } }
    if (MODE == M_CMP) {
        const int cur = qt, tk = tid >> 3, part = tid & 7; const LAS float* row = (const LAS float*)(lds + LDS_IMP) + tk * IMPS + 16 * part;
        unsigned key[16];
#pragma unroll
        for (int k = 0; k < 16; ++k) { const int j = 16 * part + k; float v = row[k]; if (j == 0 || j == cur || j == cur - 1) v = 1e4f; if (j > cur) v = -1e30f;
            const unsigned u = __float_as_uint(v); key[k] = (u & 0x80000000u) ? ~u : (u | 0x80000000u); }
        unsigned sel16;
        if (cur < 16) { sel16 = part == 0 ? ((2u << cur) - 1u) : 0u; }
        else {
            auto sum8 = [](int v) { v += __builtin_amdgcn_mov_dpp(v, 0xB1, 0xf, 0xf, true); v += __builtin_amdgcn_mov_dpp(v, 0x4E, 0xf, 0xf, true); v += __builtin_amdgcn_mov_dpp(v, 0x141, 0xf, 0xf, true); return v; };
            unsigned T = 0u;
            bool done = false;
            for (int bit = 31; bit >= 0; --bit) { const unsigned cand = T | (1u << bit); int cnt = 0;
#pragma unroll
                for (int k = 0; k < 16; ++k) cnt += key[k] >= cand ? 1 : 0;
                const int tot = sum8(cnt); if (!done && tot >= 16) T = cand; done = done || tot == 16;
                if (__builtin_amdgcn_ballot_w64(!done) == 0ull) break; }
            int ngt = 0, neq = 0;
#pragma unroll
            for (int k = 0; k < 16; ++k) { ngt += key[k] > T ? 1 : 0; neq += key[k] == T ? 1 : 0; }
            const int need = 16 - sum8(ngt);
            int pre = neq;
            { int t1 = __builtin_amdgcn_update_dpp(0, pre, 0x111, 0xf, 0xf, true); if (part >= 1) pre += t1; int t2 = __builtin_amdgcn_update_dpp(0, pre, 0x112, 0xf, 0xf, true); if (part >= 2) pre += t2; int t4 = __builtin_amdgcn_update_dpp(0, pre, 0x114, 0xf, 0xf, true); if (part >= 4) pre += t4; }
            int rank = pre - neq; sel16 = 0u;
#pragma unroll
            for (int k = 0; k < 16; ++k) { const bool eq = key[k] == T; if (key[k] > T || (eq && rank < need)) sel16 |= 1u << k; rank += eq ? 1 : 0; }
        }
        *((unsigned short*)((unsigned*)(ws + WS_SEL) + (((size_t)b * SEQ + tp0 + tk) * 2 + g) * 4) + part) = (unsigned short)sel16;
        __syncthreads();
    }
}
template <int MODE> __device__ __forceinline__ void attn_phase(LAS unsigned char* lds, const Args& a, int G, int cu, size_t out_off = WS_HMON) {
    int tid = threadIdx.x; asm volatile("" : "+v"(tid)); unsigned char* ws = a.ws;
    float negM = 0.f;
    if (MODE != M_CMP) {
        const float* qw = a.in[8]; const float* kw = MODE == M_SLC ? a.in[10] : a.in[11]; float mq = fabsf(qw[tid & 63]), mk = fabsf(kw[tid & 63]);
#pragma unroll
        for (int o = 1; o < 64; o <<= 1) { mq = fmaxf(mq, __shfl_xor(mq, o)); mk = fmaxf(mk, __shfl_xor(mk, o)); }
        negM = -fminf(11.5416f * mq * mk * 1.02f, 100.f); negM = __uint_as_float(__builtin_amdgcn_readfirstlane(__float_as_uint(negM))); }
    for (int u = cu; u < 256; u += G) { const int bg = u & 7, i = u >> 3;
        for (int k = 0; k < 4; ++k) { const int qt = k == 0 ? i : k == 1 ? 63 - i : k == 2 ? 64 + i : 127 - i;
            if (MODE != M_CMP && negM >= NOSHIFT_THR) attn_unit<MODE, MODE != M_CMP>(lds, ws, bg >> 1, bg & 1, qt, tid, negM, out_off);
            else attn_unit<MODE>(lds, ws, bg >> 1, bg & 1, qt, tid, negM, out_off); } }
}
}
namespace ml {
typedef short bf16x8 __attribute__((ext_vector_type(8)));
typedef short s16x4 __attribute__((ext_vector_type(4)));
typedef float f32x16 __attribute__((ext_vector_type(16)));
constexpr size_t WS_GC = WS_MLS, WS_AM = WS_MLS + 8192, WS_MP = WS_MLS + 16384, WS_DN = WS_IPRE, WS_NP = WS_LOGF;
__device__ __forceinline__ float fexp(float x) { return __builtin_amdgcn_exp2f(x * 1.4426950408889634f); }
__device__ __forceinline__ float logsig(float x) { return x >= 0.f ? -log1pf(expf(-x)) : x - log1pf(expf(x)); }
__device__ __forceinline__ float scan_add(float v, int lane) {
#pragma unroll
    for (int o = 1; o < 64; o <<= 1) { const float t = __shfl_up(v, o); if (lane >= o) v += t; }
    return v;
}
__device__ __forceinline__ float scan_max(float v, int lane) {
#pragma unroll
    for (int o = 1; o < 64; o <<= 1) { const float t = __shfl_up(v, o); if (lane >= o) v = fmaxf(v, t); }
    return v;
}
__device__ __forceinline__ float wave_max(float v) {
#pragma unroll
    for (int o = 1; o < 64; o <<= 1) v = fmaxf(v, __shfl_xor(v, o));
    return v;
}
__device__ __forceinline__ float conv_silu(const bf16_t* qkpre, const float* cw, const float* cb, size_t trow, int tp, int ch) {
    float s = cb[ch];
#pragma unroll
    for (int k = 0; k < 4; ++k) { const int d = 3 - k; if (tp >= d) s += cw[k * 512 + ch] * bf2f(qkpre[(trow - d) * 512 + ch]); }
    return s * sigm(s);
}
__device__ __forceinline__ s16x4 vtr(const LAS unsigned char* p) { typedef short v4i16_t __attribute__((ext_vector_type(4))); return __builtin_bit_cast(s16x4, __builtin_amdgcn_ds_read_tr16_b64_v4i16((LAS v4i16_t*)p)); }
__device__ __forceinline__ bf16x8 cat8(const s16x4& a, const s16x4& b) { return (bf16x8){a[0], a[1], a[2], a[3], b[0], b[1], b[2], b[3]}; }

template <int NPART> __device__ __forceinline__ void stage_pre(LAS unsigned short* pre, const bf16_t* qkpre, size_t t0, int tp0, int h, int part0, int tid) {
    for (int i = tid; i < NPART * 67 * 8; i += 512) { const int ch8 = i & 7, r = (i >> 3) % 67, p = (i >> 3) / 67; const int tp = tp0 - 3 + r;
        u32x4 v = {0u, 0u, 0u, 0u}; if (tp >= 0) v = *(const u32x4*)(qkpre + (t0 - 3 + r) * 512 + (part0 + p) * 256 + h * 64 + ch8 * 8);
        *(LAS u32x4*)(pre + (p * 67 + r) * 64 + ch8 * 8) = v; }
}
__device__ __forceinline__ float conv_lds(const LAS unsigned short* pre, int p, int l, int d, const float (&cw4)[4], float cb1) {
    float s = cb1;
#pragma unroll
    for (int k = 0; k < 4; ++k) s += cw4[k] * bf2f(pre[(p * 67 + l + k) * 64 + d]);
    return s * sigm(s);
}
__device__ __forceinline__ int off256(int row, int colbyte) { return row * 256 + ((((colbyte >> 6) ^ row) & 3) << 6) + (colbyte & 63); }
__device__ __forceinline__ int off128t(int row, int colbyte) { return row * 128 + (colbyte ^ (((row >> 1) & 1) << 6)); }
__device__ __forceinline__ int off128r(int row, int chunk) { return row * 128 + ((chunk ^ ((row >> 1) & 7)) << 4); }
__device__ __forceinline__ void stage256(LAS unsigned char* dst, const bf16_t* src, size_t ld, int tid) {
    for (int i = tid; i < 64 * 16; i += 512) { const int r = i >> 4, c16 = i & 15; *(LAS u32x4*)(dst + off256(r, c16 * 16)) = *(const u32x4*)(src + (size_t)r * ld + c16 * 8); }
}

__device__ __forceinline__ void a_stage(LAS unsigned char* lds, const Args& a, int U, int tid, int lane, int wave) {
    unsigned char* ws = a.ws; const bf16_t* qkpre = (const bf16_t*)(ws + WS_QKPRE); const bf16_t* mv = (const bf16_t*)(ws + WS_MV); const float* sg = (const float*)(ws + WS_SMALLG);
    LAS float* wl = (LAS float*)(lds + 24576); LAS unsigned short* pre = (LAS unsigned short*)(lds + 25600);
    const int c = U & 127, h = (U >> 7) & 3, b = U >> 9; const int tp0 = 64 * c; const size_t t0 = (size_t)b * SEQ + tp0;
    if (wave == 0) { const size_t t = t0 + lane; const float ip = sg[t * 32 + h] + a.in[5][h]; const float lf = logsig(sg[t * 32 + 4 + h] + a.in[6][h]);
        const float bc = scan_add(lf, lane); const float g = __shfl(bc, 63); const float av = g - bc + ip; const float am = wave_max(av); wl[lane] = fexp(av - am);
        if (lane == 0) { ((float*)(ws + WS_GC))[U] = g; ((float*)(ws + WS_AM))[U] = am; } }
    stage256(lds, mv + t0 * 512 + h * 128, 512, tid); stage_pre<1>(pre, qkpre, t0, tp0, h, 1, tid);
}
__device__ __forceinline__ void a_conv(LAS unsigned char* lds, const Args& a, int U, int tid) {
    asm volatile("" : "+v"(tid));
    const int h = (U >> 7) & 3; const int d2 = tid & 31, l0 = tid >> 5, ch = 256 + h * 64 + 2 * d2;
    float cw[4][2];
#pragma unroll
    for (int k = 0; k < 4; ++k) { cw[k][0] = a.in[3][k * 512 + ch]; cw[k][1] = a.in[3][k * 512 + ch + 1]; }
    const float cb0 = a.in[4][ch], cb1 = a.in[4][ch + 1];
    const LAS float* wl = (const LAS float*)(lds + 24576) + l0; const LAS unsigned* pre = (const LAS unsigned*)(lds + 25600) + l0 * 32 + d2;
    LAS unsigned char* w0 = lds + 16384 + off128t(l0, 4 * d2);
#pragma unroll
    for (int i = 0; i < 4; ++i) { float s0 = cb0, s1 = cb1;
#pragma unroll
        for (int k = 0; k < 4; ++k) { const unsigned w = pre[(16 * i + k) * 32]; s0 += cw[k][0] * pg8::bflo(w); s1 += cw[k][1] * pg8::bfhi(w); }
        const float wv = wl[16 * i]; *(LAS unsigned*)(w0 + i * 2048) = pg8::cvt_pk_bf16(wv * s0 * sigm(s0), wv * s1 * sigm(s1)); }
}
__device__ __forceinline__ void a_compute(LAS unsigned char* lds, const Args& a, int U, int tid, int lane, int wave) {
    unsigned char* ws = a.ws; LAS unsigned char* Vs = lds; LAS unsigned char* KW = lds + 16384; const int r32 = lane & 31, hi = lane >> 5;
    const int dtile = wave & 1, et = wave >> 1; const int li = lane & 15, cb16 = 16 * ((lane >> 4) & 1);
    f32x16 acc = {0.f, 0.f, 0.f, 0.f, 0.f, 0.f, 0.f, 0.f, 0.f, 0.f, 0.f, 0.f, 0.f, 0.f, 0.f, 0.f};
#pragma unroll
    for (int kk = 0; kk < 4; ++kk) { const int rb = 16 * kk + 8 * hi + (li >> 2);
        const int ca = (32 * dtile + cb16 + 4 * (li & 3)) * 2, cv = (32 * et + cb16 + 4 * (li & 3)) * 2;
        const bf16x8 af = cat8(vtr(KW + off128t(rb, ca)), vtr(KW + off128t(rb + 4, ca)));
        const bf16x8 bf = cat8(vtr(Vs + off256(rb, cv)), vtr(Vs + off256(rb + 4, cv)));
        acc = __builtin_amdgcn_mfma_f32_32x32x16_bf16(af, bf, acc, 0, 0, 0); }
    bf16_t* dc = (bf16_t*)(ws + WS_DC) + (size_t)U * 8192 + 32 * et + r32;
#pragma unroll
    for (int r = 0; r < 16; ++r) dc[(32 * dtile + (r & 3) + 8 * (r >> 2) + 4 * hi) * 128] = (bf16_t)f2bf(acc[r]);
    if (tid < 64) { float s = 0.f; for (int l = 0; l < 64; ++l) s += bf2f(*(const LAS unsigned short*)(KW + off128t(l, tid * 2))); ((float*)(ws + WS_DN))[(size_t)U * 64 + tid] = s; }
}
__device__ __forceinline__ void phase_a(LAS unsigned char* lds, const Args& a, int G, int cu) {
    int tid = threadIdx.x; asm volatile("" : "+v"(tid)); const int lane = tid & 63, wave = __builtin_amdgcn_readfirstlane(tid >> 6);
    LAS unsigned char* l0 = lds; LAS unsigned char* l1 = lds + 36864;
    for (int U = cu; U < 2048; U += 2 * G) { const int U1 = U + G; const bool two = U1 < 2048;
        a_stage(l0, a, U, tid, lane, wave); if (two) a_stage(l1, a, U1, tid, lane, wave);
        __syncthreads();
        a_conv(l0, a, U, tid); if (two) a_conv(l1, a, U1, tid);
        __syncthreads();
        a_compute(l0, a, U, tid, lane, wave); if (two) a_compute(l1, a, U1, tid, lane, wave);
        __syncthreads();
    }
}
__device__ __forceinline__ void phase_b(const Args& a, int gtid, int nthr) {
    unsigned char* ws = a.ws; const float* __restrict__ gc = (const float*)(ws + WS_GC); const float* __restrict__ am = (const float*)(ws + WS_AM); float* __restrict__ mp = (float*)(ws + WS_MP);
    const bf16_t* __restrict__ dc = (const bf16_t*)(ws + WS_DC); bf16_t* __restrict__ cp = (bf16_t*)(ws + WS_CPREV); const float* __restrict__ dn = (const float*)(ws + WS_DN); float* __restrict__ np = (float*)(ws + WS_NP);
    for (int i = gtid; i < 16 * 2048; i += nthr) { const int bh = i >> 11, de = (i & 2047) * 4; f32x4 C = {0.f, 0.f, 0.f, 0.f}; float m = 0.f;
        for (int c0 = 0; c0 < 128; c0 += 8) { pg8::u32x2 xr[8]; float g[8], ax[8];
#pragma unroll
            for (int j = 0; j < 8; ++j) { const int U = bh * 128 + c0 + j; xr[j] = *(const pg8::u32x2*)(dc + (size_t)U * 8192 + de); g[j] = gc[U]; ax[j] = am[U]; }
#pragma unroll
            for (int j = 0; j < 8; ++j) { const int U = bh * 128 + c0 + j;
                pg8::u32x2 w; w.x = pg8::cvt_pk_bf16(C[0], C[1]); w.y = pg8::cvt_pk_bf16(C[2], C[3]); *(pg8::u32x2*)(cp + (size_t)U * 8192 + de) = w;
                const float mn = fmaxf(g[j] + m, ax[j]); const float dec = fexp(g[j] + m - mn), sc = fexp(ax[j] - mn); const f32x4 x = {pg8::bflo(xr[j].x), pg8::bfhi(xr[j].x), pg8::bflo(xr[j].y), pg8::bfhi(xr[j].y)}; C = C * dec + x * sc; m = mn; } } }
    for (int i = nthr - 1 - gtid; i < 16 * 64; i += nthr) { const int bh = i >> 6, d = i & 63; float nn = 0.f, m = 0.f;
        for (int c0 = 0; c0 < 128; c0 += 8) { float g[8], ax[8], x[8];
#pragma unroll
            for (int j = 0; j < 8; ++j) { const int U = bh * 128 + c0 + j; g[j] = gc[U]; ax[j] = am[U]; x[j] = dn[(size_t)U * 64 + d]; }
#pragma unroll
            for (int j = 0; j < 8; ++j) { const int U = bh * 128 + c0 + j; np[(size_t)U * 64 + d] = nn; if (d == 0) mp[U] = m;
                const float mn = fmaxf(g[j] + m, ax[j]); const float dec = fexp(g[j] + m - mn), sc = fexp(ax[j] - mn); nn = dec * nn + sc * x[j]; m = mn; } } }
}
struct CRegs { u32x4 pre[3], v[2], c[2]; };
__device__ __forceinline__ void c_load(CRegs& R, const Args& a, int U, int tid) {
    unsigned char* ws = a.ws; const bf16_t* qkpre = (const bf16_t*)(ws + WS_QKPRE); const bf16_t* mv = (const bf16_t*)(ws + WS_MV);
    const int c = U & 127, h = (U >> 7) & 3, b = U >> 9; const int tp0 = 64 * c; const size_t t0 = (size_t)b * SEQ + tp0;
#pragma unroll
    for (int k = 0; k < 3; ++k) { const int i = tid + 512 * k; R.pre[k] = (u32x4){0u, 0u, 0u, 0u};
        if (i < 2 * 67 * 8) { const int ch8 = i & 7, r = (i >> 3) % 67, p = (i >> 3) / 67; if (tp0 - 3 + r >= 0) R.pre[k] = *(const u32x4*)(qkpre + (t0 - 3 + r) * 512 + p * 256 + h * 64 + ch8 * 8); } }
#pragma unroll
    for (int k = 0; k < 2; ++k) { const int i = tid + 512 * k, r = i >> 4, c16 = i & 15; R.v[k] = *(const u32x4*)(mv + (t0 + r) * 512 + h * 128 + c16 * 8); R.c[k] = *(const u32x4*)((const bf16_t*)(ws + WS_CPREV) + (size_t)U * 8192 + r * 128 + c16 * 8); }
}
__device__ __forceinline__ void c_store(const CRegs& R, LAS unsigned char* lds, int tid) {
    LAS unsigned short* pre = (LAS unsigned short*)(lds + 49152);
#pragma unroll
    for (int k = 0; k < 3; ++k) { const int i = tid + 512 * k; if (i < 2 * 67 * 8) { const int ch8 = i & 7, r = (i >> 3) % 67, p = (i >> 3) / 67; *(LAS u32x4*)(pre + (p * 67 + r) * 64 + ch8 * 8) = R.pre[k]; } }
#pragma unroll
    for (int k = 0; k < 2; ++k) { const int i = tid + 512 * k, r = i >> 4, c16 = i & 15; *(LAS u32x4*)(lds + off256(r, c16 * 16)) = R.v[k]; *(LAS u32x4*)(lds + 16384 + off256(r, c16 * 16)) = R.c[k]; }
}
__device__ __forceinline__ void c_gates(LAS unsigned char* lds, const Args& a, int U, int lane) {
    unsigned char* ws = a.ws; const float* sg = (const float*)(ws + WS_SMALLG); LAS float* sm = (LAS float*)(lds + 67584);
    const int c = U & 127, h = (U >> 7) & 3, b = U >> 9; const size_t tg = (size_t)b * SEQ + 64 * c + lane;
    const float ip = sg[tg * 32 + h] + a.in[5][h]; const float lf = logsig(sg[tg * 32 + 4 + h] + a.in[6][h]);
    const float bc = scan_add(lf, lane); const float u = ip - bc; const float pm = scan_max(u, lane); const float mprev = ((const float*)(ws + WS_MP))[U];
    const float mt = bc + fmaxf(mprev, pm); sm[lane] = bc; sm[64 + lane] = u * 1.4426950408889634f  ; sm[128 + lane] = mt; sm[192 + lane] = fexp(bc + mprev - mt); sm[256 + lane] = ((const float*)(ws + WS_NP))[(size_t)U * 64 + lane];
}
__device__ __forceinline__ void c_conv(LAS unsigned char* lds, const Args& a, int U, int tid) {
    asm volatile("" : "+v"(tid));
    const int h = (U >> 7) & 3;
    const int d2 = tid & 31, part = (tid >> 5) & 1, l0 = tid >> 6;
    const int ch = part * 256 + h * 64 + 2 * d2; float cw[4][2];
#pragma unroll
    for (int k = 0; k < 4; ++k) { cw[k][0] = a.in[3][k * 512 + ch]; cw[k][1] = a.in[3][k * 512 + ch + 1]; }
    const float cb0 = a.in[4][ch], cb1 = a.in[4][ch + 1], sc = part ? 1.0f : 0.125f;
    const LAS unsigned* pre = (const LAS unsigned*)(lds + 49152) + (part * 67 + l0) * 32 + d2;
    const int c0 = (d2 >> 2) ^ (l0 >> 1);
    LAS unsigned char* w0 = lds + 32768 + part * 8192 + l0 * 128 + (d2 & 3) * 4 + (c0 << 4); LAS unsigned char* w1 = lds + 32768 + part * 8192 + l0 * 128 + (d2 & 3) * 4 + ((c0 ^ 4) << 4);
#pragma unroll
    for (int i = 0; i < 8; ++i) { float s0 = cb0, s1 = cb1;
#pragma unroll
        for (int k = 0; k < 4; ++k) { const unsigned w = pre[(8 * i + k) * 32]; s0 += cw[k][0] * pg8::bflo(w); s1 += cw[k][1] * pg8::bfhi(w); }
        *(LAS unsigned*)((i & 1 ? w1 : w0) + i * 1024) = pg8::cvt_pk_bf16(sc * s0 * sigm(s0), sc * s1 * sigm(s1)); }
}
template <bool B> struct BTag { static constexpr bool value = B; };
__device__ __forceinline__ void c_compute(f32x16& o, LAS unsigned char* lds, int lane, int wave) {
    asm volatile("" : "+v"(lane));
    LAS unsigned char* Vs = lds; LAS unsigned char* Cs = lds + 16384; LAS unsigned char* Qs = lds + 32768; LAS unsigned char* Ks = lds + 40960; LAS float* sm = (LAS float*)(lds + 67584);
    const int r32 = lane & 31, hi = lane >> 5, tt = wave & 1, et = wave >> 1, t = 32 * tt + r32;
    bf16x8 qf[4];
#pragma unroll
    for (int kk = 0; kk < 4; ++kk) qf[kk] = *(const LAS bf16x8*)(Qs + off128r(t, 2 * kk + hi));
    const float bt = (sm[t] - sm[128 + t]) * 1.4426950408889634f, isc = sm[192 + t], mt = sm[128 + t];
    float dq = 0.f;
#pragma unroll
    for (int kk = 0; kk < 4; ++kk) { const u32x4 w = __builtin_bit_cast(u32x4, qf[kk]); f32x4 x0, x1; pg8::unpack8(w, x0, x1); const LAS float* npp = sm + 256 + 16 * kk + 8 * hi;
        dq += x0[0] * npp[0] + x0[1] * npp[1] + x0[2] * npp[2] + x0[3] * npp[3] + x1[0] * npp[4] + x1[1] * npp[5] + x1[2] * npp[6] + x1[3] * npp[7]; }
    o = (f32x16){0.f, 0.f, 0.f, 0.f, 0.f, 0.f, 0.f, 0.f, 0.f, 0.f, 0.f, 0.f, 0.f, 0.f, 0.f, 0.f};
    const int li = lane & 15, cv = (32 * et + 16 * ((lane >> 4) & 1) + 4 * (li & 3)) * 2;
#pragma unroll
    for (int kk = 0; kk < 4; ++kk) { const int rb = 16 * kk + 8 * hi + (li >> 2); const bf16x8 cf = cat8(vtr(Cs + off256(rb, cv)), vtr(Cs + off256(rb + 4, cv)));
        o = __builtin_amdgcn_mfma_f32_32x32x16_bf16(cf, qf[kk], o, 0, 0, 0); }
#pragma unroll
    for (int r = 0; r < 16; ++r) o[r] *= isc;
    float psum = 0.f;
#pragma unroll
    for (int sh = 0; sh < 2; ++sh) { if (sh > tt) continue;
        f32x16 s = {0.f, 0.f, 0.f, 0.f, 0.f, 0.f, 0.f, 0.f, 0.f, 0.f, 0.f, 0.f, 0.f, 0.f, 0.f, 0.f};
#pragma unroll
        for (int kk = 0; kk < 4; ++kk) { const bf16x8 kf = *(const LAS bf16x8*)(Ks + off128r(32 * sh + r32, 2 * kk + hi)); s = __builtin_amdgcn_mfma_f32_32x32x16_bf16(kf, qf[kk], s, 0, 0, 0); }
        f32x4 u4[4];
#pragma unroll
        for (int rr = 0; rr < 4; ++rr) u4[rr] = *(const LAS f32x4*)(sm + 64 + 32 * sh + 8 * rr + 4 * hi);
        if (sh == tt) {
#pragma unroll
            for (int r = 0; r < 16; ++r) { float p = s[r] * __builtin_amdgcn_exp2f(u4[r >> 2][r & 3] + bt); if (8 * (r >> 2) + 4 * hi + (r & 3) > r32) p = 0.f; s[r] = p; psum += p; }
        } else {
#pragma unroll
            for (int r = 0; r < 16; ++r) { const float p = s[r] * __builtin_amdgcn_exp2f(u4[r >> 2][r & 3] + bt); s[r] = p; psum += p; }
        }
#pragma unroll
        for (int ks = 0; ks < 2; ++ks) { const int rb = 32 * sh + 16 * ks + 4 * hi + (li >> 2); const bf16x8 vf = cat8(vtr(Vs + off256(rb, cv)), vtr(Vs + off256(rb + 8, cv)));
            u32x4 w; w.x = pg8::cvt_pk_bf16(s[8 * ks + 0], s[8 * ks + 1]); w.y = pg8::cvt_pk_bf16(s[8 * ks + 2], s[8 * ks + 3]); w.z = pg8::cvt_pk_bf16(s[8 * ks + 4], s[8 * ks + 5]); w.w = pg8::cvt_pk_bf16(s[8 * ks + 6], s[8 * ks + 7]);
            o = __builtin_amdgcn_mfma_f32_32x32x16_bf16(vf, __builtin_bit_cast(bf16x8, w), o, 0, 0, 0); } }
    psum += __shfl_xor(psum, 32); dq += __shfl_xor(dq, 32);
    const float den = isc * dq + psum; const float dv = 1.0f / fmaxf(fabsf(den), fexp(-mt));
    float ss = 0.f;
#pragma unroll
    for (int r = 0; r < 16; ++r) { o[r] *= dv; ss += o[r] * o[r]; }
    ss += __shfl_xor(ss, 32);
    if (hi == 0) sm[320 + et * 64 + t] = ss;
}
__device__ __forceinline__ void c_epilogue(const f32x16& o, LAS unsigned char* lds, const Args& a, int U, int lane, int wave) {
    unsigned char* ws = a.ws; const bf16_t* mo = (const bf16_t*)(ws + WS_MO); LAS float* sm = (LAS float*)(lds + 67584);
    const int r32 = lane & 31, hi = lane >> 5, tt = wave & 1, et = wave >> 1, t = 32 * tt + r32; const int c = U & 127, h = (U >> 7) & 3, b = U >> 9; const size_t t0 = (size_t)b * SEQ + 64 * c;
    const float tot = (sm[320 + t] + sm[384 + t]) + (sm[448 + t] + sm[512 + t]); const float rs = 1.0f / sqrtf(tot * (1.0f / 128.f) + NEPS); const size_t tr = t0 + t;
    const float* onw = a.in[7] + h * 128 + 32 * et + 4 * hi; const bf16_t* mop = mo + tr * 512 + h * 128 + 32 * et + 4 * hi; bf16_t* op = (bf16_t*)(ws + WS_HMON) + tr * 1024 + h * 128 + 32 * et + 4 * hi;
#pragma unroll
    for (int rr = 0; rr < 4; ++rr) { const f32x4 w4 = *(const f32x4*)(onw + 8 * rr); const pg8::u32x2 m2 = *(const pg8::u32x2*)(mop + 8 * rr);
        const float o0 = o[4 * rr] * rs * w4[0] * sigm(pg8::bflo(m2.x)), o1 = o[4 * rr + 1] * rs * w4[1] * sigm(pg8::bfhi(m2.x)), o2 = o[4 * rr + 2] * rs * w4[2] * sigm(pg8::bflo(m2.y)), o3 = o[4 * rr + 3] * rs * w4[3] * sigm(pg8::bfhi(m2.y));
        pg8::u32x2 ov; ov.x = pg8::cvt_pk_bf16(o0, o1); ov.y = pg8::cvt_pk_bf16(o2, o3); *(pg8::u32x2*)(op + 8 * rr) = ov; }
}
__device__ __forceinline__ void phase_c(LAS unsigned char* lds, const Args& a, int G, int cu) {
    int tid = threadIdx.x; asm volatile("" : "+v"(tid)); const int lane = tid & 63, wave = __builtin_amdgcn_readfirstlane(tid >> 6);
    LAS unsigned char* l0 = lds; LAS unsigned char* l1 = lds + 71680;
    for (int U = cu; U < 2048; U += 2 * G) { const int U1 = U + G; const bool two = U1 < 2048;
        { CRegs r0, r1; c_load(r0, a, U, tid); if (two) c_load(r1, a, U1, tid);
          if (wave == 0) { c_gates(l0, a, U, lane); if (two) c_gates(l1, a, U1, lane); }
          c_store(r0, l0, tid); if (two) c_store(r1, l1, tid); }
        __syncthreads();
        c_conv(l0, a, U, tid); if (two) c_conv(l1, a, U1, tid);
        __syncthreads();
        f32x16 o0, o1;
        c_compute(o0, l0, lane, wave); if (two) c_compute(o1, l1, lane, wave);
        __syncthreads();
        c_epilogue(o0, l0, a, U, lane, wave); if (two) c_epilogue(o1, l1, a, U1, lane, wave);
        __syncthreads();
    }
}
}
__device__ __forceinline__ void cmpout_phase(const Args& a, int G, int cu, int tid_) {
    typedef short bf16x8_t __attribute__((ext_vector_type(8)));
    int tid = tid_; asm volatile("" : "+v"(tid));
    unsigned char* ws = a.ws; const bf16_t* hid = (const bf16_t*)(ws + WS_CMPH); bf16_t* cmpb = (bf16_t*)(ws + WS_CMPB);
    const int lane = tid & 63, wave = tid >> 6, rh = wave & 1, ct = wave >> 1, li = lane & 15, kg = lane >> 4;
    for (int rb = cu; rb < 256; rb += G) { const int r0 = 32 * rb + 16 * rh, kv = r0 >> 12; const float* w2 = (kv ? a.in[17] : a.in[14]) + 16 * ct + li;
        const bf16_t* hp = hid + (size_t)(r0 + li) * 256 + 8 * kg;
        f32x4 acc = {0.f, 0.f, 0.f, 0.f};
#pragma unroll
        for (int kk = 0; kk < 8; ++kk) { const u32x4 av = *(const u32x4*)(hp + 32 * kk); const float* w = w2 + (size_t)(32 * kk + 8 * kg) * 64;
            u32x4 bv; bv.x = pg8::cvt_pk_bf16(w[0], w[64]); bv.y = pg8::cvt_pk_bf16(w[128], w[192]); bv.z = pg8::cvt_pk_bf16(w[256], w[320]); bv.w = pg8::cvt_pk_bf16(w[384], w[448]);
            acc = __builtin_amdgcn_mfma_f32_16x16x32_bf16(__builtin_bit_cast(bf16x8_t, av), __builtin_bit_cast(bf16x8_t, bv), acc, 0, 0, 0); }
#pragma unroll
        for (int r = 0; r < 4; ++r) { const int row = r0 + 4 * kg + r; cmpb[(size_t)row * 64 + 16 * ct + li] = (bf16_t)f2bf((row & 511) < NCMP ? acc[r] : 0.f); } }
}
#ifndef PG8_SP2
#define PG8_SP2 true
#endif
#define WSP(T, off) ((T*)(ws + (off)))
__device__ __forceinline__ Ctx make_ctx(unsigned char* lds_raw) {
    Ctx C; C.lds = (LAS unsigned char*)lds_raw; { int t_ = threadIdx.x; asm volatile("" : "+v"(t_)); C.tid = t_; } C.lane = C.tid & 63; C.wave = __builtin_amdgcn_readfirstlane(C.tid >> 6); C.G = gridDim.x;
    C.vcu = blockIdx.x; C.gw = blockIdx.x * 8 + C.wave; C.ngw = C.G * 8; C.gtid = blockIdx.x * 512 + C.tid; C.nthr = C.G * 512; return C; }
__device__ __forceinline__ void run_ph0(unsigned char* lds_raw, const Args& args) { const Ctx C = make_ctx(lds_raw); unsigned char* ws = args.ws;
    phase_prologue(C, args);
#if defined(REPEAT_P0)
    __syncthreads(); phase_prologue(C, args);
#endif
}
__device__ __forceinline__ void run_ph1(unsigned char* lds_raw, const Args& args) { const Ctx C = make_ctx(lds_raw); unsigned char* ws = args.ws;
    { pg8::Gemm g{WSP(bf16_t, WS_XB), WSP(bf16_t, WS_WIN), TT, 3072, 1024, 1024, 128}; pg8::StaticOrder S; S.init(TT, 3072, C.G, (int)blockIdx.x);
      pg8::EpiInProj E{ws, args.in[8], args.in[9], args.in[10], args.in[11]};
      pg8::gemm_phase<pg8::EpiInProj, pg8::StaticOrder, true, PG8_SP2>(C.lds, g, S, E);
#if defined(REPEAT_G17)
      pg8::gemm_phase<pg8::EpiInProj, pg8::StaticOrder, true, PG8_SP2>(C.lds, g, S, E);
#endif
    }
}
__device__ __forceinline__ void run_ph2(unsigned char* lds_raw, const Args& args) { const Ctx C = make_ctx(lds_raw); unsigned char* ws = args.ws;
    { pg8::Gemm g{nullptr, nullptr, 8192, 256, 2048, 2048, 256}; pg8::CmpOrder S{C.G, (int)blockIdx.x, WSP(bf16_t, WS_KC), WSP(bf16_t, WS_VC), WSP(bf16_t, WS_CW1)};
      pg8::EpiCmpHid E{WSP(float, WS_CBIAS), WSP(bf16_t, WS_CMPH)};
      pg8::gemm_phase<pg8::EpiCmpHid, pg8::CmpOrder, true, PG8_SP2>(C.lds, g, S, E);
#if defined(REPEAT_CH)
      pg8::gemm_phase<pg8::EpiCmpHid, pg8::CmpOrder, true, PG8_SP2>(C.lds, g, S, E);
#endif
    }
    if (C.G >= 64) { if ((int)blockIdx.x >= 32) { ml::phase_a(C.lds, args, C.G - 32, (int)blockIdx.x - 32); Ctx C2 = C; C2.gw = C.gw - 32 * 8; C2.ngw = C.ngw - 32 * 8; __syncthreads(); phase_transposes<1>(C2, args); } }
    else { ml::phase_a(C.lds, args, C.G, (int)blockIdx.x); __syncthreads(); phase_transposes<1>(C, args); }
#if defined(REPEAT_ML) || defined(REPEAT_MLA)
    __syncthreads(); if ((int)blockIdx.x >= 32) ml::phase_a(C.lds, args, C.G - 32, (int)blockIdx.x - 32);
#endif
}
__device__ __forceinline__ void run_ph3(unsigned char* lds_raw, const Args& args) { const Ctx C = make_ctx(lds_raw); unsigned char* ws = args.ws;
    cmpout_phase(args, C.G, (int)blockIdx.x, C.tid);
#if defined(REPEAT_CO)
    for (int rep = 0; rep < REPEAT_CO; ++rep) { __syncthreads(); cmpout_phase(args, C.G, (int)blockIdx.x, C.tid); }
#endif
    att::attn_phase<att::M_WIN>(C.lds, args, C.G, (int)blockIdx.x);
    ml::phase_b(args, C.gtid, C.nthr);
#if defined(REPEAT_ML) || defined(REPEAT_MLB)
    ml::phase_b(args, C.gtid, C.nthr);
#endif
}
__device__ __forceinline__ void run_ph4(unsigned char* lds_raw, const Args& args) { const Ctx C = make_ctx(lds_raw); unsigned char* ws = args.ws;
#if !defined(ONLY_MLC)
    att::attn_phase<att::M_CMP>(C.lds, args, C.G, (int)blockIdx.x);
#endif
#if defined(REPEAT_WC) || defined(REPEAT_CMP)
    __syncthreads(); att::attn_phase<att::M_CMP>(C.lds, args, C.G, (int)blockIdx.x, WS_Y);
#endif
    ml::phase_c(C.lds, args, C.G, (int)blockIdx.x);
#if defined(REPEAT_ML) || defined(REPEAT_MLC)
    __syncthreads(); ml::phase_c(C.lds, args, C.G, (int)blockIdx.x);
#endif
}
__device__ __forceinline__ void run_ph5(unsigned char* lds_raw, const Args& args) { const Ctx C = make_ctx(lds_raw); unsigned char* ws = args.ws;
    __syncthreads();
    att::attn_phase<att::M_SLC>(C.lds, args, C.G, (int)blockIdx.x);
#if defined(REPEAT_SLC)
    for (int rep = 0; rep < REPEAT_SLC; ++rep) { __syncthreads(); att::attn_phase<att::M_SLC>(C.lds, args, C.G, (int)blockIdx.x, WS_DC); }
#endif
}
__device__ __forceinline__ void run_ph6(unsigned char* lds_raw, const Args& args) { const Ctx C = make_ctx(lds_raw); unsigned char* ws = args.ws;
    __syncthreads();
    { pg8::Gemm g{WSP(bf16_t, WS_XB), WSP(bf16_t, WS_WG), TT, 2048, 1024, 1024, 128}; pg8::StaticOrder S; S.init(TT, 2048, C.G, (int)blockIdx.x);
      pg8::EpiGate E{WSP(float, WS_RSTD1), args.in[20], (bf16_t*)args.out, (bf16_t*)args.out + (size_t)TT * 1024};
      pg8::gemm_phase<pg8::EpiGate, pg8::StaticOrder, true, PG8_SP2>(C.lds, g, S, E);
#if defined(REPEAT_G4) || defined(REPEAT_P5A)
      pg8::gemm_phase<pg8::EpiGate, pg8::StaticOrder, true, PG8_SP2>(C.lds, g, S, E);
#endif
    }
}
__device__ __forceinline__ void run_ph7(unsigned char* lds_raw, const Args& args) { const Ctx C = make_ctx(lds_raw); unsigned char* ws = args.ws;
    { pg8::Gemm g{WSP(bf16_t, WS_HMON), WSP(bf16_t, WS_WMN), TT, 1024, 1024, 1024, 128}; pg8::StaticOrder S; S.init(TT, 1024, C.G, (int)blockIdx.x);
      pg8::EpiMerge E{(const bf16_t*)args.out, (const bf16_t*)args.out + (size_t)TT * 1024, WSP(bf16_t, WS_Y)};
      pg8::gemm_phase<pg8::EpiMerge, pg8::StaticOrder, true, PG8_SP2>(C.lds, g, S, E);
#if defined(REPEAT_G4) || defined(REPEAT_P5B)
      pg8::gemm_phase<pg8::EpiMerge, pg8::StaticOrder, true, PG8_SP2>(C.lds, g, S, E);
#endif
    }
}
__device__ __forceinline__ void run_ph8(unsigned char* lds_raw, const Args& args) { const Ctx C = make_ctx(lds_raw); unsigned char* ws = args.ws;
    { pg8::Gemm g{WSP(bf16_t, WS_Y), WSP(bf16_t, WS_WOUT), TT, 1024, 1024, 1024, 128}; pg8::StaticOrder S; S.init(TT, 1024, C.G, (int)blockIdx.x);
      pg8::EpiWout E{args.in[0], args.out, WSP(bf16_t, WS_XB), WSP(float, WS_SSQ2)};
      pg8::gemm_phase<pg8::EpiWout, pg8::StaticOrder, true, PG8_SP2>(C.lds, g, S, E);
#if defined(REPEAT_G4) || defined(REPEAT_P6)
      pg8::gemm_phase<pg8::EpiWout, pg8::StaticOrder, true, PG8_SP2>(C.lds, g, S, E);
#endif
    }
}
__device__ __forceinline__ void run_ph9(unsigned char* lds_raw, const Args& args) { const Ctx C = make_ctx(lds_raw); unsigned char* ws = args.ws;
    { pg8::Gemm g{WSP(bf16_t, WS_XB), WSP(bf16_t, WS_WUP), TT, 5632, 1024, 1024, 128}; pg8::StaticOrder S; S.init(TT, 5632, C.G, (int)blockIdx.x);
      pg8::EpiFfnUp E{WSP(float, WS_SSQ2), args.in[24], args.in[25], WSP(bf16_t, WS_MID), WSP(float, WS_EDGEA), WSP(float, WS_EDGEV), (LAS float*)(C.lds + LDS_EX)};
      pg8::gemm_phase<pg8::EpiFfnUp, pg8::StaticOrder, true, PG8_SP2>(C.lds, g, S, E);
#if defined(REPEAT_G17)
      pg8::gemm_phase<pg8::EpiFfnUp, pg8::StaticOrder, true, PG8_SP2>(C.lds, g, S, E);
#endif
    }
}
__device__ __forceinline__ void run_ph11(unsigned char* lds_raw, const Args& args) { const Ctx C = make_ctx(lds_raw); unsigned char* ws = args.ws;
    { pg8::Gemm g{WSP(bf16_t, WS_MID), WSP(bf16_t, WS_WDN), TT, 1024, 2816, 2816, 128}; pg8::StaticOrder S; S.init(TT, 1024, C.G, (int)blockIdx.x);
      { pg8::Unit u; int pl = -1; for (int i = 0; S.next(i, u); ++i) if (u.pm != pl) { p7b_fixup_panel(C, args, u.pm); pl = u.pm; } }
      __syncthreads();
#if defined(REPEAT_G4) || defined(REPEAT_P8)
      { pg8::EpiFfnDown E0{WSP(bf16_t, WS_XB), WSP(float, WS_HMON)}; pg8::gemm_phase<pg8::EpiFfnDown, pg8::StaticOrder, true, PG8_SP2>(C.lds, g, S, E0); }
#endif
      pg8::EpiFfnDown E{WSP(bf16_t, WS_XB), args.out};
      pg8::gemm_phase<pg8::EpiFfnDown, pg8::StaticOrder, true, PG8_SP2>(C.lds, g, S, E); }
}
__device__ __forceinline__ void run_rstd2(const Args& args) {
    const float* ssq = (const float*)(args.ws + WS_SSQ2); float* r2 = (float*)(args.ws + WS_RSTD1);
    for (int t = blockIdx.x * 512 + threadIdx.x; t < TT; t += gridDim.x * 512) { const f32x4* sp = (const f32x4*)(ssq + (size_t)t * 16); const f32x4 s0 = sp[0], s1 = sp[1], s2 = sp[2], s3 = sp[3];
        const float ss = ((s0[0] + s0[1]) + (s0[2] + s0[3])) + ((s1[0] + s1[1]) + (s1[2] + s1[3])) + ((s2[0] + s2[1]) + (s2[2] + s2[3])) + ((s3[0] + s3[1]) + (s3[2] + s3[3]));
        r2[t] = 1.0f / sqrtf(ss * (1.0f / 1024.0f) + NEPS); }
}
constexpr int NPHASE = 12;
#ifndef SPLIT_TEST
__global__ void __launch_bounds__(512, 2) mega_fwd(Args args) {
    extern __shared__ __attribute__((aligned(16))) unsigned char lds_raw[];
#if defined(USE_CG_SYNC)
    cg::grid_group grid = cg::this_grid();
#endif
    volatile LAS unsigned* xst = (volatile LAS unsigned*)((LAS unsigned char*)lds_raw + LDS_XB);
    if (threadIdx.x < 2) xst[threadIdx.x] = 0u;
    __syncthreads();
    (void)xcd_barrier_post((unsigned*)(args.ws + WS_CTL) + 4096, xst);
#define GRID_BAR() do { XcdBarrier b_; b_.bar = (unsigned*)(args.ws + WS_CTL) + 4096; b_.x = xb_xcc_id(); b_.st = (volatile LAS unsigned*)((LAS unsigned char*)lds_raw + LDS_XB); xcd_barrier(b_); } while (0)
#if defined(PROBE_TS)
#define TS(i) do { if (blockIdx.x == 0 && threadIdx.x == 0) ((unsigned long long*)(args.ws + WS_CTL))[64 + (i)] = __builtin_amdgcn_s_memrealtime(); } while (0)
#else
#define TS(i) do {} while (0)
#endif
    TS(0);
    run_ph0(lds_raw, args);
#if defined(USE_CG_SYNC)
    grid.sync();
#else
    GRID_BAR();
#endif
    TS(1);
    run_ph1(lds_raw, args);
    GRID_BAR();
    TS(2);
    run_ph2(lds_raw, args);
    GRID_BAR();
    TS(3);
    run_ph3(lds_raw, args);
    GRID_BAR();
    TS(4);
    run_ph4(lds_raw, args);
    TS(5);
    run_ph5(lds_raw, args);
#if defined(EXTRA_BARS)
    for (int eb = 0; eb < EXTRA_BARS; ++eb) GRID_BAR();
#endif
    TS(6);
    run_ph6(lds_raw, args);
    GRID_BAR();
    TS(7);
    run_ph7(lds_raw, args);
    GRID_BAR();
    TS(8);
    run_ph8(lds_raw, args);
    GRID_BAR();
    TS(9);
    run_ph9(lds_raw, args);
    GRID_BAR();
    TS(10);
    TS(11);
    run_ph11(lds_raw, args);
    TS(12);
#if defined(PROBE_TS)
    GRID_BAR();
    { const unsigned long long* ts = (const unsigned long long*)(args.ws + WS_CTL) + 64; const float f = (float)(ts[PROBE_TS] - ts[0]) / (float)(ts[12] - ts[0]); const float sc = 1.0f + sqrtf(f);
      for (int i = blockIdx.x * 512 + threadIdx.x; i < TT * DM; i += gridDim.x * 512) args.out[i] *= sc; }
#endif
}
#else
__global__ void __launch_bounds__(512, 2) ph0_k(Args args) { extern __shared__ __attribute__((aligned(16))) unsigned char lds_raw[]; run_ph0(lds_raw, args); }
__global__ void __launch_bounds__(512, 2) ph1_k(Args args) { extern __shared__ __attribute__((aligned(16))) unsigned char lds_raw[]; run_ph1(lds_raw, args); }
__global__ void __launch_bounds__(512, 2) ph2_k(Args args) { extern __shared__ __attribute__((aligned(16))) unsigned char lds_raw[]; run_ph2(lds_raw, args); }
__global__ void __launch_bounds__(512, 2) ph3_k(Args args) { extern __shared__ __attribute__((aligned(16))) unsigned char lds_raw[]; run_ph3(lds_raw, args); }
__global__ void __launch_bounds__(512, 2) ph4_k(Args args) { extern __shared__ __attribute__((aligned(16))) unsigned char lds_raw[]; run_ph4(lds_raw, args); }
__global__ void __launch_bounds__(512, 2) ph5_k(Args args) { extern __shared__ __attribute__((aligned(16))) unsigned char lds_raw[]; run_ph5(lds_raw, args); }
__global__ void __launch_bounds__(512, 2) ph6_k(Args args) { extern __shared__ __attribute__((aligned(16))) unsigned char lds_raw[]; run_ph6(lds_raw, args); }
__global__ void __launch_bounds__(512, 2) ph7_k(Args args) { extern __shared__ __attribute__((aligned(16))) unsigned char lds_raw[]; run_ph7(lds_raw, args); }
__global__ void __launch_bounds__(512, 2) ph8_k(Args args) { extern __shared__ __attribute__((aligned(16))) unsigned char lds_raw[]; run_ph8(lds_raw, args); }
__global__ void __launch_bounds__(512, 2) ph9_k(Args args) { extern __shared__ __attribute__((aligned(16))) unsigned char lds_raw[]; run_ph9(lds_raw, args); }
__global__ void __launch_bounds__(512, 2) ph11_k(Args args) { extern __shared__ __attribute__((aligned(16))) unsigned char lds_raw[]; run_ph11(lds_raw, args); }
__global__ void __launch_bounds__(512, 2) rstd2_k(Args args) { run_rstd2(args); }
__global__ void __launch_bounds__(512, 2) mega_fwd(Args args) {}
#endif
extern "C" void kernel_launch(void* const* d_in, const int* in_sizes, int n_in, void* d_out, int out_size, void* d_ws, size_t ws_size, hipStream_t stream) {
    static int grid = 0;
    if (grid == 0) {
        if (n_in != 27 || out_size != TT * DM || ws_size < WS_END) { fprintf(stderr, "kernel_launch: unexpected shapes (n_in %d out %d ws %zu)\n", n_in, out_size, ws_size); grid = -1; return; }
        int dev = 0, cus = 0, per_cu = 0;
        hipGetDevice(&dev); hipDeviceGetAttribute(&cus, hipDeviceAttributeMultiprocessorCount, dev);
        hipFuncSetAttribute((const void*)mega_fwd, hipFuncAttributeMaxDynamicSharedMemorySize, LDS_BYTES);
        hipOccupancyMaxActiveBlocksPerMultiprocessor(&per_cu, (const void*)mega_fwd, 512, LDS_BYTES);
        if (per_cu < 1) { fprintf(stderr, "kernel_launch: occupancy query says %d blocks per CU\n", per_cu); grid = -1; return; }
        grid = cus * 1;
    }
    if (grid < 0) return;
    hipMemsetAsync((char*)d_ws + WS_CTL, 0, 1 * MiB, stream);
    Args a{}; for (int i = 0; i < 27; ++i) a.in[i] = (const float*)d_in[i]; a.out = (float*)d_out; a.ws = (unsigned char*)d_ws;
    for (int j = 0; j < 32; ++j) a.rope_inv[j] = (float)pow(10000.0, -(double)j / 32.0);
    void* kargs[] = {&a};
    hipError_t e = hipLaunchCooperativeKernel((const void*)mega_fwd, dim3(grid), dim3(512), kargs, LDS_BYTES, stream);
    if (e != hipSuccess) fprintf(stderr, "cooperative launch failed: %s (grid %d)\n", hipGetErrorString(e), grid);
#if defined(REPEAT_LAUNCH)
    for (int rl = 0; rl < REPEAT_LAUNCH; ++rl) { hipMemsetAsync((char*)d_ws + WS_CTL, 0, 1 * MiB, stream); hipLaunchCooperativeKernel((const void*)mega_fwd, dim3(grid), dim3(512), kargs, LDS_BYTES, stream); }
#endif
}
```

```cpp
#include <hip/hip_runtime.h>
#include <hip/hip_cooperative_groups.h>
#include <cstdio>
#include <cstdint>
#include <cmath>
namespace cg = cooperative_groups;
constexpr int NB = 4, DM = 1024, DIN = 4896, DFF = 2816, NCMP = 511, NSEL = 128;
constexpr int C_MQ = 0, C_MK = 256, C_MV = 512, C_MO = 1024, C_MI = 1536, C_MF = 1540, C_NQ = 1544, C_KC = 2056, C_VC = 2184, C_KS = 2312, C_VS = 2440, C_KW = 2568, C_VW = 2696, C_NG = 2824, C_GM = 2848;
constexpr size_t MiB = 1u << 20;
constexpr size_t WS_CTL = 0;
constexpr size_t WS_ROPEC = 1 * MiB, WS_ROPES = 2 * MiB, WS_RSTD1 = 3 * MiB, WS_SSQ2 = 4 * MiB, WS_SMALLG = 6 * MiB, WS_SEL = 10 * MiB, WS_CMPB = 11 * MiB, WS_CBIAS = 12 * MiB;
constexpr size_t WS_EDGEA = 13 * MiB, WS_EDGEV = 19 * MiB, WS_IPRE = 22 * MiB, WS_LOGF = 22 * MiB + 524288, WS_MLS = 23 * MiB;
constexpr size_t WS_WIN = 24 * MiB  , WS_WG = 30 * MiB  , WS_WMN = 34 * MiB, WS_WOUT = 36 * MiB, WS_WUP = 38 * MiB, WS_WDN = 49 * MiB, WS_CW1 = 55 * MiB;
constexpr size_t WS_XB = 60 * MiB;
constexpr size_t WS_QKPRE = 124 * MiB, WS_MV = 156 * MiB, WS_MO = 188 * MiB, WS_NQ = 220 * MiB, WS_KC = 252 * MiB, WS_KS = 260 * MiB, WS_KW = 268 * MiB, WS_VC = 276 * MiB, WS_VS = 284 * MiB, WS_VW = 292 * MiB;
constexpr size_t WS_HMON = 300 * MiB;
constexpr size_t WS_DC = 364 * MiB, WS_CPREV = 428 * MiB, WS_CMPH = 492 * MiB;
constexpr size_t WS_Y = 124 * MiB;
constexpr size_t WS_MID = 124 * MiB;
constexpr size_t WS_END = 500 * MiB;
constexpr size_t WS_QKF = 364 * MiB  , WS_HRAW = 428 * MiB  , WS_IMP = 364 * MiB  , WS_IDX = 396 * MiB  ;
constexpr int RING_BYTES = 131072, LDS_EX = RING_BYTES  , LDS_BYTES = 147456, LDS_XB = 147456 - 64  ;

namespace pg8 {
#define PG8_LAS __attribute__((address_space(3)))
typedef unsigned short bf16_t;
typedef short bf16x8 __attribute__((ext_vector_type(8)));
typedef float f32x4 __attribute__((ext_vector_type(4)));
typedef unsigned u32x4 __attribute__((ext_vector_type(4)));
constexpr int BM = 256, BK = 64, HALF = 128, HTB = HALF * BK * 2  , STAGE_BYTES = 8 * HTB, NXCD = 8, WGM = 8;

__host__ __device__ __forceinline__ int lds_byte(int r, int c) { const int st = (r >> 4) * 2 + (c >> 5), rr = r & 15, cc = c & 31, ob = rr * 64 + cc * 2; return st * 1024 + (ob ^ (((ob >> 9) & 1) << 5)); }
__host__ __device__ __forceinline__ void stage_rc(int b, int& R, int& C) { const int st = b / 1024, sb = b % 1024, swz = sb ^ (((sb >> 9) & 1) << 5); R = (st >> 1) * 16 + swz / 64; C = (st & 1) * 32 + (swz % 64) / 2; }
__host__ __device__ __forceinline__ int perm32(int rho) { const int n = rho >> 4, i = rho & 15; return 8 * (i >> 2) + 4 * n + (i & 3); }

struct Unit { int pm, pn; };
struct Gemm { const bf16_t* A; const bf16_t* Bt; int M, N, K; int lda; int ksA; };

struct StaticOrder {
    int nM, nN, nwg, G, c;
    __host__ __device__ void init(int M, int N, int G_, int c_) { nM = M / BM; nN = N / BM; nwg = nM * nN; G = G_; c = c_; }
    __host__ __device__ bool next(int i, Unit& u) const {
        const long L = (long)i * G + c; if (L >= nwg) return false;
        int wgid = (int)L; { const int q = nwg / NXCD, r = nwg % NXCD, xcd = wgid % NXCD, off = wgid / NXCD; wgid = (xcd < r ? xcd * (q + 1) : r * (q + 1) + (xcd - r) * q) + off; }
        const int nig = WGM * nN, gid = wgid / nig, fm = gid * WGM, gsz = (nM - fm) < WGM ? (nM - fm) : WGM;
        u.pm = fm + ((wgid % nig) % gsz); u.pn = (wgid % nig) / gsz; return true;
    }
    __device__ __forceinline__ const char* a_ptr(const Gemm& g, const Unit& u) const { return (const char*)g.A + (size_t)u.pm * BM * g.lda * 2; }
    __device__ __forceinline__ const char* b_ptr(const Gemm& g, const Unit& u) const { return (const char*)g.Bt + (size_t)u.pn * BM * g.K * 2; }
    __device__ __forceinline__ void a_ready(const Unit&) const {}
    __device__ __forceinline__ void done(const Unit&) const {}
};

typedef float f32x2_cv __attribute__((ext_vector_type(2))); typedef __bf16 bf16x2_cv __attribute__((ext_vector_type(2)));
__device__ __forceinline__ unsigned cvt_pk_bf16(float lo, float hi) { const f32x2_cv v = {lo, hi}; const bf16x2_cv b = __builtin_convertvector(v, bf16x2_cv); return __builtin_bit_cast(unsigned, b); }
typedef float f32x2 __attribute__((ext_vector_type(2)));
__device__ __forceinline__ f32x2 gelu_pk(f32x2 v) {
    const f32x2 av = __builtin_elementwise_abs(v), d = av * 0.2316418882f + 1.0f;
    f32x2 t; t.x = __builtin_amdgcn_rcpf(d.x); t.y = __builtin_amdgcn_rcpf(d.y);
    f32x2 q = t * 0.5307027145f + (-0.7265760135f); q = q * t + 0.7107068705f; q = q * t + (-0.142248368f); q = q * t + 0.127414796f; q = q * t;
    const f32x2 s = (v * v) * (-0.72134752044f);
    f32x2 e; e.x = __builtin_amdgcn_exp2f(s.x); e.y = __builtin_amdgcn_exp2f(s.y);
    const f32x2 mx = {fmaxf(v.x, 0.f), fmaxf(v.y, 0.f)};
    return mx - av * (q * e);
}

constexpr int TT = 32768, SEQ = 8192;
constexpr float NEPS = 1e-6f;
constexpr float QC2 = 0.125f * 1.4426950408889634f;
typedef unsigned u32x2 __attribute__((ext_vector_type(2)));
__device__ __forceinline__ float bf2f(unsigned short v) { return __uint_as_float((unsigned)v << 16); }
__device__ __forceinline__ float bflo(unsigned w) { return __uint_as_float(w << 16); }
__device__ __forceinline__ float bfhi(unsigned w) { return __uint_as_float(w & 0xffff0000u); }
__device__ __forceinline__ float sigm(float x) { return __builtin_amdgcn_rcpf(1.0f + __builtin_amdgcn_exp2f(-1.4426950408889634f * x)); }
__device__ __forceinline__ u32x4 pack8(const f32x4& a, const f32x4& b) { u32x4 w; w.x = cvt_pk_bf16(a[0], a[1]); w.y = cvt_pk_bf16(a[2], a[3]); w.z = cvt_pk_bf16(b[0], b[1]); w.w = cvt_pk_bf16(b[2], b[3]); return w; }
__device__ __forceinline__ void unpack8(const u32x4& w, f32x4& a, f32x4& b) { a = (f32x4){bflo(w.x), bfhi(w.x), bflo(w.y), bfhi(w.y)}; b = (f32x4){bflo(w.z), bfhi(w.z), bflo(w.w), bfhi(w.w)}; }


struct EpiInProj {
    static constexpr bool PERM = true, AFTER_DRAIN = false, HAS_MID = false;
    unsigned char* ws; const float *qnw, *kcw, *ksw, *kww;
    __device__ __forceinline__ void mid(f32x4 (&)[2][2][4][2], const Unit&, int, int, int, int) const {}
    __device__ __forceinline__ void operator()(f32x4 (&acc)[2][2][4][2], const Unit& u, int wr, int wc, int fr, int fq_) const {
        int fq = fq_; asm volatile("" : "+v"(fq));
        const int pn = u.pn; int row0 = u.pm * BM + wr * 64 + fr; asm volatile("" : "+v"(row0));
        const float* rstd = (const float*)(ws + WS_RSTD1); const float* rope_c = (const float*)(ws + WS_ROPEC); const float* rope_s = (const float*)(ws + WS_ROPES);
        float rsv[8];
#pragma unroll
        for (int g = 0; g < 8; ++g) rsv[g] = rstd[row0 + (g >> 2) * HALF + (g & 3) * 16];
        if (pn < 6) {
            bf16_t* base = (bf16_t*)(ws + (pn < 2 ? WS_QKPRE : pn < 4 ? WS_MV : WS_MO)); const int col0 = (pn & 1) * 256 + wc * 32 + 8 * fq;
#pragma unroll
            for (int ai = 0; ai < 2; ++ai)
#pragma unroll
                for (int m = 0; m < 4; ++m) { const int row = row0 + ai * HALF + m * 16; const float rs = rsv[ai * 4 + m]; bf16_t* rowp = base + (size_t)row * 512 + col0;
#pragma unroll
                    for (int bj = 0; bj < 2; ++bj) *(u32x4*)(rowp + bj * HALF) = pack8(acc[ai][bj][m][0] * rs, acc[ai][bj][m][1] * rs); }
        } else if (pn < 11) {
            bf16_t* dst; int ld; const float* nw = nullptr; float osc = 1.0f;
            if (pn < 8) { dst = (bf16_t*)(ws + WS_NQ) + (4 * (pn - 6) + wc) * 64; ld = 512; nw = qnw; osc = QC2; }
            else { const int seg = (pn - 8) * 2 + (wc >> 1);
                const size_t so = seg == 0 ? WS_KC : seg == 1 ? WS_KS : seg == 2 ? WS_KW : seg == 3 ? WS_VC : seg == 4 ? WS_VS : WS_VW;
                dst = (bf16_t*)(ws + so) + (wc & 1) * 64; ld = 128; nw = seg == 0 ? kcw : seg == 1 ? ksw : seg == 2 ? kww : nullptr; }
            f32x4 w0[2] = {{1.f, 1.f, 1.f, 1.f}, {1.f, 1.f, 1.f, 1.f}}, w1[2] = {{1.f, 1.f, 1.f, 1.f}, {1.f, 1.f, 1.f, 1.f}};
            if (nw) {
#pragma unroll
                for (int n = 0; n < 2; ++n) { w0[n] = *(const f32x4*)(nw + 8 * fq + 4 * n); w1[n] = *(const f32x4*)(nw + 32 + 8 * fq + 4 * n); } }
            f32x4 cs[2][4];
            if (nw) { const int tp = row0 & (SEQ - 1); cs[0][0] = *(const f32x4*)(rope_c + tp * 32 + 8 * fq); cs[0][1] = *(const f32x4*)(rope_c + tp * 32 + 8 * fq + 4); cs[0][2] = *(const f32x4*)(rope_s + tp * 32 + 8 * fq); cs[0][3] = *(const f32x4*)(rope_s + tp * 32 + 8 * fq + 4); }
#pragma unroll
            for (int g = 0; g < 8; ++g) { const int ai = g >> 2, m = g & 3; const int row = row0 + ai * HALF + m * 16; const float rs = rsv[g];
                if (nw && g < 7) { const int tn = (row0 + ((g + 1) >> 2) * HALF + ((g + 1) & 3) * 16) & (SEQ - 1); f32x4 (&nx)[4] = cs[(g + 1) & 1];
                    nx[0] = *(const f32x4*)(rope_c + tn * 32 + 8 * fq); nx[1] = *(const f32x4*)(rope_c + tn * 32 + 8 * fq + 4); nx[2] = *(const f32x4*)(rope_s + tn * 32 + 8 * fq); nx[3] = *(const f32x4*)(rope_s + tn * 32 + 8 * fq + 4); }
#pragma unroll
                for (int n = 0; n < 2; ++n) { acc[ai][0][m][n] = acc[ai][0][m][n] * rs; acc[ai][1][m][n] = acc[ai][1][m][n] * rs; }
                if (nw) {
                    float s = 0.f;
#pragma unroll
                    for (int n = 0; n < 2; ++n)
#pragma unroll
                        for (int e = 0; e < 4; ++e) s += acc[ai][0][m][n][e] * acc[ai][0][m][n][e] + acc[ai][1][m][n][e] * acc[ai][1][m][n][e];
                    s += __shfl_xor(s, 16); s += __shfl_xor(s, 32);
                    const float rn = 1.0f / sqrtf(s * (1.0f / 64.0f) + NEPS); const f32x4 (&cc)[4] = cs[g & 1];
#pragma unroll
                    for (int n = 0; n < 2; ++n) { const f32x4 a = acc[ai][0][m][n] * rn * w0[n], b = acc[ai][1][m][n] * rn * w1[n]; acc[ai][0][m][n] = (a * cc[n] - b * cc[2 + n]) * osc; acc[ai][1][m][n] = (b * cc[n] + a * cc[2 + n]) * osc; }
                }
                bf16_t* rowp = dst + (size_t)row * ld + 8 * fq;
                *(u32x4*)(rowp) = pack8(acc[ai][0][m][0], acc[ai][0][m][1]); *(u32x4*)(rowp + 32) = pack8(acc[ai][1][m][0], acc[ai][1][m][1]); asm volatile("" ::: "memory"); }
        } else {
            if (wc == 0) {
#pragma unroll
                for (int ai = 0; ai < 2; ++ai)
#pragma unroll
                    for (int m = 0; m < 4; ++m) { const int row = row0 + ai * HALF + m * 16; const float rs = rsv[ai * 4 + m]; float* rowp = (float*)(ws + WS_SMALLG) + (size_t)row * 32 + 8 * fq;
                        *(f32x4*)(rowp) = acc[ai][0][m][0] * rs; *(f32x4*)(rowp + 4) = acc[ai][0][m][1] * rs; }
            }
        }
    }
};
struct EpiGate {
    static constexpr bool PERM = true, AFTER_DRAIN = false, HAS_MID = false;
    const float* rstd; const float* bias  ; bf16_t* gr; bf16_t* gn;
    __device__ __forceinline__ void mid(f32x4 (&)[2][2][4][2], const Unit&, int, int, int, int) const {}
    __device__ __forceinline__ void operator()(f32x4 (&acc)[2][2][4][2], const Unit& u, int wr, int wc, int fr, int fq) const {
        int row0 = u.pm * BM + wr * 64 + fr; asm volatile("" : "+v"(row0)); const int col0 = u.pn * 128 + wc * 32 + 8 * fq; const float* bp = bias + col0;
        f32x4 bv[2][2];
#pragma unroll
        for (int bj = 0; bj < 2; ++bj)
#pragma unroll
            for (int n = 0; n < 2; ++n) bv[bj][n] = *(const f32x4*)(bp + bj * 1024 + 4 * n);
        float rsv[8];
#pragma unroll
        for (int g = 0; g < 8; ++g) rsv[g] = rstd[row0 + (g >> 2) * HALF + (g & 3) * 16];
#pragma unroll
        for (int ai = 0; ai < 2; ++ai)
#pragma unroll
            for (int m = 0; m < 4; ++m) { const int row = row0 + ai * HALF + m * 16; const float rs = rsv[ai * 4 + m]; const size_t off = (size_t)row * 1024 + col0;
                f32x4 r[2], q[2];
#pragma unroll
                for (int n = 0; n < 2; ++n) { const f32x4 vm = acc[ai][0][m][n] * rs + bv[0][n], vn = acc[ai][1][m][n] * rs + bv[1][n];
#pragma unroll
                    for (int e = 0; e < 4; ++e) { const float gmv = sigm(vm[e]), gnv = sigm(vn[e]); q[n][e] = gnv; r[n][e] = gmv * __builtin_amdgcn_rcpf(fmaxf(gnv, 1e-30f)); } }
                *(u32x4*)(gr + off) = pack8(r[0], r[1]); *(u32x4*)(gn + off) = pack8(q[0], q[1]); }
    }
};
struct EpiMerge {
    static constexpr bool PERM = true, AFTER_DRAIN = false, HAS_MID = true;
    const bf16_t* gr; const bf16_t* gn; bf16_t* y;
    __device__ __forceinline__ void mid(f32x4 (&acc)[2][2][4][2], const Unit& u, int wr, int wc, int fr, int fq) const {
        int row0 = u.pm * BM + wr * 64 + fr; asm volatile("" : "+v"(row0)); const int col0 = u.pn * BM + wc * 32 + 8 * fq;
        u32x4 gq[4][2];
#pragma unroll
        for (int g = 0; g < 3; ++g) { const size_t off = (size_t)(row0 + (g >> 2) * HALF + (g & 3) * 16) * 1024 + col0; gq[g][0] = __builtin_nontemporal_load((const u32x4*)(gr + off)); gq[g][1] = __builtin_nontemporal_load((const u32x4*)(gr + off + HALF)); }
#pragma unroll
        for (int g = 0; g < 8; ++g) { const int ai = g >> 2, m = g & 3;
            if (g + 3 < 8) { const size_t off = (size_t)(row0 + ((g + 3) >> 2) * HALF + ((g + 3) & 3) * 16) * 1024 + col0; gq[(g + 3) & 3][0] = __builtin_nontemporal_load((const u32x4*)(gr + off)); gq[(g + 3) & 3][1] = __builtin_nontemporal_load((const u32x4*)(gr + off + HALF)); }
#pragma unroll
            for (int bj = 0; bj < 2; ++bj) { f32x4 a0, a1; unpack8(gq[g & 3][bj], a0, a1); acc[ai][bj][m][0] = acc[ai][bj][m][0] * a0; acc[ai][bj][m][1] = acc[ai][bj][m][1] * a1; }
            asm volatile("" : "+v"(acc[ai][0][m][0]), "+v"(acc[ai][0][m][1]), "+v"(acc[ai][1][m][0]), "+v"(acc[ai][1][m][1]) :: "memory"); }
    }
    __device__ __forceinline__ void operator()(f32x4 (&acc)[2][2][4][2], const Unit& u, int wr, int wc, int fr, int fq) const {
        int row0 = u.pm * BM + wr * 64 + fr; asm volatile("" : "+v"(row0)); const int col0 = u.pn * BM + wc * 32 + 8 * fq;
        u32x4 gq[2][2];
        { const size_t off = (size_t)row0 * 1024 + col0; gq[0][0] = __builtin_nontemporal_load((const u32x4*)(gn + off)); gq[0][1] = __builtin_nontemporal_load((const u32x4*)(gn + off + HALF)); }
#pragma unroll
        for (int g = 0; g < 8; ++g) { const int ai = g >> 2, m = g & 3; const size_t off = (size_t)(row0 + ai * HALF + m * 16) * 1024 + col0;
            if (g < 7) { const size_t offn = (size_t)(row0 + ((g + 1) >> 2) * HALF + ((g + 1) & 3) * 16) * 1024 + col0; gq[(g + 1) & 1][0] = __builtin_nontemporal_load((const u32x4*)(gn + offn)); gq[(g + 1) & 1][1] = __builtin_nontemporal_load((const u32x4*)(gn + offn + HALF)); }
#pragma unroll
            for (int bj = 0; bj < 2; ++bj) { f32x4 b0, b1; unpack8(gq[g & 1][bj], b0, b1); *(u32x4*)(y + off + bj * HALF) = pack8(acc[ai][bj][m][0] * b0, acc[ai][bj][m][1] * b1); }
            asm volatile("" ::: "memory"); }
    }
};
struct EpiWout {
    static constexpr bool PERM = true, AFTER_DRAIN = false, HAS_MID = false;
    const float* x; float* x1; bf16_t* x1b; float* ssq  ;
    __device__ __forceinline__ void mid(f32x4 (&)[2][2][4][2], const Unit&, int, int, int, int) const {}
    __device__ __forceinline__ void operator()(f32x4 (&acc)[2][2][4][2], const Unit& u, int wr, int wc, int fr, int fq) const {
        int row0 = u.pm * BM + wr * 64 + fr; asm volatile("" : "+v"(row0)); const int col0 = u.pn * BM + wc * 32 + 8 * fq;
        f32x4 xv[2][4];
        { const float* p = x + (size_t)row0 * 1024 + col0; xv[0][0] = *(const f32x4*)(p); xv[0][1] = *(const f32x4*)(p + 4); xv[0][2] = *(const f32x4*)(p + HALF); xv[0][3] = *(const f32x4*)(p + HALF + 4); }
#pragma unroll
        for (int g = 0; g < 8; ++g) { const int ai = g >> 2, m = g & 3; const int row = row0 + ai * HALF + m * 16; const size_t off = (size_t)row * 1024 + col0; float s = 0.f;
            if (g < 7) { const float* p = x + (size_t)(row0 + ((g + 1) >> 2) * HALF + ((g + 1) & 3) * 16) * 1024 + col0; f32x4 (&nx)[4] = xv[(g + 1) & 1];
                nx[0] = *(const f32x4*)(p); nx[1] = *(const f32x4*)(p + 4); nx[2] = *(const f32x4*)(p + HALF); nx[3] = *(const f32x4*)(p + HALF + 4); }
#pragma unroll
            for (int bj = 0; bj < 2; ++bj) { const f32x4 v0 = xv[g & 1][2 * bj] + acc[ai][bj][m][0], v1 = xv[g & 1][2 * bj + 1] + acc[ai][bj][m][1];
                *(u32x4*)(x1b + off + bj * HALF) = pack8(v0, v1);
#pragma unroll
                for (int e = 0; e < 4; ++e) s += v0[e] * v0[e] + v1[e] * v1[e]; }
            s += __shfl_xor(s, 16); s += __shfl_xor(s, 32);
            if (fq == 0) ssq[(size_t)row * 16 + u.pn * 4 + wc] = s;
            asm volatile("" ::: "memory"); }
    }
};
__device__ __forceinline__ float dpp_shr(float old, float v, int n) { return n == 1 ? __builtin_bit_cast(float, __builtin_amdgcn_update_dpp(__builtin_bit_cast(int, old), __builtin_bit_cast(int, v), 0x111, 0xf, 0xf, false))
                                                                                       : __builtin_bit_cast(float, __builtin_amdgcn_update_dpp(__builtin_bit_cast(int, old), __builtin_bit_cast(int, v), 0x112, 0xf, 0xf, false)); }
__device__ __forceinline__ float dpp_shl15(float v) { return __builtin_bit_cast(float, __builtin_amdgcn_update_dpp(0, __builtin_bit_cast(int, v), 0x10F, 0xf, 0xf, true)); }
__device__ __forceinline__ float dpp_shl14(float v) { return __builtin_bit_cast(float, __builtin_amdgcn_update_dpp(0, __builtin_bit_cast(int, v), 0x10E, 0xf, 0xf, true)); }
struct EpiFfnUp {
    static constexpr bool PERM = true, AFTER_DRAIN = false, HAS_MID = false;
    const float* ssq; const float* cw  ; const float* cb; bf16_t* midb; float* edgeA  ; float* edgeV  ; PG8_LAS float* ex  ;
    __device__ __forceinline__ void mid(f32x4 (&)[2][2][4][2], const Unit&, int, int, int, int) const {}
    __device__ __forceinline__ void operator()(f32x4 (&acc)[2][2][4][2], const Unit& u, int wr, int wc, int fr, int fq) const {
        constexpr int FF = 2816;
        int row0 = u.pm * BM + wr * 64 + fr; asm volatile("" : "+v"(row0)); const int cl = wc * 32 + 8 * fq, col0 = u.pn * 128 + cl;
        { const float* sp = ssq + (size_t)row0 * 16 + 4 * fq;
#pragma unroll
          for (int ai = 0; ai < 2; ++ai) { float rsv[4];
#pragma unroll
              for (int m = 0; m < 4; ++m) { const f32x4 p = *(const f32x4*)(sp + (size_t)(ai * HALF + m * 16) * 16); rsv[m] = (p[0] + p[1]) + (p[2] + p[3]); }
#pragma unroll
              for (int m = 0; m < 4; ++m) { rsv[m] += __shfl_xor(rsv[m], 16); rsv[m] += __shfl_xor(rsv[m], 32); rsv[m] = __builtin_amdgcn_rsqf(rsv[m] * (1.0f / 1024.0f) + NEPS); }
#pragma unroll
              for (int m = 0; m < 4; ++m) {
#pragma unroll
                  for (int n = 0; n < 2; ++n) { acc[ai][0][m][n] = acc[ai][0][m][n] * rsv[m]; acc[ai][1][m][n] = acc[ai][1][m][n] * rsv[m]; } }
              asm volatile("" ::: "memory"); } }
#pragma unroll
        for (int ai = 0; ai < 2; ++ai) { const int s = ai * 2 + wr;
            if (fr >= 14) { PG8_LAS float* p = ex + (s * 2 + (fr - 14)) * 128 + cl; *(PG8_LAS f32x4*)(p) = acc[ai][0][3][0]; *(PG8_LAS f32x4*)(p + 4) = acc[ai][0][3][1]; } }
        if (wr == 0 && fr < 2) { float* pa = edgeA + ((size_t)u.pm * 4 + fr) * FF + col0; float* pv = edgeV + ((size_t)u.pm * 2 + fr) * FF + col0;
            *(f32x4*)(pa) = acc[0][0][0][0]; *(f32x4*)(pa + 4) = acc[0][0][0][1]; *(f32x4*)(pv) = acc[0][1][0][0]; *(f32x4*)(pv + 4) = acc[0][1][0][1]; }
        if (wr == 1 && fr >= 14) { float* pa = edgeA + ((size_t)u.pm * 4 + 2 + (fr - 14)) * FF + col0; *(f32x4*)(pa) = acc[1][0][3][0]; *(f32x4*)(pa + 4) = acc[1][0][3][1]; }
        asm volatile("s_waitcnt lgkmcnt(0)" ::: "memory"); __builtin_amdgcn_s_barrier(); asm volatile("" ::: "memory");
        f32x4 w0[2], w1[2], w2[2], bb[2];
#pragma unroll
        for (int n = 0; n < 2; ++n) { w0[n] = *(const f32x4*)(cw + col0 + 4 * n); w1[n] = *(const f32x4*)(cw + FF + col0 + 4 * n); w2[n] = *(const f32x4*)(cw + 2 * FF + col0 + 4 * n); bb[n] = *(const f32x4*)(cb + col0 + 4 * n); }
#pragma unroll
        for (int ai = 0; ai < 2; ++ai) { const int s = ai * 2 + wr;
            f32x4 t1[2], t2[2];
#pragma unroll
            for (int n = 0; n < 2; ++n) { f32x4 h62 = (f32x4){0.f, 0.f, 0.f, 0.f}, h63 = h62;
                if (s > 0) { h62 = *(const PG8_LAS f32x4*)(ex + ((s - 1) * 2 + 0) * 128 + cl + 4 * n); h63 = *(const PG8_LAS f32x4*)(ex + ((s - 1) * 2 + 1) * 128 + cl + 4 * n); }
                t1[n] = h63; t2[n] = fr == 0 ? h62 : h63; }
#pragma unroll
            for (int m = 0; m < 4; ++m) { f32x4 o[2];
#pragma unroll
                for (int n = 0; n < 2; ++n) {
                    f32x4 cv;
#pragma unroll
                    for (int e = 0; e < 4; ++e) { const float X = acc[ai][0][m][n][e]; const float p1 = dpp_shr(t1[n][e], X, 1), p2 = dpp_shr(t2[n][e], X, 2);
                        t1[n][e] = dpp_shl15(X); t2[n][e] = dpp_shl14(X);
                        cv[e] = w2[n][e] * X + w1[n][e] * p1 + w0[n][e] * p2 + bb[n][e]; }
                    const f32x2 ga = gelu_pk((f32x2){cv[0], cv[1]}), gb = gelu_pk((f32x2){cv[2], cv[3]});
                    o[n] = (f32x4){ga.x, ga.y, gb.x, gb.y} * acc[ai][1][m][n]; }
                const bool skip = (s == 0 && m == 0 && fr < 2);
                if (!skip) __builtin_nontemporal_store(pack8(o[0], o[1]), (u32x4*)(midb + (size_t)(row0 + ai * HALF + m * 16) * FF + col0));
                asm volatile("" ::: "memory"); }
        }
    }
};
struct EpiFfnDown {
    static constexpr bool PERM = true, AFTER_DRAIN = false, HAS_MID = false;
    const bf16_t* in; float* out;
    __device__ __forceinline__ void mid(f32x4 (&)[2][2][4][2], const Unit&, int, int, int, int) const {}
    __device__ __forceinline__ void operator()(f32x4 (&acc)[2][2][4][2], const Unit& u, int wr, int wc, int fr, int fq) const {
        int row0 = u.pm * BM + wr * 64 + fr; asm volatile("" : "+v"(row0)); const int col0 = u.pn * BM + wc * 32 + 8 * fq;
        u32x4 xv[2][2];
        { const bf16_t* p = in + (size_t)row0 * 1024 + col0; xv[0][0] = *(const u32x4*)(p); xv[0][1] = *(const u32x4*)(p + HALF); }
#pragma unroll
        for (int g = 0; g < 8; ++g) { const int ai = g >> 2, m = g & 3; const size_t off = (size_t)(row0 + ai * HALF + m * 16) * 1024 + col0;
            if (g < 7) { const bf16_t* p = in + (size_t)(row0 + ((g + 1) >> 2) * HALF + ((g + 1) & 3) * 16) * 1024 + col0; xv[(g + 1) & 1][0] = *(const u32x4*)(p); xv[(g + 1) & 1][1] = *(const u32x4*)(p + HALF); }
#pragma unroll
            for (int bj = 0; bj < 2; ++bj) { f32x4 r0, r1; unpack8(xv[g & 1][bj], r0, r1); float* q = out + off + bj * HALF; __builtin_nontemporal_store(r0 + acc[ai][bj][m][0], (f32x4*)(q)); __builtin_nontemporal_store(r1 + acc[ai][bj][m][1], (f32x4*)(q + 4)); }
            asm volatile("" ::: "memory"); }
    }
};
struct EpiCmpHid {
    static constexpr bool PERM = true, AFTER_DRAIN = false, HAS_MID = false;
    const float* cbias  ; bf16_t* hid;
    __device__ __forceinline__ void mid(f32x4 (&)[2][2][4][2], const Unit&, int, int, int, int) const {}
    __device__ __forceinline__ void operator()(f32x4 (&acc)[2][2][4][2], const Unit& u, int wr, int wc, int fr, int fq) const {
        int row0 = u.pm * BM + wr * 64 + fr; asm volatile("" : "+v"(row0)); const int col0 = wc * 32 + 8 * fq; const float* bp = cbias + (u.pm >> 4) * 256 + col0;
#pragma unroll
        for (int ai = 0; ai < 2; ++ai)
#pragma unroll
            for (int m = 0; m < 4; ++m) { bf16_t* rowp = hid + (size_t)(row0 + ai * HALF + m * 16) * 256 + col0;
#pragma unroll
                for (int bj = 0; bj < 2; ++bj) { f32x4 v0 = acc[ai][bj][m][0] + *(const f32x4*)(bp + bj * HALF), v1 = acc[ai][bj][m][1] + *(const f32x4*)(bp + bj * HALF + 4);
                    const f32x2 g0 = gelu_pk((f32x2){v0[0], v0[1]}), g1 = gelu_pk((f32x2){v0[2], v0[3]}), g2 = gelu_pk((f32x2){v1[0], v1[1]}), g3 = gelu_pk((f32x2){v1[2], v1[3]});
                    *(u32x4*)(rowp + bj * HALF) = pack8((f32x4){g0.x, g0.y, g1.x, g1.y}, (f32x4){g2.x, g2.y, g3.x, g3.y}); } }
    }
};
struct CmpOrder {
    int G, c; const bf16_t* kc; const bf16_t* vc; const bf16_t* w1t;
    __device__ bool next(int i, Unit& u) const { const int L = i * G + c; if (L >= 32) return false; u.pm = (L & 7) * 4 + (L >> 3); u.pn = 0; return true; }
    __device__ __forceinline__ const char* a_ptr(const Gemm&, const Unit& u) const { const int kvbg = u.pm >> 1, half = u.pm & 1, kv = kvbg >> 3, b = (kvbg >> 1) & 3, g = kvbg & 1;
        return (const char*)((kv ? vc : kc) + ((size_t)(b * SEQ + 16 * 256 * half) * 128 + g * 64)); }
    __device__ __forceinline__ const char* b_ptr(const Gemm&, const Unit& u) const { return (const char*)(w1t + (size_t)(u.pm >> 4) * 256 * 2048); }
    __device__ __forceinline__ void a_ready(const Unit&) const {}
    __device__ __forceinline__ void done(const Unit&) const {}
};
template <class Epi, class Sched, bool ALIGN_EPI = false, bool SP2 = false>
__device__ __forceinline__ void gemm_phase(PG8_LAS unsigned char* lds, const Gemm g, const Sched& S, const Epi& E) {
    int tid_ = threadIdx.x; asm volatile("" : "+v"(tid_));
    const int tid = tid_, wid = __builtin_amdgcn_readfirstlane(tid >> 6), lane = tid & 63, wr = wid >> 2, wc = wid & 3, fr = lane & 15, fq = lane >> 4;
    const int K = g.K, nt = K / BK;
    unsigned voffA[2], voffB[2];
#pragma unroll
    for (int i = 0; i < 2; ++i) { int R, C; stage_rc(tid * 16 + i * 8192, R, C); const int Rb = Epi::PERM ? ((R & ~31) + perm32(R & 31)) : R;
        voffA[i] = (unsigned)(R * g.lda + C) * 2u; voffB[i] = (unsigned)(Rb * K + C) * 2u; }
    const size_t kstepA = (size_t)g.ksA, kstepB = (size_t)(BK * 2);
    const size_t hstepA = (size_t)HALF * g.lda * 2, hstepB = (size_t)HALF * K * 2;
    const unsigned ldsw = (unsigned)wid * 1024u;
    const int aoff = lds_byte(wr * 64 + fr, fq * 8), boff = lds_byte(wc * 32 + fr, fq * 8);
#define PG8_SA(b, h) (((b) * 2 + (h)) * HTB)
#define PG8_SB(b, h) ((4 + (b) * 2 + (h)) * HTB)
#define PG8_STAGE(bufoff, gbase, voff) do { _Pragma("unroll") for (int _i = 0; _i < 2; ++_i) \
        __builtin_amdgcn_global_load_lds((const unsigned*)((const char*)(gbase) + (voff)[_i]), (PG8_LAS unsigned*)(lds + (bufoff) + ldsw + _i * 8192), 16, 0, 0); } while (0)
#define PG8_LDA(dst, b, h) do { _Pragma("unroll") for (int m = 0; m < 4; ++m) _Pragma("unroll") for (int k = 0; k < 2; ++k) dst[m][k] = *(const PG8_LAS bf16x8*)(lds + PG8_SA(b, h) + aoff + m * 2048 + k * 1024); } while (0)
#define PG8_LDB(dst, b, h) do { _Pragma("unroll") for (int n = 0; n < 2; ++n) _Pragma("unroll") for (int k = 0; k < 2; ++k) dst[n][k] = *(const PG8_LAS bf16x8*)(lds + PG8_SB(b, h) + boff + n * 2048 + k * 1024); } while (0)
#define PG8_MMA(ai, bj, At, Bt) do { __builtin_amdgcn_s_setprio(1); _Pragma("unroll") for (int m = 0; m < 4; ++m) _Pragma("unroll") for (int n = 0; n < 2; ++n) _Pragma("unroll") for (int k = 0; k < 2; ++k) \
        acc[ai][bj][m][n] = __builtin_amdgcn_mfma_f32_16x16x32_bf16(Bt[n][k], At[m][k], acc[ai][bj][m][n], 0, 0, 0); __builtin_amdgcn_s_setprio(0); } while (0)
#define PG8_WAIT_V(n) asm volatile("s_waitcnt vmcnt(" #n ")" ::: "memory")
#define PG8_WAIT_L(n) asm volatile("s_waitcnt lgkmcnt(" #n ")" ::: "memory")
#define PG8_BAR __builtin_amdgcn_s_barrier()
#define PG8_SCHED __builtin_amdgcn_sched_barrier(0)
    Unit cur, nxt; int ui = 0;
    if (!S.next(0, cur)) return;
    f32x4 acc[2][2][4][2];
#pragma unroll
    for (int a = 0; a < 2; ++a)
#pragma unroll
        for (int b = 0; b < 2; ++b)
#pragma unroll
            for (int m = 0; m < 4; ++m)
#pragma unroll
                for (int n = 0; n < 2; ++n) acc[a][b][m][n] = (f32x4){0.f, 0.f, 0.f, 0.f};
    bf16x8 At[4][2], B0[2][2], B1[2][2];
    const char* cA = S.a_ptr(g, cur); const char* cB = S.b_ptr(g, cur);
    S.a_ready(cur);
    if constexpr (SP2) {
        PG8_STAGE(PG8_SB(0, 0), cB, voffB); PG8_STAGE(PG8_SB(0, 1), cB + hstepB, voffB); PG8_STAGE(PG8_SA(0, 0), cA, voffA); PG8_STAGE(PG8_SA(0, 1), cA + hstepA, voffA);
        if (wr == 1) PG8_BAR;
        PG8_WAIT_V(2); PG8_BAR;
        PG8_STAGE(PG8_SB(1, 0), cB + kstepB, voffB); PG8_STAGE(PG8_SA(1, 0), cA + kstepA, voffA); PG8_STAGE(PG8_SB(1, 1), cB + hstepB + kstepB, voffB);
        PG8_WAIT_V(6); PG8_BAR;
    } else {
        PG8_STAGE(PG8_SB(0, 0), cB, voffB); PG8_STAGE(PG8_SA(0, 0), cA, voffA); PG8_STAGE(PG8_SB(0, 1), cB + hstepB, voffB); PG8_STAGE(PG8_SA(0, 1), cA + hstepA, voffA);
        if (wr == 1) PG8_BAR;
        PG8_WAIT_V(4); PG8_BAR;
        PG8_STAGE(PG8_SB(1, 0), cB + kstepB, voffB); PG8_STAGE(PG8_SA(1, 0), cA + kstepA, voffA); PG8_STAGE(PG8_SB(1, 1), cB + hstepB + kstepB, voffB);
        PG8_WAIT_V(6); PG8_BAR;
    }
    for (;;) {
        const bool has_next = S.next(ui + 1, nxt);
        const char* nA = has_next ? S.a_ptr(g, nxt) : cA; const char* nB = has_next ? S.b_ptr(g, nxt) : cB;
        for (int t = 0; t < nt; t += 2) {
            if constexpr (Epi::HAS_MID) { if (t == nt / 2) E.mid(acc, cur, wr, wc, fr, fq); }
            const bool last = (t == nt - 2);
            const char* a1 = cA + (size_t)(t + 1) * kstepA;
            const char* a2 = last ? nA : cA + (size_t)(t + 2) * kstepA; const char* b2 = last ? nB : cB + (size_t)(t + 2) * kstepB;
            const char* a3 = a2 + kstepA; const char* b3 = b2 + kstepB;
            if (last && has_next) S.a_ready(nxt);
            if constexpr (SP2) {
            PG8_LDB(B0, 0, 0); PG8_LDB(B1, 0, 1); PG8_SCHED; PG8_LDA(At, 0, 0); PG8_STAGE(PG8_SA(1, 1), a1 + hstepA, voffA);
            PG8_WAIT_V(8); PG8_WAIT_L(0); PG8_BAR; PG8_MMA(0, 0, At, B0); PG8_MMA(0, 1, At, B1); PG8_BAR; PG8_SCHED;
            PG8_LDA(At, 0, 1); PG8_STAGE(PG8_SB(0, 0), b2, voffB); PG8_STAGE(PG8_SB(0, 1), b2 + hstepB, voffB); PG8_STAGE(PG8_SA(0, 0), a2, voffA);
            PG8_WAIT_V(8); PG8_WAIT_L(0); PG8_BAR; PG8_MMA(1, 0, At, B0); PG8_MMA(1, 1, At, B1); PG8_BAR; PG8_SCHED;
            PG8_LDB(B0, 1, 0); PG8_LDB(B1, 1, 1); PG8_SCHED; PG8_LDA(At, 1, 0); PG8_STAGE(PG8_SA(0, 1), a2 + hstepA, voffA);
            PG8_WAIT_V(8); PG8_WAIT_L(0); PG8_BAR; PG8_MMA(0, 0, At, B0); PG8_MMA(0, 1, At, B1); PG8_BAR; PG8_SCHED;
            PG8_LDA(At, 1, 1); PG8_STAGE(PG8_SB(1, 0), b3, voffB); PG8_STAGE(PG8_SB(1, 1), b3 + hstepB, voffB); PG8_STAGE(PG8_SA(1, 0), a3, voffA);
            PG8_WAIT_V(8); PG8_WAIT_L(0); PG8_BAR; PG8_MMA(1, 0, At, B0); PG8_MMA(1, 1, At, B1); PG8_BAR; PG8_SCHED;
            } else {
            PG8_LDB(B0, 0, 0); PG8_SCHED; PG8_LDA(At, 0, 0); PG8_STAGE(PG8_SA(1, 1), a1 + hstepA, voffA);
            PG8_WAIT_L(8); PG8_BAR; PG8_WAIT_L(0); PG8_MMA(0, 0, At, B0); PG8_BAR; PG8_SCHED;
            PG8_LDB(B1, 0, 1); PG8_STAGE(PG8_SB(0, 0), b2, voffB);
            PG8_BAR; PG8_WAIT_L(0); PG8_MMA(0, 1, At, B1); PG8_BAR;
            PG8_LDA(At, 0, 1); PG8_STAGE(PG8_SA(0, 0), a2, voffA);
            PG8_BAR; PG8_WAIT_L(0); PG8_MMA(1, 0, At, B0); PG8_BAR; PG8_SCHED;
            PG8_STAGE(PG8_SB(0, 1), b2 + hstepB, voffB);
            PG8_WAIT_V(6); PG8_BAR; PG8_MMA(1, 1, At, B1); PG8_BAR;
            PG8_LDB(B0, 1, 0); PG8_SCHED; PG8_LDA(At, 1, 0); PG8_STAGE(PG8_SA(0, 1), a2 + hstepA, voffA);
            PG8_WAIT_L(8); PG8_BAR; PG8_WAIT_L(0); PG8_MMA(0, 0, At, B0); PG8_BAR; PG8_SCHED;
            PG8_LDB(B1, 1, 1); PG8_STAGE(PG8_SB(1, 0), b3, voffB);
            PG8_BAR; PG8_WAIT_L(0); PG8_MMA(0, 1, At, B1); PG8_BAR;
            PG8_LDA(At, 1, 1); PG8_STAGE(PG8_SA(1, 0), a3, voffA);
            PG8_BAR; PG8_WAIT_L(0); PG8_MMA(1, 0, At, B0); PG8_BAR; PG8_SCHED;
            PG8_STAGE(PG8_SB(1, 1), b3 + hstepB, voffB);
            PG8_WAIT_V(6); PG8_BAR; PG8_MMA(1, 1, At, B1); PG8_BAR;
            }
        }
        if constexpr (ALIGN_EPI) { if (wr == 0) PG8_BAR; }
        if constexpr (!Epi::AFTER_DRAIN) { E(acc, cur, wr, wc, fr, fq); S.done(cur); }
        if (!has_next) break;
#pragma unroll
        for (int a = 0; a < 2; ++a)
#pragma unroll
            for (int b = 0; b < 2; ++b)
#pragma unroll
                for (int m = 0; m < 4; ++m)
#pragma unroll
                    for (int n = 0; n < 2; ++n) acc[a][b][m][n] = (f32x4){0.f, 0.f, 0.f, 0.f};
        cur = nxt; cA = nA; cB = nB; ++ui;
        if constexpr (ALIGN_EPI) { if (wr == 1) PG8_BAR; }
    }
    PG8_WAIT_V(0);
    if constexpr (!ALIGN_EPI) { if (wr == 0) PG8_BAR; }
    PG8_BAR;
    if constexpr (Epi::AFTER_DRAIN) { E.fused(acc, cur, wr, wc, fr, fq, lds, wid, lane); S.done(cur); }
#undef PG8_SA
#undef PG8_SB
#undef PG8_STAGE
#undef PG8_LDA
#undef PG8_LDB
#undef PG8_MMA
#undef PG8_WAIT_V
#undef PG8_WAIT_L
#undef PG8_BAR
#undef PG8_SCHED
}
}

using pg8::bf16_t; using pg8::f32x4; using pg8::u32x4; using pg8::TT; using pg8::SEQ; using pg8::NEPS; using pg8::QC2; using pg8::bf2f; using pg8::sigm;
#define LAS __attribute__((address_space(3)))
struct Args { const float* in[27]; float* out; unsigned char* ws; float rope_inv[32]; };

__device__ __forceinline__ unsigned f2bf(float f) { unsigned u = __builtin_bit_cast(unsigned, f); return (u + 0x7fffu + ((u >> 16) & 1u)) >> 16; }
__device__ __forceinline__ unsigned pk2(float lo, float hi) { return f2bf(lo) | (f2bf(hi) << 16); }
__device__ __forceinline__ float wave_sum(float v) {
#pragma unroll
    for (int o = 1; o < 64; o <<= 1) v += __shfl_xor(v, o);
    return v;
}
template <class F> __device__ __forceinline__ void transpose_item(const float* W, int ldw, int k0src, const float* kscale, bf16_t* WT, int ldt, int k0dst, int row0, LAS float* scr, int lane, F srccol) {
    { const int c4 = lane & 7, kr = lane >> 3; const int sc = srccol(4 * c4); f32x4 v[8];
#pragma unroll
      for (int i = 0; i < 8; ++i) { const int kk = 8 * i + kr; v[i] = (f32x4){0.f, 0.f, 0.f, 0.f}; if (sc >= 0) { v[i] = __builtin_nontemporal_load((const f32x4*)(W + (size_t)(k0src + kk) * ldw + sc));   if (kscale) v[i] = v[i] * kscale[k0src + kk]; } }
#pragma unroll
      for (int i = 0; i < 8; ++i) { LAS float* p = scr + (8 * i + kr) * 33 + 4 * c4; p[0] = v[i][0]; p[1] = v[i][1]; p[2] = v[i][2]; p[3] = v[i][3]; } }
    asm volatile("s_waitcnt lgkmcnt(0)" ::: "memory");
    const int c = lane & 7;
#pragma unroll
    for (int jj = 0; jj < 4; ++jj) { const int n = (lane >> 3) + 8 * jj; const LAS float* s = scr + (8 * c) * 33 + n;
        u32x4 o; o.x = pk2(s[0 * 33], s[1 * 33]); o.y = pk2(s[2 * 33], s[3 * 33]); o.z = pk2(s[4 * 33], s[5 * 33]); o.w = pk2(s[6 * 33], s[7 * 33]);
        *(u32x4*)(WT + (size_t)(row0 + n) * ldt + k0dst + 8 * c) = o; }
    asm volatile("s_waitcnt lgkmcnt(0)" ::: "memory");
}
__device__ __forceinline__ int inproj_src(int p) {
    const int tile = p >> 8, l = p & 255;
    if (tile < 6) return p;
    const int half = l >> 7, wh = (l >> 5) & 3, j = l & 31;
    if (tile < 8) return C_NQ + 64 * (4 * (tile - 6) + wh) + 32 * half + j;
    if (tile == 8) return (wh < 2 ? C_KC + 64 * wh : C_KS + 64 * (wh - 2)) + 32 * half + j;
    if (tile == 9) return (wh < 2 ? C_KW + 64 * wh : C_VC + 64 * (wh - 2)) + 32 * half + j;
    if (tile == 10) return (wh < 2 ? C_VS + 64 * wh : C_VW + 64 * (wh - 2)) + 32 * half + j;
    if (l < 8) return C_MI + l; if (l < 32) return C_NG + (l - 8); return -1;
}
#define GAS __attribute__((address_space(1)))
typedef GAS unsigned gu32;
typedef GAS unsigned long long gu64;
#define RLX_AGENT __ATOMIC_RELAXED, __HIP_MEMORY_SCOPE_AGENT
__device__ __forceinline__ unsigned long long rt() { return __builtin_amdgcn_s_memrealtime(); }
#define XB_TMO      128
#define XB_XCNT(j)  (256  + 64 * (j))
#define XB_XSUB(j)  (1280 + 64 * (j))
#define XB_XGEN(j)  (2304 + 64 * (j))
#define XB_TOP      3328
#define XB_TOPGEN   3392
#define XCD_BAR_WORDS 3456
#define XB_SPIN_CAP (1u << 18)

__device__ __forceinline__ unsigned xb_ld(unsigned* p)              { return __hip_atomic_load(p, __ATOMIC_RELAXED, __HIP_MEMORY_SCOPE_AGENT); }
__device__ __forceinline__ unsigned xb_add(unsigned* p, unsigned v) { return __hip_atomic_fetch_add(p, v, __ATOMIC_RELAXED, __HIP_MEMORY_SCOPE_AGENT); }
__device__ __forceinline__ unsigned xb_xcc_id() { return (unsigned)__builtin_amdgcn_s_getreg((3 << 11) | 20) & 0xFu; }
#define XB_SPIN(cond, bar) do { unsigned _sp = 0; while (cond) { __builtin_amdgcn_s_sleep(1); \
    if ((++_sp & 255u) == 0u) { if (xb_ld(&(bar)[XB_TMO])) break; if (_sp > XB_SPIN_CAP) { atomicAdd(&(bar)[XB_TMO], 1u); break; } } } } while (0)

struct XcdBarrier {
    unsigned* bar; unsigned x;
    volatile LAS unsigned* st;
};

__device__ __forceinline__ XcdBarrier xcd_barrier_post(unsigned* bar, volatile LAS unsigned* st) {
    XcdBarrier b; b.bar = bar; b.x = xb_xcc_id(); b.st = st;
    if (threadIdx.x == 0) (void)xb_add(&bar[XB_XCNT(b.x)], 1u);
    return b;
}
__device__ __forceinline__ void xcd_barrier_complete(unsigned* bar, unsigned x, unsigned& nloc, unsigned& nx) {
    const unsigned G = gridDim.x * gridDim.y * gridDim.z;
    unsigned sum, cnt, mine, sp = 0u;
    for (;;) {
        sum = 0u; cnt = 0u; mine = 0u;
#pragma unroll
        for (unsigned j = 0; j < 16; ++j) { const unsigned c = xb_ld(&bar[XB_XCNT(j)]); sum += c; cnt += (c > 0u) ? 1u : 0u; mine = (j == x) ? c : mine; }
        if (sum == G) break;
        __builtin_amdgcn_s_sleep(1);
        if ((++sp & 255u) == 0u) { if (xb_ld(&bar[XB_TMO])) break; if (sp > XB_SPIN_CAP) { atomicAdd(&bar[XB_TMO], 1u); break; } }
    }
    nloc = mine > 0u ? mine : 1u; nx = cnt > 0u ? cnt : 1u;
}

__device__ __forceinline__ void xcd_barrier(const XcdBarrier& b) {
    asm volatile("s_waitcnt vmcnt(0)" ::: "memory");
    __syncthreads();
    if (threadIdx.x == 0) {
        unsigned* bar = b.bar;
        __builtin_amdgcn_s_waitcnt(0);
        unsigned nloc = b.st[0], nx = b.st[1];
        if (nloc == 0u) { xcd_barrier_complete(bar, b.x, nloc, nx); b.st[0] = nloc; b.st[1] = nx; }
        const unsigned old = xb_add(&bar[XB_XSUB(b.x)], 1u);
        const unsigned gen = old / nloc;
        if (old + 1u == (gen + 1u) * nloc) {
            __builtin_amdgcn_fence(__ATOMIC_RELEASE, "agent");
            asm volatile("s_waitcnt vmcnt(0)" ::: "memory");
            const unsigned og = xb_add(&bar[XB_TOP], 1u);
            const unsigned tg = og / nx;
            if (og + 1u == (tg + 1u) * nx) xb_add(&bar[XB_TOPGEN], 1u);
            else XB_SPIN(xb_ld(&bar[XB_TOPGEN]) == tg, bar);
            __builtin_amdgcn_fence(__ATOMIC_ACQUIRE, "agent");
            xb_add(&bar[XB_XGEN(b.x)], 1u);
            asm volatile("s_waitcnt vmcnt(0)" ::: "memory");
        } else {
            XB_SPIN(xb_ld(&bar[XB_XGEN(b.x)]) == gen, bar);
            __builtin_amdgcn_fence(__ATOMIC_ACQUIRE, "agent");
            asm volatile("s_waitcnt vmcnt(0)" ::: "memory");
        }
    }
    __syncthreads();
}

struct Ctx { int tid, lane, wave, G, vcu, gw, ngw, gtid, nthr; LAS unsigned char* lds; };

template <int PART> __device__ __forceinline__ void phase_transposes(const Ctx& C, const Args& a) {
    unsigned char* ws = a.ws;
    LAS float* scr = (LAS float*)(C.lds + C.wave * 16384);
    const float* w_in = a.in[2]; const float* norm1 = a.in[1]; const float* norm2 = a.in[22];
    constexpr int I_WIN = 96 * 16, I_WG = 64 * 16, I_WMN = 32 * 16, I_WOUT = 32 * 16, I_WUP = 176 * 16, I_WDN = 32 * 44, I_CW1 = 16 * 32;
    constexpr int NITEMS = I_WIN + I_WG + I_WMN + I_WOUT + I_WUP + I_WDN + I_CW1;
    const int it_lo = PART == 0 ? 0 : I_WIN, it_hi = PART == 0 ? I_WIN + I_CW1 : NITEMS - I_CW1;
    for (int it0 = it_lo + C.gw; it0 < it_hi; it0 += C.ngw) {
        int r = (PART == 0 && it0 >= I_WIN) ? it0 + (NITEMS - I_CW1 - I_WIN) : it0;
        if (r < I_WIN) { const int blk = r >> 4, kb = r & 15; transpose_item(w_in, DIN, 64 * kb, norm1, (bf16_t*)(ws + WS_WIN), 1024, 64 * kb, 32 * blk, scr, C.lane, [=](int j) { return inproj_src(32 * blk + j); }); continue; } r -= I_WIN;
        if (r < I_WG) { const int blk = r >> 4, kb = r & 15; const int p0 = 32 * blk, pn = p0 >> 8, half = (p0 >> 7) & 1, jj = p0 & 127;
            transpose_item(w_in, DIN, 64 * kb, norm1, (bf16_t*)(ws + WS_WG), 1024, 64 * kb, p0, scr, C.lane, [=](int j) { return C_GM + half * 1024 + 128 * pn + jj + j; }); continue; } r -= I_WG;
        if (r < I_WMN) { const int blk = r >> 4, kb = r & 15; const float* W = kb < 8 ? a.in[18] : a.in[19]; transpose_item(W, 1024, 64 * (kb & 7), nullptr, (bf16_t*)(ws + WS_WMN), 1024, 64 * kb, 32 * blk, scr, C.lane, [=](int j) { return 32 * blk + j; }); continue; } r -= I_WMN;
        if (r < I_WOUT) { const int blk = r >> 4, kb = r & 15; transpose_item(a.in[21], 1024, 64 * kb, nullptr, (bf16_t*)(ws + WS_WOUT), 1024, 64 * kb, 32 * blk, scr, C.lane, [=](int j) { return 32 * blk + j; }); continue; } r -= I_WOUT;
        if (r < I_WUP) { const int blk = r >> 4, kb = r & 15; const int p0 = 32 * blk, pn = p0 >> 8, half = (p0 >> 7) & 1, jj = p0 & 127;
            transpose_item(a.in[23], 2 * DFF, 64 * kb, norm2, (bf16_t*)(ws + WS_WUP), 1024, 64 * kb, p0, scr, C.lane, [=](int j) { return half * DFF + 128 * pn + jj + j; }); continue; } r -= I_WUP;
        if (r < I_WDN) { const int blk = r / 44, kb = r % 44; transpose_item(a.in[26], 1024, 64 * kb, nullptr, (bf16_t*)(ws + WS_WDN), DFF, 64 * kb, 32 * blk, scr, C.lane, [=](int j) { return 32 * blk + j; }); continue; } r -= I_WDN;
        { const int kv = r >> 8, blk = (r >> 5) & 7, kb = r & 31; transpose_item(kv ? a.in[16] : a.in[13], 256, 64 * kb, nullptr, (bf16_t*)(ws + WS_CW1) + (size_t)kv * 256 * 2048, 2048, 64 * kb, 32 * blk, scr, C.lane, [=](int j) { return 32 * blk + j; }); }
    }
}
__device__ __forceinline__ void xrow_load(f32x4 (&v)[4][4], const float* x, int m0, int lane) {
#pragma unroll
    for (int r = 0; r < 4; ++r) { const f32x4* xr = (const f32x4*)(x + (size_t)(m0 + r) * DM) + lane;
#pragma unroll
        for (int j = 0; j < 4; ++j) v[r][j] = __builtin_nontemporal_load(xr + 64 * j); }
}
__device__ __forceinline__ void xrow_store(const f32x4 (&v)[4][4], bf16_t* xb, float* rstd, int m0, int lane) {
    float s[4];
#pragma unroll
    for (int r = 0; r < 4; ++r) { s[r] = 0.f;
#pragma unroll
        for (int j = 0; j < 4; ++j) s[r] += (v[r][j][0] * v[r][j][0] + v[r][j][1] * v[r][j][1]) + (v[r][j][2] * v[r][j][2] + v[r][j][3] * v[r][j][3]); }
#pragma unroll
    for (int o = 1; o < 64; o <<= 1) {
#pragma unroll
        for (int r = 0; r < 4; ++r) s[r] += __shfl_xor(s[r], o); }
#pragma unroll
    for (int r = 0; r < 4; ++r) { if (lane == 0) rstd[m0 + r] = 1.0f / sqrtf(s[r] * (1.0f / DM) + NEPS);
        unsigned long long* o8 = (unsigned long long*)(xb + (size_t)(m0 + r) * DM) + lane;
#pragma unroll
        for (int j = 0; j < 4; ++j) o8[64 * j] = (unsigned long long)pk2(v[r][j][0], v[r][j][1]) | ((unsigned long long)pk2(v[r][j][2], v[r][j][3]) << 32); }
}
__device__ __forceinline__ void phase_prologue(const Ctx& C, const Args& a) {
    unsigned char* ws = a.ws; const float* x = a.in[0]; bf16_t* xb = (bf16_t*)(ws + WS_XB); float* rstd = (float*)(ws + WS_RSTD1);
    const int mstep = 4 * C.ngw; int m0 = 4 * C.gw;
    f32x4 va[4][4], vb[4][4];
    if (m0 < TT) xrow_load(va, x, m0, C.lane);
    phase_transposes<0>(C, a);
#if defined(REPEAT_T0)
    for (int rep = 0; rep < REPEAT_T0; ++rep) { __syncthreads(); phase_transposes<0>(C, a); }
#endif
    { float* cbias = (float*)(ws + WS_CBIAS); LAS float* part = (LAS float*)(C.lds + 8 * 16384);
      for (int i0 = 2 * C.vcu; i0 < 512; i0 += 2 * C.G) { const int i = i0 + (C.wave >> 2), kq = C.wave & 3, kv = i >> 8, j = i & 255; const float* pe = kv ? a.in[15] : a.in[12]; const float* w1 = kv ? a.in[16] : a.in[13]; float s = 0.f;
#pragma unroll
          for (int q = 0; q < 8; ++q) { const int k = 512 * kq + 64 * q + C.lane; s += pe[k] * w1[(size_t)k * 256 + j]; }
          s = wave_sum(s); if (C.lane == 0) part[C.wave] = s;
          __syncthreads();
          if (C.tid < 2) cbias[i0 + C.tid] = (part[4 * C.tid] + part[4 * C.tid + 1]) + (part[4 * C.tid + 2] + part[4 * C.tid + 3]);
          __syncthreads(); } }
    for (; m0 < TT; m0 += 2 * mstep) {
        const int m1 = m0 + mstep, m2 = m1 + mstep;
        if (m1 < TT) xrow_load(vb, x, m1, C.lane);
        xrow_store(va, xb, rstd, m0, C.lane);
        if (m2 < TT) xrow_load(va, x, m2, C.lane);
        if (m1 < TT) xrow_store(vb, xb, rstd, m1, C.lane);
    }
#if defined(REPEAT_ROPE)
    for (int rep = 0; rep < REPEAT_ROPE; ++rep)
#endif
    { float* rc = (float*)(ws + WS_ROPEC); float* rsn = (float*)(ws + WS_ROPES);
      for (int i = C.gtid; i < SEQ * 32; i += C.nthr) { const int t = i >> 5, j = i & 31; const float ang = (float)t * a.rope_inv[j]; float sv, cv; sincosf(ang, &sv, &cv); rc[i] = cv; rsn[i] = sv; } }
}

__device__ __forceinline__ void p7b_fixup_panel(const Ctx& C, const Args& a, int pm) {
    unsigned char* ws = a.ws; const float* __restrict__ eA = (const float*)(ws + WS_EDGEA); const float* __restrict__ eV = (const float*)(ws + WS_EDGEV); bf16_t* __restrict__ mid = (bf16_t*)(ws + WS_MID);
    const float* __restrict__ cw = a.in[24]; const float* __restrict__ cb = a.in[25];
    const bool first = (pm & 31) == 0;
    const float* e0 = eA + (size_t)pm * 4 * DFF; const float* ep = eA + (size_t)(first ? pm : pm - 1) * 4 * DFF; const float* v0 = eV + (size_t)pm * 2 * DFF;
    float x0[6], x1[6], pa[6], pb[6], w0[6], w1[6], w2[6], bb[6], g0[6], g1[6];
#pragma unroll
    for (int j = 0; j < 6; ++j) { const int c = C.tid + 512 * j; const int cc = c < DFF ? c : DFF - 1;
        x0[j] = e0[cc]; x1[j] = e0[DFF + cc]; pa[j] = ep[3 * DFF + cc]; pb[j] = ep[2 * DFF + cc]; w0[j] = cw[cc]; w1[j] = cw[DFF + cc]; w2[j] = cw[2 * DFF + cc]; bb[j] = cb[cc]; g0[j] = v0[cc]; g1[j] = v0[DFF + cc]; }
#pragma unroll
    for (int j = 0; j < 6; ++j) { const int c = C.tid + 512 * j; const float pA = first ? 0.f : pa[j], pB = first ? 0.f : pb[j];
        const float c0 = w2[j] * x0[j] + w1[j] * pA + w0[j] * pB + bb[j], c1 = w2[j] * x1[j] + w1[j] * x0[j] + w0[j] * pA + bb[j];
        const pg8::f32x2 gl = pg8::gelu_pk((pg8::f32x2){c0, c1});
        if (c < DFF) { mid[(size_t)(pm * 256) * DFF + c] = (bf16_t)f2bf(gl.x * g0[j]); mid[(size_t)(pm * 256 + 1) * DFF + c] = (bf16_t)f2bf(gl.y * g1[j]); } }
}
__device__ __forceinline__ void p7b_fixup_two(const Ctx& C, const Args& a, int pmA, int pmB) {
    unsigned char* ws = a.ws; const float* __restrict__ eA = (const float*)(ws + WS_EDGEA); const float* __restrict__ eV = (const float*)(ws + WS_EDGEV); bf16_t* __restrict__ mid = (bf16_t*)(ws + WS_MID);
    const float* __restrict__ cw = a.in[24]; const float* __restrict__ cb = a.in[25];
    const int half = C.tid >> 8, t = C.tid & 255, pm = half ? pmB : pmA;
    const bool first = (pm & 31) == 0;
    const float* e0 = eA + (size_t)pm * 4 * DFF; const float* ep = eA + (size_t)(first ? pm : pm - 1) * 4 * DFF; const float* v0 = eV + (size_t)pm * 2 * DFF;
    float x0[11], x1[11], pa[11], pb[11], w0[11], w1[11], w2[11], bb[11], g0[11], g1[11];
#pragma unroll
    for (int j = 0; j < 11; ++j) { const int cc = t + 256 * j;
        x0[j] = e0[cc]; x1[j] = e0[DFF + cc]; pa[j] = ep[3 * DFF + cc]; pb[j] = ep[2 * DFF + cc]; w0[j] = cw[cc]; w1[j] = cw[DFF + cc]; w2[j] = cw[2 * DFF + cc]; bb[j] = cb[cc]; g0[j] = v0[cc]; g1[j] = v0[DFF + cc]; }
#pragma unroll
    for (int j = 0; j < 11; ++j) { const int c = t + 256 * j; const float pA = first ? 0.f : pa[j], pB = first ? 0.f : pb[j];
        const float c0 = w2[j] * x0[j] + w1[j] * pA + w0[j] * pB + bb[j], c1 = w2[j] * x1[j] + w1[j] * x0[j] + w0[j] * pA + bb[j];
        const pg8::f32x2 gl = pg8::gelu_pk((pg8::f32x2){c0, c1});
        mid[(size_t)(pm * 256) * DFF + c] = (bf16_t)f2bf(gl.x * g0[j]); mid[(size_t)(pm * 256 + 1) * DFF + c] = (bf16_t)f2bf(gl.y * g1[j]); }
}
#ifndef NOSHIFT_THR
#define NOSHIFT_THR (-64.f)
#endif
namespace att {
typedef short bf16x8 __attribute__((ext_vector_type(8)));
typedef short s16x4 __attribute__((ext_vector_type(4)));
typedef float f32x16 __attribute__((ext_vector_type(16)));
typedef unsigned u32x2 __attribute__((ext_vector_type(2)));
enum { M_WIN = 0, M_CMP = 1, M_SLC = 2 };
constexpr int LDS_KV = 0  , LDS_IMP = 65536  , IMPS = 129;
__device__ __forceinline__ void lds_barrier() { asm volatile("s_waitcnt lgkmcnt(0)" ::: "memory"); __builtin_amdgcn_s_barrier(); asm volatile("" ::: "memory"); }
__device__ __forceinline__ int crow(int r, int hi) { return (r & 3) + 8 * (r >> 2) + 4 * hi; }
__device__ __forceinline__ s16x4 vtr(const LAS unsigned char* p) { typedef short v4i16_t __attribute__((ext_vector_type(4))); return __builtin_bit_cast(s16x4, __builtin_amdgcn_ds_read_tr16_b64_v4i16((LAS v4i16_t*)p)); }
__device__ __forceinline__ unsigned cvtpk(float lo, float hi) { return pg8::cvt_pk_bf16(lo, hi); }
__device__ __forceinline__ bf16x8 pack_p(const f32x16& p, int base) {
    u32x4 w; w.x = cvtpk(p[base + 0], p[base + 1]); w.y = cvtpk(p[base + 2], p[base + 3]); w.z = cvtpk(p[base + 4], p[base + 5]); w.w = cvtpk(p[base + 6], p[base + 7]); return __builtin_bit_cast(bf16x8, w); }

struct KVRegs { u32x4 k, v; };
template <bool LOADV> __device__ __forceinline__ void kv_load(KVRegs& R, const bf16_t* K, const bf16_t* V, int ldk, int kt, int tid) {
    const int rowl = tid >> 3, ch = tid & 7; const size_t off = (size_t)(64 * kt + rowl) * ldk + ch * 8;
    R.k = *(const u32x4*)(K + off); if (LOADV) R.v = *(const u32x4*)(V + off);
}
template <bool LOADV> __device__ __forceinline__ void kv_write(const KVRegs& R, LAS unsigned char* buf, int tid) {
    const int rowl = tid >> 3, ch = tid & 7;
    *(LAS u32x4*)(buf + rowl * 128 + ((ch ^ ((rowl >> 1) & 7)) << 4)) = R.k; if (LOADV) *(LAS u32x4*)(buf + 8192 + rowl * 128 + ((ch ^ (((rowl >> 1) & 1) << 2)) << 4)) = R.v;
}
__device__ __forceinline__ void qk_tile(f32x16& s0, f32x16& s1, const LAS unsigned char* buf, const bf16x8 (&qf)[4], int r32, int hi, float init) {
    const f32x16 z = {init, init, init, init, init, init, init, init, init, init, init, init, init, init, init, init}; s0 = z; s1 = z;
#pragma unroll
    for (int d0 = 0; d0 < 4; ++d0) { const int c = 2 * d0 + hi; const int sw = (c ^ ((r32 >> 1) & 7)) << 4;
        const bf16x8 k0 = *(const LAS bf16x8*)(buf + r32 * 128 + sw); const bf16x8 k1 = *(const LAS bf16x8*)(buf + (32 + r32) * 128 + sw);
        s0 = __builtin_amdgcn_mfma_f32_32x32x16_bf16(k0, qf[d0], s0, 0, 0, 0); s1 = __builtin_amdgcn_mfma_f32_32x32x16_bf16(k1, qf[d0], s1, 0, 0, 0); }
}
__device__ __forceinline__ void pv_tile(f32x16 (&o)[2], const LAS unsigned char* vbuf, const f32x16& p0, const f32x16& p1, int lane) {
    const int hi = lane >> 5, qb = (lane >> 3) & 1; const LAS unsigned char* vb = vbuf + (4 * hi + ((lane & 15) >> 2)) * 128 + (16 * ((lane >> 4) & 1) + 4 * (lane & 3)) * 2;
#pragma unroll
    for (int ks = 0; ks < 4; ++ks) { const bf16x8 pb = pack_p(ks < 2 ? p0 : p1, 8 * (ks & 1));
#pragma unroll
        for (int dt = 0; dt < 2; ++dt) { const s16x4 lo = vtr(vb + (16 * ks) * 128 + (dt ^ qb) * 64), hi4 = vtr(vb + (16 * ks + 8) * 128 + (dt ^ qb) * 64);
            const bf16x8 va = {lo[0], lo[1], lo[2], lo[3], hi4[0], hi4[1], hi4[2], hi4[3]};
            o[dt] = __builtin_amdgcn_mfma_f32_32x32x16_bf16(va, pb, o[dt], 0, 0, 0); } }
}
template <int MODE> __device__ __forceinline__ bool key_valid(int kt, int kh, int r, int hi, int tpos, int aux) {
    const int kp = 64 * kt + 32 * kh + crow(r, hi);
    if (MODE == M_WIN) return kp <= tpos && kp > tpos - 512;
    if (MODE == M_CMP) return kp <= aux;
    return aux != 0 && kp <= tpos;
}

__device__ __forceinline__ void k_frags(bf16x8 (&kf)[8], const LAS unsigned char* buf, int r32, int hi) {
#pragma unroll
    for (int d0 = 0; d0 < 4; ++d0) { const int sw = ((2 * d0 + hi) ^ ((r32 >> 1) & 7)) << 4; kf[2 * d0] = *(const LAS bf16x8*)(buf + r32 * 128 + sw); kf[2 * d0 + 1] = *(const LAS bf16x8*)(buf + (32 + r32) * 128 + sw); }
}
__device__ __forceinline__ void qk_mfma(f32x16& s0, f32x16& s1, const bf16x8 (&kf)[8], const bf16x8 (&qf)[4], float init) {
    const f32x16 z = {init, init, init, init, init, init, init, init, init, init, init, init, init, init, init, init}; s0 = z; s1 = z;
#pragma unroll
    for (int d0 = 0; d0 < 4; ++d0) { s0 = __builtin_amdgcn_mfma_f32_32x32x16_bf16(kf[2 * d0], qf[d0], s0, 0, 0, 0); s1 = __builtin_amdgcn_mfma_f32_32x32x16_bf16(kf[2 * d0 + 1], qf[d0], s1, 0, 0, 0); }
}
__device__ __forceinline__ void qk_mfma_c(f32x16& s0, f32x16& s1, const bf16x8 (&kf)[8], const bf16x8 (&qf)[4], const f32x16& c) {
    s0 = __builtin_amdgcn_mfma_f32_32x32x16_bf16(kf[0], qf[0], c, 0, 0, 0); s1 = __builtin_amdgcn_mfma_f32_32x32x16_bf16(kf[1], qf[0], c, 0, 0, 0);
#pragma unroll
    for (int d0 = 1; d0 < 4; ++d0) { s0 = __builtin_amdgcn_mfma_f32_32x32x16_bf16(kf[2 * d0], qf[d0], s0, 0, 0, 0); s1 = __builtin_amdgcn_mfma_f32_32x32x16_bf16(kf[2 * d0 + 1], qf[d0], s1, 0, 0, 0); }
}
__device__ __forceinline__ void qk_mfma_z(f32x16& s0, f32x16& s1, const bf16x8 (&kf)[8], const bf16x8 (&qf)[4]) {
    const f32x16 z = {0.f, 0.f, 0.f, 0.f, 0.f, 0.f, 0.f, 0.f, 0.f, 0.f, 0.f, 0.f, 0.f, 0.f, 0.f, 0.f};
    s0 = __builtin_amdgcn_mfma_f32_32x32x16_bf16(kf[0], qf[0], z, 0, 0, 0); s1 = __builtin_amdgcn_mfma_f32_32x32x16_bf16(kf[1], qf[0], z, 0, 0, 0);
#pragma unroll
    for (int d0 = 1; d0 < 4; ++d0) { s0 = __builtin_amdgcn_mfma_f32_32x32x16_bf16(kf[2 * d0], qf[d0], s0, 0, 0, 0); s1 = __builtin_amdgcn_mfma_f32_32x32x16_bf16(kf[2 * d0 + 1], qf[d0], s1, 0, 0, 0); }
}
template <bool B> struct BTag { static constexpr bool value = B; };
__device__ __forceinline__ void v_frags(bf16x8 (&vf)[8], const LAS unsigned char* vbuf, int lane) {
    const int hi = lane >> 5, qb = (lane >> 3) & 1; const LAS unsigned char* vb = vbuf + (4 * hi + ((lane & 15) >> 2)) * 128 + (16 * ((lane >> 4) & 1) + 4 * (lane & 3)) * 2;
#pragma unroll
    for (int ks = 0; ks < 4; ++ks)
#pragma unroll
        for (int dt = 0; dt < 2; ++dt) { const s16x4 lo = vtr(vb + (16 * ks) * 128 + (dt ^ qb) * 64), hi4 = vtr(vb + (16 * ks + 8) * 128 + (dt ^ qb) * 64);
            vf[2 * ks + dt] = (bf16x8){lo[0], lo[1], lo[2], lo[3], hi4[0], hi4[1], hi4[2], hi4[3]}; }
}
template <bool USEM> __device__ __forceinline__ void pv_mfma(f32x16 (&o)[2], const bf16x8 (&vf)[8], const f32x16& p0, const f32x16& p1, unsigned msk) {
#pragma unroll
    for (int ks = 0; ks < 4; ++ks) { bf16x8 pb = pack_p(ks < 2 ? p0 : p1, 8 * (ks & 1));
        if (USEM) { u32x4 w = __builtin_bit_cast(u32x4, pb); w.x &= msk; w.y &= msk; w.z &= msk; w.w &= msk; pb = __builtin_bit_cast(bf16x8, w); }
        o[0] = __builtin_amdgcn_mfma_f32_32x32x16_bf16(vf[2 * ks], pb, o[0], 0, 0, 0); o[1] = __builtin_amdgcn_mfma_f32_32x32x16_bf16(vf[2 * ks + 1], pb, o[1], 0, 0, 0); }
}
template <int MODE> __device__ __forceinline__ void mask_tile(f32x16& s0, f32x16& s1, int kt, int qt, int tp0, int th, int hi, int tpos) {
    bool full;
    if (MODE == M_WIN) full = (64 * kt + 63 <= tp0 + 32 * th) && (64 * kt > tp0 + 32 * th + 31 - 512); else full = kt < qt;
    if (!full) {
#pragma unroll
        for (int r = 0; r < 16; ++r) { if (!key_valid<MODE>(kt, 0, r, hi, tpos, 1)) s0[r] = -INFINITY; if (!key_valid<MODE>(kt, 1, r, hi, tpos, 1)) s1[r] = -INFINITY; } }
}
__device__ __forceinline__ float exp_tile(f32x16& s0, f32x16& s1) {
    float sa = 0.f, sb = 0.f;
#pragma unroll
    for (int r = 0; r < 16; ++r) { s0[r] = __builtin_amdgcn_exp2f(s0[r]); s1[r] = __builtin_amdgcn_exp2f(s1[r]); sa += s0[r]; asm("" : "+v"(sa)); sb += s1[r]; asm("" : "+v"(sb)); }
    return sa + sb;
}

template <int MODE, bool NOSHIFT = false> __device__ __forceinline__ void attn_unit(LAS unsigned char* lds, unsigned char* ws, int b, int g, int qt, int tid_, float negM, size_t out_off) {
    int tid = tid_; asm volatile("" : "+v"(tid));
    const int lane = tid & 63, wave = __builtin_amdgcn_readfirstlane(tid >> 6), r32 = lane & 31, hi = lane >> 5, hg = wave & 3, th = wave >> 2;
    const int tokl = MODE == M_CMP ? 8 * wave + (r32 >> 2) : 32 * th + r32; const int head = 4 * g + (MODE == M_CMP ? (r32 & 3) : hg);
    const int tp0 = 64 * qt, tpos = tp0 + tokl; const size_t trow = (size_t)b * SEQ + tpos;
    const bf16_t *K, *V; int ldk, kt0, kt1;
    if (MODE == M_WIN) { K = (const bf16_t*)(ws + WS_KW) + (size_t)b * SEQ * 128 + g * 64; V = (const bf16_t*)(ws + WS_VW) + (size_t)b * SEQ * 128 + g * 64; ldk = 128; kt0 = qt - 8 > 0 ? qt - 8 : 0; kt1 = qt; }
    else if (MODE == M_SLC) { K = (const bf16_t*)(ws + WS_KS) + (size_t)b * SEQ * 128 + g * 64; V = (const bf16_t*)(ws + WS_VS) + (size_t)b * SEQ * 128 + g * 64; ldk = 128; kt0 = 0; kt1 = qt; }
    else { K = (const bf16_t*)(ws + WS_CMPB) + (size_t)((b * 2 + g) * 512) * 64; V = (const bf16_t*)(ws + WS_CMPB) + (size_t)((8 + b * 2 + g) * 512) * 64; ldk = 64; kt0 = 0; kt1 = (4 * qt + 2) >> 6; }
    bf16x8 qf[4];
    { const bf16_t* qp = (const bf16_t*)(ws + WS_NQ) + trow * 512 + head * 64 + 8 * hi;
#pragma unroll
      for (int d0 = 0; d0 < 4; ++d0) qf[d0] = *(const bf16x8*)(qp + 16 * d0); }
    unsigned selw[4] = {0u, 0u, 0u, 0u};
    if (MODE == M_SLC) { const u32x4 sv = *(const u32x4*)((const unsigned*)(ws + WS_SEL) + (trow * 2 + g) * 4); selw[0] = sv.x; selw[1] = sv.y; selw[2] = sv.z; selw[3] = sv.w; }
    const int cmaxl = tpos >= 31 ? (tpos - 31) >> 4 : -1;
    const int tfirst = tp0 + 8 * wave; const int cmin = tfirst >= 31 ? (tfirst - 31) >> 4 : -1;
    LAS unsigned char* kvb = lds + LDS_KV;
    float m = -INFINITY, l = 0.f; f32x16 o[2]; { const f32x16 z = {0.f, 0.f, 0.f, 0.f, 0.f, 0.f, 0.f, 0.f, 0.f, 0.f, 0.f, 0.f, 0.f, 0.f, 0.f, 0.f}; o[0] = z; o[1] = z; }
    KVRegs R;
    bf16_t* op = (bf16_t*)(ws + out_off) + trow * 1024 + 512 + head * 64 + 4 * hi;
    u32x2 old[2][4];
    auto load_old = [&]() __attribute__((always_inline)) {
#pragma unroll
        for (int dt = 0; dt < 2; ++dt)
#pragma unroll
            for (int rr = 0; rr < 4; ++rr) old[dt][rr] = *(const u32x2*)(op + 32 * dt + 8 * rr); };
    if (MODE == M_CMP) {
        kv_load<false>(R, K, V, ldk, kt0, tid);
        for (int kt = kt0; kt <= kt1; ++kt) { LAS unsigned char* buf = kvb + ((kt - kt0) & 1) * 16384;
            kv_write<false>(R, buf, tid); if (kt < kt1) kv_load<false>(R, K, V, ldk, kt + 1, tid); else kv_load<true>(R, K, V, ldk, kt0, tid);
            lds_barrier();
            f32x16 s0, s1; qk_tile(s0, s1, buf, qf, r32, hi, 0.f);
            float mx = -INFINITY;
            const bool fullc = (64 * kt + 63) <= cmin;
            if (!fullc) {
#pragma unroll
                for (int r = 0; r < 16; ++r) { if (!key_valid<MODE>(kt, 0, r, hi, tpos, cmaxl)) s0[r] = -INFINITY; if (!key_valid<MODE>(kt, 1, r, hi, tpos, cmaxl)) s1[r] = -INFINITY; } }
#pragma unroll
            for (int r = 0; r < 16; ++r) mx = fmaxf(mx, fmaxf(s0[r], s1[r]));
            mx = fmaxf(mx, __shfl_xor(mx, 32));
            const float mn = fmaxf(m, mx);
            if (mn > -INFINITY) { float sum = 0.f;
#pragma unroll
                for (int r = 0; r < 16; ++r) sum += __builtin_amdgcn_exp2f(s0[r] - mn) + __builtin_amdgcn_exp2f(s1[r] - mn);
                l = l * __builtin_amdgcn_exp2f(m - mn) + sum; m = mn; }
        }
        lds_barrier();
        l += __shfl_xor(l, 32); const float il = l > 0.f ? 1.0f / l : 0.f; const float negm = l > 0.f ? -m : -INFINITY;
        LAS float* impt = (LAS float*)(lds + LDS_IMP) + tokl * IMPS;
        load_old();
        float carry = 0.f;
        for (int kt = kt0; kt <= kt1; ++kt) { LAS unsigned char* buf = kvb + ((kt - kt0) & 1) * 16384;
            kv_write<true>(R, buf, tid); if (kt < kt1) kv_load<true>(R, K, V, ldk, kt + 1, tid);
            lds_barrier();
            f32x16 s0, s1; qk_tile(s0, s1, buf, qf, r32, hi, negm);
            const bool fullc = (64 * kt + 63) <= cmin;
            if (!fullc) {
#pragma unroll
                for (int r = 0; r < 16; ++r) { if (!key_valid<MODE>(kt, 0, r, hi, tpos, cmaxl)) s0[r] = -INFINITY; if (!key_valid<MODE>(kt, 1, r, hi, tpos, cmaxl)) s1[r] = -INFINITY; } }
#pragma unroll
            for (int r = 0; r < 16; ++r) { s0[r] = __builtin_amdgcn_exp2f(s0[r]); s1[r] = __builtin_amdgcn_exp2f(s1[r]); }
            float px[2][4];
#pragma unroll
            for (int rr = 0; rr < 4; ++rr) { px[0][rr] = __shfl_xor(s0[4 * rr + 3], 32); px[1][rr] = __shfl_xor(s1[4 * rr + 3], 32); }
#pragma unroll
            for (int kh = 0; kh < 2; ++kh)
#pragma unroll
                for (int rr = 0; rr < 4; ++rr) { const f32x16& p = kh ? s1 : s0; const int j = 16 * kt + 8 * kh + 2 * rr + hi;
                    const float inc = hi ? px[kh][rr] : (rr >= 1 ? px[kh][rr - 1] : (kh ? px[0][3] : carry));
                    float bin = (((p[4 * rr] + p[4 * rr + 1]) + (p[4 * rr + 2] + p[4 * rr + 3])) + inc) * il;
                    bin += __builtin_bit_cast(float, __builtin_amdgcn_mov_dpp(__builtin_bit_cast(int, bin), 0xB1, 0xf, 0xf, true));
                    bin += __builtin_bit_cast(float, __builtin_amdgcn_mov_dpp(__builtin_bit_cast(int, bin), 0x4E, 0xf, 0xf, true));
                    if ((r32 & 3) == 0 && j < 128) impt[j] = bin; }
            carry = px[1][3];
            pv_tile(o, buf + 8192, s0, s1, lane);
        }
        lds_barrier();
    } else {
        KVRegs R1;
        kv_load<true>(R, K, V, ldk, kt0, tid); if (kt0 + 1 <= kt1) kv_load<true>(R1, K, V, ldk, kt0 + 1, tid);
        kv_write<true>(R, kvb, tid); if (kt0 + 1 <= kt1) kv_write<true>(R1, kvb + 16384, tid);
        if (kt0 + 2 <= kt1) kv_load<true>(R, K, V, ldk, kt0 + 2, tid); if (kt0 + 3 <= kt1) kv_load<true>(R1, K, V, ldk, kt0 + 3, tid);
        lds_barrier();
        auto step = [&](auto mtag, int kt) __attribute__((always_inline)) {
            constexpr bool MASKED = decltype(mtag)::value; constexpr bool SEL = MODE == M_SLC;
            LAS unsigned char* bufA = kvb + (((kt - kt0) >> 1) & 1) * 32768; LAS unsigned char* bufB = bufA + 16384; const bool two = kt + 1 <= kt1;
            { LAS unsigned char* nA = kvb + ((((kt - kt0) >> 1) + 1) & 1) * 32768;
              if (kt + 2 <= kt1) kv_write<true>(R, nA, tid); if (kt + 3 <= kt1) kv_write<true>(R1, nA + 16384, tid);
              if (kt + 4 <= kt1) kv_load<true>(R, K, V, ldk, kt + 4, tid); if (kt + 5 <= kt1) kv_load<true>(R1, K, V, ldk, kt + 5, tid); }
            unsigned mA = ~0u, mB = ~0u;
            if (SEL) { const unsigned w = kt < 32 ? selw[0] : kt < 64 ? selw[1] : kt < 96 ? selw[2] : selw[3]; mA = 0u - ((w >> (kt & 31)) & 1u);
                const int k2 = kt + 1; const unsigned w2 = k2 < 32 ? selw[0] : k2 < 64 ? selw[1] : k2 < 96 ? selw[2] : selw[3]; mB = 0u - ((w2 >> (k2 & 31)) & 1u); }
            f32x16 a0, a1, b0, b1; bf16x8 fa[8], fb[8];
            if (two) {
                k_frags(fa, bufA, r32, hi); k_frags(fb, bufB, r32, hi); __builtin_amdgcn_sched_barrier(0);
                if (NOSHIFT) qk_mfma_z(a0, a1, fa, qf); else qk_mfma(a0, a1, fa, qf, negM);
                if (MASKED) mask_tile<MODE>(a0, a1, kt, qt, tp0, th, hi, tpos);
                if (NOSHIFT) qk_mfma_z(b0, b1, fb, qf); else qk_mfma(b0, b1, fb, qf, negM); { const float sa = exp_tile(a0, a1); l += SEL ? __uint_as_float(__float_as_uint(sa) & mA) : sa; }
                v_frags(fa, bufA + 8192, lane); __builtin_amdgcn_sched_barrier(0);
                if (MASKED) mask_tile<MODE>(b0, b1, kt + 1, qt, tp0, th, hi, tpos);
                pv_mfma<SEL>(o, fa, a0, a1, mA); { const float sb = exp_tile(b0, b1); l += SEL ? __uint_as_float(__float_as_uint(sb) & mB) : sb; }
                v_frags(fb, bufB + 8192, lane); __builtin_amdgcn_sched_barrier(0);
                pv_mfma<SEL>(o, fb, b0, b1, mB);
            } else {
                k_frags(fa, bufA, r32, hi); if (NOSHIFT) qk_mfma_z(a0, a1, fa, qf); else qk_mfma(a0, a1, fa, qf, negM); v_frags(fa, bufA + 8192, lane);
                if (MASKED) mask_tile<MODE>(a0, a1, kt, qt, tp0, th, hi, tpos);
                { const float sa = exp_tile(a0, a1); l += SEL ? __uint_as_float(__float_as_uint(sa) & mA) : sa; }
                pv_mfma<SEL>(o, fa, a0, a1, mA);
            }
            lds_barrier();
        };
        int kt = kt0;
        if (MODE == M_WIN) { step(BTag<true>{}, kt); kt += 2; }
        for (; kt + 1 < kt1; kt += 2) step(BTag<false>{}, kt);
        if (MODE == M_SLC) load_old();
        if (kt <= kt1) step(BTag<true>{}, kt);
        l += __shfl_xor(l, 32);
    }
    { const float* sg = (const float*)(ws + WS_SMALLG); const int br = MODE == M_CMP ? 0 : MODE == M_SLC ? 1 : 2;
      const float gt = sigm(sg[trow * 32 + 8 + head * 3 + br]) * (l > 0.f ? 1.0f / l : 0.f);
#pragma unroll
      for (int dt = 0; dt < 2; ++dt)
#pragma unroll
          for (int rr = 0; rr < 4; ++rr) { float v0 = o[dt][4 * rr] * gt, v1 = o[dt][4 * rr + 1] * gt, v2 = o[dt][4 * rr + 2] * gt, v3 = o[dt][4 * rr + 3] * gt;
              if (MODE != M_WIN) { v0 += pg8::bflo(old[dt][rr].x); v1 += pg8::bfhi(old[dt][rr].x); v2 += pg8::bflo(old[dt][rr].y); v3 += pg8::bfhi(old[dt][rr].y); }
              u32x2 nw; nw.x = cvtpk(v0, v1); nw.y = cvtpk(v2, v3); *(u32x2*)(op + 32 * dt + 8 * rr) = nw; } }
    if (MODE == M_CMP) {
        const int cur = qt, tk = tid >> 3, part = tid & 7; const LAS float* row = (const LAS float*)(lds + LDS_IMP) + tk * IMPS + 16 * part;
        unsigned key[16];
#pragma unroll
        for (int k = 0; k < 16; ++k) { const int j = 16 * part + k; float v = row[k]; if (j == 0 || j == cur || j == cur - 1) v = 1e4f; if (j > cur) v = -1e30f;
            const unsigned u = __float_as_uint(v); key[k] = (u & 0x80000000u) ? ~u : (u | 0x80000000u); }
        unsigned sel16;
        if (cur < 16) { sel16 = part == 0 ? ((2u << cur) - 1u) : 0u; }
        else {
            auto sum8 = [](int v) { v += __builtin_amdgcn_mov_dpp(v, 0xB1, 0xf, 0xf, true); v += __builtin_amdgcn_mov_dpp(v, 0x4E, 0xf, 0xf, true); v += __builtin_amdgcn_mov_dpp(v, 0x141, 0xf, 0xf, true); return v; };
            unsigned T = 0u;
            bool done = false;
            for (int bit = 31; bit >= 0; --bit) { const unsigned cand = T | (1u << bit); int cnt = 0;
#pragma unroll
                for (int k = 0; k < 16; ++k) cnt += key[k] >= cand ? 1 : 0;
                const int tot = sum8(cnt); if (!done && tot >= 16) T = cand; done = done || tot == 16;
                if (__builtin_amdgcn_ballot_w64(!done) == 0ull) break; }
            int ngt = 0, neq = 0;
#pragma unroll
            for (int k = 0; k < 16; ++k) { ngt += key[k] > T ? 1 : 0; neq += key[k] == T ? 1 : 0; }
            const int need = 16 - sum8(ngt);
            int pre = neq;
            { int t1 = __builtin_amdgcn_update_dpp(0, pre, 0x111, 0xf, 0xf, true); if (part >= 1) pre += t1; int t2 = __builtin_amdgcn_update_dpp(0, pre, 0x112, 0xf, 0xf, true); if (part >= 2) pre += t2; int t4 = __builtin_amdgcn_update_dpp(0, pre, 0x114, 0xf, 0xf, true); if (part >= 4) pre += t4; }
            int rank = pre - neq; sel16 = 0u;
#pragma unroll
            for (int k = 0; k < 16; ++k) { const bool eq = key[k] == T; if (key[k] > T || (eq && rank < need)) sel16 |= 1u << k; rank += eq ? 1 : 0; }
        }
        *((unsigned short*)((unsigned*)(ws + WS_SEL) + (((size_t)b * SEQ + tp0 + tk) * 2 + g) * 4) + part) = (unsigned short)sel16;
        __syncthreads();
    }
}
__device__ __forceinline__ void slc_unit64(LAS unsigned char* lds, unsigned char* ws, int b, int g, int qt, int tid_) {
    int tid = tid_; asm volatile("" : "+v"(tid));
    const int lane = tid & 63, wave = __builtin_amdgcn_readfirstlane(tid >> 6), r32 = lane & 31, hi = lane >> 5, hg = wave & 3, tb = wave >> 2;
    const int head = 4 * g + hg, tposA = 128 * qt + 64 * tb + r32, tposB = tposA + 32; const size_t trowA = (size_t)b * SEQ + tposA, trowB = trowA + 32;
    const bf16_t* K = (const bf16_t*)(ws + WS_KS) + (size_t)b * SEQ * 128 + g * 64; const bf16_t* V = (const bf16_t*)(ws + WS_VS) + (size_t)b * SEQ * 128 + g * 64;
    const int kt1 = 2 * qt + 1, ktw = 2 * qt + tb;
    bf16x8 qfA[4], qfB[4];
    { const bf16_t* qp = (const bf16_t*)(ws + WS_NQ) + trowA * 512 + head * 64 + 8 * hi;
#pragma unroll
      for (int d0 = 0; d0 < 4; ++d0) { qfA[d0] = *(const bf16x8*)(qp + 16 * d0); qfB[d0] = *(const bf16x8*)(qp + 32 * 512 + 16 * d0); } }
    LAS unsigned* sl = (LAS unsigned*)(lds + 49152) + tid * 8;
    { const unsigned* sp = (const unsigned*)(ws + WS_SEL) + (trowA * 2 + g) * 4; const u32x4 sa = *(const u32x4*)sp, sb = *(const u32x4*)(sp + 32 * 8); *(LAS u32x4*)sl = sa; *(LAS u32x4*)(sl + 4) = sb; }
    LAS unsigned char* kvb = lds + LDS_KV;
    float lA = 0.f, lB = 0.f; f32x16 oA[2], oB[2]; { const f32x16 z = {0.f, 0.f, 0.f, 0.f, 0.f, 0.f, 0.f, 0.f, 0.f, 0.f, 0.f, 0.f, 0.f, 0.f, 0.f, 0.f}; oA[0] = z; oA[1] = z; oB[0] = z; oB[1] = z; }
    KVRegs R;
    kv_load<true>(R, K, V, 128, 0, tid); kv_write<true>(R, kvb, tid); kv_load<true>(R, K, V, 128, 1, tid);
    __syncthreads();
    if (tb == 1) __builtin_amdgcn_s_barrier();
    auto tile = [&](auto mtag, int kt, int st) __attribute__((always_inline)) {
        constexpr bool MASKED = decltype(mtag)::value;
        LAS unsigned char* buf = kvb + st * 16384; const bool act = kt <= ktw;
        if (kt + 1 <= kt1) kv_write<true>(R, kvb + (st == 2 ? 0 : st + 1) * 16384, tid);
        if (kt + 2 <= kt1) kv_load<true>(R, K, V, 128, kt + 2, tid);
        f32x16 a0, a1, b0, b1; bf16x8 fk[8]; unsigned wA = 0u, wB = 0u;
        if (act) {
            wA = sl[kt >> 5]; wB = sl[4 + (kt >> 5)];
            k_frags(fk, buf, r32, hi);
            qk_mfma_z(a0, a1, fk, qfA); qk_mfma_z(b0, b1, fk, qfB);
            if (MASKED && kt == ktw) {
#pragma unroll
                for (int r = 0; r < 16; ++r) { const int kp0 = 64 * kt + crow(r, hi), kp1 = kp0 + 32;
                    if (kp0 > tposA) a0[r] = -INFINITY; if (kp1 > tposA) a1[r] = -INFINITY; if (kp0 > tposB) b0[r] = -INFINITY; if (kp1 > tposB) b1[r] = -INFINITY; } }
        }
        asm volatile("s_waitcnt lgkmcnt(0)" ::: "memory"); __builtin_amdgcn_s_barrier(); asm volatile("" ::: "memory");
        if (act) {
            const unsigned mA = 0u - ((wA >> (kt & 31)) & 1u), mB = 0u - ((wB >> (kt & 31)) & 1u);
            { const float sa = exp_tile(a0, a1); lA += __uint_as_float(__float_as_uint(sa) & mA); }
            v_frags(fk, buf + 8192, lane); __builtin_amdgcn_sched_barrier(0);
            { const float sb = exp_tile(b0, b1); lB += __uint_as_float(__float_as_uint(sb) & mB); }
            pv_mfma<true>(oA, fk, a0, a1, mA); pv_mfma<true>(oB, fk, b0, b1, mB);
        }
        asm volatile("s_waitcnt lgkmcnt(0)" ::: "memory"); __builtin_amdgcn_s_barrier(); asm volatile("" ::: "memory");
    };
    int kt = 0, st = 0;
    for (; kt < 2 * qt; ++kt) { tile(BTag<false>{}, kt, st); st = st == 2 ? 0 : st + 1; }
    tile(BTag<true>{}, kt, st); st = st == 2 ? 0 : st + 1; tile(BTag<true>{}, kt + 1, st);
    if (tb == 0) __builtin_amdgcn_s_barrier();
    lA += __shfl_xor(lA, 32); lB += __shfl_xor(lB, 32);
    const float* sg = (const float*)(ws + WS_SMALLG);
    int tid2 = tid_; asm volatile("" : "+v"(tid2)); const int hi2 = (tid2 & 63) >> 5; const size_t trowA2 = (size_t)b * SEQ + 128 * qt + 64 * ((tid2 >> 6) >> 2) + (tid2 & 31); const int head2 = 4 * g + ((tid2 >> 6) & 3);
#pragma unroll
    for (int st = 0; st < 2; ++st) { const size_t trow = st ? trowA2 + 32 : trowA2; const float l = st ? lB : lA; const f32x16 (&o)[2] = st ? oB : oA;
        const float gt = sigm(sg[trow * 32 + 8 + head2 * 3 + 1]) * (l > 0.f ? 1.0f / l : 0.f);
        bf16_t* op = (bf16_t*)(ws + WS_HMON) + trow * 1024 + 512 + head2 * 64 + 4 * hi2;
        u32x2 old[2][4];
#pragma unroll
        for (int dt = 0; dt < 2; ++dt)
#pragma unroll
            for (int rr = 0; rr < 4; ++rr) old[dt][rr] = *(const u32x2*)(op + 32 * dt + 8 * rr);
#pragma unroll
        for (int dt = 0; dt < 2; ++dt)
#pragma unroll
            for (int rr = 0; rr < 4; ++rr) { const float v0 = o[dt][4 * rr] * gt + pg8::bflo(old[dt][rr].x), v1 = o[dt][4 * rr + 1] * gt + pg8::bfhi(old[dt][rr].x), v2 = o[dt][4 * rr + 2] * gt + pg8::bflo(old[dt][rr].y), v3 = o[dt][4 * rr + 3] * gt + pg8::bfhi(old[dt][rr].y);
                u32x2 nw; nw.x = cvtpk(v0, v1); nw.y = cvtpk(v2, v3); *(u32x2*)(op + 32 * dt + 8 * rr) = nw; } }
}
template <int MODE> __device__ __forceinline__ void attn_phase(LAS unsigned char* lds, const Args& a, int G, int cu, size_t out_off = WS_HMON) {
    int tid = threadIdx.x; asm volatile("" : "+v"(tid)); unsigned char* ws = a.ws;
    float negM = 0.f;
    if (MODE != M_CMP) {
        const float* qw = a.in[8]; const float* kw = MODE == M_SLC ? a.in[10] : a.in[11]; float mq = fabsf(qw[tid & 63]), mk = fabsf(kw[tid & 63]);
#pragma unroll
        for (int o = 1; o < 64; o <<= 1) { mq = fmaxf(mq, __shfl_xor(mq, o)); mk = fmaxf(mk, __shfl_xor(mk, o)); }
        negM = -fminf(11.5416f * mq * mk * 1.02f, 100.f); negM = __uint_as_float(__builtin_amdgcn_readfirstlane(__float_as_uint(negM))); }
    for (int u = cu; u < 256; u += G) { const int bg = u & 7, i = u >> 3;
        if (MODE == M_SLC && negM >= NOSHIFT_THR) { slc_unit64(lds, ws, bg >> 1, bg & 1, i, tid); slc_unit64(lds, ws, bg >> 1, bg & 1, 63 - i, tid); continue; }
        for (int k = 0; k < 4; ++k) { const int qt = k == 0 ? 2 * i : k == 1 ? 2 * i + 1 : k == 2 ? 126 - 2 * i : 127 - 2 * i;
            if (MODE != M_CMP && negM >= NOSHIFT_THR) attn_unit<MODE, MODE != M_CMP>(lds, ws, bg >> 1, bg & 1, qt, tid, negM, out_off);
            else attn_unit<MODE>(lds, ws, bg >> 1, bg & 1, qt, tid, negM, out_off); } }
}
}
namespace ml {
typedef short bf16x8 __attribute__((ext_vector_type(8)));
typedef short s16x4 __attribute__((ext_vector_type(4)));
typedef float f32x16 __attribute__((ext_vector_type(16)));
constexpr size_t WS_GC = WS_MLS, WS_AM = WS_MLS + 8192, WS_MP = WS_MLS + 16384, WS_DN = WS_IPRE, WS_NP = WS_LOGF;
__device__ __forceinline__ float fexp(float x) { return __builtin_amdgcn_exp2f(x * 1.4426950408889634f); }
__device__ __forceinline__ float logsig(float x) { return x >= 0.f ? -log1pf(expf(-x)) : x - log1pf(expf(x)); }
__device__ __forceinline__ float scan_add(float v, int lane) {
#pragma unroll
    for (int o = 1; o < 64; o <<= 1) { const float t = __shfl_up(v, o); if (lane >= o) v += t; }
    return v;
}
__device__ __forceinline__ float scan_max(float v, int lane) {
#pragma unroll
    for (int o = 1; o < 64; o <<= 1) { const float t = __shfl_up(v, o); if (lane >= o) v = fmaxf(v, t); }
    return v;
}
__device__ __forceinline__ float wave_max(float v) {
#pragma unroll
    for (int o = 1; o < 64; o <<= 1) v = fmaxf(v, __shfl_xor(v, o));
    return v;
}
__device__ __forceinline__ float conv_silu(const bf16_t* qkpre, const float* cw, const float* cb, size_t trow, int tp, int ch) {
    float s = cb[ch];
#pragma unroll
    for (int k = 0; k < 4; ++k) { const int d = 3 - k; if (tp >= d) s += cw[k * 512 + ch] * bf2f(qkpre[(trow - d) * 512 + ch]); }
    return s * sigm(s);
}
__device__ __forceinline__ s16x4 vtr(const LAS unsigned char* p) { typedef short v4i16_t __attribute__((ext_vector_type(4))); return __builtin_bit_cast(s16x4, __builtin_amdgcn_ds_read_tr16_b64_v4i16((LAS v4i16_t*)p)); }
__device__ __forceinline__ bf16x8 cat8(const s16x4& a, const s16x4& b) { return (bf16x8){a[0], a[1], a[2], a[3], b[0], b[1], b[2], b[3]}; }

template <int NPART> __device__ __forceinline__ void stage_pre(LAS unsigned short* pre, const bf16_t* qkpre, size_t t0, int tp0, int h, int part0, int tid) {
    for (int i = tid; i < NPART * 67 * 8; i += 512) { const int ch8 = i & 7, r = (i >> 3) % 67, p = (i >> 3) / 67; const int tp = tp0 - 3 + r;
        u32x4 v = {0u, 0u, 0u, 0u}; if (tp >= 0) v = *(const u32x4*)(qkpre + (t0 - 3 + r) * 512 + (part0 + p) * 256 + h * 64 + ch8 * 8);
        *(LAS u32x4*)(pre + (p * 67 + r) * 64 + ch8 * 8) = v; }
}
__device__ __forceinline__ float conv_lds(const LAS unsigned short* pre, int p, int l, int d, const float (&cw4)[4], float cb1) {
    float s = cb1;
#pragma unroll
    for (int k = 0; k < 4; ++k) s += cw4[k] * bf2f(pre[(p * 67 + l + k) * 64 + d]);
    return s * sigm(s);
}
__device__ __forceinline__ int off256(int row, int colbyte) { return row * 256 + ((((colbyte >> 6) ^ row) & 3) << 6) + (colbyte & 63); }
__device__ __forceinline__ int off128t(int row, int colbyte) { return row * 128 + (colbyte ^ (((row >> 1) & 1) << 6)); }
__device__ __forceinline__ int off128r(int row, int chunk) { return row * 128 + ((chunk ^ ((row >> 1) & 7)) << 4); }
__device__ __forceinline__ void stage256(LAS unsigned char* dst, const bf16_t* src, size_t ld, int tid) {
    for (int i = tid; i < 64 * 16; i += 512) { const int r = i >> 4, c16 = i & 15; *(LAS u32x4*)(dst + off256(r, c16 * 16)) = *(const u32x4*)(src + (size_t)r * ld + c16 * 8); }
}

__device__ __forceinline__ void a_stage(LAS unsigned char* lds, const Args& a, int U, int tid, int lane, int wave) {
    unsigned char* ws = a.ws; const bf16_t* qkpre = (const bf16_t*)(ws + WS_QKPRE); const bf16_t* mv = (const bf16_t*)(ws + WS_MV); const float* sg = (const float*)(ws + WS_SMALLG);
    LAS float* wl = (LAS float*)(lds + 24576); LAS unsigned short* pre = (LAS unsigned short*)(lds + 25600);
    const int c = U & 127, h = (U >> 7) & 3, b = U >> 9; const int tp0 = 64 * c; const size_t t0 = (size_t)b * SEQ + tp0;
    if (wave == 0) { const size_t t = t0 + lane; const float ip = sg[t * 32 + h] + a.in[5][h]; const float lf = logsig(sg[t * 32 + 4 + h] + a.in[6][h]);
        const float bc = scan_add(lf, lane); const float g = __shfl(bc, 63); const float av = g - bc + ip; const float am = wave_max(av); wl[lane] = fexp(av - am);
        if (lane == 0) { ((float*)(ws + WS_GC))[U] = g; ((float*)(ws + WS_AM))[U] = am; } }
    stage256(lds, mv + t0 * 512 + h * 128, 512, tid); stage_pre<1>(pre, qkpre, t0, tp0, h, 1, tid);
}
__device__ __forceinline__ void a_conv(LAS unsigned char* lds, const Args& a, int U, int tid) {
    asm volatile("" : "+v"(tid));
    const int h = (U >> 7) & 3; const int d2 = tid & 31, l0 = tid >> 5, ch = 256 + h * 64 + 2 * d2;
    float cw[4][2];
#pragma unroll
    for (int k = 0; k < 4; ++k) { cw[k][0] = a.in[3][k * 512 + ch]; cw[k][1] = a.in[3][k * 512 + ch + 1]; }
    const float cb0 = a.in[4][ch], cb1 = a.in[4][ch + 1];
    const LAS float* wl = (const LAS float*)(lds + 24576) + l0; const LAS unsigned* pre = (const LAS unsigned*)(lds + 25600) + l0 * 32 + d2;
    LAS unsigned char* w0 = lds + 16384 + off128t(l0, 4 * d2);
#pragma unroll
    for (int i = 0; i < 4; ++i) { float s0 = cb0, s1 = cb1;
#pragma unroll
        for (int k = 0; k < 4; ++k) { const unsigned w = pre[(16 * i + k) * 32]; s0 += cw[k][0] * pg8::bflo(w); s1 += cw[k][1] * pg8::bfhi(w); }
        const float wv = wl[16 * i]; *(LAS unsigned*)(w0 + i * 2048) = pg8::cvt_pk_bf16(wv * s0 * sigm(s0), wv * s1 * sigm(s1)); }
}
__device__ __forceinline__ void a_compute(LAS unsigned char* lds, const Args& a, int U, int tid, int lane, int wave) {
    unsigned char* ws = a.ws; LAS unsigned char* Vs = lds; LAS unsigned char* KW = lds + 16384; const int r32 = lane & 31, hi = lane >> 5;
    const int dtile = wave & 1, et = wave >> 1; const int li = lane & 15, cb16 = 16 * ((lane >> 4) & 1);
    f32x16 acc = {0.f, 0.f, 0.f, 0.f, 0.f, 0.f, 0.f, 0.f, 0.f, 0.f, 0.f, 0.f, 0.f, 0.f, 0.f, 0.f};
#pragma unroll
    for (int kk = 0; kk < 4; ++kk) { const int rb = 16 * kk + 8 * hi + (li >> 2);
        const int ca = (32 * dtile + cb16 + 4 * (li & 3)) * 2, cv = (32 * et + cb16 + 4 * (li & 3)) * 2;
        const bf16x8 af = cat8(vtr(KW + off128t(rb, ca)), vtr(KW + off128t(rb + 4, ca)));
        const bf16x8 bf = cat8(vtr(Vs + off256(rb, cv)), vtr(Vs + off256(rb + 4, cv)));
        acc = __builtin_amdgcn_mfma_f32_32x32x16_bf16(af, bf, acc, 0, 0, 0); }
    bf16_t* dc = (bf16_t*)(ws + WS_DC) + (size_t)U * 8192 + 32 * et + r32;
#pragma unroll
    for (int r = 0; r < 16; ++r) dc[(32 * dtile + (r & 3) + 8 * (r >> 2) + 4 * hi) * 128] = (bf16_t)f2bf(acc[r]);
    if (tid < 64) { float s = 0.f; for (int l = 0; l < 64; ++l) s += bf2f(*(const LAS unsigned short*)(KW + off128t(l, tid * 2))); ((float*)(ws + WS_DN))[(size_t)U * 64 + tid] = s; }
}
__device__ __forceinline__ void phase_a(LAS unsigned char* lds, const Args& a, int G, int cu) {
    int tid = threadIdx.x; asm volatile("" : "+v"(tid)); const int lane = tid & 63, wave = __builtin_amdgcn_readfirstlane(tid >> 6);
    LAS unsigned char* l0 = lds; LAS unsigned char* l1 = lds + 36864;
    for (int U = cu; U < 2048; U += 2 * G) { const int U1 = U + G; const bool two = U1 < 2048;
        a_stage(l0, a, U, tid, lane, wave); if (two) a_stage(l1, a, U1, tid, lane, wave);
        __syncthreads();
        a_conv(l0, a, U, tid); if (two) a_conv(l1, a, U1, tid);
        __syncthreads();
        a_compute(l0, a, U, tid, lane, wave); if (two) a_compute(l1, a, U1, tid, lane, wave);
        __syncthreads();
    }
}
__device__ __forceinline__ void phase_b(const Args& a, int gtid, int nthr) {
    unsigned char* ws = a.ws; const float* __restrict__ gc = (const float*)(ws + WS_GC); const float* __restrict__ am = (const float*)(ws + WS_AM); float* __restrict__ mp = (float*)(ws + WS_MP);
    const bf16_t* __restrict__ dc = (const bf16_t*)(ws + WS_DC); bf16_t* __restrict__ cp = (bf16_t*)(ws + WS_CPREV); const float* __restrict__ dn = (const float*)(ws + WS_DN); float* __restrict__ np = (float*)(ws + WS_NP);
    for (int i = gtid; i < 16 * 4096; i += nthr) { const int bh = i >> 12, de = (i & 4095) * 2; float C0 = 0.f, C1 = 0.f, m = 0.f;
        for (int c0 = 0; c0 < 128; c0 += 8) { unsigned xr[8]; float g[8], ax[8];
#pragma unroll
            for (int j = 0; j < 8; ++j) { const int U = bh * 128 + c0 + j; xr[j] = __builtin_nontemporal_load((const unsigned*)(dc + (size_t)U * 8192 + de)); g[j] = gc[U]; ax[j] = am[U]; }
#pragma unroll
            for (int j = 0; j < 8; ++j) { const int U = bh * 128 + c0 + j;
                __builtin_nontemporal_store(pg8::cvt_pk_bf16(C0, C1), (unsigned*)(cp + (size_t)U * 8192 + de));
                const float mn = fmaxf(g[j] + m, ax[j]); const float dec = fexp(g[j] + m - mn), sc = fexp(ax[j] - mn); C0 = C0 * dec + pg8::bflo(xr[j]) * sc; C1 = C1 * dec + pg8::bfhi(xr[j]) * sc; m = mn; } } }
    for (int i = nthr - 1 - gtid; i < 16 * 64; i += nthr) { const int bh = i >> 6, d = i & 63; float nn = 0.f, m = 0.f;
        for (int c0 = 0; c0 < 128; c0 += 16) { float g[16], ax[16], x[16];
#pragma unroll
            for (int j = 0; j < 16; ++j) { const int U = bh * 128 + c0 + j; g[j] = gc[U]; ax[j] = am[U]; x[j] = dn[(size_t)U * 64 + d]; }
#pragma unroll
            for (int j = 0; j < 16; ++j) { const int U = bh * 128 + c0 + j; np[(size_t)U * 64 + d] = nn; if (d == 0) mp[U] = m;
                const float mn = fmaxf(g[j] + m, ax[j]); const float dec = fexp(g[j] + m - mn), sc = fexp(ax[j] - mn); nn = dec * nn + sc * x[j]; m = mn; } } }
}
struct CRegs { u32x4 pre[3], v[2], c[2]; };
__device__ __forceinline__ void c_load(CRegs& R, const Args& a, int U, int tid) {
    unsigned char* ws = a.ws; const bf16_t* qkpre = (const bf16_t*)(ws + WS_QKPRE); const bf16_t* mv = (const bf16_t*)(ws + WS_MV);
    const int c = U & 127, h = (U >> 7) & 3, b = U >> 9; const int tp0 = 64 * c; const size_t t0 = (size_t)b * SEQ + tp0;
#pragma unroll
    for (int k = 0; k < 3; ++k) { const int i = tid + 512 * k; R.pre[k] = (u32x4){0u, 0u, 0u, 0u};
        if (i < 2 * 67 * 8) { const int ch8 = i & 7, r = (i >> 3) % 67, p = (i >> 3) / 67; if (tp0 - 3 + r >= 0) R.pre[k] = __builtin_nontemporal_load((const u32x4*)(qkpre + (t0 - 3 + r) * 512 + p * 256 + h * 64 + ch8 * 8)); } }
#pragma unroll
    for (int k = 0; k < 2; ++k) { const int i = tid + 512 * k, r = i >> 4, c16 = i & 15; R.v[k] = __builtin_nontemporal_load((const u32x4*)(mv + (t0 + r) * 512 + h * 128 + c16 * 8)); R.c[k] = __builtin_nontemporal_load((const u32x4*)((const bf16_t*)(ws + WS_CPREV) + (size_t)U * 8192 + r * 128 + c16 * 8)); }
}
__device__ __forceinline__ void c_store(const CRegs& R, LAS unsigned char* lds, int tid) {
    LAS unsigned short* pre = (LAS unsigned short*)(lds + 49152);
#pragma unroll
    for (int k = 0; k < 3; ++k) { const int i = tid + 512 * k; if (i < 2 * 67 * 8) { const int ch8 = i & 7, r = (i >> 3) % 67, p = (i >> 3) / 67; *(LAS u32x4*)(pre + (p * 67 + r) * 64 + ch8 * 8) = R.pre[k]; } }
#pragma unroll
    for (int k = 0; k < 2; ++k) { const int i = tid + 512 * k, r = i >> 4, c16 = i & 15; *(LAS u32x4*)(lds + off256(r, c16 * 16)) = R.v[k]; *(LAS u32x4*)(lds + 16384 + off256(r, c16 * 16)) = R.c[k]; }
}
__device__ __forceinline__ void c_gates(LAS unsigned char* lds, const Args& a, int U, int lane) {
    unsigned char* ws = a.ws; const float* sg = (const float*)(ws + WS_SMALLG); LAS float* sm = (LAS float*)(lds + 67584);
    const int c = U & 127, h = (U >> 7) & 3, b = U >> 9; const size_t tg = (size_t)b * SEQ + 64 * c + lane;
    const float ip = sg[tg * 32 + h] + a.in[5][h]; const float lf = logsig(sg[tg * 32 + 4 + h] + a.in[6][h]);
    const float bc = scan_add(lf, lane); const float u = ip - bc; const float pm = scan_max(u, lane); const float mprev = ((const float*)(ws + WS_MP))[U];
    const float mt = bc + fmaxf(mprev, pm); sm[lane] = bc; sm[64 + lane] = u * 1.4426950408889634f  ; sm[128 + lane] = mt; sm[192 + lane] = fexp(bc + mprev - mt); sm[256 + lane] = ((const float*)(ws + WS_NP))[(size_t)U * 64 + lane];
}
__device__ __forceinline__ void c_conv(LAS unsigned char* lds, const Args& a, int U, int tid) {
    asm volatile("" : "+v"(tid));
    const int h = (U >> 7) & 3;
    const int d2 = tid & 31, part = (tid >> 5) & 1, l0 = tid >> 6;
    const int ch = part * 256 + h * 64 + 2 * d2; float cw[4][2];
#pragma unroll
    for (int k = 0; k < 4; ++k) { cw[k][0] = a.in[3][k * 512 + ch]; cw[k][1] = a.in[3][k * 512 + ch + 1]; }
    const float cb0 = a.in[4][ch], cb1 = a.in[4][ch + 1], sc = part ? 1.0f : 0.125f;
    const LAS unsigned* pre = (const LAS unsigned*)(lds + 49152) + (part * 67 + l0) * 32 + d2;
    const int c0 = (d2 >> 2) ^ (l0 >> 1);
    LAS unsigned char* w0 = lds + 32768 + part * 8192 + l0 * 128 + (d2 & 3) * 4 + (c0 << 4); LAS unsigned char* w1 = lds + 32768 + part * 8192 + l0 * 128 + (d2 & 3) * 4 + ((c0 ^ 4) << 4);
#pragma unroll
    for (int i = 0; i < 8; ++i) { float s0 = cb0, s1 = cb1;
#pragma unroll
        for (int k = 0; k < 4; ++k) { const unsigned w = pre[(8 * i + k) * 32]; s0 += cw[k][0] * pg8::bflo(w); s1 += cw[k][1] * pg8::bfhi(w); }
        *(LAS unsigned*)((i & 1 ? w1 : w0) + i * 1024) = pg8::cvt_pk_bf16(sc * s0 * sigm(s0), sc * s1 * sigm(s1)); }
}
template <bool B> struct BTag { static constexpr bool value = B; };
__device__ __forceinline__ void c_compute(f32x16& o, LAS unsigned char* lds, int lane, int wave) {
    asm volatile("" : "+v"(lane));
    LAS unsigned char* Vs = lds; LAS unsigned char* Cs = lds + 16384; LAS unsigned char* Qs = lds + 32768; LAS unsigned char* Ks = lds + 40960; LAS float* sm = (LAS float*)(lds + 67584);
    const int r32 = lane & 31, hi = lane >> 5, tt = wave & 1, et = wave >> 1, t = 32 * tt + r32;
    bf16x8 qf[4];
#pragma unroll
    for (int kk = 0; kk < 4; ++kk) qf[kk] = *(const LAS bf16x8*)(Qs + off128r(t, 2 * kk + hi));
    const float bt = (sm[t] - sm[128 + t]) * 1.4426950408889634f, isc = sm[192 + t], mt = sm[128 + t];
    float dq = 0.f;
#pragma unroll
    for (int kk = 0; kk < 4; ++kk) { const u32x4 w = __builtin_bit_cast(u32x4, qf[kk]); f32x4 x0, x1; pg8::unpack8(w, x0, x1); const LAS float* npp = sm + 256 + 16 * kk + 8 * hi;
        dq += x0[0] * npp[0] + x0[1] * npp[1] + x0[2] * npp[2] + x0[3] * npp[3] + x1[0] * npp[4] + x1[1] * npp[5] + x1[2] * npp[6] + x1[3] * npp[7]; }
    o = (f32x16){0.f, 0.f, 0.f, 0.f, 0.f, 0.f, 0.f, 0.f, 0.f, 0.f, 0.f, 0.f, 0.f, 0.f, 0.f, 0.f};
    const int li = lane & 15, cv = (32 * et + 16 * ((lane >> 4) & 1) + 4 * (li & 3)) * 2;
#pragma unroll
    for (int kk = 0; kk < 4; ++kk) { const int rb = 16 * kk + 8 * hi + (li >> 2); const bf16x8 cf = cat8(vtr(Cs + off256(rb, cv)), vtr(Cs + off256(rb + 4, cv)));
        o = __builtin_amdgcn_mfma_f32_32x32x16_bf16(cf, qf[kk], o, 0, 0, 0); }
#pragma unroll
    for (int r = 0; r < 16; ++r) o[r] *= isc;
    float psum = 0.f;
#pragma unroll
    for (int sh = 0; sh < 2; ++sh) { if (sh > tt) continue;
        f32x16 s = {0.f, 0.f, 0.f, 0.f, 0.f, 0.f, 0.f, 0.f, 0.f, 0.f, 0.f, 0.f, 0.f, 0.f, 0.f, 0.f};
#pragma unroll
        for (int kk = 0; kk < 4; ++kk) { const bf16x8 kf = *(const LAS bf16x8*)(Ks + off128r(32 * sh + r32, 2 * kk + hi)); s = __builtin_amdgcn_mfma_f32_32x32x16_bf16(kf, qf[kk], s, 0, 0, 0); }
        f32x4 u4[4];
#pragma unroll
        for (int rr = 0; rr < 4; ++rr) u4[rr] = *(const LAS f32x4*)(sm + 64 + 32 * sh + 8 * rr + 4 * hi);
        if (sh == tt) {
#pragma unroll
            for (int r = 0; r < 16; ++r) { float p = s[r] * __builtin_amdgcn_exp2f(u4[r >> 2][r & 3] + bt); if (8 * (r >> 2) + 4 * hi + (r & 3) > r32) p = 0.f; s[r] = p; psum += p; }
        } else {
#pragma unroll
            for (int r = 0; r < 16; ++r) { const float p = s[r] * __builtin_amdgcn_exp2f(u4[r >> 2][r & 3] + bt); s[r] = p; psum += p; }
        }
#pragma unroll
        for (int ks = 0; ks < 2; ++ks) { const int rb = 32 * sh + 16 * ks + 4 * hi + (li >> 2); const bf16x8 vf = cat8(vtr(Vs + off256(rb, cv)), vtr(Vs + off256(rb + 8, cv)));
            u32x4 w; w.x = pg8::cvt_pk_bf16(s[8 * ks + 0], s[8 * ks + 1]); w.y = pg8::cvt_pk_bf16(s[8 * ks + 2], s[8 * ks + 3]); w.z = pg8::cvt_pk_bf16(s[8 * ks + 4], s[8 * ks + 5]); w.w = pg8::cvt_pk_bf16(s[8 * ks + 6], s[8 * ks + 7]);
            o = __builtin_amdgcn_mfma_f32_32x32x16_bf16(vf, __builtin_bit_cast(bf16x8, w), o, 0, 0, 0); } }
    psum += __shfl_xor(psum, 32); dq += __shfl_xor(dq, 32);
    const float den = isc * dq + psum; const float dv = 1.0f / fmaxf(fabsf(den), fexp(-mt));
    float ss = 0.f;
#pragma unroll
    for (int r = 0; r < 16; ++r) { o[r] *= dv; ss += o[r] * o[r]; }
    ss += __shfl_xor(ss, 32);
    if (hi == 0) sm[320 + et * 64 + t] = ss;
}
__device__ __forceinline__ void c_epilogue(const f32x16& o, LAS unsigned char* lds, const Args& a, int U, int lane, int wave) {
    unsigned char* ws = a.ws; const bf16_t* mo = (const bf16_t*)(ws + WS_MO); LAS float* sm = (LAS float*)(lds + 67584);
    const int r32 = lane & 31, hi = lane >> 5, tt = wave & 1, et = wave >> 1, t = 32 * tt + r32; const int c = U & 127, h = (U >> 7) & 3, b = U >> 9; const size_t t0 = (size_t)b * SEQ + 64 * c;
    const float tot = (sm[320 + t] + sm[384 + t]) + (sm[448 + t] + sm[512 + t]); const float rs = 1.0f / sqrtf(tot * (1.0f / 128.f) + NEPS); const size_t tr = t0 + t;
    const float* onw = a.in[7] + h * 128 + 32 * et + 4 * hi; const bf16_t* mop = mo + tr * 512 + h * 128 + 32 * et + 4 * hi; bf16_t* op = (bf16_t*)(ws + WS_HMON) + tr * 1024 + h * 128 + 32 * et + 4 * hi;
#pragma unroll
    for (int rr = 0; rr < 4; ++rr) { const f32x4 w4 = *(const f32x4*)(onw + 8 * rr); const pg8::u32x2 m2 = __builtin_nontemporal_load((const pg8::u32x2*)(mop + 8 * rr));
        const float o0 = o[4 * rr] * rs * w4[0] * sigm(pg8::bflo(m2.x)), o1 = o[4 * rr + 1] * rs * w4[1] * sigm(pg8::bfhi(m2.x)), o2 = o[4 * rr + 2] * rs * w4[2] * sigm(pg8::bflo(m2.y)), o3 = o[4 * rr + 3] * rs * w4[3] * sigm(pg8::bfhi(m2.y));
        pg8::u32x2 ov; ov.x = pg8::cvt_pk_bf16(o0, o1); ov.y = pg8::cvt_pk_bf16(o2, o3); *(pg8::u32x2*)(op + 8 * rr) = ov; }
}
__device__ __forceinline__ void phase_c(LAS unsigned char* lds, const Args& a, int G, int cu) {
    int tid = threadIdx.x; asm volatile("" : "+v"(tid)); const int lane = tid & 63, wave = __builtin_amdgcn_readfirstlane(tid >> 6);
    LAS unsigned char* l0 = lds; LAS unsigned char* l1 = lds + 71680;
    for (int U = cu; U < 2048; U += 2 * G) { const int U1 = U + G; const bool two = U1 < 2048;
        { CRegs r0, r1; c_load(r0, a, U, tid); if (two) c_load(r1, a, U1, tid);
          if (wave == 0) { c_gates(l0, a, U, lane); if (two) c_gates(l1, a, U1, lane); }
          c_store(r0, l0, tid); if (two) c_store(r1, l1, tid); }
        __syncthreads();
        c_conv(l0, a, U, tid); if (two) c_conv(l1, a, U1, tid);
        __syncthreads();
        f32x16 o0, o1;
        c_compute(o0, l0, lane, wave); if (two) c_compute(o1, l1, lane, wave);
        __syncthreads();
        c_epilogue(o0, l0, a, U, lane, wave); if (two) c_epilogue(o1, l1, a, U1, lane, wave);
        __syncthreads();
    }
}
}
__device__ __forceinline__ void cmpout_phase(const Args& a, int G, int cu, int tid_) {
    typedef short bf16x8_t __attribute__((ext_vector_type(8)));
    int tid = tid_; asm volatile("" : "+v"(tid));
    unsigned char* ws = a.ws; const bf16_t* hid = (const bf16_t*)(ws + WS_CMPH); bf16_t* cmpb = (bf16_t*)(ws + WS_CMPB);
    const int lane = tid & 63, wave = tid >> 6, rh = wave & 1, ct = wave >> 1, li = lane & 15, kg = lane >> 4;
    for (int rb = cu; rb < 256; rb += G) { const int r0 = 32 * rb + 16 * rh, kv = r0 >> 12; const float* w2 = (kv ? a.in[17] : a.in[14]) + 16 * ct + li;
        const bf16_t* hp = hid + (size_t)(r0 + li) * 256 + 8 * kg;
        f32x4 acc = {0.f, 0.f, 0.f, 0.f};
#pragma unroll
        for (int kk = 0; kk < 8; ++kk) { const u32x4 av = *(const u32x4*)(hp + 32 * kk); const float* w = w2 + (size_t)(32 * kk + 8 * kg) * 64;
            u32x4 bv; bv.x = pg8::cvt_pk_bf16(w[0], w[64]); bv.y = pg8::cvt_pk_bf16(w[128], w[192]); bv.z = pg8::cvt_pk_bf16(w[256], w[320]); bv.w = pg8::cvt_pk_bf16(w[384], w[448]);
            acc = __builtin_amdgcn_mfma_f32_16x16x32_bf16(__builtin_bit_cast(bf16x8_t, av), __builtin_bit_cast(bf16x8_t, bv), acc, 0, 0, 0); }
#pragma unroll
        for (int r = 0; r < 4; ++r) { const int row = r0 + 4 * kg + r; cmpb[(size_t)row * 64 + 16 * ct + li] = (bf16_t)f2bf((row & 511) < NCMP ? acc[r] : 0.f); } }
}
#ifndef PG8_SP2
#define PG8_SP2 true
#endif
#define WSP(T, off) ((T*)(ws + (off)))
__device__ __forceinline__ Ctx make_ctx(unsigned char* lds_raw) {
    Ctx C; C.lds = (LAS unsigned char*)lds_raw; { int t_ = threadIdx.x; asm volatile("" : "+v"(t_)); C.tid = t_; } C.lane = C.tid & 63; C.wave = __builtin_amdgcn_readfirstlane(C.tid >> 6); C.G = gridDim.x;
    C.vcu = blockIdx.x; C.gw = blockIdx.x * 8 + C.wave; C.ngw = C.G * 8; C.gtid = blockIdx.x * 512 + C.tid; C.nthr = C.G * 512; return C; }
__device__ __forceinline__ void run_ph0(unsigned char* lds_raw, const Args& args) { const Ctx C = make_ctx(lds_raw); unsigned char* ws = args.ws;
    phase_prologue(C, args);
#if defined(REPEAT_P0)
    __syncthreads(); phase_prologue(C, args);
#endif
}
__device__ __forceinline__ void run_ph1(unsigned char* lds_raw, const Args& args) { const Ctx C = make_ctx(lds_raw); unsigned char* ws = args.ws;
    { pg8::Gemm g{WSP(bf16_t, WS_XB), WSP(bf16_t, WS_WIN), TT, 3072, 1024, 1024, 128}; pg8::StaticOrder S; S.init(TT, 3072, C.G, (int)blockIdx.x);
      pg8::EpiInProj E{ws, args.in[8], args.in[9], args.in[10], args.in[11]};
      pg8::gemm_phase<pg8::EpiInProj, pg8::StaticOrder, true, PG8_SP2>(C.lds, g, S, E);
#if defined(REPEAT_G17)
      pg8::gemm_phase<pg8::EpiInProj, pg8::StaticOrder, true, PG8_SP2>(C.lds, g, S, E);
#endif
    }
}
__device__ __forceinline__ void run_ph2(unsigned char* lds_raw, const Args& args) { const Ctx C = make_ctx(lds_raw); unsigned char* ws = args.ws;
    { pg8::Gemm g{nullptr, nullptr, 8192, 256, 2048, 2048, 256}; pg8::CmpOrder S{C.G, (int)blockIdx.x, WSP(bf16_t, WS_KC), WSP(bf16_t, WS_VC), WSP(bf16_t, WS_CW1)};
      pg8::EpiCmpHid E{WSP(float, WS_CBIAS), WSP(bf16_t, WS_CMPH)};
      pg8::gemm_phase<pg8::EpiCmpHid, pg8::CmpOrder, true, PG8_SP2>(C.lds, g, S, E);
#if defined(REPEAT_CH)
      pg8::gemm_phase<pg8::EpiCmpHid, pg8::CmpOrder, true, PG8_SP2>(C.lds, g, S, E);
#endif
    }
    if (C.G >= 64) { if ((int)blockIdx.x >= 32) { ml::phase_a(C.lds, args, C.G - 32, (int)blockIdx.x - 32); Ctx C2 = C; C2.gw = C.gw - 32 * 8; C2.ngw = C.ngw - 32 * 8; __syncthreads(); phase_transposes<1>(C2, args); } }
    else { ml::phase_a(C.lds, args, C.G, (int)blockIdx.x); __syncthreads(); phase_transposes<1>(C, args); }
#if defined(REPEAT_ML) || defined(REPEAT_MLA)
    __syncthreads(); if ((int)blockIdx.x >= 32) ml::phase_a(C.lds, args, C.G - 32, (int)blockIdx.x - 32);
#endif
}
__device__ __forceinline__ void run_ph3(unsigned char* lds_raw, const Args& args) { const Ctx C = make_ctx(lds_raw); unsigned char* ws = args.ws;
    cmpout_phase(args, C.G, (int)blockIdx.x, C.tid);
#if defined(REPEAT_CO)
    for (int rep = 0; rep < REPEAT_CO; ++rep) { __syncthreads(); cmpout_phase(args, C.G, (int)blockIdx.x, C.tid); }
#endif
    ml::phase_b(args, C.gtid, C.nthr);
#if defined(REPEAT_ML) || defined(REPEAT_MLB)
    ml::phase_b(args, C.gtid, C.nthr);
#endif
}
__device__ __forceinline__ void run_ph4(unsigned char* lds_raw, const Args& args) { const Ctx C = make_ctx(lds_raw); unsigned char* ws = args.ws;
#if !defined(ONLY_MLC)
    att::attn_phase<att::M_WIN>(C.lds, args, C.G, (int)blockIdx.x);
    __syncthreads();
    att::attn_phase<att::M_CMP>(C.lds, args, C.G, (int)blockIdx.x);
#endif
#if defined(REPEAT_WC) || defined(REPEAT_CMP)
    __syncthreads(); att::attn_phase<att::M_CMP>(C.lds, args, C.G, (int)blockIdx.x, WS_Y);
#endif
    ml::phase_c(C.lds, args, C.G, (int)blockIdx.x);
#if defined(REPEAT_ML) || defined(REPEAT_MLC)
    __syncthreads(); ml::phase_c(C.lds, args, C.G, (int)blockIdx.x);
#endif
}
__device__ __forceinline__ void run_ph5(unsigned char* lds_raw, const Args& args) { const Ctx C = make_ctx(lds_raw); unsigned char* ws = args.ws;
    __syncthreads();
    att::attn_phase<att::M_SLC>(C.lds, args, C.G, (int)blockIdx.x);
#if defined(REPEAT_SLC)
    for (int rep = 0; rep < REPEAT_SLC; ++rep) { __syncthreads(); att::attn_phase<att::M_SLC>(C.lds, args, C.G, (int)blockIdx.x, WS_DC); }
#endif
}
__device__ __forceinline__ void run_ph6(unsigned char* lds_raw, const Args& args) { const Ctx C = make_ctx(lds_raw); unsigned char* ws = args.ws;
    __syncthreads();
    { pg8::Gemm g{WSP(bf16_t, WS_XB), WSP(bf16_t, WS_WG), TT, 2048, 1024, 1024, 128}; pg8::StaticOrder S; S.init(TT, 2048, C.G, (int)blockIdx.x);
      pg8::EpiGate E{WSP(float, WS_RSTD1), args.in[20], (bf16_t*)args.out, (bf16_t*)args.out + (size_t)TT * 1024};
      pg8::gemm_phase<pg8::EpiGate, pg8::StaticOrder, true, PG8_SP2>(C.lds, g, S, E);
#if defined(REPEAT_G4) || defined(REPEAT_P5A)
      pg8::gemm_phase<pg8::EpiGate, pg8::StaticOrder, true, PG8_SP2>(C.lds, g, S, E);
#endif
    }
}
__device__ __forceinline__ void run_ph7(unsigned char* lds_raw, const Args& args) { const Ctx C = make_ctx(lds_raw); unsigned char* ws = args.ws;
    { pg8::Gemm g{WSP(bf16_t, WS_HMON), WSP(bf16_t, WS_WMN), TT, 1024, 1024, 1024, 128}; pg8::StaticOrder S; S.init(TT, 1024, C.G, (int)blockIdx.x);
      pg8::EpiMerge E{(const bf16_t*)args.out, (const bf16_t*)args.out + (size_t)TT * 1024, WSP(bf16_t, WS_Y)};
      pg8::gemm_phase<pg8::EpiMerge, pg8::StaticOrder, true, PG8_SP2>(C.lds, g, S, E);
#if defined(REPEAT_G4) || defined(REPEAT_P5B)
      pg8::gemm_phase<pg8::EpiMerge, pg8::StaticOrder, true, PG8_SP2>(C.lds, g, S, E);
#endif
    }
}
__device__ __forceinline__ void run_ph8(unsigned char* lds_raw, const Args& args) { const Ctx C = make_ctx(lds_raw); unsigned char* ws = args.ws;
    { pg8::Gemm g{WSP(bf16_t, WS_Y), WSP(bf16_t, WS_WOUT), TT, 1024, 1024, 1024, 128}; pg8::StaticOrder S; S.init(TT, 1024, C.G, (int)blockIdx.x);
      pg8::EpiWout E{args.in[0], args.out, WSP(bf16_t, WS_XB), WSP(float, WS_SSQ2)};
      pg8::gemm_phase<pg8::EpiWout, pg8::StaticOrder, true, PG8_SP2>(C.lds, g, S, E);
#if defined(REPEAT_G4) || defined(REPEAT_P6)
      pg8::gemm_phase<pg8::EpiWout, pg8::StaticOrder, true, PG8_SP2>(C.lds, g, S, E);
#endif
    }
}
__device__ __forceinline__ void run_ph9(unsigned char* lds_raw, const Args& args) { const Ctx C = make_ctx(lds_raw); unsigned char* ws = args.ws;
    { pg8::Gemm g{WSP(bf16_t, WS_XB), WSP(bf16_t, WS_WUP), TT, 5632, 1024, 1024, 128}; pg8::StaticOrder S; S.init(TT, 5632, C.G, (int)blockIdx.x);
      pg8::EpiFfnUp E{WSP(float, WS_SSQ2), args.in[24], args.in[25], WSP(bf16_t, WS_MID), WSP(float, WS_EDGEA), WSP(float, WS_EDGEV), (LAS float*)(C.lds + LDS_EX)};
      pg8::gemm_phase<pg8::EpiFfnUp, pg8::StaticOrder, true, PG8_SP2>(C.lds, g, S, E);
#if defined(REPEAT_G17)
      pg8::gemm_phase<pg8::EpiFfnUp, pg8::StaticOrder, true, PG8_SP2>(C.lds, g, S, E);
#endif
    }
}
__device__ __forceinline__ void run_ph11(unsigned char* lds_raw, const Args& args) { const Ctx C = make_ctx(lds_raw); unsigned char* ws = args.ws;
    { pg8::Gemm g{WSP(bf16_t, WS_MID), WSP(bf16_t, WS_WDN), TT, 1024, 2816, 2816, 128}; pg8::StaticOrder S; S.init(TT, 1024, C.G, (int)blockIdx.x);
      { pg8::Unit u0, u1; if (S.next(0, u0)) { if (S.next(1, u1) && !S.next(2, u1) && S.next(1, u1)) p7b_fixup_two(C, args, u0.pm, u1.pm); else { pg8::Unit u; int pl = -1; for (int i = 0; S.next(i, u); ++i) if (u.pm != pl) { p7b_fixup_panel(C, args, u.pm); pl = u.pm; } } } }
      __syncthreads();
#if defined(REPEAT_G4) || defined(REPEAT_P8)
      { pg8::EpiFfnDown E0{WSP(bf16_t, WS_XB), WSP(float, WS_HMON)}; pg8::gemm_phase<pg8::EpiFfnDown, pg8::StaticOrder, true, PG8_SP2>(C.lds, g, S, E0); }
#endif
      pg8::EpiFfnDown E{WSP(bf16_t, WS_XB), args.out};
      pg8::gemm_phase<pg8::EpiFfnDown, pg8::StaticOrder, true, PG8_SP2>(C.lds, g, S, E); }
}
__device__ __forceinline__ void run_rstd2(const Args& args) {
    const float* ssq = (const float*)(args.ws + WS_SSQ2); float* r2 = (float*)(args.ws + WS_RSTD1);
    for (int t = blockIdx.x * 512 + threadIdx.x; t < TT; t += gridDim.x * 512) { const f32x4* sp = (const f32x4*)(ssq + (size_t)t * 16); const f32x4 s0 = sp[0], s1 = sp[1], s2 = sp[2], s3 = sp[3];
        const float ss = ((s0[0] + s0[1]) + (s0[2] + s0[3])) + ((s1[0] + s1[1]) + (s1[2] + s1[3])) + ((s2[0] + s2[1]) + (s2[2] + s2[3])) + ((s3[0] + s3[1]) + (s3[2] + s3[3]));
        r2[t] = 1.0f / sqrtf(ss * (1.0f / 1024.0f) + NEPS); }
}
constexpr int NPHASE = 12;
#ifndef SPLIT_TEST
__global__ void __launch_bounds__(512, 2) mega_fwd(Args args) {
    extern __shared__ __attribute__((aligned(16))) unsigned char lds_raw[];
#if defined(USE_CG_SYNC)
    cg::grid_group grid = cg::this_grid();
#endif
    volatile LAS unsigned* xst = (volatile LAS unsigned*)((LAS unsigned char*)lds_raw + LDS_XB);
    if (threadIdx.x < 2) xst[threadIdx.x] = 0u;
    __syncthreads();
    (void)xcd_barrier_post((unsigned*)(args.ws + WS_CTL) + 4096, xst);
#define GRID_BAR() do { XcdBarrier b_; b_.bar = (unsigned*)(args.ws + WS_CTL) + 4096; b_.x = xb_xcc_id(); b_.st = (volatile LAS unsigned*)((LAS unsigned char*)lds_raw + LDS_XB); xcd_barrier(b_); } while (0)
#if defined(PROBE_TS)
#define TS(i) do { if (blockIdx.x == 0 && threadIdx.x == 0) ((unsigned long long*)(args.ws + WS_CTL))[64 + (i)] = __builtin_amdgcn_s_memrealtime(); } while (0)
#else
#define TS(i) do {} while (0)
#endif
    TS(0);
    run_ph0(lds_raw, args);
#if defined(USE_CG_SYNC)
    grid.sync();
#else
    GRID_BAR();
#endif
    TS(1);
    run_ph1(lds_raw, args);
    GRID_BAR();
    TS(2);
    run_ph2(lds_raw, args);
    GRID_BAR();
    TS(3);
    run_ph3(lds_raw, args);
    GRID_BAR();
    TS(4);
    run_ph4(lds_raw, args);
    TS(5);
    run_ph5(lds_raw, args);
#if defined(EXTRA_BARS)
    for (int eb = 0; eb < EXTRA_BARS; ++eb) GRID_BAR();
#endif
    TS(6);
    run_ph6(lds_raw, args);
    GRID_BAR();
    TS(7);
    run_ph7(lds_raw, args);
    GRID_BAR();
    TS(8);
    run_ph8(lds_raw, args);
    GRID_BAR();
    TS(9);
    run_ph9(lds_raw, args);
    GRID_BAR();
    TS(10);
    TS(11);
    run_ph11(lds_raw, args);
    TS(12);
#if defined(PROBE_TS)
    GRID_BAR();
    { const unsigned long long* ts = (const unsigned long long*)(args.ws + WS_CTL) + 64; const float f = (float)(ts[PROBE_TS] - ts[0]) / (float)(ts[12] - ts[0]); const float sc = 1.0f + sqrtf(f);
      for (int i = blockIdx.x * 512 + threadIdx.x; i < TT * DM; i += gridDim.x * 512) args.out[i] *= sc; }
#endif
}
#else
__global__ void __launch_bounds__(512, 2) ph0_k(Args args) { extern __shared__ __attribute__((aligned(16))) unsigned char lds_raw[]; run_ph0(lds_raw, args); }
__global__ void __launch_bounds__(512, 2) ph1_k(Args args) { extern __shared__ __attribute__((aligned(16))) unsigned char lds_raw[]; run_ph1(lds_raw, args); }
__global__ void __launch_bounds__(512, 2) ph2_k(Args args) { extern __shared__ __attribute__((aligned(16))) unsigned char lds_raw[]; run_ph2(lds_raw, args); }
__global__ void __launch_bounds__(512, 2) ph3_k(Args args) { extern __shared__ __attribute__((aligned(16))) unsigned char lds_raw[]; run_ph3(lds_raw, args); }
__global__ void __launch_bounds__(512, 2) ph4_k(Args args) { extern __shared__ __attribute__((aligned(16))) unsigned char lds_raw[]; run_ph4(lds_raw, args); }
__global__ void __launch_bounds__(512, 2) ph5_k(Args args) { extern __shared__ __attribute__((aligned(16))) unsigned char lds_raw[]; run_ph5(lds_raw, args); }
__global__ void __launch_bounds__(512, 2) ph6_k(Args args) { extern __shared__ __attribute__((aligned(16))) unsigned char lds_raw[]; run_ph6(lds_raw, args); }
__global__ void __launch_bounds__(512, 2) ph7_k(Args args) { extern __shared__ __attribute__((aligned(16))) unsigned char lds_raw[]; run_ph7(lds_raw, args); }
__global__ void __launch_bounds__(512, 2) ph8_k(Args args) { extern __shared__ __attribute__((aligned(16))) unsigned char lds_raw[]; run_ph8(lds_raw, args); }
__global__ void __launch_bounds__(512, 2) ph9_k(Args args) { extern __shared__ __attribute__((aligned(16))) unsigned char lds_raw[]; run_ph9(lds_raw, args); }
__global__ void __launch_bounds__(512, 2) ph11_k(Args args) { extern __shared__ __attribute__((aligned(16))) unsigned char lds_raw[]; run_ph11(lds_raw, args); }
__global__ void __launch_bounds__(512, 2) rstd2_k(Args args) { run_rstd2(args); }
__global__ void __launch_bounds__(512, 2) mega_fwd(Args args) {}
#endif
extern "C" void kernel_launch(void* const* d_in, const int* in_sizes, int n_in, void* d_out, int out_size, void* d_ws, size_t ws_size, hipStream_t stream) {
    static int grid = 0;
    if (grid == 0) {
        if (n_in != 27 || out_size != TT * DM || ws_size < WS_END) { fprintf(stderr, "kernel_launch: unexpected shapes (n_in %d out %d ws %zu)\n", n_in, out_size, ws_size); grid = -1; return; }
        int dev = 0, cus = 0, per_cu = 0;
        hipGetDevice(&dev); hipDeviceGetAttribute(&cus, hipDeviceAttributeMultiprocessorCount, dev);
        hipFuncSetAttribute((const void*)mega_fwd, hipFuncAttributeMaxDynamicSharedMemorySize, LDS_BYTES);
        hipOccupancyMaxActiveBlocksPerMultiprocessor(&per_cu, (const void*)mega_fwd, 512, LDS_BYTES);
        if (per_cu < 1) { fprintf(stderr, "kernel_launch: occupancy query says %d blocks per CU\n", per_cu); grid = -1; return; }
        grid = cus * 1;
    }
    if (grid < 0) return;
    hipMemsetAsync((char*)d_ws + WS_CTL, 0, 1 * MiB, stream);
    Args a{}; for (int i = 0; i < 27; ++i) a.in[i] = (const float*)d_in[i]; a.out = (float*)d_out; a.ws = (unsigned char*)d_ws;
    for (int j = 0; j < 32; ++j) a.rope_inv[j] = (float)pow(10000.0, -(double)j / 32.0);
    void* kargs[] = {&a};
    hipError_t e = hipLaunchCooperativeKernel((const void*)mega_fwd, dim3(grid), dim3(512), kargs, LDS_BYTES, stream);
    if (e != hipSuccess) fprintf(stderr, "cooperative launch failed: %s (grid %d)\n", hipGetErrorString(e), grid);
#if defined(REPEAT_LAUNCH)
    for (int rl = 0; rl < REPEAT_LAUNCH; ++rl) { hipMemsetAsync((char*)d_ws + WS_CTL, 0, 1 * MiB, stream); hipLaunchCooperativeKernel((const void*)mega_fwd, dim3(grid), dim3(512), kargs, LDS_BYTES, stream); }
#endif
}
```
